# Optimizing an MI355X kernel written in HIP

```python
import functools
import jax, jax.numpy as jnp
from jax import lax
import numpy as np

D_MODEL = 2048
BATCH = 2
SEQ = 4096
DEPTH = 4
DEC_BATCH = 8
DEC_SEQ = 16
PAST_LEN = 4096

CHUNK = 64
CONV_DIM = D_MODEL // 4
CONV_WIDTH = 31
SWA_HEAD_DIM = 64
SWA_DIM = D_MODEL // 2
SWA_HEADS = SWA_DIM // SWA_HEAD_DIM
SWA_KV_HEADS = 2
SWA_GROUP = SWA_HEADS // SWA_KV_HEADS
SWA_KV_DIM = SWA_KV_HEADS * SWA_HEAD_DIM
WINDOW = 128
WIN_CHUNKS = WINDOW // CHUNK
MEM_TOKENS = 256
MEM_HEADS = 4
MEM_DIM = D_MODEL // 4
MEM_HEAD_DIM = MEM_DIM // MEM_HEADS
MIX_DIM = CONV_DIM + SWA_DIM + MEM_DIM
NUM_BUCKETS = 32
MAX_DISTANCE = 128
EPS = 1e-6
NEG_INF = -1e30
SWA_SCALE = SWA_HEAD_DIM ** -0.5
MEM_SCALE = MEM_HEAD_DIM ** -0.5
IN_SPLITS = (CONV_DIM, CONV_DIM, CONV_DIM, SWA_DIM, SWA_KV_DIM, SWA_KV_DIM, SWA_DIM, MEM_DIM, MEM_DIM)
IN_DIM = sum(IN_SPLITS)

kernel_name = "hybrid_conv_swa_memory_stream_step"


def rms_norm(x, g):
    xf = x.astype(jnp.float32)
    y = xf * lax.rsqrt(jnp.mean(xf * xf, axis=-1, keepdims=True) + EPS)
    return (y * g.astype(jnp.float32)).astype(x.dtype)


def layer_norm(x, g, b):
    xf = x.astype(jnp.float32)
    mu = jnp.mean(xf, axis=-1, keepdims=True)
    xc = xf - mu
    y = xc * lax.rsqrt(jnp.mean(xc * xc, axis=-1, keepdims=True) + EPS)
    return (y * g.astype(jnp.float32) + b.astype(jnp.float32)).astype(x.dtype)


def t5_bucket(rel):
    half = NUM_BUCKETS // 2
    exact = half // 2
    side = jnp.where(rel > 0, half, 0)
    n = jnp.abs(rel)
    nf = jnp.maximum(n, 1).astype(jnp.float32)
    large = exact + (jnp.log(nf / exact) / np.float32(np.log(MAX_DISTANCE / exact)) * (half - exact)).astype(jnp.int32)
    large = jnp.minimum(large, half - 1)
    return side + jnp.where(n < exact, n, large)


def rel_pos_bias(table, n_q, n_k, offset):
    rel = jnp.arange(n_k)[None, :] - offset - jnp.arange(n_q)[:, None]
    b = jnp.take(table, t5_bucket(rel), axis=0)
    b = jnp.transpose(b, (2, 0, 1)).astype(jnp.float32)
    return b.reshape(SWA_KV_HEADS, SWA_GROUP, n_q, n_k)


def sink_attention(q, k, v, bias, mask, sinks):
    s = jnp.einsum('...ikgd,...jkd->...kgij', q, k).astype(jnp.float32) * SWA_SCALE + bias
    if mask is not None:
        s = jnp.where(mask, s, NEG_INF)
    sink = sinks.astype(jnp.float32).reshape(SWA_KV_HEADS, SWA_GROUP, 1, 1)
    m = jnp.maximum(jnp.max(s, axis=-1, keepdims=True), sink)
    p = jnp.exp(s - m)
    w = p / (jnp.sum(p, axis=-1, keepdims=True) + jnp.exp(sink - m))
    return jnp.einsum('...kgij,...jkd->...ikgd', w.astype(v.dtype), v)


def swa_prompt(q, k, v, sinks, bias):
    B, T = q.shape[0], q.shape[1]
    nC = T // CHUNK
    pad = WIN_CHUNKS * CHUNK
    qb = q.reshape(B, nC, CHUNK, SWA_KV_HEADS, SWA_GROUP, SWA_HEAD_DIM)

    def band(t):
        tp = jnp.pad(t, ((0, 0), (pad, 0), (0, 0), (0, 0)))
        tp = tp.reshape(B, nC + WIN_CHUNKS, CHUNK, SWA_KV_HEADS, SWA_HEAD_DIM)
        return jnp.concatenate([tp[:, w:w + nC] for w in range(WIN_CHUNKS + 1)], axis=2)

    kb, vb = band(k), band(v)
    key_pos = jnp.arange(nC)[:, None] * CHUNK + jnp.arange(pad + CHUNK)[None, :] - pad
    mask = (key_pos >= 0)[:, None, None, None, :]
    o = sink_attention(qb, kb, vb, bias, mask, sinks)
    return o.reshape(B, T, SWA_DIM), k[:, -WINDOW:], v[:, -WINDOW:]


def swa_sample(q, k, v, cache_k, cache_v, sinks, bias):
    B, S = q.shape[0], q.shape[1]
    L = cache_k.shape[1]
    qh = q.reshape(B, S, SWA_KV_HEADS, SWA_GROUP, SWA_HEAD_DIM)
    kf = jnp.concatenate([cache_k, k], axis=1)
    vf = jnp.concatenate([cache_v, v], axis=1)
    o = sink_attention(qh, kf, vf, bias, None, sinks)
    return o.reshape(B, S, SWA_DIM), kf[:, -L:], vf[:, -L:]


def memory_kv(mem, mem_g, w_mem_kv):
    B, M = mem.shape[0], mem.shape[1]
    kv = rms_norm(mem, mem_g) @ w_mem_kv
    mk, mv = jnp.split(kv, 2, axis=-1)
    return (mk.reshape(B, M, MEM_HEADS, MEM_HEAD_DIM), mv.reshape(B, M, MEM_HEADS, MEM_HEAD_DIM))


def mem_attention(q, mk, mv):
    B, T = q.shape[0], q.shape[1]
    qh = q.reshape(B, T, MEM_HEADS, MEM_HEAD_DIM)
    s = jnp.einsum('bthd,bmhd->bhtm', qh, mk).astype(jnp.float32) * MEM_SCALE
    p = jax.nn.softmax(s, axis=-1).astype(mv.dtype)
    return jnp.einsum('bhtm,bmhd->bthd', p, mv).reshape(B, T, MEM_DIM)


def causal_dwconv(x_padded, w, b):
    y = lax.conv_general_dilated(x_padded, w[:, None, :], window_strides=(1,), padding='VALID',
                                 dimension_numbers=('NWC', 'WIO', 'NWC'), feature_group_count=CONV_DIM)
    return y + b


def mixer_layer(x, conv_left, swa_fn, mem_k, mem_v, norm_g, w_in, conv_w, conv_b,
                conv_ln_g, conv_ln_b, w_pw, b_pw, w_out):
    B, T = x.shape[0], x.shape[1]
    h = rms_norm(x, norm_g)
    z = h @ w_in
    pts = []
    acc = 0
    for wdt in IN_SPLITS[:-1]:
        acc += wdt
        pts.append(acc)
    a_val, a_glu, a_gate, bq, bk, bv, b_gate, cq, c_gate = jnp.split(z, pts, axis=-1)
    u = a_val * jax.nn.sigmoid(a_glu)
    conv_in = jnp.concatenate([conv_left, u], axis=1)
    new_conv = conv_in[:, -(CONV_WIDTH - 1):]
    c = causal_dwconv(conv_in, conv_w, conv_b)
    c = jax.nn.silu(layer_norm(c, conv_ln_g, conv_ln_b))
    c = c @ w_pw + b_pw
    y_a = c * jax.nn.silu(a_gate)
    k = bk.reshape(B, T, SWA_KV_HEADS, SWA_HEAD_DIM)
    v = bv.reshape(B, T, SWA_KV_HEADS, SWA_HEAD_DIM)
    o_b, new_k, new_v = swa_fn(bq, k, v)
    y_b = o_b * jax.nn.silu(b_gate)
    y_c = mem_attention(cq, mem_k, mem_v) * jax.nn.silu(c_gate)
    y = jnp.concatenate([y_a, y_b, y_c], axis=-1) @ w_out
    return x + y, new_conv, new_k, new_v


def setup_inputs(seed: int = 0) -> dict:
    key = jax.random.key(seed)
    ks = jax.random.split(key, 24)
    f32 = jnp.float32
    n = lambda k, s: jax.random.normal(k, s, f32)
    n_win = min(WINDOW, PAST_LEN)
    return {
        "x_prompt": n(ks[0], (BATCH, SEQ, D_MODEL)),
        "x_sample": n(ks[1], (DEC_BATCH, DEC_SEQ, D_MODEL)),
        "mem_prompt": n(ks[2], (BATCH, MEM_TOKENS, D_MODEL)),
        "cache_swa_k": n(ks[3], (DEPTH, DEC_BATCH, n_win, SWA_KV_HEADS, SWA_HEAD_DIM)),
        "cache_swa_v": n(ks[4], (DEPTH, DEC_BATCH, n_win, SWA_KV_HEADS, SWA_HEAD_DIM)),
        "cache_conv": 0.5 * n(ks[5], (DEPTH, DEC_BATCH, CONV_WIDTH - 1, CONV_DIM)),
        "cache_mem_k": n(ks[6], (DEPTH, DEC_BATCH, MEM_TOKENS, MEM_HEADS, MEM_HEAD_DIM)),
        "cache_mem_v": n(ks[7], (DEPTH, DEC_BATCH, MEM_TOKENS, MEM_HEADS, MEM_HEAD_DIM)),
        "norm_g": 1.0 + 0.02 * n(ks[8], (DEPTH, D_MODEL)),
        "w_in": n(ks[9], (DEPTH, D_MODEL, IN_DIM)) * D_MODEL ** -0.5,
        "conv_w": n(ks[10], (DEPTH, CONV_WIDTH, CONV_DIM)) * CONV_WIDTH ** -0.5,
        "conv_b": 0.02 * n(ks[11], (DEPTH, CONV_DIM)),
        "conv_ln_g": 1.0 + 0.02 * n(ks[12], (DEPTH, CONV_DIM)),
        "conv_ln_b": 0.02 * n(ks[13], (DEPTH, CONV_DIM)),
        "w_pw": n(ks[14], (DEPTH, CONV_DIM, CONV_DIM)) * CONV_DIM ** -0.5,
        "b_pw": 0.02 * n(ks[15], (DEPTH, CONV_DIM)),
        "swa_sinks": n(ks[16], (DEPTH, SWA_HEADS)),
        "mem_norm_g": 1.0 + 0.02 * n(ks[17], (DEPTH, D_MODEL)),
        "w_mem_kv": n(ks[18], (DEPTH, D_MODEL, 2 * MEM_DIM)) * D_MODEL ** -0.5,
        "rel_bias": 0.5 * n(ks[19], (NUM_BUCKETS, SWA_HEADS)),
        "w_out": n(ks[20], (DEPTH, MIX_DIM, D_MODEL)) * MIX_DIM ** -0.5,
        "final_norm_g": 1.0 + 0.02 * n(ks[21], (D_MODEL,)),
    }


def reference(x_prompt, x_sample, mem_prompt, cache_swa_k, cache_swa_v, cache_conv, cache_mem_k,
              cache_mem_v, norm_g, w_in, conv_w, conv_b, conv_ln_g, conv_ln_b, w_pw, b_pw,
              swa_sinks, mem_norm_g, w_mem_kv, rel_bias, w_out, final_norm_g):
    B, T = x_prompt.shape[0], x_prompt.shape[1]
    S = x_sample.shape[1]
    L = cache_swa_k.shape[2]
    band = WIN_CHUNKS * CHUNK
    bias_p = rel_pos_bias(rel_bias, CHUNK, band + CHUNK, band)
    bias_s = rel_pos_bias(rel_bias, S, L + S, L)
    hp, hs = x_prompt, x_sample
    p_k, p_v, p_conv, p_mk, p_mv = [], [], [], [], []
    s_k, s_v, s_conv = [], [], []
    for l in range(DEPTH):
        lw = (norm_g[l], w_in[l], conv_w[l], conv_b[l], conv_ln_g[l], conv_ln_b[l], w_pw[l], b_pw[l], w_out[l])
        mk, mv = memory_kv(mem_prompt, mem_norm_g[l], w_mem_kv[l])
        left = jnp.zeros((B, CONV_WIDTH - 1, CONV_DIM), hp.dtype)
        fn_p = functools.partial(swa_prompt, sinks=swa_sinks[l], bias=bias_p)
        hp, c_new, k_new, v_new = mixer_layer(hp, left, fn_p, mk, mv, *lw)
        p_k.append(k_new)
        p_v.append(v_new)
        p_conv.append(c_new)
        p_mk.append(mk)
        p_mv.append(mv)
        fn_s = functools.partial(swa_sample, cache_k=cache_swa_k[l], cache_v=cache_swa_v[l],
                                 sinks=swa_sinks[l], bias=bias_s)
        hs, c_new, k_new, v_new = mixer_layer(hs, cache_conv[l], fn_s, cache_mem_k[l], cache_mem_v[l], *lw)
        s_k.append(k_new)
        s_v.append(v_new)
        s_conv.append(c_new)
    y_prompt = rms_norm(hp, final_norm_g)
    y_sample = rms_norm(hs, final_norm_g)
    return (y_prompt, y_sample, jnp.stack(p_k), jnp.stack(p_v), jnp.stack(p_conv), jnp.stack(p_mk),
            jnp.stack(p_mv), jnp.stack(s_k), jnp.stack(s_v), jnp.stack(s_conv))
```

```cpp
#include <hip/hip_runtime.h>
#include <cstdio>
#include <cstdint>

namespace pg8 {
#define PG8_LAS __attribute__((address_space(3)))
typedef unsigned short bf16_t;
typedef short bf16x8 __attribute__((ext_vector_type(8)));
typedef float f32x4 __attribute__((ext_vector_type(4)));
typedef unsigned u32x4 __attribute__((ext_vector_type(4)));
constexpr int BM = 256, BK = 64, HALF = 128, HTB = HALF * BK * 2  , STAGE_BYTES = 8 * HTB, NXCD = 8, WGM = 8;

__host__ __device__ __forceinline__ int lds_byte(int r, int c) { const int st = (r >> 4) * 2 + (c >> 5), rr = r & 15, cc = c & 31, ob = rr * 64 + cc * 2; return st * 1024 + (ob ^ (((ob >> 9) & 1) << 5)); }
__host__ __device__ __forceinline__ void stage_rc(int b, int& R, int& C) { const int st = b / 1024, sb = b % 1024, swz = sb ^ (((sb >> 9) & 1) << 5); R = (st >> 1) * 16 + swz / 64; C = (st & 1) * 32 + (swz % 64) / 2; }
__host__ __device__ __forceinline__ int perm32(int rho) { const int n = rho >> 4, i = rho & 15; return 8 * (i >> 2) + 4 * n + (i & 3); }

struct Unit { int pm, pn; };
struct Gemm { const bf16_t* A; const bf16_t* Bt; int M, N, K; };

struct StaticOrder {
    int nM, nN, nwg, G, c;
    __host__ __device__ void init(int M, int N, int G_, int c_) { nM = M / BM; nN = N / BM; nwg = nM * nN; G = G_; c = c_; }
    __host__ __device__ bool next(int i, Unit& u) const {
        const long L = (long)i * G + c; if (L >= nwg) return false;
        int wgid = (int)L; { const int q = nwg / NXCD, r = nwg % NXCD, xcd = wgid % NXCD, off = wgid / NXCD; wgid = (xcd < r ? xcd * (q + 1) : r * (q + 1) + (xcd - r) * q) + off; }
        const int nig = WGM * nN, gid = wgid / nig, fm = gid * WGM, gsz = (nM - fm) < WGM ? (nM - fm) : WGM;
        u.pm = fm + ((wgid % nig) % gsz); u.pn = (wgid % nig) / gsz; return true;
    }
    __device__ __forceinline__ void a_ready(const Unit&) const {}
    __device__ __forceinline__ void done(const Unit&) const {}
};

__device__ __forceinline__ unsigned cvt_pk_bf16(float lo, float hi) { unsigned r; asm volatile("v_cvt_pk_bf16_f32 %0, %1, %2" : "=v"(r) : "v"(lo), "v"(hi)); return r; }
typedef float f32x2 __attribute__((ext_vector_type(2)));


constexpr int P_D = 2048, P_INDIM = 4864, P_NROW = 8320  , P_MPAD = 8448, P_NSSQ = 32;
constexpr long OFF_YP = 0, OFF_YS = 16777216, OFF_KP = 17039360, OFF_VP = 17170432, OFF_CP = 17301504, OFF_MKP = 17424384, OFF_MVP = 18472960,
               OFF_KS = 19521536, OFF_VS = 20045824, OFF_CS = 20570112, OUT_TOTAL = 21061632;
constexpr float QS_SWA = 0.125f * 1.4426950408889634f;
constexpr float QS_MEM = 0.08838834764831845f * 1.4426950408889634f;

__device__ __forceinline__ float sigmoid_f(float x) { return 1.0f / (1.0f + __expf(-x)); }
__device__ __forceinline__ f32x4 sigmoid4(f32x4 x) { return (f32x4){sigmoid_f(x[0]), sigmoid_f(x[1]), sigmoid_f(x[2]), sigmoid_f(x[3])}; }
__device__ __forceinline__ u32x4 pack8(f32x4 a, f32x4 b) { u32x4 w; w.x = cvt_pk_bf16(a[0], a[1]); w.y = cvt_pk_bf16(a[2], a[3]); w.z = cvt_pk_bf16(b[0], b[1]); w.w = cvt_pk_bf16(b[2], b[3]); return w; }

__device__ __forceinline__ void row_rstd(float (&rs)[2][4], const float* ssq, int rbase, int fq) {
#pragma unroll
    for (int ai = 0; ai < 2; ++ai)
#pragma unroll
        for (int m = 0; m < 4; ++m) {
            const int row = rbase + ai * HALF + m * 16;
            const f32x4* p = (const f32x4*)(ssq + (size_t)row * P_NSSQ + fq * 8);
            const f32x4 a = p[0], b = p[1];
            float s = ((a[0] + a[1]) + (a[2] + a[3])) + ((b[0] + b[1]) + (b[2] + b[3]));
            s += __shfl_xor(s, 16); s += __shfl_xor(s, 32);
            rs[ai][m] = 1.0f / sqrtf(s * (1.0f / (float)P_D) + 1e-6f);
        }
}

struct EpiIn {
    static constexpr bool PERM = true, AFTER_DRAIN = false;
    bf16_t* Z; const float* ssq; float* out; int layer;
    __device__ __forceinline__ void operator()(const f32x4 (&acc)[2][2][4][2], const Unit& u, int wr, int wc, int fr, int fq) const {
        const int pn = u.pn, rbase = u.pm * BM + wr * 64 + fr;
        bf16_t* Z = this->Z; const float* ssq = this->ssq; float* out = this->out;
        asm volatile("" : "+s"(Z), "+s"(ssq), "+s"(out));
        float rs[2][4];
        row_rstd(rs, ssq, rbase, fq);
        const bool tailtile = (u.pm == 15) || (u.pm == 31) || (u.pm == 32);
        if (pn < 4) {
            const int ch0 = 128 * pn + 32 * wc + 8 * fq;
#pragma unroll
            for (int ai = 0; ai < 2; ++ai)
#pragma unroll
                for (int m = 0; m < 4; ++m) {
                    const int row = rbase + ai * HALF + m * 16;
                    if (row >= P_NROW) continue;
                    const float r = rs[ai][m];
                    const f32x4 u0 = (acc[ai][0][m][0] * r) * sigmoid4(acc[ai][1][m][0] * r), u1 = (acc[ai][0][m][1] * r) * sigmoid4(acc[ai][1][m][1] * r);
                    *(u32x4*)(Z + (size_t)row * P_INDIM + ch0) = pack8(u0, u1);
                    if (tailtile) {
                        float* dst = nullptr;
                        if (row < 8192) { const int t = row & 4095, b = row >> 12; if (t >= 4066) dst = out + OFF_CP + ((size_t)(layer * 2 + b) * 30 + (t - 4066)) * 512 + ch0; }
                        else { const int rr = row - 8192, b = rr >> 4, s = rr & 15; dst = out + OFF_CS + ((size_t)(layer * 8 + b) * 30 + 14 + s) * 512 + ch0; }
                        if (dst) { *(f32x4*)dst = u0; *(f32x4*)(dst + 4) = u1; }
                    }
                }
        } else if (pn == 10) {
#pragma unroll
            for (int ai = 0; ai < 2; ++ai)
#pragma unroll
                for (int m = 0; m < 4; ++m) {
                    const int row = rbase + ai * HALF + m * 16;
                    if (row >= P_NROW) continue;
                    const float r = rs[ai][m];
#pragma unroll
                    for (int bj = 0; bj < 2; ++bj) {
                        const f32x4 v0 = acc[ai][bj][m][0] * r, v1 = acc[ai][bj][m][1] * r;
                        const int c128 = 32 * wc + 8 * fq;
                        *(u32x4*)(Z + (size_t)row * P_INDIM + 2560 + 128 * bj + c128) = pack8(v0, v1);
                        if (tailtile) {
                            float* dst = nullptr;
                            if (row < 8192) { const int t = row & 4095, b = row >> 12; if (t >= 3968) dst = out + (bj ? OFF_VP : OFF_KP) + ((size_t)(layer * 2 + b) * 128 + (t - 3968)) * 128 + c128; }
                            else { const int rr = row - 8192, b = rr >> 4, s = rr & 15; dst = out + (bj ? OFF_VS : OFF_KS) + ((size_t)(layer * 8 + b) * 128 + 112 + s) * 128 + c128; }
                            if (dst) { *(f32x4*)dst = v0; *(f32x4*)(dst + 4) = v1; }
                        }
                    }
                }
        } else {
            const bool is_q = (pn >= 6 && pn <= 9), is_cq = (pn == 15 || pn == 16);
            const float qs = is_q ? QS_SWA : QS_MEM;
            const bool gate = !(is_q || is_cq);
#pragma unroll
            for (int ai = 0; ai < 2; ++ai)
#pragma unroll
                for (int m = 0; m < 4; ++m) {
                    const int row = rbase + ai * HALF + m * 16;
                    if (row >= P_NROW) continue;
                    const float r = rs[ai][m];
#pragma unroll
                    for (int bj = 0; bj < 2; ++bj) {
                        f32x4 v0 = acc[ai][bj][m][0] * r, v1 = acc[ai][bj][m][1] * r;
                        if (gate) { v0 = v0 * sigmoid4(v0); v1 = v1 * sigmoid4(v1); } else { v0 = v0 * qs; v1 = v1 * qs; }
                        *(u32x4*)(Z + (size_t)row * P_INDIM + pn * BM + 128 * bj + 32 * wc + 8 * fq) = pack8(v0, v1);
                    }
                }
        }
    }
};

struct EpiMemKV {
    static constexpr bool PERM = true, AFTER_DRAIN = false;
    bf16_t* MKV; float* out;
    __device__ __forceinline__ void operator()(const f32x4 (&acc)[2][2][4][2], const Unit& u, int wr, int wc, int fr, int fq) const {
        const int l = u.pn >> 2, kv = (u.pn >> 1) & 1, cb = (u.pn & 1) * 256;
        bf16_t* MKV = this->MKV; float* out = this->out; asm volatile("" : "+s"(MKV), "+s"(out));
        const int row0 = u.pm * BM + wr * 64 + fr, cl = 32 * wc + 8 * fq;
        bf16_t* zb = MKV + (size_t)row0 * 4096 + u.pn * BM + cl;
        float* ob = out + (kv ? OFF_MVP : OFF_MKP) + ((size_t)(l * 512 + row0)) * 512 + cb + cl;
#pragma unroll
        for (int ai = 0; ai < 2; ++ai)
#pragma unroll
            for (int m = 0; m < 4; ++m)
#pragma unroll
                for (int bj = 0; bj < 2; ++bj) {
                    const f32x4 v0 = acc[ai][bj][m][0], v1 = acc[ai][bj][m][1];
                    *(u32x4*)(zb + (size_t)(ai * HALF + m * 16) * 4096 + 128 * bj) = pack8(v0, v1);
                    float* dst = ob + (size_t)(ai * HALF + m * 16) * 512 + 128 * bj;
                    *(f32x4*)dst = v0; *(f32x4*)(dst + 4) = v1;
                }
    }
};

struct EpiOut {
    static constexpr bool PERM = false, AFTER_DRAIN = false;
    float* X; bf16_t* XB; float* ssq;
    __device__ __forceinline__ void operator()(const f32x4 (&acc)[2][2][4][2], const Unit& u, int wr, int wc, int fr, int fq) const {
        typedef unsigned u32x2v __attribute__((ext_vector_type(2)));
        const int rbase = u.pm * BM + wr * 64 + fr;
        float* X = this->X; bf16_t* XB = this->XB; float* ssq = this->ssq; asm volatile("" : "+s"(X), "+s"(XB), "+s"(ssq));
#pragma unroll
        for (int ai = 0; ai < 2; ++ai)
#pragma unroll
            for (int m = 0; m < 4; ++m) {
                const int row = rbase + ai * HALF + m * 16;
                if (row >= P_NROW) continue;
                float q = 0.f;
#pragma unroll
                for (int bj = 0; bj < 2; ++bj)
#pragma unroll
                    for (int n = 0; n < 2; ++n) {
                        const size_t off = (size_t)row * P_D + u.pn * BM + bj * HALF + wc * 32 + n * 16 + fq * 4;
                        const f32x4 xn = *(const f32x4*)(X + off) + acc[ai][bj][m][n];
                        *(f32x4*)(X + off) = xn;
                        u32x2v w; w.x = cvt_pk_bf16(xn[0], xn[1]); w.y = cvt_pk_bf16(xn[2], xn[3]);
                        *(u32x2v*)(XB + off) = w;
                        q += (xn[0] * xn[0] + xn[1] * xn[1]) + (xn[2] * xn[2] + xn[3] * xn[3]);
                    }
                q += __shfl_xor(q, 16); q += __shfl_xor(q, 32);
                if (fq == 0) ssq[(size_t)row * P_NSSQ + u.pn * 4 + wc] = q;
            }
    }
};

template <class Epi, class Sched, bool ALIGN_EPI = false, bool SP2 = false>
__device__ __forceinline__ void gemm_phase(PG8_LAS unsigned char* lds, const Gemm g, const Sched& S, const Epi& E) {
    int tid_ = threadIdx.x; asm volatile("" : "+v"(tid_));
    const int tid = tid_, wid = __builtin_amdgcn_readfirstlane(tid >> 6), lane = tid & 63, wr = wid >> 2, wc = wid & 3, fr = lane & 15, fq = lane >> 4;
    const int K = g.K, nt = K / BK;
    unsigned voffA[2], voffB[2];
#pragma unroll
    for (int i = 0; i < 2; ++i) { int R, C; stage_rc(tid * 16 + i * 8192, R, C); const int Rb = Epi::PERM ? ((R & ~31) + perm32(R & 31)) : R;
        voffA[i] = (unsigned)(R * K + C) * 2u; voffB[i] = (unsigned)(Rb * K + C) * 2u; }
    const size_t kstep = (size_t)(BK * 2);
    const size_t hstep = (size_t)HALF * K * 2;
    const size_t tstep = 2 * hstep;
    const unsigned ldsw = (unsigned)wid * 1024u;
    const int aoff = lds_byte(wr * 64 + fr, fq * 8), boff = lds_byte(wc * 32 + fr, fq * 8);
#define PG8_SA(b, h) (((b) * 2 + (h)) * HTB)
#define PG8_SB(b, h) ((4 + (b) * 2 + (h)) * HTB)
#define PG8_STAGE(bufoff, gbase, voff) do { _Pragma("unroll") for (int _i = 0; _i < 2; ++_i) \
        __builtin_amdgcn_global_load_lds((const unsigned*)((const char*)(gbase) + (voff)[_i]), (PG8_LAS unsigned*)(lds + (bufoff) + ldsw + _i * 8192), 16, 0, 0); } while (0)
#define PG8_LDA(dst, b, h) do { _Pragma("unroll") for (int m = 0; m < 4; ++m) _Pragma("unroll") for (int k = 0; k < 2; ++k) dst[m][k] = *(const PG8_LAS bf16x8*)(lds + PG8_SA(b, h) + aoff + m * 2048 + k * 1024); } while (0)
#define PG8_LDB(dst, b, h) do { _Pragma("unroll") for (int n = 0; n < 2; ++n) _Pragma("unroll") for (int k = 0; k < 2; ++k) dst[n][k] = *(const PG8_LAS bf16x8*)(lds + PG8_SB(b, h) + boff + n * 2048 + k * 1024); } while (0)
#define PG8_MMA(ai, bj, At, Bt) do { __builtin_amdgcn_s_setprio(1); _Pragma("unroll") for (int m = 0; m < 4; ++m) _Pragma("unroll") for (int n = 0; n < 2; ++n) _Pragma("unroll") for (int k = 0; k < 2; ++k) \
        acc[ai][bj][m][n] = __builtin_amdgcn_mfma_f32_16x16x32_bf16(Bt[n][k], At[m][k], acc[ai][bj][m][n], 0, 0, 0); __builtin_amdgcn_s_setprio(0); } while (0)
#define PG8_WAIT_V(n) asm volatile("s_waitcnt vmcnt(" #n ")" ::: "memory")
#define PG8_WAIT_L(n) asm volatile("s_waitcnt lgkmcnt(" #n ")" ::: "memory")
#define PG8_BAR __builtin_amdgcn_s_barrier()
#define PG8_SCHED __builtin_amdgcn_sched_barrier(0)
    Unit cur, nxt; int ui = 0;
    if (!S.next(0, cur)) return;
    f32x4 acc[2][2][4][2];
#pragma unroll
    for (int a = 0; a < 2; ++a)
#pragma unroll
        for (int b = 0; b < 2; ++b)
#pragma unroll
            for (int m = 0; m < 4; ++m)
#pragma unroll
                for (int n = 0; n < 2; ++n) acc[a][b][m][n] = (f32x4){0.f, 0.f, 0.f, 0.f};
    bf16x8 At[4][2], B0[2][2], B1[2][2];
    const char* cA = (const char*)g.A + (size_t)cur.pm * tstep; const char* cB = (const char*)g.Bt + (size_t)cur.pn * tstep;
    S.a_ready(cur);
    if constexpr (SP2) {
        PG8_STAGE(PG8_SB(0, 0), cB, voffB); PG8_STAGE(PG8_SB(0, 1), cB + hstep, voffB); PG8_STAGE(PG8_SA(0, 0), cA, voffA); PG8_STAGE(PG8_SA(0, 1), cA + hstep, voffA);
        if (wr == 1) PG8_BAR;
        PG8_WAIT_V(2); PG8_BAR;
        PG8_STAGE(PG8_SB(1, 0), cB + kstep, voffB); PG8_STAGE(PG8_SA(1, 0), cA + kstep, voffA); PG8_STAGE(PG8_SB(1, 1), cB + hstep + kstep, voffB);
        PG8_WAIT_V(6); PG8_BAR;
    } else {
        PG8_STAGE(PG8_SB(0, 0), cB, voffB); PG8_STAGE(PG8_SA(0, 0), cA, voffA); PG8_STAGE(PG8_SB(0, 1), cB + hstep, voffB); PG8_STAGE(PG8_SA(0, 1), cA + hstep, voffA);
        if (wr == 1) PG8_BAR;
        PG8_WAIT_V(4); PG8_BAR;
        PG8_STAGE(PG8_SB(1, 0), cB + kstep, voffB); PG8_STAGE(PG8_SA(1, 0), cA + kstep, voffA); PG8_STAGE(PG8_SB(1, 1), cB + hstep + kstep, voffB);
        PG8_WAIT_V(6); PG8_BAR;
    }
    for (;;) {
        const bool has_next = S.next(ui + 1, nxt);
        const char* nA = has_next ? (const char*)g.A + (size_t)nxt.pm * tstep : cA; const char* nB = has_next ? (const char*)g.Bt + (size_t)nxt.pn * tstep : cB;
        for (int t = 0; t < nt; t += 2) {
            const bool last = (t == nt - 2);
            const char* a1 = cA + (size_t)(t + 1) * kstep;
            const char* a2 = last ? nA : cA + (size_t)(t + 2) * kstep; const char* b2 = last ? nB : cB + (size_t)(t + 2) * kstep;
            const char* a3 = a2 + kstep; const char* b3 = b2 + kstep;
            if (last && has_next) S.a_ready(nxt);
            if constexpr (SP2) {
            PG8_LDB(B0, 0, 0); PG8_LDB(B1, 0, 1); PG8_SCHED; PG8_LDA(At, 0, 0); PG8_STAGE(PG8_SA(1, 1), a1 + hstep, voffA);
            PG8_WAIT_V(8); PG8_WAIT_L(0); PG8_BAR; PG8_MMA(0, 0, At, B0); PG8_MMA(0, 1, At, B1); PG8_BAR; PG8_SCHED;
            PG8_LDA(At, 0, 1); PG8_STAGE(PG8_SB(0, 0), b2, voffB); PG8_STAGE(PG8_SB(0, 1), b2 + hstep, voffB); PG8_STAGE(PG8_SA(0, 0), a2, voffA);
            PG8_WAIT_V(8); PG8_WAIT_L(0); PG8_BAR; PG8_MMA(1, 0, At, B0); PG8_MMA(1, 1, At, B1); PG8_BAR; PG8_SCHED;
            PG8_LDB(B0, 1, 0); PG8_LDB(B1, 1, 1); PG8_SCHED; PG8_LDA(At, 1, 0); PG8_STAGE(PG8_SA(0, 1), a2 + hstep, voffA);
            PG8_WAIT_V(8); PG8_WAIT_L(0); PG8_BAR; PG8_MMA(0, 0, At, B0); PG8_MMA(0, 1, At, B1); PG8_BAR; PG8_SCHED;
            PG8_LDA(At, 1, 1); PG8_STAGE(PG8_SB(1, 0), b3, voffB); PG8_STAGE(PG8_SB(1, 1), b3 + hstep, voffB); PG8_STAGE(PG8_SA(1, 0), a3, voffA);
            PG8_WAIT_V(8); PG8_WAIT_L(0); PG8_BAR; PG8_MMA(1, 0, At, B0); PG8_MMA(1, 1, At, B1); PG8_BAR; PG8_SCHED;
            } else {
            PG8_LDB(B0, 0, 0); PG8_SCHED; PG8_LDA(At, 0, 0); PG8_STAGE(PG8_SA(1, 1), a1 + hstep, voffA);
            PG8_WAIT_L(8); PG8_BAR; PG8_WAIT_L(0); PG8_MMA(0, 0, At, B0); PG8_BAR; PG8_SCHED;
            PG8_LDB(B1, 0, 1); PG8_STAGE(PG8_SB(0, 0), b2, voffB);
            PG8_BAR; PG8_WAIT_L(0); PG8_MMA(0, 1, At, B1); PG8_BAR;
            PG8_LDA(At, 0, 1); PG8_STAGE(PG8_SA(0, 0), a2, voffA);
            PG8_BAR; PG8_WAIT_L(0); PG8_MMA(1, 0, At, B0); PG8_BAR; PG8_SCHED;
            PG8_STAGE(PG8_SB(0, 1), b2 + hstep, voffB);
            PG8_WAIT_V(6); PG8_BAR; PG8_MMA(1, 1, At, B1); PG8_BAR;
            PG8_LDB(B0, 1, 0); PG8_SCHED; PG8_LDA(At, 1, 0); PG8_STAGE(PG8_SA(0, 1), a2 + hstep, voffA);
            PG8_WAIT_L(8); PG8_BAR; PG8_WAIT_L(0); PG8_MMA(0, 0, At, B0); PG8_BAR; PG8_SCHED;
            PG8_LDB(B1, 1, 1); PG8_STAGE(PG8_SB(1, 0), b3, voffB);
            PG8_BAR; PG8_WAIT_L(0); PG8_MMA(0, 1, At, B1); PG8_BAR;
            PG8_LDA(At, 1, 1); PG8_STAGE(PG8_SA(1, 0), a3, voffA);
            PG8_BAR; PG8_WAIT_L(0); PG8_MMA(1, 0, At, B0); PG8_BAR; PG8_SCHED;
            PG8_STAGE(PG8_SB(1, 1), b3 + hstep, voffB);
            PG8_WAIT_V(6); PG8_BAR; PG8_MMA(1, 1, At, B1); PG8_BAR;
            }
        }
        if constexpr (ALIGN_EPI) { if (wr == 0) PG8_BAR; }
        if constexpr (!Epi::AFTER_DRAIN) { E(acc, cur, wr, wc, fr, fq); S.done(cur); }
        if (!has_next) break;
#pragma unroll
        for (int a = 0; a < 2; ++a)
#pragma unroll
            for (int b = 0; b < 2; ++b)
#pragma unroll
                for (int m = 0; m < 4; ++m)
#pragma unroll
                    for (int n = 0; n < 2; ++n) acc[a][b][m][n] = (f32x4){0.f, 0.f, 0.f, 0.f};
        cur = nxt; cA = nA; cB = nB; ++ui;
        if constexpr (ALIGN_EPI) { if (wr == 1) PG8_BAR; }
    }
    PG8_WAIT_V(0);
    if constexpr (!ALIGN_EPI) { if (wr == 0) PG8_BAR; }
    PG8_BAR;
    if constexpr (Epi::AFTER_DRAIN) { E.fused(acc, cur, wr, wc, fr, fq, lds, wid, lane); S.done(cur); }
#undef PG8_SA
#undef PG8_SB
#undef PG8_STAGE
#undef PG8_LDA
#undef PG8_LDB
#undef PG8_MMA
#undef PG8_WAIT_V
#undef PG8_WAIT_L
#undef PG8_BAR
#undef PG8_SCHED
}
}


constexpr int NWAVES = 8, NTHREADS = 512;
constexpr int DM = 2048, SEQ = 4096, NBP = 2, NROWP = 8192, NBS = 8, NSS = 16, NROWS = 128, NROW = 8320, MPAD = 8448, INDIM = 4864, DEPTH = 4;
constexpr int ZP = INDIM;
constexpr int ZC_U = 0, ZC_GA = 1024, ZC_Q = 1536, ZC_K = 2560, ZC_V = 2688, ZC_GB = 2816, ZC_CQ = 3840, ZC_GC = 4352;
constexpr float LOG2E = 1.4426950408889634f;
using pg8::OFF_YP; using pg8::OFF_YS; using pg8::OFF_KP; using pg8::OFF_VP; using pg8::OFF_CP; using pg8::OFF_MKP; using pg8::OFF_MVP; using pg8::OFF_KS; using pg8::OFF_VS; using pg8::OFF_CS; using pg8::OUT_TOTAL;

constexpr size_t MiB = 1u << 20;
constexpr size_t WS_CTL = 0, CTL_ZERO_BYTES = 1 * MiB;
constexpr size_t WS_BT = 1 * MiB;
constexpr size_t WS_SSQ = 2 * MiB;
constexpr size_t WS_WIN = 4 * MiB;
constexpr size_t WS_WOUT = 80 * MiB;
constexpr size_t WS_WMEM = 112 * MiB;
constexpr size_t WS_WPW = 128 * MiB;
constexpr size_t WS_MEMN = 130 * MiB;
constexpr size_t WS_MKVP = 132 * MiB;
constexpr size_t WS_CMK = 136 * MiB, WS_CMV = 144 * MiB;
constexpr size_t WS_CSK = 152 * MiB, WS_CSV = 153 * MiB;
constexpr size_t WS_XB = 154 * MiB;
constexpr size_t WS_X = 187 * MiB;
constexpr size_t WS_Z = 253 * MiB;
constexpr size_t WS_YMIX = 332 * MiB;
constexpr size_t WS_END = 365 * MiB;
constexpr int CW_BAR = 4096;

constexpr int RING_BYTES = 131072;
constexpr int LDSCTL_OFF = 158720, MISC_OFF = LDSCTL_OFF + 320;
constexpr int LDS_BYTES = 159744;


#define GAS __attribute__((address_space(1)))
#define LAS __attribute__((address_space(3)))
typedef unsigned short bf16;
typedef unsigned v4u __attribute__((ext_vector_type(4)));
typedef float f32x4 __attribute__((ext_vector_type(4)));
typedef short bf16x8 __attribute__((ext_vector_type(8)));
typedef GAS unsigned gu32;
typedef GAS unsigned long long gu64;
#define RLX_AGENT __ATOMIC_RELAXED, __HIP_MEMORY_SCOPE_AGENT
#define LDS_WAIT() asm volatile("s_waitcnt lgkmcnt(0)" ::: "memory")
#define VM_WAIT() asm volatile("s_waitcnt vmcnt(0)" ::: "memory")
__device__ __forceinline__ unsigned long long rt() { return __builtin_amdgcn_s_memrealtime(); }
__device__ __forceinline__ unsigned f2bf(float f) { unsigned u = __builtin_bit_cast(unsigned, f); return (u + 0x7fffu + ((u >> 16) & 1u)) >> 16; }
__device__ __forceinline__ unsigned pk2(float lo, float hi) { return f2bf(lo) | (f2bf(hi) << 16); }

#define XB_TMO      128
#define XB_XCNT(j)  (256  + 64 * (j))
#define XB_XSUB(j)  (1280 + 64 * (j))
#define XB_XGEN(j)  (2304 + 64 * (j))
#define XB_TOP      3328
#define XB_TOPGEN   3392
#define XCD_BAR_WORDS 3456
#define XB_SPIN_CAP (1u << 18)

__device__ __forceinline__ unsigned xb_ld(unsigned* p)              { return __hip_atomic_load(p, __ATOMIC_RELAXED, __HIP_MEMORY_SCOPE_AGENT); }
__device__ __forceinline__ unsigned xb_add(unsigned* p, unsigned v) { return __hip_atomic_fetch_add(p, v, __ATOMIC_RELAXED, __HIP_MEMORY_SCOPE_AGENT); }
__device__ __forceinline__ unsigned xb_xcc_id() { return (unsigned)__builtin_amdgcn_s_getreg((3 << 11) | 20) & 0xFu; }
#define XB_SPIN(cond, bar) do { unsigned _sp = 0; while (cond) { __builtin_amdgcn_s_sleep(1); \
    if ((++_sp & 255u) == 0u) { if (xb_ld(&(bar)[XB_TMO])) break; if (_sp > XB_SPIN_CAP) { atomicAdd(&(bar)[XB_TMO], 1u); break; } } } } while (0)

struct XcdBarrier {
    unsigned* bar; unsigned x;
    volatile LAS unsigned* st;
};

__device__ __forceinline__ XcdBarrier xcd_barrier_post(unsigned* bar, volatile LAS unsigned* st) {
    XcdBarrier b; b.bar = bar; b.x = xb_xcc_id(); b.st = st;
    if (threadIdx.x == 0) (void)xb_add(&bar[XB_XCNT(b.x)], 1u);
    return b;
}
__device__ __forceinline__ void xcd_barrier_complete(unsigned* bar, unsigned x, unsigned& nloc, unsigned& nx) {
    const unsigned G = gridDim.x * gridDim.y * gridDim.z;
    unsigned sum, cnt, mine, sp = 0u;
    for (;;) {
        sum = 0u; cnt = 0u; mine = 0u;
#pragma unroll
        for (unsigned j = 0; j < 16; ++j) { const unsigned c = xb_ld(&bar[XB_XCNT(j)]); sum += c; cnt += (c > 0u) ? 1u : 0u; mine = (j == x) ? c : mine; }
        if (sum == G) break;
        __builtin_amdgcn_s_sleep(1);
        if ((++sp & 255u) == 0u) { if (xb_ld(&bar[XB_TMO])) break; if (sp > XB_SPIN_CAP) { atomicAdd(&bar[XB_TMO], 1u); break; } }
    }
    nloc = mine > 0u ? mine : 1u; nx = cnt > 0u ? cnt : 1u;
}

__device__ __forceinline__ void xcd_barrier(const XcdBarrier& b) {
    asm volatile("s_waitcnt vmcnt(0)" ::: "memory");
    __syncthreads();
    if (threadIdx.x == 0) {
        unsigned* bar = b.bar;
        __builtin_amdgcn_s_waitcnt(0);
        unsigned nloc = b.st[0], nx = b.st[1];
        if (nloc == 0u) { xcd_barrier_complete(bar, b.x, nloc, nx); b.st[0] = nloc; b.st[1] = nx; }
        const unsigned old = xb_add(&bar[XB_XSUB(b.x)], 1u);
        const unsigned gen = old / nloc;
        if (old + 1u == (gen + 1u) * nloc) {
            __builtin_amdgcn_fence(__ATOMIC_RELEASE, "agent");
            asm volatile("s_waitcnt vmcnt(0)" ::: "memory");
            const unsigned og = xb_add(&bar[XB_TOP], 1u);
            const unsigned tg = og / nx;
            if (og + 1u == (tg + 1u) * nx) xb_add(&bar[XB_TOPGEN], 1u);
            else XB_SPIN(xb_ld(&bar[XB_TOPGEN]) == tg, bar);
            __builtin_amdgcn_fence(__ATOMIC_ACQUIRE, "agent");
            xb_add(&bar[XB_XGEN(b.x)], 1u);
            asm volatile("s_waitcnt vmcnt(0)" ::: "memory");
        } else {
            XB_SPIN(xb_ld(&bar[XB_XGEN(b.x)]) == gen, bar);
            __builtin_amdgcn_fence(__ATOMIC_ACQUIRE, "agent");
            asm volatile("s_waitcnt vmcnt(0)" ::: "memory");
        }
    }
    __syncthreads();
}


struct Args { const float* in[22]; float* out; unsigned char* ws; int ph_lo, ph_hi; };
struct Frame {
    LAS unsigned char* lds; unsigned char* glds;
    volatile LAS unsigned* MISC;
    gu32* ctl;
    int tid, lane, wave, vcu, G;
};
__device__ __forceinline__ float wave_sum(float v) {
#pragma unroll
    for (int o = 1; o < 64; o <<= 1) v += __shfl_xor(v, o);
    return v;
}
__device__ __forceinline__ float wave_max(float v) {
#pragma unroll
    for (int o = 1; o < 64; o <<= 1) v = fmaxf(v, __shfl_xor(v, o));
    return v;
}
__device__ __forceinline__ int opaque_tid() { int t = threadIdx.x; asm volatile("" : "+v"(t)); return t; }
__device__ __forceinline__ float bf2f(bf16 v) { return __builtin_bit_cast(float, (unsigned)v << 16); }
__device__ __forceinline__ float rbf(float f) { return __builtin_bit_cast(float, f2bf(f) << 16); }

__device__ __forceinline__ void p0_transpose_item(const float* W, int K, int N, const float* g, bf16* WT, int k0, int n0, int dst_row0, LAS float* scr, int lane) {
#pragma unroll 8
    for (int i = 0; i < 32; ++i) { const int kk = 2 * i + (lane >> 5); float v = W[(size_t)(k0 + kk) * N + n0 + (lane & 31)]; if (g) v *= g[k0 + kk]; scr[kk * 33 + (lane & 31)] = v; }
    LDS_WAIT(); asm volatile("" ::: "memory");
    const int c = lane & 7;
#pragma unroll
    for (int j = 0; j < 4; ++j) { const int n = (lane >> 3) + 8 * j; const LAS float* s = scr + (8 * c) * 33 + n;
        v4u o; o.x = pk2(s[0 * 33], s[1 * 33]); o.y = pk2(s[2 * 33], s[3 * 33]); o.z = pk2(s[4 * 33], s[5 * 33]); o.w = pk2(s[6 * 33], s[7 * 33]);
        *(GAS v4u*)(WT + (size_t)(dst_row0 + n) * K + k0 + 8 * c) = o; }
    LDS_WAIT(); asm volatile("" ::: "memory");
}
__device__ __forceinline__ int t5_bucket(int rel) {
    const int side = rel > 0 ? 16 : 0, n = rel < 0 ? -rel : rel;
    const int large = 8 + (n >= 12) + (n >= 16) + (n >= 23) + (n >= 32) + (n >= 46) + (n >= 64) + (n >= 91);
    return side + (n < 8 ? n : large);
}
__device__ __forceinline__ void p0_prologue(Frame& F, const Args& A) {
    unsigned char* ws = A.ws;
    const int tid_ = opaque_tid(), lane = tid_ & 63, wave_ = __builtin_amdgcn_readfirstlane(tid_ >> 6);
    const int gw = F.vcu * NWAVES + wave_, NGW = F.G * NWAVES;
    LAS float* scr = (LAS float*)(F.lds + wave_ * 16384);
    constexpr int I_IN = 32 * 152, I_OUT = 32 * 64, I_MEM = 32 * 32, I_PW = 8 * 16;
    constexpr int NITEMS = DEPTH * (I_IN + I_OUT + I_MEM + I_PW);
    for (int it = gw; it < NITEMS; it += NGW) {
        int r = it;
        if (r < DEPTH * I_IN) { const int l = r / I_IN, q = r % I_IN, kb = q / 152, nb = q % 152, n0 = nb * 32;
            int dst; if (n0 < 512) dst = 256 * (n0 >> 7) + (n0 & 127); else if (n0 < 1024) dst = 256 * ((n0 - 512) >> 7) + 128 + (n0 & 127); else dst = n0;
            p0_transpose_item(A.in[9] + (size_t)l * DM * INDIM, DM, INDIM, A.in[8] + l * DM, (bf16*)(ws + WS_WIN) + (size_t)l * INDIM * DM, kb * 64, n0, dst, scr, lane); continue; }
        r -= DEPTH * I_IN;
        if (r < DEPTH * I_OUT) { const int l = r / I_OUT, q = r % I_OUT, kb = q / 64, nb = q % 64;
            p0_transpose_item(A.in[20] + (size_t)l * DM * DM, DM, DM, nullptr, (bf16*)(ws + WS_WOUT) + (size_t)l * DM * DM, kb * 64, nb * 32, nb * 32, scr, lane); continue; }
        r -= DEPTH * I_OUT;
        if (r < DEPTH * I_MEM) { const int l = r / I_MEM, q = r % I_MEM, kb = q / 32, nb = q % 32;
            p0_transpose_item(A.in[18] + (size_t)l * DM * 1024, DM, 1024, A.in[17] + l * DM, (bf16*)(ws + WS_WMEM) + (size_t)l * 1024 * DM, kb * 64, nb * 32, nb * 32, scr, lane); continue; }
        r -= DEPTH * I_MEM;
        { const int l = r / I_PW, q = r % I_PW, kb = q / 16, nb = q % 16;
            p0_transpose_item(A.in[14] + (size_t)l * 512 * 512, 512, 512, nullptr, (bf16*)(ws + WS_WPW) + (size_t)l * 512 * 512, kb * 64, nb * 32, nb * 32, scr, lane); }
    }
    float* X = (float*)(ws + WS_X); bf16* XB = (bf16*)(ws + WS_XB); float* SSQ = (float*)(ws + WS_SSQ);
    for (int m = gw; m < MPAD; m += NGW) {
        GAS unsigned long long* o8 = (GAS unsigned long long*)(XB + (size_t)m * DM) + lane;
        if (m >= NROW) {
#pragma unroll
            for (int j = 0; j < 8; ++j) o8[64 * j] = 0ull;
            continue;
        }
        const float* src = (m < NROWP) ? A.in[0] + (size_t)m * DM : A.in[1] + (size_t)(m - NROWP) * DM;
        const GAS f32x4* xr = (const GAS f32x4*)src + lane;
        GAS f32x4* xo = (GAS f32x4*)(X + (size_t)m * DM) + lane;
        float s = 0.f;
#pragma unroll
        for (int j = 0; j < 8; ++j) { const f32x4 v = xr[64 * j]; xo[64 * j] = v; s += (v.x * v.x + v.y * v.y) + (v.z * v.z + v.w * v.w);
            o8[64 * j] = (unsigned long long)pk2(v.x, v.y) | ((unsigned long long)pk2(v.z, v.w) << 32); }
        s = wave_sum(s);
        if (lane < 32) SSQ[(size_t)m * 32 + lane] = (lane == 0) ? s : 0.f;
    }
    for (int m = gw; m < 512; m += NGW) {
        const GAS f32x4* xr = (const GAS f32x4*)(A.in[2] + (size_t)m * DM) + lane;
        f32x4 v[8]; float s = 0.f;
#pragma unroll
        for (int j = 0; j < 8; ++j) { v[j] = xr[64 * j]; s += (v[j].x * v[j].x + v[j].y * v[j].y) + (v[j].z * v[j].z + v[j].w * v[j].w); }
        const float rstd = 1.0f / sqrtf(wave_sum(s) * (1.0f / DM) + 1e-6f);
        GAS unsigned long long* o8 = (GAS unsigned long long*)((bf16*)(ws + WS_MEMN) + (size_t)m * DM) + lane;
#pragma unroll
        for (int j = 0; j < 8; ++j) o8[64 * j] = (unsigned long long)pk2(v[j].x * rstd, v[j].y * rstd) | ((unsigned long long)pk2(v[j].z * rstd, v[j].w * rstd) << 32);
    }
    const int gt = gw * 64 + lane, NGT = NGW * 64;
    {
        const f32x4* sk = (const f32x4*)A.in[6]; const f32x4* sv = (const f32x4*)A.in[7];
        unsigned long long* dk = (unsigned long long*)(ws + WS_CMK); unsigned long long* dv = (unsigned long long*)(ws + WS_CMV);
        for (int i = gt; i < 1048576; i += NGT) { const f32x4 a = sk[i], b = sv[i];
            dk[i] = (unsigned long long)pk2(a.x, a.y) | ((unsigned long long)pk2(a.z, a.w) << 32);
            dv[i] = (unsigned long long)pk2(b.x, b.y) | ((unsigned long long)pk2(b.z, b.w) << 32); }
        const f32x4* ck = (const f32x4*)A.in[3]; const f32x4* cv = (const f32x4*)A.in[4];
        unsigned long long* ek = (unsigned long long*)(ws + WS_CSK); unsigned long long* ev = (unsigned long long*)(ws + WS_CSV);
        for (int i = gt; i < 131072; i += NGT) { const f32x4 a = ck[i], b = cv[i];
            ek[i] = (unsigned long long)pk2(a.x, a.y) | ((unsigned long long)pk2(a.z, a.w) << 32);
            ev[i] = (unsigned long long)pk2(b.x, b.y) | ((unsigned long long)pk2(b.z, b.w) << 32);
            const int lb = i >> 12, rem = i & 4095, row = rem >> 5, c4 = rem & 31;
            if (row >= 16) { const size_t o = ((size_t)lb * 128 + (row - 16)) * 128 + c4 * 4;
                *(f32x4*)(A.out + OFF_KS + o) = a; *(f32x4*)(A.out + OFF_VS + o) = b; } }
        const f32x4* cc = (const f32x4*)A.in[5];
        for (int i = gt; i < 32 * 30 * 128; i += NGT) { const int lb = i / 3840, rem = i % 3840, row = rem >> 7, c4 = rem & 127;
            if (row >= 16) *(f32x4*)(A.out + OFF_CS + ((size_t)lb * 30 + (row - 16)) * 512 + c4 * 4) = cc[i]; }
        float* BT = (float*)(ws + WS_BT);
        for (int i = gt; i < 16 * 256; i += NGT) { const int h = i >> 8, idx = i & 255; const int rel = idx - 191;
            BT[i] = (idx < 255) ? A.in[19][t5_bucket(rel) * 16 + h] * LOG2E : 0.f; }
    }
}

struct KSrc { const bf16* p0; int pitch0; int n0; const bf16* p1; int pitch1; };
__device__ __forceinline__ const bf16* ks_row(const KSrc& s, int j) { return j < s.n0 ? s.p0 + (long)j * s.pitch0 : s.p1 + (long)(j - s.n0) * s.pitch1; }

template <int HD, bool SWA>
__device__ __forceinline__ void naive_attn(float* S, float* INV, const bf16* Q, int qpitch, int nq, KSrc ks, KSrc vs, int jlo, int nk,
                                           const float* btab, float sink2, const bf16* gate, int gpitch, bf16* out, int opitch) {
    const int tid = opaque_tid(), lane = tid & 63, wave = tid >> 6;
#pragma unroll 1
    for (int idx = tid; idx < nq * nk; idx += NTHREADS) {
        const int i = idx / nk, j = idx - i * nk;
        float s;
        if (j < jlo) s = -1e30f;
        else {
            const bf16* q = Q + (long)i * qpitch; const bf16* k = ks_row(ks, j);
            float a = 0.f;
#pragma unroll 2
            for (int d = 0; d < HD; d += 8) {
                const v4u qv = *(const v4u*)(q + d), kv = *(const v4u*)(k + d);
                a += __builtin_bit_cast(float, qv.x << 16) * __builtin_bit_cast(float, kv.x << 16) + __builtin_bit_cast(float, qv.x & 0xffff0000u) * __builtin_bit_cast(float, kv.x & 0xffff0000u);
                a += __builtin_bit_cast(float, qv.y << 16) * __builtin_bit_cast(float, kv.y << 16) + __builtin_bit_cast(float, qv.y & 0xffff0000u) * __builtin_bit_cast(float, kv.y & 0xffff0000u);
                a += __builtin_bit_cast(float, qv.z << 16) * __builtin_bit_cast(float, kv.z << 16) + __builtin_bit_cast(float, qv.z & 0xffff0000u) * __builtin_bit_cast(float, kv.z & 0xffff0000u);
                a += __builtin_bit_cast(float, qv.w << 16) * __builtin_bit_cast(float, kv.w << 16) + __builtin_bit_cast(float, qv.w & 0xffff0000u) * __builtin_bit_cast(float, kv.w & 0xffff0000u);
            }
            s = a; if (SWA) s += btab[j - i + 63];
        }
        S[i * 257 + j] = s;
    }
    __syncthreads();
    for (int i = wave; i < nq; i += NWAVES) {
        float m = SWA ? sink2 : -3.0e38f;
        for (int j = lane; j < nk; j += 64) m = fmaxf(m, S[i * 257 + j]);
        m = wave_max(m);
        float sum = 0.f;
        for (int j = lane; j < nk; j += 64) { const float p = exp2f(S[i * 257 + j] - m); sum += p; S[i * 257 + j] = rbf(p); }
        sum = wave_sum(sum);
        if (SWA) sum += exp2f(sink2 - m);
        if (lane == 0) INV[i] = 1.0f / sum;
    }
    __syncthreads();
#pragma unroll 1
    for (int idx = tid; idx < nq * HD; idx += NTHREADS) {
        const int i = idx / HD, d = idx % HD;
        float o = 0.f;
#pragma unroll 4
        for (int j = jlo; j < nk; ++j) o += S[i * 257 + j] * bf2f(ks_row(vs, j)[d]);
        o *= INV[i];
        o *= bf2f(gate[(long)i * gpitch + d]);
        out[(long)i * opitch + d] = (bf16)f2bf(o);
    }
    __syncthreads();
}

__device__ __forceinline__ void naive_conv(float* C, const bf16* Useq, int t0, int nfr, const float* left, const float* cw, const float* cb, const float* lng, const float* lnb,
                                           const float* wpw  , const float* bpw, const bf16* gate  , bf16* out  ) {
    const int tid = opaque_tid(), lane = tid & 63, wave = tid >> 6;
    {
        const int ch = tid;
        float w[31];
#pragma unroll
        for (int j = 0; j < 31; ++j) w[j] = cw[j * 512 + ch];
        const float b = cb[ch];
#pragma unroll 1
        for (int tt = 0; tt < 64; ++tt) {
            float a = 0.f;
            if (tt < nfr) {
                a = b;
#pragma unroll
                for (int j = 0; j < 31; ++j) { const int e = t0 + tt - 30 + j;
                    const float uv = (e >= 0) ? bf2f(Useq[(long)e * ZP + ch]) : (left ? left[(30 + e) * 512 + ch] : 0.f);
                    a += w[j] * uv; }
            }
            C[tt * 516 + ch] = a;
        }
    }
    __syncthreads();
    for (int tt = wave; tt < 64; tt += NWAVES) {
        float v[8]; float s = 0.f;
#pragma unroll
        for (int j = 0; j < 8; ++j) { v[j] = C[tt * 516 + lane + 64 * j]; s += v[j]; }
        const float mu = wave_sum(s) * (1.0f / 512.0f); float q = 0.f;
#pragma unroll
        for (int j = 0; j < 8; ++j) { v[j] -= mu; q += v[j] * v[j]; }
        const float rstd = 1.0f / sqrtf(wave_sum(q) * (1.0f / 512.0f) + 1e-6f);
#pragma unroll
        for (int j = 0; j < 8; ++j) { const int ch = lane + 64 * j; const float y = v[j] * rstd * lng[ch] + lnb[ch]; C[tt * 516 + ch] = rbf(y / (1.0f + __expf(-y))); }
    }
    __syncthreads();
    {
        const int n = tid;
        const float bb = bpw[n];
#pragma unroll 1
        for (int tg = 0; tg < 64; tg += 16) {
            if (tg >= nfr) break;
            float acc[16];
#pragma unroll
            for (int tt = 0; tt < 16; ++tt) acc[tt] = 0.f;
#pragma unroll 1
            for (int k = 0; k < 512; k += 4) {
                const float w0 = rbf(wpw[(size_t)(k + 0) * 512 + n]), w1 = rbf(wpw[(size_t)(k + 1) * 512 + n]), w2 = rbf(wpw[(size_t)(k + 2) * 512 + n]), w3 = rbf(wpw[(size_t)(k + 3) * 512 + n]);
#pragma unroll
                for (int tt = 0; tt < 16; ++tt) { const f32x4 c = *(const f32x4*)(C + (tg + tt) * 516 + k); acc[tt] += (c.x * w0 + c.y * w1) + (c.z * w2 + c.w * w3); }
            }
#pragma unroll
            for (int tt = 0; tt < 16; ++tt) if (tg + tt < nfr) out[(long)(tg + tt) * DM + n] = (bf16)f2bf((acc[tt] + bb) * bf2f(gate[(long)(tg + tt) * ZP + n]));
        }
    }
    __syncthreads();
}

__device__ __forceinline__ void naive_mixer_phase(Frame& F, const Args& A, int l) {
    unsigned char* ws = A.ws;
    float* S = (float*)F.glds;
    float* INV = S + 64 * 257;
    const bf16* Z = (const bf16*)(ws + WS_Z); bf16* Y = (bf16*)(ws + WS_YMIX);
    const float* BT = (const float*)(ws + WS_BT);
    constexpr int U0 = 128, U1 = U0 + 8, U2 = U1 + 512, U3 = U2 + 32, U4 = U3 + 2048, U5 = U4 + 128;
    for (int u = blockIdx.x; u < U5; u += F.G) {
        if (u < U1) {
            int rowbase, t0, nfr; const float* left = nullptr;
            if (u < U0) { const int b = u >> 6, c = u & 63; rowbase = b * SEQ; t0 = c * 64; nfr = 64; }
            else { const int b = u - U0; rowbase = NROWP + b * NSS; t0 = 0; nfr = NSS; left = A.in[5] + (size_t)(l * 8 + b) * 30 * 512; }
            naive_conv(S, Z + (size_t)rowbase * ZP + ZC_U, t0, nfr, left, A.in[10] + l * 31 * 512, A.in[11] + l * 512, A.in[12] + l * 512, A.in[13] + l * 512,
                       A.in[14] + (size_t)l * 512 * 512, A.in[15] + l * 512, Z + (size_t)(rowbase + t0) * ZP + ZC_GA, Y + (size_t)(rowbase + t0) * DM);
        } else if (u < U3) {
            int row0, nq, h; KSrc ks, vs;
            if (u < U2) { const int v = u - U1, b = v >> 8, h_ = (v >> 6) & 3, qt = v & 63; h = h_; row0 = b * SEQ + qt * 64; nq = 64;
                const bf16* kb = (const bf16*)(ws + WS_MKVP) + (size_t)(b * 256) * 4096 + l * 1024 + h * 128;
                ks = KSrc{kb, 4096, 256, kb, 4096}; vs = KSrc{kb + 512, 4096, 256, kb + 512, 4096}; }
            else { const int v = u - U2, b = v >> 2; h = v & 3; row0 = NROWP + b * NSS; nq = NSS;
                const bf16* kb = (const bf16*)(ws + WS_CMK) + (size_t)((l * 8 + b) * 256) * 512 + h * 128; const bf16* vb = (const bf16*)(ws + WS_CMV) + (size_t)((l * 8 + b) * 256) * 512 + h * 128;
                ks = KSrc{kb, 512, 256, kb, 512}; vs = KSrc{vb, 512, 256, vb, 512}; }
            naive_attn<128, false>(S, INV, Z + (size_t)row0 * ZP + ZC_CQ + h * 128, ZP, nq, ks, vs, 0, 256, nullptr, 0.f,
                                   Z + (size_t)row0 * ZP + ZC_GC + h * 128, ZP, Y + (size_t)row0 * DM + 1536 + h * 128, DM);
        } else {
            int row0, nq, h, jlo, nk; KSrc ks, vs;
            if (u < U4) { const int v = u - U3, b = v >> 10, c = (v >> 4) & 63; h = v & 15; row0 = b * SEQ + c * 64; nq = 64; const int kv = h >> 3;
                const bf16* kb = Z + ((long)row0 - 128) * ZP + ZC_K + kv * 64;
                ks = KSrc{kb, ZP, 192, kb, ZP}; vs = KSrc{kb + (ZC_V - ZC_K), ZP, 192, kb + (ZC_V - ZC_K), ZP}; jlo = (c >= 2) ? 0 : 128 - 64 * c; nk = 192; }
            else { const int v = u - U4, b = v >> 4; h = v & 15; row0 = NROWP + b * NSS; nq = NSS; const int kv = h >> 3;
                const bf16* ck = (const bf16*)(ws + WS_CSK) + (size_t)((l * 8 + b) * 128) * 128 + kv * 64; const bf16* cv = (const bf16*)(ws + WS_CSV) + (size_t)((l * 8 + b) * 128) * 128 + kv * 64;
                const bf16* zk = Z + (size_t)row0 * ZP + ZC_K + kv * 64;
                ks = KSrc{ck, 128, 128, zk, ZP}; vs = KSrc{cv, 128, 128, zk + (ZC_V - ZC_K), ZP}; jlo = 0; nk = 144; }
            naive_attn<64, true>(S, INV, Z + (size_t)row0 * ZP + ZC_Q + h * 64, ZP, nq, ks, vs, jlo, nk, BT + h * 256, A.in[16][l * 16 + h] * LOG2E,
                                 Z + (size_t)row0 * ZP + ZC_GB + h * 64, ZP, Y + (size_t)row0 * DM + 512 + h * 64, DM);
        }
    }
}

__device__ __forceinline__ void final_norm_phase(Frame& F, const Args& A) {
    const float* X = (const float*)(A.ws + WS_X); const float* SSQ = (const float*)(A.ws + WS_SSQ); const float* g = A.in[21];
    const int tid_ = opaque_tid(), lane = tid_ & 63, wave_ = __builtin_amdgcn_readfirstlane(tid_ >> 6);
    const int gw = F.vcu * NWAVES + wave_, NGW = F.G * NWAVES;
    f32x4 gv[8];
#pragma unroll
    for (int j = 0; j < 8; ++j) gv[j] = ((const f32x4*)g)[lane + 64 * j];
    for (int m = gw; m < NROW; m += NGW) {
        float s = (lane < 32) ? SSQ[(size_t)m * 32 + lane] : 0.f;
        s = wave_sum(s);
        const float rstd = 1.0f / sqrtf(s * (1.0f / DM) + 1e-6f);
        const f32x4* xr = (const f32x4*)(X + (size_t)m * DM) + lane;
        f32x4* o = (f32x4*)(A.out + (m < NROWP ? OFF_YP + (size_t)m * DM : OFF_YS + (size_t)(m - NROWP) * DM)) + lane;
#pragma unroll
        for (int j = 0; j < 8; ++j) o[64 * j] = xr[64 * j] * rstd * gv[j];
    }
}

constexpr int N_PHASES = 2 + 3 * DEPTH;
#ifndef MK_SINGLE
#define MK_SINGLE 0
#endif
__global__ void __launch_bounds__(NTHREADS, 2) mk_fwd(Args args) {
    extern __shared__ __attribute__((aligned(16))) unsigned char lds[];
    Frame F;
    F.lds = (LAS unsigned char*)lds; F.glds = lds;
    F.MISC = (volatile LAS unsigned*)(F.lds + MISC_OFF);
    F.tid = threadIdx.x; F.lane = F.tid & 63; F.wave = __builtin_amdgcn_readfirstlane(F.tid >> 6);
    F.G = gridDim.x; { const int bx = blockIdx.x; F.vcu = (F.G % 8 == 0) ? (bx % 8) * (F.G / 8) + bx / 8 : bx; }
    unsigned char* ws = args.ws;
    F.ctl = (gu32*)(ws + WS_CTL);
    for (int u = F.tid; u < (LDS_BYTES - LDSCTL_OFF) / 4; u += NTHREADS) ((LAS unsigned*)(F.lds + LDSCTL_OFF))[u] = 0u;
    __syncthreads();
    XcdBarrier bar; bar.bar = (unsigned*)(F.ctl + CW_BAR); bar.x = 0; bar.st = nullptr;
    const int lo = args.ph_lo, hi = args.ph_hi;
    const bool multi = (hi - lo) > 1;
    if (multi) bar = xcd_barrier_post((unsigned*)(F.ctl + CW_BAR), F.MISC + 8);
#define SEAM(k) do { if (lo <= (k) && (k) + 1 < hi) xcd_barrier(bar); } while (0)
#define IN(k) (lo <= (k) && (k) < hi)
    if (IN(0)) { p0_prologue(F, args); SEAM(0); }
    if (IN(1)) {
        unsigned char* wsl = ws; asm volatile("" : "+s"(wsl));
        pg8::Gemm g{(const pg8::bf16_t*)(wsl + WS_MEMN), (const pg8::bf16_t*)(wsl + WS_WMEM), 512, 4096, DM};
        pg8::StaticOrder S; S.init(512, 4096, F.G, (int)(F.G - 1 - blockIdx.x));
        pg8::EpiMemKV E{(pg8::bf16_t*)(wsl + WS_MKVP), args.out};
        pg8::gemm_phase<pg8::EpiMemKV, pg8::StaticOrder, true, true>(F.lds, g, S, E);
    }
#pragma unroll 1
    for (int l = 0; l < DEPTH; ++l) {
        const int p1 = 1 + 3 * l, p2 = p1 + 1, p3 = p1 + 2;
        unsigned char* wsl = ws; asm volatile("" : "+s"(wsl));
        if (IN(p1)) {
            pg8::Gemm g{(const pg8::bf16_t*)(wsl + WS_XB), (const pg8::bf16_t*)(wsl + WS_WIN) + (size_t)l * INDIM * DM, MPAD, INDIM, DM};
            pg8::StaticOrder S; S.init(MPAD, INDIM, F.G, (int)blockIdx.x);
            pg8::EpiIn E{(pg8::bf16_t*)(wsl + WS_Z), (const float*)(wsl + WS_SSQ), args.out, l};
            pg8::gemm_phase<pg8::EpiIn, pg8::StaticOrder, true, true>(F.lds, g, S, E);
            SEAM(p1);
        }
        if (IN(p2)) { naive_mixer_phase(F, args, l); SEAM(p2); }
        if (IN(p3)) {
            pg8::Gemm g{(const pg8::bf16_t*)(wsl + WS_YMIX), (const pg8::bf16_t*)(wsl + WS_WOUT) + (size_t)l * DM * DM, MPAD, DM, DM};
            pg8::StaticOrder S; S.init(MPAD, DM, F.G, (int)blockIdx.x);
            pg8::EpiOut E{(float*)(wsl + WS_X), (pg8::bf16_t*)(wsl + WS_XB), (float*)(wsl + WS_SSQ)};
            pg8::gemm_phase<pg8::EpiOut, pg8::StaticOrder, true, true>(F.lds, g, S, E);
            SEAM(p3);
        }
    }
    if (IN(N_PHASES - 1)) final_norm_phase(F, args);
#undef SEAM
#undef IN
}

extern "C" void kernel_launch(void* const* d_in, const int* in_sizes, int n_in, void* d_out, int out_size, void* d_ws, size_t ws_size, hipStream_t stream) {
    static int grid = 0;
    if (grid == 0) {
        if (n_in != 22 || out_size != (int)OUT_TOTAL || ws_size < WS_END) { fprintf(stderr, "kernel_launch: unexpected shapes: n_in %d out %d ws %zu\n", n_in, out_size, ws_size); grid = -1; return; }
        int dev = 0, cus = 0, per_cu = 0;
        if (hipGetDevice(&dev) != hipSuccess || hipDeviceGetAttribute(&cus, hipDeviceAttributeMultiprocessorCount, dev) != hipSuccess) { grid = -1; return; }
        if (hipFuncSetAttribute((const void*)mk_fwd, hipFuncAttributeMaxDynamicSharedMemorySize, LDS_BYTES) != hipSuccess) { fprintf(stderr, "kernel_launch: hipFuncSetAttribute failed\n"); grid = -1; return; }
        if (hipOccupancyMaxActiveBlocksPerMultiprocessor(&per_cu, (const void*)mk_fwd, NTHREADS, LDS_BYTES) != hipSuccess || per_cu < 1) { fprintf(stderr, "kernel_launch: occupancy query says %d blocks per CU\n", per_cu); (void)hipGetLastError(); grid = -1; return; }
        grid = cus;
    }
    if (grid < 0) return;
    (void)hipMemsetAsync((char*)d_ws + WS_CTL, 0, CTL_ZERO_BYTES, stream);
    Args a{};
    for (int i = 0; i < 22; ++i) a.in[i] = (const float*)d_in[i];
    a.out = (float*)d_out; a.ws = (unsigned char*)d_ws;
#if MK_SINGLE
    a.ph_lo = 0; a.ph_hi = N_PHASES;
    hipLaunchKernelGGL(mk_fwd, dim3(grid), dim3(NTHREADS), LDS_BYTES, stream, a);
#else
    for (int p = 0; p < N_PHASES; ++p) { a.ph_lo = p; a.ph_hi = p + 1; hipLaunchKernelGGL(mk_fwd, dim3(grid), dim3(NTHREADS), LDS_BYTES, stream, a); }
#endif
}
```

```cpp
#include <hip/hip_runtime.h>
#include <cstdio>
#include <cstdint>

namespace pg8 {
#define PG8_LAS __attribute__((address_space(3)))
typedef unsigned short bf16_t;
typedef short bf16x8 __attribute__((ext_vector_type(8)));
typedef float f32x4 __attribute__((ext_vector_type(4)));
typedef unsigned u32x4 __attribute__((ext_vector_type(4)));
constexpr int BM = 256, BK = 64, HALF = 128, HTB = HALF * BK * 2  , STAGE_BYTES = 8 * HTB, NXCD = 8, WGM = 8;

__host__ __device__ __forceinline__ int lds_byte(int r, int c) { const int st = (r >> 4) * 2 + (c >> 5), rr = r & 15, cc = c & 31, ob = rr * 64 + cc * 2; return st * 1024 + (ob ^ (((ob >> 9) & 1) << 5)); }
__host__ __device__ __forceinline__ void stage_rc(int b, int& R, int& C) { const int st = b / 1024, sb = b % 1024, swz = sb ^ (((sb >> 9) & 1) << 5); R = (st >> 1) * 16 + swz / 64; C = (st & 1) * 32 + (swz % 64) / 2; }
__host__ __device__ __forceinline__ int perm32(int rho) { const int n = rho >> 4, i = rho & 15; return 8 * (i >> 2) + 4 * n + (i & 3); }

struct Unit { int pm, pn; };
struct Gemm { const bf16_t* A; const bf16_t* Bt; int M, N, K; };

struct StaticOrder {
    int nM, nN, nwg, G, c;
    __host__ __device__ void init(int M, int N, int G_, int c_) { nM = M / BM; nN = N / BM; nwg = nM * nN; G = G_; c = c_; }
    __host__ __device__ bool next(int i, Unit& u) const {
        const long L = (long)i * G + c; if (L >= nwg) return false;
        int wgid = (int)L; { const int q = nwg / NXCD, r = nwg % NXCD, xcd = wgid % NXCD, off = wgid / NXCD; wgid = (xcd < r ? xcd * (q + 1) : r * (q + 1) + (xcd - r) * q) + off; }
        const int nig = WGM * nN, gid = wgid / nig, fm = gid * WGM, gsz = (nM - fm) < WGM ? (nM - fm) : WGM;
        u.pm = fm + ((wgid % nig) % gsz); u.pn = (wgid % nig) / gsz; return true;
    }
    __device__ __forceinline__ void a_ready(const Unit&) const {}
    __device__ __forceinline__ void done(const Unit&) const {}
};

__device__ __forceinline__ unsigned cvt_pk_bf16(float lo, float hi) { unsigned r; asm volatile("v_cvt_pk_bf16_f32 %0, %1, %2" : "=v"(r) : "v"(lo), "v"(hi)); return r; }
typedef float f32x2 __attribute__((ext_vector_type(2)));


constexpr int P_D = 2048, P_INDIM = 4864, P_NROW = 8320  , P_MPAD = 8448, P_NSSQ = 32;
constexpr long OFF_YP = 0, OFF_YS = 16777216, OFF_KP = 17039360, OFF_VP = 17170432, OFF_CP = 17301504, OFF_MKP = 17424384, OFF_MVP = 18472960,
               OFF_KS = 19521536, OFF_VS = 20045824, OFF_CS = 20570112, OUT_TOTAL = 21061632;
constexpr float QS_SWA = 0.125f * 1.4426950408889634f;
constexpr float QS_MEM = 0.08838834764831845f * 1.4426950408889634f;

__device__ __forceinline__ float sigmoid_f(float x) { return 1.0f / (1.0f + __expf(-x)); }
__device__ __forceinline__ f32x4 sigmoid4(f32x4 x) { return (f32x4){sigmoid_f(x[0]), sigmoid_f(x[1]), sigmoid_f(x[2]), sigmoid_f(x[3])}; }
__device__ __forceinline__ u32x4 pack8(f32x4 a, f32x4 b) { u32x4 w; w.x = cvt_pk_bf16(a[0], a[1]); w.y = cvt_pk_bf16(a[2], a[3]); w.z = cvt_pk_bf16(b[0], b[1]); w.w = cvt_pk_bf16(b[2], b[3]); return w; }

__device__ __forceinline__ void row_rstd(float (&rs)[2][4], const float* ssq, int rbase, int fq) {
#pragma unroll
    for (int ai = 0; ai < 2; ++ai)
#pragma unroll
        for (int m = 0; m < 4; ++m) {
            const int row = rbase + ai * HALF + m * 16;
            const f32x4* p = (const f32x4*)(ssq + (size_t)row * P_NSSQ + fq * 8);
            const f32x4 a = p[0], b = p[1];
            float s = ((a[0] + a[1]) + (a[2] + a[3])) + ((b[0] + b[1]) + (b[2] + b[3]));
            s += __shfl_xor(s, 16); s += __shfl_xor(s, 32);
            rs[ai][m] = 1.0f / sqrtf(s * (1.0f / (float)P_D) + 1e-6f);
        }
}

struct EpiIn {
    static constexpr bool PERM = true, AFTER_DRAIN = false;
    bf16_t* Z; const float* ssq; float* out; int layer;
    __device__ __forceinline__ void operator()(const f32x4 (&acc)[2][2][4][2], const Unit& u, int wr, int wc, int fr, int fq) const {
        const int pn = u.pn, rbase = u.pm * BM + wr * 64 + fr;
        bf16_t* Z = this->Z; const float* ssq = this->ssq; float* out = this->out;
        asm volatile("" : "+s"(Z), "+s"(ssq), "+s"(out));
        float rs[2][4];
        row_rstd(rs, ssq, rbase, fq);
        const bool tailtile = (u.pm == 15) || (u.pm == 31) || (u.pm == 32);
        if (pn < 4) {
            const int ch0 = 128 * pn + 32 * wc + 8 * fq;
#pragma unroll
            for (int ai = 0; ai < 2; ++ai)
#pragma unroll
                for (int m = 0; m < 4; ++m) {
                    const int row = rbase + ai * HALF + m * 16;
                    if (row >= P_NROW) continue;
                    const float r = rs[ai][m];
                    const f32x4 u0 = (acc[ai][0][m][0] * r) * sigmoid4(acc[ai][1][m][0] * r), u1 = (acc[ai][0][m][1] * r) * sigmoid4(acc[ai][1][m][1] * r);
                    *(u32x4*)(Z + (size_t)row * P_INDIM + ch0) = pack8(u0, u1);
                    if (tailtile) {
                        float* dst = nullptr;
                        if (row < 8192) { const int t = row & 4095, b = row >> 12; if (t >= 4066) dst = out + OFF_CP + ((size_t)(layer * 2 + b) * 30 + (t - 4066)) * 512 + ch0; }
                        else { const int rr = row - 8192, b = rr >> 4, s = rr & 15; dst = out + OFF_CS + ((size_t)(layer * 8 + b) * 30 + 14 + s) * 512 + ch0; }
                        if (dst) { *(f32x4*)dst = u0; *(f32x4*)(dst + 4) = u1; }
                    }
                }
        } else if (pn == 10) {
#pragma unroll
            for (int ai = 0; ai < 2; ++ai)
#pragma unroll
                for (int m = 0; m < 4; ++m) {
                    const int row = rbase + ai * HALF + m * 16;
                    if (row >= P_NROW) continue;
                    const float r = rs[ai][m];
#pragma unroll
                    for (int bj = 0; bj < 2; ++bj) {
                        const f32x4 v0 = acc[ai][bj][m][0] * r, v1 = acc[ai][bj][m][1] * r;
                        const int c128 = 32 * wc + 8 * fq;
                        *(u32x4*)(Z + (size_t)row * P_INDIM + 2560 + 128 * bj + c128) = pack8(v0, v1);
                        if (tailtile) {
                            float* dst = nullptr;
                            if (row < 8192) { const int t = row & 4095, b = row >> 12; if (t >= 3968) dst = out + (bj ? OFF_VP : OFF_KP) + ((size_t)(layer * 2 + b) * 128 + (t - 3968)) * 128 + c128; }
                            else { const int rr = row - 8192, b = rr >> 4, s = rr & 15; dst = out + (bj ? OFF_VS : OFF_KS) + ((size_t)(layer * 8 + b) * 128 + 112 + s) * 128 + c128; }
                            if (dst) { *(f32x4*)dst = v0; *(f32x4*)(dst + 4) = v1; }
                        }
                    }
                }
        } else {
            const bool is_q = (pn >= 6 && pn <= 9), is_cq = (pn == 15 || pn == 16);
            const float qs = is_q ? QS_SWA : QS_MEM;
            const bool gate = !(is_q || is_cq);
#pragma unroll
            for (int ai = 0; ai < 2; ++ai)
#pragma unroll
                for (int m = 0; m < 4; ++m) {
                    const int row = rbase + ai * HALF + m * 16;
                    if (row >= P_NROW) continue;
                    const float r = rs[ai][m];
#pragma unroll
                    for (int bj = 0; bj < 2; ++bj) {
                        f32x4 v0 = acc[ai][bj][m][0] * r, v1 = acc[ai][bj][m][1] * r;
                        if (gate) { v0 = v0 * sigmoid4(v0); v1 = v1 * sigmoid4(v1); } else { v0 = v0 * qs; v1 = v1 * qs; }
                        *(u32x4*)(Z + (size_t)row * P_INDIM + pn * BM + 128 * bj + 32 * wc + 8 * fq) = pack8(v0, v1);
                    }
                }
        }
    }
};

struct EpiMemKV {
    static constexpr bool PERM = true, AFTER_DRAIN = false;
    bf16_t* MKV; float* out;
    __device__ __forceinline__ void operator()(const f32x4 (&acc)[2][2][4][2], const Unit& u, int wr, int wc, int fr, int fq) const {
        const int l = u.pn >> 2, kv = (u.pn >> 1) & 1, cb = (u.pn & 1) * 256;
        bf16_t* MKV = this->MKV; float* out = this->out; asm volatile("" : "+s"(MKV), "+s"(out));
        const int row0 = u.pm * BM + wr * 64 + fr, cl = 32 * wc + 8 * fq;
        bf16_t* zb = MKV + (size_t)row0 * 4096 + u.pn * BM + cl;
        float* ob = out + (kv ? OFF_MVP : OFF_MKP) + ((size_t)(l * 512 + row0)) * 512 + cb + cl;
#pragma unroll
        for (int ai = 0; ai < 2; ++ai)
#pragma unroll
            for (int m = 0; m < 4; ++m)
#pragma unroll
                for (int bj = 0; bj < 2; ++bj) {
                    const f32x4 v0 = acc[ai][bj][m][0], v1 = acc[ai][bj][m][1];
                    *(u32x4*)(zb + (size_t)(ai * HALF + m * 16) * 4096 + 128 * bj) = pack8(v0, v1);
                    float* dst = ob + (size_t)(ai * HALF + m * 16) * 512 + 128 * bj;
                    *(f32x4*)dst = v0; *(f32x4*)(dst + 4) = v1;
                }
    }
};

struct EpiOut {
    static constexpr bool PERM = false, AFTER_DRAIN = false;
    float* X; bf16_t* XB; float* ssq;
    __device__ __forceinline__ void operator()(const f32x4 (&acc)[2][2][4][2], const Unit& u, int wr, int wc, int fr, int fq) const {
        typedef unsigned u32x2v __attribute__((ext_vector_type(2)));
        const int rbase = u.pm * BM + wr * 64 + fr;
        float* X = this->X; bf16_t* XB = this->XB; float* ssq = this->ssq; asm volatile("" : "+s"(X), "+s"(XB), "+s"(ssq));
#pragma unroll
        for (int ai = 0; ai < 2; ++ai)
#pragma unroll
            for (int m = 0; m < 4; ++m) {
                const int row = rbase + ai * HALF + m * 16;
                if (row >= P_NROW) continue;
                float q = 0.f;
#pragma unroll
                for (int bj = 0; bj < 2; ++bj)
#pragma unroll
                    for (int n = 0; n < 2; ++n) {
                        const size_t off = (size_t)row * P_D + u.pn * BM + bj * HALF + wc * 32 + n * 16 + fq * 4;
                        const f32x4 xn = *(const f32x4*)(X + off) + acc[ai][bj][m][n];
                        *(f32x4*)(X + off) = xn;
                        u32x2v w; w.x = cvt_pk_bf16(xn[0], xn[1]); w.y = cvt_pk_bf16(xn[2], xn[3]);
                        *(u32x2v*)(XB + off) = w;
                        q += (xn[0] * xn[0] + xn[1] * xn[1]) + (xn[2] * xn[2] + xn[3] * xn[3]);
                    }
                q += __shfl_xor(q, 16); q += __shfl_xor(q, 32);
                if (fq == 0) ssq[(size_t)row * P_NSSQ + u.pn * 4 + wc] = q;
            }
    }
};

template <class Epi, class Sched, bool ALIGN_EPI = false, bool SP2 = false>
__device__ __forceinline__ void gemm_phase(PG8_LAS unsigned char* lds, const Gemm g, const Sched& S, const Epi& E) {
    int tid_ = threadIdx.x; asm volatile("" : "+v"(tid_));
    const int tid = tid_, wid = __builtin_amdgcn_readfirstlane(tid >> 6), lane = tid & 63, wr = wid >> 2, wc = wid & 3, fr = lane & 15, fq = lane >> 4;
    const int K = g.K, nt = K / BK;
    unsigned voffA[2], voffB[2];
#pragma unroll
    for (int i = 0; i < 2; ++i) { int R, C; stage_rc(tid * 16 + i * 8192, R, C); const int Rb = Epi::PERM ? ((R & ~31) + perm32(R & 31)) : R;
        voffA[i] = (unsigned)(R * K + C) * 2u; voffB[i] = (unsigned)(Rb * K + C) * 2u; }
    const size_t kstep = (size_t)(BK * 2);
    const size_t hstep = (size_t)HALF * K * 2;
    const size_t tstep = 2 * hstep;
    const unsigned ldsw = (unsigned)wid * 1024u;
    const int aoff = lds_byte(wr * 64 + fr, fq * 8), boff = lds_byte(wc * 32 + fr, fq * 8);
#define PG8_SA(b, h) (((b) * 2 + (h)) * HTB)
#define PG8_SB(b, h) ((4 + (b) * 2 + (h)) * HTB)
#define PG8_STAGE(bufoff, gbase, voff) do { _Pragma("unroll") for (int _i = 0; _i < 2; ++_i) \
        __builtin_amdgcn_global_load_lds((const unsigned*)((const char*)(gbase) + (voff)[_i]), (PG8_LAS unsigned*)(lds + (bufoff) + ldsw + _i * 8192), 16, 0, 0); } while (0)
#define PG8_LDA(dst, b, h) do { _Pragma("unroll") for (int m = 0; m < 4; ++m) _Pragma("unroll") for (int k = 0; k < 2; ++k) dst[m][k] = *(const PG8_LAS bf16x8*)(lds + PG8_SA(b, h) + aoff + m * 2048 + k * 1024); } while (0)
#define PG8_LDB(dst, b, h) do { _Pragma("unroll") for (int n = 0; n < 2; ++n) _Pragma("unroll") for (int k = 0; k < 2; ++k) dst[n][k] = *(const PG8_LAS bf16x8*)(lds + PG8_SB(b, h) + boff + n * 2048 + k * 1024); } while (0)
#define PG8_MMA(ai, bj, At, Bt) do { __builtin_amdgcn_s_setprio(1); _Pragma("unroll") for (int m = 0; m < 4; ++m) _Pragma("unroll") for (int n = 0; n < 2; ++n) _Pragma("unroll") for (int k = 0; k < 2; ++k) \
        acc[ai][bj][m][n] = __builtin_amdgcn_mfma_f32_16x16x32_bf16(Bt[n][k], At[m][k], acc[ai][bj][m][n], 0, 0, 0); __builtin_amdgcn_s_setprio(0); } while (0)
#define PG8_WAIT_V(n) asm volatile("s_waitcnt vmcnt(" #n ")" ::: "memory")
#define PG8_WAIT_L(n) asm volatile("s_waitcnt lgkmcnt(" #n ")" ::: "memory")
#define PG8_BAR __builtin_amdgcn_s_barrier()
#define PG8_SCHED __builtin_amdgcn_sched_barrier(0)
    Unit cur, nxt; int ui = 0;
    if (!S.next(0, cur)) return;
    f32x4 acc[2][2][4][2];
#pragma unroll
    for (int a = 0; a < 2; ++a)
#pragma unroll
        for (int b = 0; b < 2; ++b)
#pragma unroll
            for (int m = 0; m < 4; ++m)
#pragma unroll
                for (int n = 0; n < 2; ++n) acc[a][b][m][n] = (f32x4){0.f, 0.f, 0.f, 0.f};
    bf16x8 At[4][2], B0[2][2], B1[2][2];
    const char* cA = (const char*)g.A + (size_t)cur.pm * tstep; const char* cB = (const char*)g.Bt + (size_t)cur.pn * tstep;
    S.a_ready(cur);
    if constexpr (SP2) {
        PG8_STAGE(PG8_SB(0, 0), cB, voffB); PG8_STAGE(PG8_SB(0, 1), cB + hstep, voffB); PG8_STAGE(PG8_SA(0, 0), cA, voffA); PG8_STAGE(PG8_SA(0, 1), cA + hstep, voffA);
        if (wr == 1) PG8_BAR;
        PG8_WAIT_V(2); PG8_BAR;
        PG8_STAGE(PG8_SB(1, 0), cB + kstep, voffB); PG8_STAGE(PG8_SA(1, 0), cA + kstep, voffA); PG8_STAGE(PG8_SB(1, 1), cB + hstep + kstep, voffB);
        PG8_WAIT_V(6); PG8_BAR;
    } else {
        PG8_STAGE(PG8_SB(0, 0), cB, voffB); PG8_STAGE(PG8_SA(0, 0), cA, voffA); PG8_STAGE(PG8_SB(0, 1), cB + hstep, voffB); PG8_STAGE(PG8_SA(0, 1), cA + hstep, voffA);
        if (wr == 1) PG8_BAR;
        PG8_WAIT_V(4); PG8_BAR;
        PG8_STAGE(PG8_SB(1, 0), cB + kstep, voffB); PG8_STAGE(PG8_SA(1, 0), cA + kstep, voffA); PG8_STAGE(PG8_SB(1, 1), cB + hstep + kstep, voffB);
        PG8_WAIT_V(6); PG8_BAR;
    }
    for (;;) {
        const bool has_next = S.next(ui + 1, nxt);
        const char* nA = has_next ? (const char*)g.A + (size_t)nxt.pm * tstep : cA; const char* nB = has_next ? (const char*)g.Bt + (size_t)nxt.pn * tstep : cB;
        for (int t = 0; t < nt; t += 2) {
            const bool last = (t == nt - 2);
            const char* a1 = cA + (size_t)(t + 1) * kstep;
            const char* a2 = last ? nA : cA + (size_t)(t + 2) * kstep; const char* b2 = last ? nB : cB + (size_t)(t + 2) * kstep;
            const char* a3 = a2 + kstep; const char* b3 = b2 + kstep;
            if (last && has_next) S.a_ready(nxt);
            if constexpr (SP2) {
            PG8_LDB(B0, 0, 0); PG8_LDB(B1, 0, 1); PG8_SCHED; PG8_LDA(At, 0, 0); PG8_STAGE(PG8_SA(1, 1), a1 + hstep, voffA);
            PG8_WAIT_V(8); PG8_WAIT_L(0); PG8_BAR; PG8_MMA(0, 0, At, B0); PG8_MMA(0, 1, At, B1); PG8_BAR; PG8_SCHED;
            PG8_LDA(At, 0, 1); PG8_STAGE(PG8_SB(0, 0), b2, voffB); PG8_STAGE(PG8_SB(0, 1), b2 + hstep, voffB); PG8_STAGE(PG8_SA(0, 0), a2, voffA);
            PG8_WAIT_V(8); PG8_WAIT_L(0); PG8_BAR; PG8_MMA(1, 0, At, B0); PG8_MMA(1, 1, At, B1); PG8_BAR; PG8_SCHED;
            PG8_LDB(B0, 1, 0); PG8_LDB(B1, 1, 1); PG8_SCHED; PG8_LDA(At, 1, 0); PG8_STAGE(PG8_SA(0, 1), a2 + hstep, voffA);
            PG8_WAIT_V(8); PG8_WAIT_L(0); PG8_BAR; PG8_MMA(0, 0, At, B0); PG8_MMA(0, 1, At, B1); PG8_BAR; PG8_SCHED;
            PG8_LDA(At, 1, 1); PG8_STAGE(PG8_SB(1, 0), b3, voffB); PG8_STAGE(PG8_SB(1, 1), b3 + hstep, voffB); PG8_STAGE(PG8_SA(1, 0), a3, voffA);
            PG8_WAIT_V(8); PG8_WAIT_L(0); PG8_BAR; PG8_MMA(1, 0, At, B0); PG8_MMA(1, 1, At, B1); PG8_BAR; PG8_SCHED;
            } else {
            PG8_LDB(B0, 0, 0); PG8_SCHED; PG8_LDA(At, 0, 0); PG8_STAGE(PG8_SA(1, 1), a1 + hstep, voffA);
            PG8_WAIT_L(8); PG8_BAR; PG8_WAIT_L(0); PG8_MMA(0, 0, At, B0); PG8_BAR; PG8_SCHED;
            PG8_LDB(B1, 0, 1); PG8_STAGE(PG8_SB(0, 0), b2, voffB);
            PG8_BAR; PG8_WAIT_L(0); PG8_MMA(0, 1, At, B1); PG8_BAR;
            PG8_LDA(At, 0, 1); PG8_STAGE(PG8_SA(0, 0), a2, voffA);
            PG8_BAR; PG8_WAIT_L(0); PG8_MMA(1, 0, At, B0); PG8_BAR; PG8_SCHED;
            PG8_STAGE(PG8_SB(0, 1), b2 + hstep, voffB);
            PG8_WAIT_V(6); PG8_BAR; PG8_MMA(1, 1, At, B1); PG8_BAR;
            PG8_LDB(B0, 1, 0); PG8_SCHED; PG8_LDA(At, 1, 0); PG8_STAGE(PG8_SA(0, 1), a2 + hstep, voffA);
            PG8_WAIT_L(8); PG8_BAR; PG8_WAIT_L(0); PG8_MMA(0, 0, At, B0); PG8_BAR; PG8_SCHED;
            PG8_LDB(B1, 1, 1); PG8_STAGE(PG8_SB(1, 0), b3, voffB);
            PG8_BAR; PG8_WAIT_L(0); PG8_MMA(0, 1, At, B1); PG8_BAR;
            PG8_LDA(At, 1, 1); PG8_STAGE(PG8_SA(1, 0), a3, voffA);
            PG8_BAR; PG8_WAIT_L(0); PG8_MMA(1, 0, At, B0); PG8_BAR; PG8_SCHED;
            PG8_STAGE(PG8_SB(1, 1), b3 + hstep, voffB);
            PG8_WAIT_V(6); PG8_BAR; PG8_MMA(1, 1, At, B1); PG8_BAR;
            }
        }
        if constexpr (ALIGN_EPI) { if (wr == 0) PG8_BAR; }
        if constexpr (!Epi::AFTER_DRAIN) { E(acc, cur, wr, wc, fr, fq); S.done(cur); }
        if (!has_next) break;
#pragma unroll
        for (int a = 0; a < 2; ++a)
#pragma unroll
            for (int b = 0; b < 2; ++b)
#pragma unroll
                for (int m = 0; m < 4; ++m)
#pragma unroll
                    for (int n = 0; n < 2; ++n) acc[a][b][m][n] = (f32x4){0.f, 0.f, 0.f, 0.f};
        cur = nxt; cA = nA; cB = nB; ++ui;
        if constexpr (ALIGN_EPI) { if (wr == 1) PG8_BAR; }
    }
    PG8_WAIT_V(0);
    if constexpr (!ALIGN_EPI) { if (wr == 0) PG8_BAR; }
    PG8_BAR;
    if constexpr (Epi::AFTER_DRAIN) { E.fused(acc, cur, wr, wc, fr, fq, lds, wid, lane); S.done(cur); }
#undef PG8_SA
#undef PG8_SB
#undef PG8_STAGE
#undef PG8_LDA
#undef PG8_LDB
#undef PG8_MMA
#undef PG8_WAIT_V
#undef PG8_WAIT_L
#undef PG8_BAR
#undef PG8_SCHED
}
}


constexpr int NWAVES = 8, NTHREADS = 512;
constexpr int DM = 2048, SEQ = 4096, NBP = 2, NROWP = 8192, NBS = 8, NSS = 16, NROWS = 128, NROW = 8320, MPAD = 8448, INDIM = 4864, DEPTH = 4;
constexpr int ZP = INDIM;
constexpr int ZC_U = 0, ZC_GA = 1024, ZC_Q = 1536, ZC_K = 2560, ZC_V = 2688, ZC_GB = 2816, ZC_CQ = 3840, ZC_GC = 4352;
constexpr float LOG2E = 1.4426950408889634f;
using pg8::OFF_YP; using pg8::OFF_YS; using pg8::OFF_KP; using pg8::OFF_VP; using pg8::OFF_CP; using pg8::OFF_MKP; using pg8::OFF_MVP; using pg8::OFF_KS; using pg8::OFF_VS; using pg8::OFF_CS; using pg8::OUT_TOTAL;

constexpr size_t MiB = 1u << 20;
constexpr size_t WS_CTL = 0, CTL_ZERO_BYTES = 1 * MiB;
constexpr size_t WS_BT = 1 * MiB;
constexpr size_t WS_SSQ = 2 * MiB;
constexpr size_t WS_WIN = 4 * MiB;
constexpr size_t WS_WOUT = 80 * MiB;
constexpr size_t WS_WMEM = 112 * MiB;
constexpr size_t WS_WPW = 128 * MiB;
constexpr size_t WS_MEMN = 130 * MiB;
constexpr size_t WS_MKVP = 132 * MiB;
constexpr size_t WS_CMK = 136 * MiB, WS_CMV = 144 * MiB;
constexpr size_t WS_CSK = 152 * MiB, WS_CSV = 153 * MiB;
constexpr size_t WS_XB = 154 * MiB;
constexpr size_t WS_X = 187 * MiB;
constexpr size_t WS_Z = 253 * MiB;
constexpr size_t WS_YMIX = 332 * MiB;
constexpr size_t WS_END = 365 * MiB;
constexpr int CW_BAR = 4096;

constexpr int RING_BYTES = 131072;
constexpr int LDSCTL_OFF = 158720, MISC_OFF = LDSCTL_OFF + 320;
constexpr int LDS_BYTES = 159744;


#define GAS __attribute__((address_space(1)))
#define LAS __attribute__((address_space(3)))
typedef unsigned short bf16;
typedef unsigned v4u __attribute__((ext_vector_type(4)));
typedef float f32x4 __attribute__((ext_vector_type(4)));
typedef short bf16x8 __attribute__((ext_vector_type(8)));
typedef GAS unsigned gu32;
typedef GAS unsigned long long gu64;
#define RLX_AGENT __ATOMIC_RELAXED, __HIP_MEMORY_SCOPE_AGENT
#define LDS_WAIT() asm volatile("s_waitcnt lgkmcnt(0)" ::: "memory")
#define VM_WAIT() asm volatile("s_waitcnt vmcnt(0)" ::: "memory")
__device__ __forceinline__ unsigned long long rt() { return __builtin_amdgcn_s_memrealtime(); }
__device__ __forceinline__ unsigned f2bf(float f) { unsigned u = __builtin_bit_cast(unsigned, f); return (u + 0x7fffu + ((u >> 16) & 1u)) >> 16; }
__device__ __forceinline__ unsigned pk2(float lo, float hi) { return f2bf(lo) | (f2bf(hi) << 16); }

#define XB_TMO      128
#define XB_XCNT(j)  (256  + 64 * (j))
#define XB_XSUB(j)  (1280 + 64 * (j))
#define XB_XGEN(j)  (2304 + 64 * (j))
#define XB_TOP      3328
#define XB_TOPGEN   3392
#define XCD_BAR_WORDS 3456
#define XB_SPIN_CAP (1u << 18)

__device__ __forceinline__ unsigned xb_ld(unsigned* p)              { return __hip_atomic_load(p, __ATOMIC_RELAXED, __HIP_MEMORY_SCOPE_AGENT); }
__device__ __forceinline__ unsigned xb_add(unsigned* p, unsigned v) { return __hip_atomic_fetch_add(p, v, __ATOMIC_RELAXED, __HIP_MEMORY_SCOPE_AGENT); }
__device__ __forceinline__ unsigned xb_xcc_id() { return (unsigned)__builtin_amdgcn_s_getreg((3 << 11) | 20) & 0xFu; }
#define XB_SPIN(cond, bar) do { unsigned _sp = 0; while (cond) { __builtin_amdgcn_s_sleep(1); \
    if ((++_sp & 255u) == 0u) { if (xb_ld(&(bar)[XB_TMO])) break; if (_sp > XB_SPIN_CAP) { atomicAdd(&(bar)[XB_TMO], 1u); break; } } } } while (0)

struct XcdBarrier {
    unsigned* bar; unsigned x;
    volatile LAS unsigned* st;
};

__device__ __forceinline__ XcdBarrier xcd_barrier_post(unsigned* bar, volatile LAS unsigned* st) {
    XcdBarrier b; b.bar = bar; b.x = xb_xcc_id(); b.st = st;
    if (threadIdx.x == 0) (void)xb_add(&bar[XB_XCNT(b.x)], 1u);
    return b;
}
__device__ __forceinline__ void xcd_barrier_complete(unsigned* bar, unsigned x, unsigned& nloc, unsigned& nx) {
    const unsigned G = gridDim.x * gridDim.y * gridDim.z;
    unsigned sum, cnt, mine, sp = 0u;
    for (;;) {
        sum = 0u; cnt = 0u; mine = 0u;
#pragma unroll
        for (unsigned j = 0; j < 16; ++j) { const unsigned c = xb_ld(&bar[XB_XCNT(j)]); sum += c; cnt += (c > 0u) ? 1u : 0u; mine = (j == x) ? c : mine; }
        if (sum == G) break;
        __builtin_amdgcn_s_sleep(1);
        if ((++sp & 255u) == 0u) { if (xb_ld(&bar[XB_TMO])) break; if (sp > XB_SPIN_CAP) { atomicAdd(&bar[XB_TMO], 1u); break; } }
    }
    nloc = mine > 0u ? mine : 1u; nx = cnt > 0u ? cnt : 1u;
}

__device__ __forceinline__ void xcd_barrier(const XcdBarrier& b) {
    asm volatile("s_waitcnt vmcnt(0)" ::: "memory");
    __syncthreads();
    if (threadIdx.x == 0) {
        unsigned* bar = b.bar;
        __builtin_amdgcn_s_waitcnt(0);
        unsigned nloc = b.st[0], nx = b.st[1];
        if (nloc == 0u) { xcd_barrier_complete(bar, b.x, nloc, nx); b.st[0] = nloc; b.st[1] = nx; }
        const unsigned old = xb_add(&bar[XB_XSUB(b.x)], 1u);
        const unsigned gen = old / nloc;
        if (old + 1u == (gen + 1u) * nloc) {
            __builtin_amdgcn_fence(__ATOMIC_RELEASE, "agent");
            asm volatile("s_waitcnt vmcnt(0)" ::: "memory");
            const unsigned og = xb_add(&bar[XB_TOP], 1u);
            const unsigned tg = og / nx;
            if (og + 1u == (tg + 1u) * nx) xb_add(&bar[XB_TOPGEN], 1u);
            else XB_SPIN(xb_ld(&bar[XB_TOPGEN]) == tg, bar);
            __builtin_amdgcn_fence(__ATOMIC_ACQUIRE, "agent");
            xb_add(&bar[XB_XGEN(b.x)], 1u);
            asm volatile("s_waitcnt vmcnt(0)" ::: "memory");
        } else {
            XB_SPIN(xb_ld(&bar[XB_XGEN(b.x)]) == gen, bar);
            __builtin_amdgcn_fence(__ATOMIC_ACQUIRE, "agent");
            asm volatile("s_waitcnt vmcnt(0)" ::: "memory");
        }
    }
    __syncthreads();
}


struct Args { const float* in[22]; float* out; unsigned char* ws; int ph_lo, ph_hi; };
struct Frame {
    LAS unsigned char* lds; unsigned char* glds;
    volatile LAS unsigned* MISC;
    gu32* ctl;
    int tid, lane, wave, vcu, G;
};
__device__ __forceinline__ float wave_sum(float v) {
#pragma unroll
    for (int o = 1; o < 64; o <<= 1) v += __shfl_xor(v, o);
    return v;
}
__device__ __forceinline__ float wave_max(float v) {
#pragma unroll
    for (int o = 1; o < 64; o <<= 1) v = fmaxf(v, __shfl_xor(v, o));
    return v;
}
__device__ __forceinline__ int opaque_tid() { int t = threadIdx.x; asm volatile("" : "+v"(t)); return t; }
__device__ __forceinline__ float bf2f(bf16 v) { return __builtin_bit_cast(float, (unsigned)v << 16); }
__device__ __forceinline__ float rbf(float f) { return __builtin_bit_cast(float, f2bf(f) << 16); }

__device__ __forceinline__ void p0_transpose_item(const float* W, int K, int N, const float* g, bf16* WT, int k0, int n0, int dst_row0, LAS float* scr, int lane) {
#pragma unroll 8
    for (int i = 0; i < 32; ++i) { const int kk = 2 * i + (lane >> 5); float v = W[(size_t)(k0 + kk) * N + n0 + (lane & 31)]; if (g) v *= g[k0 + kk]; scr[kk * 33 + (lane & 31)] = v; }
    LDS_WAIT(); asm volatile("" ::: "memory");
    const int c = lane & 7;
#pragma unroll
    for (int j = 0; j < 4; ++j) { const int n = (lane >> 3) + 8 * j; const LAS float* s = scr + (8 * c) * 33 + n;
        v4u o; o.x = pk2(s[0 * 33], s[1 * 33]); o.y = pk2(s[2 * 33], s[3 * 33]); o.z = pk2(s[4 * 33], s[5 * 33]); o.w = pk2(s[6 * 33], s[7 * 33]);
        *(GAS v4u*)(WT + (size_t)(dst_row0 + n) * K + k0 + 8 * c) = o; }
    LDS_WAIT(); asm volatile("" ::: "memory");
}
__device__ __forceinline__ int t5_bucket(int rel) {
    const int side = rel > 0 ? 16 : 0, n = rel < 0 ? -rel : rel;
    const int large = 8 + (n >= 12) + (n >= 16) + (n >= 23) + (n >= 32) + (n >= 46) + (n >= 64) + (n >= 91);
    return side + (n < 8 ? n : large);
}
__device__ __forceinline__ void p0_prologue(Frame& F, const Args& A) {
    unsigned char* ws = A.ws;
    const int tid_ = opaque_tid(), lane = tid_ & 63, wave_ = __builtin_amdgcn_readfirstlane(tid_ >> 6);
    const int gw = F.vcu * NWAVES + wave_, NGW = F.G * NWAVES;
    LAS float* scr = (LAS float*)(F.lds + wave_ * 16384);
    constexpr int I_IN = 32 * 152, I_OUT = 32 * 64, I_MEM = 32 * 32, I_PW = 8 * 16;
    constexpr int NITEMS = DEPTH * (I_IN + I_OUT + I_MEM + I_PW);
    for (int it = gw; it < NITEMS; it += NGW) {
        int r = it;
        if (r < DEPTH * I_IN) { const int l = r / I_IN, q = r % I_IN, kb = q / 152, nb = q % 152, n0 = nb * 32;
            int dst; if (n0 < 512) dst = 256 * (n0 >> 7) + (n0 & 127); else if (n0 < 1024) dst = 256 * ((n0 - 512) >> 7) + 128 + (n0 & 127); else dst = n0;
            p0_transpose_item(A.in[9] + (size_t)l * DM * INDIM, DM, INDIM, A.in[8] + l * DM, (bf16*)(ws + WS_WIN) + (size_t)l * INDIM * DM, kb * 64, n0, dst, scr, lane); continue; }
        r -= DEPTH * I_IN;
        if (r < DEPTH * I_OUT) { const int l = r / I_OUT, q = r % I_OUT, kb = q / 64, nb = q % 64;
            p0_transpose_item(A.in[20] + (size_t)l * DM * DM, DM, DM, nullptr, (bf16*)(ws + WS_WOUT) + (size_t)l * DM * DM, kb * 64, nb * 32, nb * 32, scr, lane); continue; }
        r -= DEPTH * I_OUT;
        if (r < DEPTH * I_MEM) { const int l = r / I_MEM, q = r % I_MEM, kb = q / 32, nb = q % 32;
            p0_transpose_item(A.in[18] + (size_t)l * DM * 1024, DM, 1024, A.in[17] + l * DM, (bf16*)(ws + WS_WMEM) + (size_t)l * 1024 * DM, kb * 64, nb * 32, nb * 32, scr, lane); continue; }
        r -= DEPTH * I_MEM;
        { const int l = r / I_PW, q = r % I_PW, kb = q / 16, nb = q % 16;
            p0_transpose_item(A.in[14] + (size_t)l * 512 * 512, 512, 512, nullptr, (bf16*)(ws + WS_WPW) + (size_t)l * 512 * 512, kb * 64, nb * 32, nb * 32, scr, lane); }
    }
    float* X = (float*)(ws + WS_X); bf16* XB = (bf16*)(ws + WS_XB); float* SSQ = (float*)(ws + WS_SSQ);
    for (int m = gw; m < MPAD; m += NGW) {
        GAS unsigned long long* o8 = (GAS unsigned long long*)(XB + (size_t)m * DM) + lane;
        if (m >= NROW) {
#pragma unroll
            for (int j = 0; j < 8; ++j) o8[64 * j] = 0ull;
            continue;
        }
        const float* src = (m < NROWP) ? A.in[0] + (size_t)m * DM : A.in[1] + (size_t)(m - NROWP) * DM;
        const GAS f32x4* xr = (const GAS f32x4*)src + lane;
        GAS f32x4* xo = (GAS f32x4*)(X + (size_t)m * DM) + lane;
        float s = 0.f;
#pragma unroll
        for (int j = 0; j < 8; ++j) { const f32x4 v = xr[64 * j]; xo[64 * j] = v; s += (v.x * v.x + v.y * v.y) + (v.z * v.z + v.w * v.w);
            o8[64 * j] = (unsigned long long)pk2(v.x, v.y) | ((unsigned long long)pk2(v.z, v.w) << 32); }
        s = wave_sum(s);
        if (lane < 32) SSQ[(size_t)m * 32 + lane] = (lane == 0) ? s : 0.f;
    }
    for (int m = gw; m < 512; m += NGW) {
        const GAS f32x4* xr = (const GAS f32x4*)(A.in[2] + (size_t)m * DM) + lane;
        f32x4 v[8]; float s = 0.f;
#pragma unroll
        for (int j = 0; j < 8; ++j) { v[j] = xr[64 * j]; s += (v[j].x * v[j].x + v[j].y * v[j].y) + (v[j].z * v[j].z + v[j].w * v[j].w); }
        const float rstd = 1.0f / sqrtf(wave_sum(s) * (1.0f / DM) + 1e-6f);
        GAS unsigned long long* o8 = (GAS unsigned long long*)((bf16*)(ws + WS_MEMN) + (size_t)m * DM) + lane;
#pragma unroll
        for (int j = 0; j < 8; ++j) o8[64 * j] = (unsigned long long)pk2(v[j].x * rstd, v[j].y * rstd) | ((unsigned long long)pk2(v[j].z * rstd, v[j].w * rstd) << 32);
    }
    const int gt = gw * 64 + lane, NGT = NGW * 64;
    {
        const f32x4* sk = (const f32x4*)A.in[6]; const f32x4* sv = (const f32x4*)A.in[7];
        unsigned long long* dk = (unsigned long long*)(ws + WS_CMK); unsigned long long* dv = (unsigned long long*)(ws + WS_CMV);
        for (int i = gt; i < 1048576; i += NGT) { const f32x4 a = sk[i], b = sv[i];
            dk[i] = (unsigned long long)pk2(a.x, a.y) | ((unsigned long long)pk2(a.z, a.w) << 32);
            dv[i] = (unsigned long long)pk2(b.x, b.y) | ((unsigned long long)pk2(b.z, b.w) << 32); }
        const f32x4* ck = (const f32x4*)A.in[3]; const f32x4* cv = (const f32x4*)A.in[4];
        unsigned long long* ek = (unsigned long long*)(ws + WS_CSK); unsigned long long* ev = (unsigned long long*)(ws + WS_CSV);
        for (int i = gt; i < 131072; i += NGT) { const f32x4 a = ck[i], b = cv[i];
            ek[i] = (unsigned long long)pk2(a.x, a.y) | ((unsigned long long)pk2(a.z, a.w) << 32);
            ev[i] = (unsigned long long)pk2(b.x, b.y) | ((unsigned long long)pk2(b.z, b.w) << 32);
            const int lb = i >> 12, rem = i & 4095, row = rem >> 5, c4 = rem & 31;
            if (row >= 16) { const size_t o = ((size_t)lb * 128 + (row - 16)) * 128 + c4 * 4;
                *(f32x4*)(A.out + OFF_KS + o) = a; *(f32x4*)(A.out + OFF_VS + o) = b; } }
        const f32x4* cc = (const f32x4*)A.in[5];
        for (int i = gt; i < 32 * 30 * 128; i += NGT) { const int lb = i / 3840, rem = i % 3840, row = rem >> 7, c4 = rem & 127;
            if (row >= 16) *(f32x4*)(A.out + OFF_CS + ((size_t)lb * 30 + (row - 16)) * 512 + c4 * 4) = cc[i]; }
        float* BT = (float*)(ws + WS_BT);
        for (int i = gt; i < 16 * 256; i += NGT) { const int h = i >> 8, idx = i & 255; const int rel = idx - 191;
            BT[i] = (idx < 255) ? A.in[19][t5_bucket(rel) * 16 + h] * LOG2E : 0.f; }
    }
}

struct KSrc { const bf16* p0; int pitch0; int n0; const bf16* p1; int pitch1; };
__device__ __forceinline__ const bf16* ks_row(const KSrc& s, int j) { return j < s.n0 ? s.p0 + (long)j * s.pitch0 : s.p1 + (long)(j - s.n0) * s.pitch1; }

template <int HD, bool SWA>
__device__ __forceinline__ void naive_attn(float* S, float* INV, const bf16* Q, int qpitch, int nq, KSrc ks, KSrc vs, int jlo, int nk,
                                           const float* btab, float sink2, const bf16* gate, int gpitch, bf16* out, int opitch) {
    const int tid = opaque_tid(), lane = tid & 63, wave = tid >> 6;
#pragma unroll 1
    for (int idx = tid; idx < nq * nk; idx += NTHREADS) {
        const int i = idx / nk, j = idx - i * nk;
        float s;
        if (j < jlo) s = -1e30f;
        else {
            const bf16* q = Q + (long)i * qpitch; const bf16* k = ks_row(ks, j);
            float a = 0.f;
#pragma unroll 2
            for (int d = 0; d < HD; d += 8) {
                const v4u qv = *(const v4u*)(q + d), kv = *(const v4u*)(k + d);
                a += __builtin_bit_cast(float, qv.x << 16) * __builtin_bit_cast(float, kv.x << 16) + __builtin_bit_cast(float, qv.x & 0xffff0000u) * __builtin_bit_cast(float, kv.x & 0xffff0000u);
                a += __builtin_bit_cast(float, qv.y << 16) * __builtin_bit_cast(float, kv.y << 16) + __builtin_bit_cast(float, qv.y & 0xffff0000u) * __builtin_bit_cast(float, kv.y & 0xffff0000u);
                a += __builtin_bit_cast(float, qv.z << 16) * __builtin_bit_cast(float, kv.z << 16) + __builtin_bit_cast(float, qv.z & 0xffff0000u) * __builtin_bit_cast(float, kv.z & 0xffff0000u);
                a += __builtin_bit_cast(float, qv.w << 16) * __builtin_bit_cast(float, kv.w << 16) + __builtin_bit_cast(float, qv.w & 0xffff0000u) * __builtin_bit_cast(float, kv.w & 0xffff0000u);
            }
            s = a; if (SWA) s += btab[j - i + 63];
        }
        S[i * 257 + j] = s;
    }
    __syncthreads();
    for (int i = wave; i < nq; i += NWAVES) {
        float m = SWA ? sink2 : -3.0e38f;
        for (int j = lane; j < nk; j += 64) m = fmaxf(m, S[i * 257 + j]);
        m = wave_max(m);
        float sum = 0.f;
        for (int j = lane; j < nk; j += 64) { const float p = exp2f(S[i * 257 + j] - m); sum += p; S[i * 257 + j] = rbf(p); }
        sum = wave_sum(sum);
        if (SWA) sum += exp2f(sink2 - m);
        if (lane == 0) INV[i] = 1.0f / sum;
    }
    __syncthreads();
#pragma unroll 1
    for (int idx = tid; idx < nq * HD; idx += NTHREADS) {
        const int i = idx / HD, d = idx % HD;
        float o = 0.f;
#pragma unroll 4
        for (int j = jlo; j < nk; ++j) o += S[i * 257 + j] * bf2f(ks_row(vs, j)[d]);
        o *= INV[i];
        o *= bf2f(gate[(long)i * gpitch + d]);
        out[(long)i * opitch + d] = (bf16)f2bf(o);
    }
    __syncthreads();
}

__device__ __forceinline__ void naive_conv(float* C, const bf16* Useq, int t0, int nfr, const float* left, const float* cw, const float* cb, const float* lng, const float* lnb,
                                           const float* wpw  , const float* bpw, const bf16* gate  , bf16* out  ) {
    const int tid = opaque_tid(), lane = tid & 63, wave = tid >> 6;
    {
        const int ch = tid;
        float w[31];
#pragma unroll
        for (int j = 0; j < 31; ++j) w[j] = cw[j * 512 + ch];
        const float b = cb[ch];
#pragma unroll 1
        for (int tt = 0; tt < 64; ++tt) {
            float a = 0.f;
            if (tt < nfr) {
                a = b;
#pragma unroll
                for (int j = 0; j < 31; ++j) { const int e = t0 + tt - 30 + j;
                    const float uv = (e >= 0) ? bf2f(Useq[(long)e * ZP + ch]) : (left ? left[(30 + e) * 512 + ch] : 0.f);
                    a += w[j] * uv; }
            }
            C[tt * 516 + ch] = a;
        }
    }
    __syncthreads();
    for (int tt = wave; tt < 64; tt += NWAVES) {
        float v[8]; float s = 0.f;
#pragma unroll
        for (int j = 0; j < 8; ++j) { v[j] = C[tt * 516 + lane + 64 * j]; s += v[j]; }
        const float mu = wave_sum(s) * (1.0f / 512.0f); float q = 0.f;
#pragma unroll
        for (int j = 0; j < 8; ++j) { v[j] -= mu; q += v[j] * v[j]; }
        const float rstd = 1.0f / sqrtf(wave_sum(q) * (1.0f / 512.0f) + 1e-6f);
#pragma unroll
        for (int j = 0; j < 8; ++j) { const int ch = lane + 64 * j; const float y = v[j] * rstd * lng[ch] + lnb[ch]; C[tt * 516 + ch] = rbf(y / (1.0f + __expf(-y))); }
    }
    __syncthreads();
    {
        const int n = tid;
        const float bb = bpw[n];
#pragma unroll 1
        for (int tg = 0; tg < 64; tg += 16) {
            if (tg >= nfr) break;
            float acc[16];
#pragma unroll
            for (int tt = 0; tt < 16; ++tt) acc[tt] = 0.f;
#pragma unroll 1
            for (int k = 0; k < 512; k += 4) {
                const float w0 = rbf(wpw[(size_t)(k + 0) * 512 + n]), w1 = rbf(wpw[(size_t)(k + 1) * 512 + n]), w2 = rbf(wpw[(size_t)(k + 2) * 512 + n]), w3 = rbf(wpw[(size_t)(k + 3) * 512 + n]);
#pragma unroll
                for (int tt = 0; tt < 16; ++tt) { const f32x4 c = *(const f32x4*)(C + (tg + tt) * 516 + k); acc[tt] += (c.x * w0 + c.y * w1) + (c.z * w2 + c.w * w3); }
            }
#pragma unroll
            for (int tt = 0; tt < 16; ++tt) if (tg + tt < nfr) out[(long)(tg + tt) * DM + n] = (bf16)f2bf((acc[tt] + bb) * bf2f(gate[(long)(tg + tt) * ZP + n]));
        }
    }
    __syncthreads();
}

__device__ __forceinline__ void naive_mixer_phase(Frame& F, const Args& A, int l) {
    unsigned char* ws = A.ws;
    float* S = (float*)F.glds;
    float* INV = S + 64 * 257;
    const bf16* Z = (const bf16*)(ws + WS_Z); bf16* Y = (bf16*)(ws + WS_YMIX);
    const float* BT = (const float*)(ws + WS_BT);
    constexpr int U0 = 128, U1 = U0 + 8, U2 = U1 + 512, U3 = U2 + 32, U4 = U3 + 2048, U5 = U4 + 128;
    for (int u = blockIdx.x; u < U5; u += F.G) {
        if (u < U1) {
            int rowbase, t0, nfr; const float* left = nullptr;
            if (u < U0) { const int b = u >> 6, c = u & 63; rowbase = b * SEQ; t0 = c * 64; nfr = 64; }
            else { const int b = u - U0; rowbase = NROWP + b * NSS; t0 = 0; nfr = NSS; left = A.in[5] + (size_t)(l * 8 + b) * 30 * 512; }
            naive_conv(S, Z + (size_t)rowbase * ZP + ZC_U, t0, nfr, left, A.in[10] + l * 31 * 512, A.in[11] + l * 512, A.in[12] + l * 512, A.in[13] + l * 512,
                       A.in[14] + (size_t)l * 512 * 512, A.in[15] + l * 512, Z + (size_t)(rowbase + t0) * ZP + ZC_GA, Y + (size_t)(rowbase + t0) * DM);
        } else if (u < U3) {
            int row0, nq, h; KSrc ks, vs;
            if (u < U2) { const int v = u - U1, b = v >> 8, h_ = (v >> 6) & 3, qt = v & 63; h = h_; row0 = b * SEQ + qt * 64; nq = 64;
                const bf16* kb = (const bf16*)(ws + WS_MKVP) + (size_t)(b * 256) * 4096 + l * 1024 + h * 128;
                ks = KSrc{kb, 4096, 256, kb, 4096}; vs = KSrc{kb + 512, 4096, 256, kb + 512, 4096}; }
            else { const int v = u - U2, b = v >> 2; h = v & 3; row0 = NROWP + b * NSS; nq = NSS;
                const bf16* kb = (const bf16*)(ws + WS_CMK) + (size_t)((l * 8 + b) * 256) * 512 + h * 128; const bf16* vb = (const bf16*)(ws + WS_CMV) + (size_t)((l * 8 + b) * 256) * 512 + h * 128;
                ks = KSrc{kb, 512, 256, kb, 512}; vs = KSrc{vb, 512, 256, vb, 512}; }
            naive_attn<128, false>(S, INV, Z + (size_t)row0 * ZP + ZC_CQ + h * 128, ZP, nq, ks, vs, 0, 256, nullptr, 0.f,
                                   Z + (size_t)row0 * ZP + ZC_GC + h * 128, ZP, Y + (size_t)row0 * DM + 1536 + h * 128, DM);
        } else {
            int row0, nq, h, jlo, nk; KSrc ks, vs;
            if (u < U4) { const int v = u - U3, b = v >> 10, c = (v >> 4) & 63; h = v & 15; row0 = b * SEQ + c * 64; nq = 64; const int kv = h >> 3;
                const bf16* kb = Z + ((long)row0 - 128) * ZP + ZC_K + kv * 64;
                ks = KSrc{kb, ZP, 192, kb, ZP}; vs = KSrc{kb + (ZC_V - ZC_K), ZP, 192, kb + (ZC_V - ZC_K), ZP}; jlo = (c >= 2) ? 0 : 128 - 64 * c; nk = 192; }
            else { const int v = u - U4, b = v >> 4; h = v & 15; row0 = NROWP + b * NSS; nq = NSS; const int kv = h >> 3;
                const bf16* ck = (const bf16*)(ws + WS_CSK) + (size_t)((l * 8 + b) * 128) * 128 + kv * 64; const bf16* cv = (const bf16*)(ws + WS_CSV) + (size_t)((l * 8 + b) * 128) * 128 + kv * 64;
                const bf16* zk = Z + (size_t)row0 * ZP + ZC_K + kv * 64;
                ks = KSrc{ck, 128, 128, zk, ZP}; vs = KSrc{cv, 128, 128, zk + (ZC_V - ZC_K), ZP}; jlo = 0; nk = 144; }
            naive_attn<64, true>(S, INV, Z + (size_t)row0 * ZP + ZC_Q + h * 64, ZP, nq, ks, vs, jlo, nk, BT + h * 256, A.in[16][l * 16 + h] * LOG2E,
                                 Z + (size_t)row0 * ZP + ZC_GB + h * 64, ZP, Y + (size_t)row0 * DM + 512 + h * 64, DM);
        }
    }
}

__device__ __forceinline__ void final_norm_phase(Frame& F, const Args& A) {
    const float* X = (const float*)(A.ws + WS_X); const float* SSQ = (const float*)(A.ws + WS_SSQ); const float* g = A.in[21];
    const int tid_ = opaque_tid(), lane = tid_ & 63, wave_ = __builtin_amdgcn_readfirstlane(tid_ >> 6);
    const int gw = F.vcu * NWAVES + wave_, NGW = F.G * NWAVES;
    f32x4 gv[8];
#pragma unroll
    for (int j = 0; j < 8; ++j) gv[j] = ((const f32x4*)g)[lane + 64 * j];
    for (int m = gw; m < NROW; m += NGW) {
        float s = (lane < 32) ? SSQ[(size_t)m * 32 + lane] : 0.f;
        s = wave_sum(s);
        const float rstd = 1.0f / sqrtf(s * (1.0f / DM) + 1e-6f);
        const f32x4* xr = (const f32x4*)(X + (size_t)m * DM) + lane;
        f32x4* o = (f32x4*)(A.out + (m < NROWP ? OFF_YP + (size_t)m * DM : OFF_YS + (size_t)(m - NROWP) * DM)) + lane;
#pragma unroll
        for (int j = 0; j < 8; ++j) o[64 * j] = xr[64 * j] * rstd * gv[j];
    }
}

constexpr int N_PHASES = 2 + 3 * DEPTH;
#ifndef MK_SINGLE
#define MK_SINGLE 1
#endif
__global__ void __launch_bounds__(NTHREADS, 2) mk_fwd(Args args) {
    extern __shared__ __attribute__((aligned(16))) unsigned char lds[];
    Frame F;
    F.lds = (LAS unsigned char*)lds; F.glds = lds;
    F.MISC = (volatile LAS unsigned*)(F.lds + MISC_OFF);
    F.tid = threadIdx.x; F.lane = F.tid & 63; F.wave = __builtin_amdgcn_readfirstlane(F.tid >> 6);
    F.G = gridDim.x; { const int bx = blockIdx.x; F.vcu = (F.G % 8 == 0) ? (bx % 8) * (F.G / 8) + bx / 8 : bx; }
    unsigned char* ws = args.ws;
    F.ctl = (gu32*)(ws + WS_CTL);
    for (int u = F.tid; u < (LDS_BYTES - LDSCTL_OFF) / 4; u += NTHREADS) ((LAS unsigned*)(F.lds + LDSCTL_OFF))[u] = 0u;
    __syncthreads();
    XcdBarrier bar; bar.bar = (unsigned*)(F.ctl + CW_BAR); bar.x = 0; bar.st = nullptr;
    const int lo = args.ph_lo, hi = args.ph_hi;
    const bool multi = (hi - lo) > 1;
    if (multi) bar = xcd_barrier_post((unsigned*)(F.ctl + CW_BAR), F.MISC + 8);
#define SEAM(k) do { if (lo <= (k) && (k) + 1 < hi) xcd_barrier(bar); } while (0)
#define IN(k) (lo <= (k) && (k) < hi)
    if (IN(0)) { p0_prologue(F, args); SEAM(0); }
    if (IN(1)) {
        unsigned char* wsl = ws; asm volatile("" : "+s"(wsl));
        pg8::Gemm g{(const pg8::bf16_t*)(wsl + WS_MEMN), (const pg8::bf16_t*)(wsl + WS_WMEM), 512, 4096, DM};
        pg8::StaticOrder S; S.init(512, 4096, F.G, (int)(F.G - 1 - blockIdx.x));
        pg8::EpiMemKV E{(pg8::bf16_t*)(wsl + WS_MKVP), args.out};
        pg8::gemm_phase<pg8::EpiMemKV, pg8::StaticOrder, true, true>(F.lds, g, S, E);
    }
#pragma unroll 1
    for (int l = 0; l < DEPTH; ++l) {
        const int p1 = 1 + 3 * l, p2 = p1 + 1, p3 = p1 + 2;
        unsigned char* wsl = ws; asm volatile("" : "+s"(wsl));
        if (IN(p1)) {
            pg8::Gemm g{(const pg8::bf16_t*)(wsl + WS_XB), (const pg8::bf16_t*)(wsl + WS_WIN) + (size_t)l * INDIM * DM, MPAD, INDIM, DM};
            pg8::StaticOrder S; S.init(MPAD, INDIM, F.G, (int)blockIdx.x);
            pg8::EpiIn E{(pg8::bf16_t*)(wsl + WS_Z), (const float*)(wsl + WS_SSQ), args.out, l};
            pg8::gemm_phase<pg8::EpiIn, pg8::StaticOrder, true, true>(F.lds, g, S, E);
            SEAM(p1);
        }
        if (IN(p2)) { naive_mixer_phase(F, args, l); SEAM(p2); }
        if (IN(p3)) {
            pg8::Gemm g{(const pg8::bf16_t*)(wsl + WS_YMIX), (const pg8::bf16_t*)(wsl + WS_WOUT) + (size_t)l * DM * DM, MPAD, DM, DM};
            pg8::StaticOrder S; S.init(MPAD, DM, F.G, (int)blockIdx.x);
            pg8::EpiOut E{(float*)(wsl + WS_X), (pg8::bf16_t*)(wsl + WS_XB), (float*)(wsl + WS_SSQ)};
            pg8::gemm_phase<pg8::EpiOut, pg8::StaticOrder, true, true>(F.lds, g, S, E);
            SEAM(p3);
        }
    }
    if (IN(N_PHASES - 1)) final_norm_phase(F, args);
#undef SEAM
#undef IN
}

extern "C" void kernel_launch(void* const* d_in, const int* in_sizes, int n_in, void* d_out, int out_size, void* d_ws, size_t ws_size, hipStream_t stream) {
    static int grid = 0;
    if (grid == 0) {
        if (n_in != 22 || out_size != (int)OUT_TOTAL || ws_size < WS_END) { fprintf(stderr, "kernel_launch: unexpected shapes: n_in %d out %d ws %zu\n", n_in, out_size, ws_size); grid = -1; return; }
        int dev = 0, cus = 0, per_cu = 0;
        if (hipGetDevice(&dev) != hipSuccess || hipDeviceGetAttribute(&cus, hipDeviceAttributeMultiprocessorCount, dev) != hipSuccess) { grid = -1; return; }
        if (hipFuncSetAttribute((const void*)mk_fwd, hipFuncAttributeMaxDynamicSharedMemorySize, LDS_BYTES) != hipSuccess) { fprintf(stderr, "kernel_launch: hipFuncSetAttribute failed\n"); grid = -1; return; }
        if (hipOccupancyMaxActiveBlocksPerMultiprocessor(&per_cu, (const void*)mk_fwd, NTHREADS, LDS_BYTES) != hipSuccess || per_cu < 1) { fprintf(stderr, "kernel_launch: occupancy query says %d blocks per CU\n", per_cu); (void)hipGetLastError(); grid = -1; return; }
        grid = cus;
    }
    if (grid < 0) return;
    (void)hipMemsetAsync((char*)d_ws + WS_CTL, 0, CTL_ZERO_BYTES, stream);
    Args a{};
    for (int i = 0; i < 22; ++i) a.in[i] = (const float*)d_in[i];
    a.out = (float*)d_out; a.ws = (unsigned char*)d_ws;
#if MK_SINGLE
    a.ph_lo = 0; a.ph_hi = N_PHASES;
    hipLaunchKernelGGL(mk_fwd, dim3(grid), dim3(NTHREADS), LDS_BYTES, stream, a);
#else
    for (int p = 0; p < N_PHASES; ++p) { a.ph_lo = p; a.ph_hi = p + 1; hipLaunchKernelGGL(mk_fwd, dim3(grid), dim3(NTHREADS), LDS_BYTES, stream, a); }
#endif
}
```

```cpp
#include <hip/hip_runtime.h>
#include <cstdio>
#include <cstdint>

namespace pg8 {
#define PG8_LAS __attribute__((address_space(3)))
typedef unsigned short bf16_t;
typedef short bf16x8 __attribute__((ext_vector_type(8)));
typedef float f32x4 __attribute__((ext_vector_type(4)));
typedef unsigned u32x4 __attribute__((ext_vector_type(4)));
constexpr int BM = 256, BK = 64, HALF = 128, HTB = HALF * BK * 2  , STAGE_BYTES = 8 * HTB, NXCD = 8, WGM = 8;

__host__ __device__ __forceinline__ int lds_byte(int r, int c) { const int st = (r >> 4) * 2 + (c >> 5), rr = r & 15, cc = c & 31, ob = rr * 64 + cc * 2; return st * 1024 + (ob ^ (((ob >> 9) & 1) << 5)); }
__host__ __device__ __forceinline__ void stage_rc(int b, int& R, int& C) { const int st = b / 1024, sb = b % 1024, swz = sb ^ (((sb >> 9) & 1) << 5); R = (st >> 1) * 16 + swz / 64; C = (st & 1) * 32 + (swz % 64) / 2; }
__host__ __device__ __forceinline__ int perm32(int rho) { const int n = rho >> 4, i = rho & 15; return 8 * (i >> 2) + 4 * n + (i & 3); }

struct Unit { int pm, pn; };
struct Gemm { const bf16_t* A; const bf16_t* Bt; int M, N, K; };

struct StaticOrder {
    int nM, nN, nwg, G, c;
    __host__ __device__ void init(int M, int N, int G_, int c_) { nM = M / BM; nN = N / BM; nwg = nM * nN; G = G_; c = c_; }
    __host__ __device__ bool next(int i, Unit& u) const {
        const long L = (long)i * G + c; if (L >= nwg) return false;
        int wgid = (int)L; { const int q = nwg / NXCD, r = nwg % NXCD, xcd = wgid % NXCD, off = wgid / NXCD; wgid = (xcd < r ? xcd * (q + 1) : r * (q + 1) + (xcd - r) * q) + off; }
        const int nig = WGM * nN, gid = wgid / nig, fm = gid * WGM, gsz = (nM - fm) < WGM ? (nM - fm) : WGM;
        u.pm = fm + ((wgid % nig) % gsz); u.pn = (wgid % nig) / gsz; return true;
    }
    __device__ __forceinline__ void a_ready(const Unit&) const {}
    __device__ __forceinline__ void done(const Unit&) const {}
};

__device__ __forceinline__ unsigned cvt_pk_bf16(float lo, float hi) { unsigned r; asm volatile("v_cvt_pk_bf16_f32 %0, %1, %2" : "=v"(r) : "v"(lo), "v"(hi)); return r; }
typedef float f32x2 __attribute__((ext_vector_type(2)));


constexpr int P_D = 2048, P_INDIM = 4864, P_NROW = 8320  , P_MPAD = 8448, P_NSSQ = 32;
constexpr long OFF_YP = 0, OFF_YS = 16777216, OFF_KP = 17039360, OFF_VP = 17170432, OFF_CP = 17301504, OFF_MKP = 17424384, OFF_MVP = 18472960,
               OFF_KS = 19521536, OFF_VS = 20045824, OFF_CS = 20570112, OUT_TOTAL = 21061632;
constexpr float QS_SWA = 0.125f * 1.4426950408889634f;
constexpr float QS_MEM = 0.08838834764831845f * 1.4426950408889634f;

__device__ __forceinline__ float sigmoid_f(float x) { return 1.0f / (1.0f + __expf(-x)); }
__device__ __forceinline__ f32x4 sigmoid4(f32x4 x) { return (f32x4){sigmoid_f(x[0]), sigmoid_f(x[1]), sigmoid_f(x[2]), sigmoid_f(x[3])}; }
__device__ __forceinline__ u32x4 pack8(f32x4 a, f32x4 b) { u32x4 w; w.x = cvt_pk_bf16(a[0], a[1]); w.y = cvt_pk_bf16(a[2], a[3]); w.z = cvt_pk_bf16(b[0], b[1]); w.w = cvt_pk_bf16(b[2], b[3]); return w; }

__device__ __forceinline__ void row_rstd(float (&rs)[2][4], const float* ssq, int rbase, int fq) {
#pragma unroll
    for (int ai = 0; ai < 2; ++ai)
#pragma unroll
        for (int m = 0; m < 4; ++m) {
            const int row = rbase + ai * HALF + m * 16;
            const f32x4* p = (const f32x4*)(ssq + (size_t)row * P_NSSQ + fq * 8);
            const f32x4 a = p[0], b = p[1];
            float s = ((a[0] + a[1]) + (a[2] + a[3])) + ((b[0] + b[1]) + (b[2] + b[3]));
            s += __shfl_xor(s, 16); s += __shfl_xor(s, 32);
            rs[ai][m] = 1.0f / sqrtf(s * (1.0f / (float)P_D) + 1e-6f);
        }
}

struct EpiIn {
    static constexpr bool PERM = true, AFTER_DRAIN = false;
    bf16_t* Z; const float* ssq; float* out; int layer;
    __device__ __forceinline__ void operator()(const f32x4 (&acc)[2][2][4][2], const Unit& u, int wr, int wc, int fr, int fq) const {
        const int pn = u.pn, rbase = u.pm * BM + wr * 64 + fr;
        bf16_t* Z = this->Z; const float* ssq = this->ssq; float* out = this->out;
        asm volatile("" : "+s"(Z), "+s"(ssq), "+s"(out));
        float rs[2][4];
        row_rstd(rs, ssq, rbase, fq);
        const bool tailtile = (u.pm == 15) || (u.pm == 31) || (u.pm == 32);
        if (pn < 4) {
            const int ch0 = 128 * pn + 32 * wc + 8 * fq;
#pragma unroll
            for (int ai = 0; ai < 2; ++ai)
#pragma unroll
                for (int m = 0; m < 4; ++m) {
                    const int row = rbase + ai * HALF + m * 16;
                    if (row >= P_NROW) continue;
                    const float r = rs[ai][m];
                    const f32x4 u0 = (acc[ai][0][m][0] * r) * sigmoid4(acc[ai][1][m][0] * r), u1 = (acc[ai][0][m][1] * r) * sigmoid4(acc[ai][1][m][1] * r);
                    *(u32x4*)(Z + (size_t)row * P_INDIM + ch0) = pack8(u0, u1);
                    if (tailtile) {
                        float* dst = nullptr;
                        if (row < 8192) { const int t = row & 4095, b = row >> 12; if (t >= 4066) dst = out + OFF_CP + ((size_t)(layer * 2 + b) * 30 + (t - 4066)) * 512 + ch0; }
                        else { const int rr = row - 8192, b = rr >> 4, s = rr & 15; dst = out + OFF_CS + ((size_t)(layer * 8 + b) * 30 + 14 + s) * 512 + ch0; }
                        if (dst) { *(f32x4*)dst = u0; *(f32x4*)(dst + 4) = u1; }
                    }
                }
        } else if (pn == 10) {
#pragma unroll
            for (int ai = 0; ai < 2; ++ai)
#pragma unroll
                for (int m = 0; m < 4; ++m) {
                    const int row = rbase + ai * HALF + m * 16;
                    if (row >= P_NROW) continue;
                    const float r = rs[ai][m];
#pragma unroll
                    for (int bj = 0; bj < 2; ++bj) {
                        const f32x4 v0 = acc[ai][bj][m][0] * r, v1 = acc[ai][bj][m][1] * r;
                        const int c128 = 32 * wc + 8 * fq;
                        *(u32x4*)(Z + (size_t)row * P_INDIM + 2560 + 128 * bj + c128) = pack8(v0, v1);
                        if (tailtile) {
                            float* dst = nullptr;
                            if (row < 8192) { const int t = row & 4095, b = row >> 12; if (t >= 3968) dst = out + (bj ? OFF_VP : OFF_KP) + ((size_t)(layer * 2 + b) * 128 + (t - 3968)) * 128 + c128; }
                            else { const int rr = row - 8192, b = rr >> 4, s = rr & 15; dst = out + (bj ? OFF_VS : OFF_KS) + ((size_t)(layer * 8 + b) * 128 + 112 + s) * 128 + c128; }
                            if (dst) { *(f32x4*)dst = v0; *(f32x4*)(dst + 4) = v1; }
                        }
                    }
                }
        } else {
            const bool is_q = (pn >= 6 && pn <= 9), is_cq = (pn == 15 || pn == 16);
            const float qs = is_q ? QS_SWA : QS_MEM;
            const bool gate = !(is_q || is_cq);
#pragma unroll
            for (int ai = 0; ai < 2; ++ai)
#pragma unroll
                for (int m = 0; m < 4; ++m) {
                    const int row = rbase + ai * HALF + m * 16;
                    if (row >= P_NROW) continue;
                    const float r = rs[ai][m];
#pragma unroll
                    for (int bj = 0; bj < 2; ++bj) {
                        f32x4 v0 = acc[ai][bj][m][0] * r, v1 = acc[ai][bj][m][1] * r;
                        if (gate) { v0 = v0 * sigmoid4(v0); v1 = v1 * sigmoid4(v1); } else { v0 = v0 * qs; v1 = v1 * qs; }
                        *(u32x4*)(Z + (size_t)row * P_INDIM + pn * BM + 128 * bj + 32 * wc + 8 * fq) = pack8(v0, v1);
                    }
                }
        }
    }
};

struct EpiMemKV {
    static constexpr bool PERM = true, AFTER_DRAIN = false;
    bf16_t* MKV; float* out;
    __device__ __forceinline__ void operator()(const f32x4 (&acc)[2][2][4][2], const Unit& u, int wr, int wc, int fr, int fq) const {
        const int l = u.pn >> 2, kv = (u.pn >> 1) & 1, cb = (u.pn & 1) * 256;
        bf16_t* MKV = this->MKV; float* out = this->out; asm volatile("" : "+s"(MKV), "+s"(out));
        const int row0 = u.pm * BM + wr * 64 + fr, cl = 32 * wc + 8 * fq;
        bf16_t* zb = MKV + (size_t)row0 * 4096 + u.pn * BM + cl;
        float* ob = out + (kv ? OFF_MVP : OFF_MKP) + ((size_t)(l * 512 + row0)) * 512 + cb + cl;
#pragma unroll
        for (int ai = 0; ai < 2; ++ai)
#pragma unroll
            for (int m = 0; m < 4; ++m)
#pragma unroll
                for (int bj = 0; bj < 2; ++bj) {
                    const f32x4 v0 = acc[ai][bj][m][0], v1 = acc[ai][bj][m][1];
                    *(u32x4*)(zb + (size_t)(ai * HALF + m * 16) * 4096 + 128 * bj) = pack8(v0, v1);
                    float* dst = ob + (size_t)(ai * HALF + m * 16) * 512 + 128 * bj;
                    *(f32x4*)dst = v0; *(f32x4*)(dst + 4) = v1;
                }
    }
};

struct EpiOut {
    static constexpr bool PERM = false, AFTER_DRAIN = false;
    float* X; bf16_t* XB; float* ssq;
    __device__ __forceinline__ void operator()(const f32x4 (&acc)[2][2][4][2], const Unit& u, int wr, int wc, int fr, int fq) const {
        typedef unsigned u32x2v __attribute__((ext_vector_type(2)));
        const int rbase = u.pm * BM + wr * 64 + fr;
        float* X = this->X; bf16_t* XB = this->XB; float* ssq = this->ssq; asm volatile("" : "+s"(X), "+s"(XB), "+s"(ssq));
#pragma unroll
        for (int ai = 0; ai < 2; ++ai)
#pragma unroll
            for (int m = 0; m < 4; ++m) {
                const int row = rbase + ai * HALF + m * 16;
                if (row >= P_NROW) continue;
                float q = 0.f;
#pragma unroll
                for (int bj = 0; bj < 2; ++bj)
#pragma unroll
                    for (int n = 0; n < 2; ++n) {
                        const size_t off = (size_t)row * P_D + u.pn * BM + bj * HALF + wc * 32 + n * 16 + fq * 4;
                        const f32x4 xn = *(const f32x4*)(X + off) + acc[ai][bj][m][n];
                        *(f32x4*)(X + off) = xn;
                        u32x2v w; w.x = cvt_pk_bf16(xn[0], xn[1]); w.y = cvt_pk_bf16(xn[2], xn[3]);
                        *(u32x2v*)(XB + off) = w;
                        q += (xn[0] * xn[0] + xn[1] * xn[1]) + (xn[2] * xn[2] + xn[3] * xn[3]);
                    }
                q += __shfl_xor(q, 16); q += __shfl_xor(q, 32);
                if (fq == 0) ssq[(size_t)row * P_NSSQ + u.pn * 4 + wc] = q;
            }
    }
};

template <class Epi, class Sched, bool ALIGN_EPI = false, bool SP2 = false>
__device__ __forceinline__ void gemm_phase(PG8_LAS unsigned char* lds, const Gemm g, const Sched& S, const Epi& E) {
    int tid_ = threadIdx.x; asm volatile("" : "+v"(tid_));
    const int tid = tid_, wid = __builtin_amdgcn_readfirstlane(tid >> 6), lane = tid & 63, wr = wid >> 2, wc = wid & 3, fr = lane & 15, fq = lane >> 4;
    const int K = g.K, nt = K / BK;
    unsigned voffA[2], voffB[2];
#pragma unroll
    for (int i = 0; i < 2; ++i) { int R, C; stage_rc(tid * 16 + i * 8192, R, C); const int Rb = Epi::PERM ? ((R & ~31) + perm32(R & 31)) : R;
        voffA[i] = (unsigned)(R * K + C) * 2u; voffB[i] = (unsigned)(Rb * K + C) * 2u; }
    const size_t kstep = (size_t)(BK * 2);
    const size_t hstep = (size_t)HALF * K * 2;
    const size_t tstep = 2 * hstep;
    const unsigned ldsw = (unsigned)wid * 1024u;
    const int aoff = lds_byte(wr * 64 + fr, fq * 8), boff = lds_byte(wc * 32 + fr, fq * 8);
#define PG8_SA(b, h) (((b) * 2 + (h)) * HTB)
#define PG8_SB(b, h) ((4 + (b) * 2 + (h)) * HTB)
#define PG8_STAGE(bufoff, gbase, voff) do { _Pragma("unroll") for (int _i = 0; _i < 2; ++_i) \
        __builtin_amdgcn_global_load_lds((const unsigned*)((const char*)(gbase) + (voff)[_i]), (PG8_LAS unsigned*)(lds + (bufoff) + ldsw + _i * 8192), 16, 0, 0); } while (0)
#define PG8_LDA(dst, b, h) do { _Pragma("unroll") for (int m = 0; m < 4; ++m) _Pragma("unroll") for (int k = 0; k < 2; ++k) dst[m][k] = *(const PG8_LAS bf16x8*)(lds + PG8_SA(b, h) + aoff + m * 2048 + k * 1024); } while (0)
#define PG8_LDB(dst, b, h) do { _Pragma("unroll") for (int n = 0; n < 2; ++n) _Pragma("unroll") for (int k = 0; k < 2; ++k) dst[n][k] = *(const PG8_LAS bf16x8*)(lds + PG8_SB(b, h) + boff + n * 2048 + k * 1024); } while (0)
#define PG8_MMA(ai, bj, At, Bt) do { __builtin_amdgcn_s_setprio(1); _Pragma("unroll") for (int m = 0; m < 4; ++m) _Pragma("unroll") for (int n = 0; n < 2; ++n) _Pragma("unroll") for (int k = 0; k < 2; ++k) \
        acc[ai][bj][m][n] = __builtin_amdgcn_mfma_f32_16x16x32_bf16(Bt[n][k], At[m][k], acc[ai][bj][m][n], 0, 0, 0); __builtin_amdgcn_s_setprio(0); } while (0)
#define PG8_WAIT_V(n) asm volatile("s_waitcnt vmcnt(" #n ")" ::: "memory")
#define PG8_WAIT_L(n) asm volatile("s_waitcnt lgkmcnt(" #n ")" ::: "memory")
#define PG8_BAR __builtin_amdgcn_s_barrier()
#define PG8_SCHED __builtin_amdgcn_sched_barrier(0)
    Unit cur, nxt; int ui = 0;
    if (!S.next(0, cur)) return;
    f32x4 acc[2][2][4][2];
#pragma unroll
    for (int a = 0; a < 2; ++a)
#pragma unroll
        for (int b = 0; b < 2; ++b)
#pragma unroll
            for (int m = 0; m < 4; ++m)
#pragma unroll
                for (int n = 0; n < 2; ++n) acc[a][b][m][n] = (f32x4){0.f, 0.f, 0.f, 0.f};
    bf16x8 At[4][2], B0[2][2], B1[2][2];
    const char* cA = (const char*)g.A + (size_t)cur.pm * tstep; const char* cB = (const char*)g.Bt + (size_t)cur.pn * tstep;
    S.a_ready(cur);
    if constexpr (SP2) {
        PG8_STAGE(PG8_SB(0, 0), cB, voffB); PG8_STAGE(PG8_SB(0, 1), cB + hstep, voffB); PG8_STAGE(PG8_SA(0, 0), cA, voffA); PG8_STAGE(PG8_SA(0, 1), cA + hstep, voffA);
        if (wr == 1) PG8_BAR;
        PG8_WAIT_V(2); PG8_BAR;
        PG8_STAGE(PG8_SB(1, 0), cB + kstep, voffB); PG8_STAGE(PG8_SA(1, 0), cA + kstep, voffA); PG8_STAGE(PG8_SB(1, 1), cB + hstep + kstep, voffB);
        PG8_WAIT_V(6); PG8_BAR;
    } else {
        PG8_STAGE(PG8_SB(0, 0), cB, voffB); PG8_STAGE(PG8_SA(0, 0), cA, voffA); PG8_STAGE(PG8_SB(0, 1), cB + hstep, voffB); PG8_STAGE(PG8_SA(0, 1), cA + hstep, voffA);
        if (wr == 1) PG8_BAR;
        PG8_WAIT_V(4); PG8_BAR;
        PG8_STAGE(PG8_SB(1, 0), cB + kstep, voffB); PG8_STAGE(PG8_SA(1, 0), cA + kstep, voffA); PG8_STAGE(PG8_SB(1, 1), cB + hstep + kstep, voffB);
        PG8_WAIT_V(6); PG8_BAR;
    }
    for (;;) {
        const bool has_next = S.next(ui + 1, nxt);
        const char* nA = has_next ? (const char*)g.A + (size_t)nxt.pm * tstep : cA; const char* nB = has_next ? (const char*)g.Bt + (size_t)nxt.pn * tstep : cB;
        for (int t = 0; t < nt; t += 2) {
            const bool last = (t == nt - 2);
            const char* a1 = cA + (size_t)(t + 1) * kstep;
            const char* a2 = last ? nA : cA + (size_t)(t + 2) * kstep; const char* b2 = last ? nB : cB + (size_t)(t + 2) * kstep;
            const char* a3 = a2 + kstep; const char* b3 = b2 + kstep;
            if (last && has_next) S.a_ready(nxt);
            if constexpr (SP2) {
            PG8_LDB(B0, 0, 0); PG8_LDB(B1, 0, 1); PG8_SCHED; PG8_LDA(At, 0, 0); PG8_STAGE(PG8_SA(1, 1), a1 + hstep, voffA);
            PG8_WAIT_V(8); PG8_WAIT_L(0); PG8_BAR; PG8_MMA(0, 0, At, B0); PG8_MMA(0, 1, At, B1); PG8_BAR; PG8_SCHED;
            PG8_LDA(At, 0, 1); PG8_STAGE(PG8_SB(0, 0), b2, voffB); PG8_STAGE(PG8_SB(0, 1), b2 + hstep, voffB); PG8_STAGE(PG8_SA(0, 0), a2, voffA);
            PG8_WAIT_V(8); PG8_WAIT_L(0); PG8_BAR; PG8_MMA(1, 0, At, B0); PG8_MMA(1, 1, At, B1); PG8_BAR; PG8_SCHED;
            PG8_LDB(B0, 1, 0); PG8_LDB(B1, 1, 1); PG8_SCHED; PG8_LDA(At, 1, 0); PG8_STAGE(PG8_SA(0, 1), a2 + hstep, voffA);
            PG8_WAIT_V(8); PG8_WAIT_L(0); PG8_BAR; PG8_MMA(0, 0, At, B0); PG8_MMA(0, 1, At, B1); PG8_BAR; PG8_SCHED;
            PG8_LDA(At, 1, 1); PG8_STAGE(PG8_SB(1, 0), b3, voffB); PG8_STAGE(PG8_SB(1, 1), b3 + hstep, voffB); PG8_STAGE(PG8_SA(1, 0), a3, voffA);
            PG8_WAIT_V(8); PG8_WAIT_L(0); PG8_BAR; PG8_MMA(1, 0, At, B0); PG8_MMA(1, 1, At, B1); PG8_BAR; PG8_SCHED;
            } else {
            PG8_LDB(B0, 0, 0); PG8_SCHED; PG8_LDA(At, 0, 0); PG8_STAGE(PG8_SA(1, 1), a1 + hstep, voffA);
            PG8_WAIT_L(8); PG8_BAR; PG8_WAIT_L(0); PG8_MMA(0, 0, At, B0); PG8_BAR; PG8_SCHED;
            PG8_LDB(B1, 0, 1); PG8_STAGE(PG8_SB(0, 0), b2, voffB);
            PG8_BAR; PG8_WAIT_L(0); PG8_MMA(0, 1, At, B1); PG8_BAR;
            PG8_LDA(At, 0, 1); PG8_STAGE(PG8_SA(0, 0), a2, voffA);
            PG8_BAR; PG8_WAIT_L(0); PG8_MMA(1, 0, At, B0); PG8_BAR; PG8_SCHED;
            PG8_STAGE(PG8_SB(0, 1), b2 + hstep, voffB);
            PG8_WAIT_V(6); PG8_BAR; PG8_MMA(1, 1, At, B1); PG8_BAR;
            PG8_LDB(B0, 1, 0); PG8_SCHED; PG8_LDA(At, 1, 0); PG8_STAGE(PG8_SA(0, 1), a2 + hstep, voffA);
            PG8_WAIT_L(8); PG8_BAR; PG8_WAIT_L(0); PG8_MMA(0, 0, At, B0); PG8_BAR; PG8_SCHED;
            PG8_LDB(B1, 1, 1); PG8_STAGE(PG8_SB(1, 0), b3, voffB);
            PG8_BAR; PG8_WAIT_L(0); PG8_MMA(0, 1, At, B1); PG8_BAR;
            PG8_LDA(At, 1, 1); PG8_STAGE(PG8_SA(1, 0), a3, voffA);
            PG8_BAR; PG8_WAIT_L(0); PG8_MMA(1, 0, At, B0); PG8_BAR; PG8_SCHED;
            PG8_STAGE(PG8_SB(1, 1), b3 + hstep, voffB);
            PG8_WAIT_V(6); PG8_BAR; PG8_MMA(1, 1, At, B1); PG8_BAR;
            }
        }
        if constexpr (ALIGN_EPI) { if (wr == 0) PG8_BAR; }
        if constexpr (!Epi::AFTER_DRAIN) { E(acc, cur, wr, wc, fr, fq); S.done(cur); }
        if (!has_next) break;
#pragma unroll
        for (int a = 0; a < 2; ++a)
#pragma unroll
            for (int b = 0; b < 2; ++b)
#pragma unroll
                for (int m = 0; m < 4; ++m)
#pragma unroll
                    for (int n = 0; n < 2; ++n) acc[a][b][m][n] = (f32x4){0.f, 0.f, 0.f, 0.f};
        cur = nxt; cA = nA; cB = nB; ++ui;
        if constexpr (ALIGN_EPI) { if (wr == 1) PG8_BAR; }
    }
    PG8_WAIT_V(0);
    if constexpr (!ALIGN_EPI) { if (wr == 0) PG8_BAR; }
    PG8_BAR;
    if constexpr (Epi::AFTER_DRAIN) { E.fused(acc, cur, wr, wc, fr, fq, lds, wid, lane); S.done(cur); }
#undef PG8_SA
#undef PG8_SB
#undef PG8_STAGE
#undef PG8_LDA
#undef PG8_LDB
#undef PG8_MMA
#undef PG8_WAIT_V
#undef PG8_WAIT_L
#undef PG8_BAR
#undef PG8_SCHED
}
}


constexpr int NWAVES = 8, NTHREADS = 512;
constexpr int DM = 2048, SEQ = 4096, NBP = 2, NROWP = 8192, NBS = 8, NSS = 16, NROWS = 128, NROW = 8320, MPAD = 8448, INDIM = 4864, DEPTH = 4;
constexpr int ZP = INDIM;
constexpr int ZC_U = 0, ZC_GA = 1024, ZC_Q = 1536, ZC_K = 2560, ZC_V = 2688, ZC_GB = 2816, ZC_CQ = 3840, ZC_GC = 4352;
constexpr float LOG2E = 1.4426950408889634f;
using pg8::OFF_YP; using pg8::OFF_YS; using pg8::OFF_KP; using pg8::OFF_VP; using pg8::OFF_CP; using pg8::OFF_MKP; using pg8::OFF_MVP; using pg8::OFF_KS; using pg8::OFF_VS; using pg8::OFF_CS; using pg8::OUT_TOTAL;

constexpr size_t MiB = 1u << 20;
constexpr size_t WS_CTL = 0, CTL_ZERO_BYTES = 1 * MiB;
constexpr size_t WS_BT = 1 * MiB;
constexpr size_t WS_SSQ = 2 * MiB;
constexpr size_t WS_WIN = 4 * MiB;
constexpr size_t WS_WOUT = 80 * MiB;
constexpr size_t WS_WMEM = 112 * MiB;
constexpr size_t WS_WPW = 128 * MiB;
constexpr size_t WS_MEMN = 130 * MiB;
constexpr size_t WS_MKVP = 132 * MiB;
constexpr size_t WS_CMK = 136 * MiB, WS_CMV = 144 * MiB;
constexpr size_t WS_CSK = 152 * MiB, WS_CSV = 153 * MiB;
constexpr size_t WS_XB = 154 * MiB;
constexpr size_t WS_X = 187 * MiB;
constexpr size_t WS_Z = 253 * MiB;
constexpr size_t WS_YMIX = 332 * MiB;
constexpr size_t WS_END = 365 * MiB;
constexpr int CW_BAR = 4096;

constexpr int RING_BYTES = 131072;
constexpr int LDSCTL_OFF = 158720, MISC_OFF = LDSCTL_OFF + 320;
constexpr int LDS_BYTES = 159744;


#define GAS __attribute__((address_space(1)))
#define LAS __attribute__((address_space(3)))
typedef unsigned short bf16;
typedef unsigned v4u __attribute__((ext_vector_type(4)));
typedef float f32x4 __attribute__((ext_vector_type(4)));
typedef short bf16x8 __attribute__((ext_vector_type(8)));
typedef GAS unsigned gu32;
typedef GAS unsigned long long gu64;
#define RLX_AGENT __ATOMIC_RELAXED, __HIP_MEMORY_SCOPE_AGENT
#define LDS_WAIT() asm volatile("s_waitcnt lgkmcnt(0)" ::: "memory")
#define VM_WAIT() asm volatile("s_waitcnt vmcnt(0)" ::: "memory")
__device__ __forceinline__ unsigned long long rt() { return __builtin_amdgcn_s_memrealtime(); }
__device__ __forceinline__ unsigned f2bf(float f) { unsigned u = __builtin_bit_cast(unsigned, f); return (u + 0x7fffu + ((u >> 16) & 1u)) >> 16; }
__device__ __forceinline__ unsigned pk2(float lo, float hi) { return f2bf(lo) | (f2bf(hi) << 16); }

#define XB_TMO      128
#define XB_XCNT(j)  (256  + 64 * (j))
#define XB_XSUB(j)  (1280 + 64 * (j))
#define XB_XGEN(j)  (2304 + 64 * (j))
#define XB_TOP      3328
#define XB_TOPGEN   3392
#define XCD_BAR_WORDS 3456
#define XB_SPIN_CAP (1u << 18)

__device__ __forceinline__ unsigned xb_ld(unsigned* p)              { return __hip_atomic_load(p, __ATOMIC_RELAXED, __HIP_MEMORY_SCOPE_AGENT); }
__device__ __forceinline__ unsigned xb_add(unsigned* p, unsigned v) { return __hip_atomic_fetch_add(p, v, __ATOMIC_RELAXED, __HIP_MEMORY_SCOPE_AGENT); }
__device__ __forceinline__ unsigned xb_xcc_id() { return (unsigned)__builtin_amdgcn_s_getreg((3 << 11) | 20) & 0xFu; }
#define XB_SPIN(cond, bar) do { unsigned _sp = 0; while (cond) { __builtin_amdgcn_s_sleep(1); \
    if ((++_sp & 255u) == 0u) { if (xb_ld(&(bar)[XB_TMO])) break; if (_sp > XB_SPIN_CAP) { atomicAdd(&(bar)[XB_TMO], 1u); break; } } } } while (0)

struct XcdBarrier {
    unsigned* bar; unsigned x;
    volatile LAS unsigned* st;
};

__device__ __forceinline__ XcdBarrier xcd_barrier_post(unsigned* bar, volatile LAS unsigned* st) {
    XcdBarrier b; b.bar = bar; b.x = xb_xcc_id(); b.st = st;
    if (threadIdx.x == 0) (void)xb_add(&bar[XB_XCNT(b.x)], 1u);
    return b;
}
__device__ __forceinline__ void xcd_barrier_complete(unsigned* bar, unsigned x, unsigned& nloc, unsigned& nx) {
    const unsigned G = gridDim.x * gridDim.y * gridDim.z;
    unsigned sum, cnt, mine, sp = 0u;
    for (;;) {
        sum = 0u; cnt = 0u; mine = 0u;
#pragma unroll
        for (unsigned j = 0; j < 16; ++j) { const unsigned c = xb_ld(&bar[XB_XCNT(j)]); sum += c; cnt += (c > 0u) ? 1u : 0u; mine = (j == x) ? c : mine; }
        if (sum == G) break;
        __builtin_amdgcn_s_sleep(1);
        if ((++sp & 255u) == 0u) { if (xb_ld(&bar[XB_TMO])) break; if (sp > XB_SPIN_CAP) { atomicAdd(&bar[XB_TMO], 1u); break; } }
    }
    nloc = mine > 0u ? mine : 1u; nx = cnt > 0u ? cnt : 1u;
}

__device__ __forceinline__ void xcd_barrier(const XcdBarrier& b) {
    asm volatile("s_waitcnt vmcnt(0)" ::: "memory");
    __syncthreads();
    if (threadIdx.x == 0) {
        unsigned* bar = b.bar;
        __builtin_amdgcn_s_waitcnt(0);
        unsigned nloc = b.st[0], nx = b.st[1];
        if (nloc == 0u) { xcd_barrier_complete(bar, b.x, nloc, nx); b.st[0] = nloc; b.st[1] = nx; }
        const unsigned old = xb_add(&bar[XB_XSUB(b.x)], 1u);
        const unsigned gen = old / nloc;
        if (old + 1u == (gen + 1u) * nloc) {
            __builtin_amdgcn_fence(__ATOMIC_RELEASE, "agent");
            asm volatile("s_waitcnt vmcnt(0)" ::: "memory");
            const unsigned og = xb_add(&bar[XB_TOP], 1u);
            const unsigned tg = og / nx;
            if (og + 1u == (tg + 1u) * nx) xb_add(&bar[XB_TOPGEN], 1u);
            else XB_SPIN(xb_ld(&bar[XB_TOPGEN]) == tg, bar);
            __builtin_amdgcn_fence(__ATOMIC_ACQUIRE, "agent");
            xb_add(&bar[XB_XGEN(b.x)], 1u);
            asm volatile("s_waitcnt vmcnt(0)" ::: "memory");
        } else {
            XB_SPIN(xb_ld(&bar[XB_XGEN(b.x)]) == gen, bar);
            __builtin_amdgcn_fence(__ATOMIC_ACQUIRE, "agent");
            asm volatile("s_waitcnt vmcnt(0)" ::: "memory");
        }
    }
    __syncthreads();
}


struct Args { const float* in[22]; float* out; unsigned char* ws; int ph_lo, ph_hi; };
struct Frame {
    LAS unsigned char* lds; unsigned char* glds;
    volatile LAS unsigned* MISC;
    gu32* ctl;
    int tid, lane, wave, vcu, G;
};
__device__ __forceinline__ float wave_sum(float v) {
#pragma unroll
    for (int o = 1; o < 64; o <<= 1) v += __shfl_xor(v, o);
    return v;
}
__device__ __forceinline__ float wave_max(float v) {
#pragma unroll
    for (int o = 1; o < 64; o <<= 1) v = fmaxf(v, __shfl_xor(v, o));
    return v;
}
__device__ __forceinline__ int opaque_tid() { int t = threadIdx.x; asm volatile("" : "+v"(t)); return t; }
__device__ __forceinline__ float bf2f(bf16 v) { return __builtin_bit_cast(float, (unsigned)v << 16); }
__device__ __forceinline__ float rbf(float f) { return __builtin_bit_cast(float, f2bf(f) << 16); }

__device__ __forceinline__ void p0_transpose_item(const float* W, int K, int N, const float* g, bf16* WT, int k0, int n0, int dst_row0, LAS float* scr, int lane) {
#pragma unroll 8
    for (int i = 0; i < 32; ++i) { const int kk = 2 * i + (lane >> 5); float v = W[(size_t)(k0 + kk) * N + n0 + (lane & 31)]; if (g) v *= g[k0 + kk]; scr[kk * 33 + (lane & 31)] = v; }
    LDS_WAIT(); asm volatile("" ::: "memory");
    const int c = lane & 7;
#pragma unroll
    for (int j = 0; j < 4; ++j) { const int n = (lane >> 3) + 8 * j; const LAS float* s = scr + (8 * c) * 33 + n;
        v4u o; o.x = pk2(s[0 * 33], s[1 * 33]); o.y = pk2(s[2 * 33], s[3 * 33]); o.z = pk2(s[4 * 33], s[5 * 33]); o.w = pk2(s[6 * 33], s[7 * 33]);
        *(GAS v4u*)(WT + (size_t)(dst_row0 + n) * K + k0 + 8 * c) = o; }
    LDS_WAIT(); asm volatile("" ::: "memory");
}
__device__ __forceinline__ int t5_bucket(int rel) {
    const int side = rel > 0 ? 16 : 0, n = rel < 0 ? -rel : rel;
    const int large = 8 + (n >= 12) + (n >= 16) + (n >= 23) + (n >= 32) + (n >= 46) + (n >= 64) + (n >= 91);
    return side + (n < 8 ? n : large);
}
__device__ __forceinline__ void p0_prologue(Frame& F, const Args& A) {
    unsigned char* ws = A.ws;
    const int tid_ = opaque_tid(), lane = tid_ & 63, wave_ = __builtin_amdgcn_readfirstlane(tid_ >> 6);
    const int gw = F.vcu * NWAVES + wave_, NGW = F.G * NWAVES;
    LAS float* scr = (LAS float*)(F.lds + wave_ * 16384);
    constexpr int I_IN = 32 * 152, I_OUT = 32 * 64, I_MEM = 32 * 32, I_PW = 8 * 16;
    constexpr int NITEMS = DEPTH * (I_IN + I_OUT + I_MEM + I_PW);
    for (int it = gw; it < NITEMS; it += NGW) {
        int r = it;
        if (r < DEPTH * I_IN) { const int l = r / I_IN, q = r % I_IN, kb = q / 152, nb = q % 152, n0 = nb * 32;
            int dst; if (n0 < 512) dst = 256 * (n0 >> 7) + (n0 & 127); else if (n0 < 1024) dst = 256 * ((n0 - 512) >> 7) + 128 + (n0 & 127); else dst = n0;
            p0_transpose_item(A.in[9] + (size_t)l * DM * INDIM, DM, INDIM, A.in[8] + l * DM, (bf16*)(ws + WS_WIN) + (size_t)l * INDIM * DM, kb * 64, n0, dst, scr, lane); continue; }
        r -= DEPTH * I_IN;
        if (r < DEPTH * I_OUT) { const int l = r / I_OUT, q = r % I_OUT, kb = q / 64, nb = q % 64;
            p0_transpose_item(A.in[20] + (size_t)l * DM * DM, DM, DM, nullptr, (bf16*)(ws + WS_WOUT) + (size_t)l * DM * DM, kb * 64, nb * 32, nb * 32, scr, lane); continue; }
        r -= DEPTH * I_OUT;
        if (r < DEPTH * I_MEM) { const int l = r / I_MEM, q = r % I_MEM, kb = q / 32, nb = q % 32;
            p0_transpose_item(A.in[18] + (size_t)l * DM * 1024, DM, 1024, A.in[17] + l * DM, (bf16*)(ws + WS_WMEM) + (size_t)l * 1024 * DM, kb * 64, nb * 32, nb * 32, scr, lane); continue; }
        r -= DEPTH * I_MEM;
        { const int l = r / I_PW, q = r % I_PW, kb = q / 16, nb = q % 16;
            p0_transpose_item(A.in[14] + (size_t)l * 512 * 512, 512, 512, nullptr, (bf16*)(ws + WS_WPW) + (size_t)l * 512 * 512, kb * 64, nb * 32, nb * 32, scr, lane); }
    }
    float* X = (float*)(ws + WS_X); bf16* XB = (bf16*)(ws + WS_XB); float* SSQ = (float*)(ws + WS_SSQ);
    for (int m = gw; m < MPAD; m += NGW) {
        GAS unsigned long long* o8 = (GAS unsigned long long*)(XB + (size_t)m * DM) + lane;
        if (m >= NROW) {
#pragma unroll
            for (int j = 0; j < 8; ++j) o8[64 * j] = 0ull;
            continue;
        }
        const float* src = (m < NROWP) ? A.in[0] + (size_t)m * DM : A.in[1] + (size_t)(m - NROWP) * DM;
        const GAS f32x4* xr = (const GAS f32x4*)src + lane;
        GAS f32x4* xo = (GAS f32x4*)(X + (size_t)m * DM) + lane;
        float s = 0.f;
#pragma unroll
        for (int j = 0; j < 8; ++j) { const f32x4 v = xr[64 * j]; xo[64 * j] = v; s += (v.x * v.x + v.y * v.y) + (v.z * v.z + v.w * v.w);
            o8[64 * j] = (unsigned long long)pk2(v.x, v.y) | ((unsigned long long)pk2(v.z, v.w) << 32); }
        s = wave_sum(s);
        if (lane < 32) SSQ[(size_t)m * 32 + lane] = (lane == 0) ? s : 0.f;
    }
    for (int m = gw; m < 512; m += NGW) {
        const GAS f32x4* xr = (const GAS f32x4*)(A.in[2] + (size_t)m * DM) + lane;
        f32x4 v[8]; float s = 0.f;
#pragma unroll
        for (int j = 0; j < 8; ++j) { v[j] = xr[64 * j]; s += (v[j].x * v[j].x + v[j].y * v[j].y) + (v[j].z * v[j].z + v[j].w * v[j].w); }
        const float rstd = 1.0f / sqrtf(wave_sum(s) * (1.0f / DM) + 1e-6f);
        GAS unsigned long long* o8 = (GAS unsigned long long*)((bf16*)(ws + WS_MEMN) + (size_t)m * DM) + lane;
#pragma unroll
        for (int j = 0; j < 8; ++j) o8[64 * j] = (unsigned long long)pk2(v[j].x * rstd, v[j].y * rstd) | ((unsigned long long)pk2(v[j].z * rstd, v[j].w * rstd) << 32);
    }
    const int gt = gw * 64 + lane, NGT = NGW * 64;
    {
        const f32x4* sk = (const f32x4*)A.in[6]; const f32x4* sv = (const f32x4*)A.in[7];
        unsigned long long* dk = (unsigned long long*)(ws + WS_CMK); unsigned long long* dv = (unsigned long long*)(ws + WS_CMV);
        for (int i = gt; i < 1048576; i += NGT) { const f32x4 a = sk[i], b = sv[i];
            dk[i] = (unsigned long long)pk2(a.x, a.y) | ((unsigned long long)pk2(a.z, a.w) << 32);
            dv[i] = (unsigned long long)pk2(b.x, b.y) | ((unsigned long long)pk2(b.z, b.w) << 32); }
        const f32x4* ck = (const f32x4*)A.in[3]; const f32x4* cv = (const f32x4*)A.in[4];
        unsigned long long* ek = (unsigned long long*)(ws + WS_CSK); unsigned long long* ev = (unsigned long long*)(ws + WS_CSV);
        for (int i = gt; i < 131072; i += NGT) { const f32x4 a = ck[i], b = cv[i];
            ek[i] = (unsigned long long)pk2(a.x, a.y) | ((unsigned long long)pk2(a.z, a.w) << 32);
            ev[i] = (unsigned long long)pk2(b.x, b.y) | ((unsigned long long)pk2(b.z, b.w) << 32);
            const int lb = i >> 12, rem = i & 4095, row = rem >> 5, c4 = rem & 31;
            if (row >= 16) { const size_t o = ((size_t)lb * 128 + (row - 16)) * 128 + c4 * 4;
                *(f32x4*)(A.out + OFF_KS + o) = a; *(f32x4*)(A.out + OFF_VS + o) = b; } }
        const f32x4* cc = (const f32x4*)A.in[5];
        for (int i = gt; i < 32 * 30 * 128; i += NGT) { const int lb = i / 3840, rem = i % 3840, row = rem >> 7, c4 = rem & 127;
            if (row >= 16) *(f32x4*)(A.out + OFF_CS + ((size_t)lb * 30 + (row - 16)) * 512 + c4 * 4) = cc[i]; }
        float* BT = (float*)(ws + WS_BT);
        for (int i = gt; i < 16 * 256; i += NGT) { const int h = i >> 8, idx = i & 255; const int rel = idx - 191;
            BT[i] = (idx < 255) ? A.in[19][t5_bucket(rel) * 16 + h] * LOG2E : 0.f; }
    }
}

struct KSrc { const bf16* p0; int pitch0; int n0; const bf16* p1; int pitch1; };
__device__ __forceinline__ const bf16* ks_row(const KSrc& s, int j) { return j < s.n0 ? s.p0 + (long)j * s.pitch0 : s.p1 + (long)(j - s.n0) * s.pitch1; }

template <int HD, bool SWA>
__device__ __forceinline__ void naive_attn(float* S, float* INV, const bf16* Q, int qpitch, int nq, KSrc ks, KSrc vs, int jlo, int nk,
                                           const float* btab, float sink2, const bf16* gate, int gpitch, bf16* out, int opitch) {
    const int tid = opaque_tid(), lane = tid & 63, wave = tid >> 6;
#pragma unroll 1
    for (int idx = tid; idx < nq * nk; idx += NTHREADS) {
        const int i = idx / nk, j = idx - i * nk;
        float s;
        if (j < jlo) s = -1e30f;
        else {
            const bf16* q = Q + (long)i * qpitch; const bf16* k = ks_row(ks, j);
            float a = 0.f;
#pragma unroll 2
            for (int d = 0; d < HD; d += 8) {
                const v4u qv = *(const v4u*)(q + d), kv = *(const v4u*)(k + d);
                a += __builtin_bit_cast(float, qv.x << 16) * __builtin_bit_cast(float, kv.x << 16) + __builtin_bit_cast(float, qv.x & 0xffff0000u) * __builtin_bit_cast(float, kv.x & 0xffff0000u);
                a += __builtin_bit_cast(float, qv.y << 16) * __builtin_bit_cast(float, kv.y << 16) + __builtin_bit_cast(float, qv.y & 0xffff0000u) * __builtin_bit_cast(float, kv.y & 0xffff0000u);
                a += __builtin_bit_cast(float, qv.z << 16) * __builtin_bit_cast(float, kv.z << 16) + __builtin_bit_cast(float, qv.z & 0xffff0000u) * __builtin_bit_cast(float, kv.z & 0xffff0000u);
                a += __builtin_bit_cast(float, qv.w << 16) * __builtin_bit_cast(float, kv.w << 16) + __builtin_bit_cast(float, qv.w & 0xffff0000u) * __builtin_bit_cast(float, kv.w & 0xffff0000u);
            }
            s = a; if (SWA) s += btab[j - i + 63];
        }
        S[i * 257 + j] = s;
    }
    __syncthreads();
    for (int i = wave; i < nq; i += NWAVES) {
        float m = SWA ? sink2 : -3.0e38f;
        for (int j = lane; j < nk; j += 64) m = fmaxf(m, S[i * 257 + j]);
        m = wave_max(m);
        float sum = 0.f;
        for (int j = lane; j < nk; j += 64) { const float p = exp2f(S[i * 257 + j] - m); sum += p; S[i * 257 + j] = rbf(p); }
        sum = wave_sum(sum);
        if (SWA) sum += exp2f(sink2 - m);
        if (lane == 0) INV[i] = 1.0f / sum;
    }
    __syncthreads();
#pragma unroll 1
    for (int idx = tid; idx < nq * HD; idx += NTHREADS) {
        const int i = idx / HD, d = idx % HD;
        float o = 0.f;
#pragma unroll 4
        for (int j = jlo; j < nk; ++j) o += S[i * 257 + j] * bf2f(ks_row(vs, j)[d]);
        o *= INV[i];
        o *= bf2f(gate[(long)i * gpitch + d]);
        out[(long)i * opitch + d] = (bf16)f2bf(o);
    }
    __syncthreads();
}

__device__ __forceinline__ void naive_conv(float* C, const bf16* Useq, int t0, int nfr, const float* left, const float* cw, const float* cb, const float* lng, const float* lnb,
                                           const float* wpw  , const float* bpw, const bf16* gate  , bf16* out  ) {
    const int tid = opaque_tid(), lane = tid & 63, wave = tid >> 6;
    {
        const int ch = tid;
        float w[31];
#pragma unroll
        for (int j = 0; j < 31; ++j) w[j] = cw[j * 512 + ch];
        const float b = cb[ch];
#pragma unroll 1
        for (int tt = 0; tt < 64; ++tt) {
            float a = 0.f;
            if (tt < nfr) {
                a = b;
#pragma unroll
                for (int j = 0; j < 31; ++j) { const int e = t0 + tt - 30 + j;
                    const float uv = (e >= 0) ? bf2f(Useq[(long)e * ZP + ch]) : (left ? left[(30 + e) * 512 + ch] : 0.f);
                    a += w[j] * uv; }
            }
            C[tt * 516 + ch] = a;
        }
    }
    __syncthreads();
    for (int tt = wave; tt < 64; tt += NWAVES) {
        float v[8]; float s = 0.f;
#pragma unroll
        for (int j = 0; j < 8; ++j) { v[j] = C[tt * 516 + lane + 64 * j]; s += v[j]; }
        const float mu = wave_sum(s) * (1.0f / 512.0f); float q = 0.f;
#pragma unroll
        for (int j = 0; j < 8; ++j) { v[j] -= mu; q += v[j] * v[j]; }
        const float rstd = 1.0f / sqrtf(wave_sum(q) * (1.0f / 512.0f) + 1e-6f);
#pragma unroll
        for (int j = 0; j < 8; ++j) { const int ch = lane + 64 * j; const float y = v[j] * rstd * lng[ch] + lnb[ch]; C[tt * 516 + ch] = rbf(y / (1.0f + __expf(-y))); }
    }
    __syncthreads();
    {
        const int n = tid;
        const float bb = bpw[n];
#pragma unroll 1
        for (int tg = 0; tg < 64; tg += 16) {
            if (tg >= nfr) break;
            float acc[16];
#pragma unroll
            for (int tt = 0; tt < 16; ++tt) acc[tt] = 0.f;
#pragma unroll 1
            for (int k = 0; k < 512; k += 4) {
                const float w0 = rbf(wpw[(size_t)(k + 0) * 512 + n]), w1 = rbf(wpw[(size_t)(k + 1) * 512 + n]), w2 = rbf(wpw[(size_t)(k + 2) * 512 + n]), w3 = rbf(wpw[(size_t)(k + 3) * 512 + n]);
#pragma unroll
                for (int tt = 0; tt < 16; ++tt) { const f32x4 c = *(const f32x4*)(C + (tg + tt) * 516 + k); acc[tt] += (c.x * w0 + c.y * w1) + (c.z * w2 + c.w * w3); }
            }
#pragma unroll
            for (int tt = 0; tt < 16; ++tt) if (tg + tt < nfr) out[(long)(tg + tt) * DM + n] = (bf16)f2bf((acc[tt] + bb) * bf2f(gate[(long)(tg + tt) * ZP + n]));
        }
    }
    __syncthreads();
}

__device__ __forceinline__ void naive_mixer_phase(Frame& F, const Args& A, int l) {
    unsigned char* ws = A.ws;
    float* S = (float*)F.glds;
    float* INV = S + 64 * 257;
    const bf16* Z = (const bf16*)(ws + WS_Z); bf16* Y = (bf16*)(ws + WS_YMIX);
    const float* BT = (const float*)(ws + WS_BT);
    constexpr int U0 = 128, U1 = U0 + 8, U2 = U1 + 512, U3 = U2 + 32, U4 = U3 + 2048, U5 = U4 + 128;
    for (int u = blockIdx.x; u < U5; u += F.G) {
        if (u < U1) {
            int rowbase, t0, nfr; const float* left = nullptr;
            if (u < U0) { const int b = u >> 6, c = u & 63; rowbase = b * SEQ; t0 = c * 64; nfr = 64; }
            else { const int b = u - U0; rowbase = NROWP + b * NSS; t0 = 0; nfr = NSS; left = A.in[5] + (size_t)(l * 8 + b) * 30 * 512; }
            naive_conv(S, Z + (size_t)rowbase * ZP + ZC_U, t0, nfr, left, A.in[10] + l * 31 * 512, A.in[11] + l * 512, A.in[12] + l * 512, A.in[13] + l * 512,
                       A.in[14] + (size_t)l * 512 * 512, A.in[15] + l * 512, Z + (size_t)(rowbase + t0) * ZP + ZC_GA, Y + (size_t)(rowbase + t0) * DM);
        } else if (u < U3) {
            int row0, nq, h; KSrc ks, vs;
            if (u < U2) { const int v = u - U1, b = v >> 8, h_ = (v >> 6) & 3, qt = v & 63; h = h_; row0 = b * SEQ + qt * 64; nq = 64;
                const bf16* kb = (const bf16*)(ws + WS_MKVP) + (size_t)(b * 256) * 4096 + l * 1024 + h * 128;
                ks = KSrc{kb, 4096, 256, kb, 4096}; vs = KSrc{kb + 512, 4096, 256, kb + 512, 4096}; }
            else { const int v = u - U2, b = v >> 2; h = v & 3; row0 = NROWP + b * NSS; nq = NSS;
                const bf16* kb = (const bf16*)(ws + WS_CMK) + (size_t)((l * 8 + b) * 256) * 512 + h * 128; const bf16* vb = (const bf16*)(ws + WS_CMV) + (size_t)((l * 8 + b) * 256) * 512 + h * 128;
                ks = KSrc{kb, 512, 256, kb, 512}; vs = KSrc{vb, 512, 256, vb, 512}; }
            naive_attn<128, false>(S, INV, Z + (size_t)row0 * ZP + ZC_CQ + h * 128, ZP, nq, ks, vs, 0, 256, nullptr, 0.f,
                                   Z + (size_t)row0 * ZP + ZC_GC + h * 128, ZP, Y + (size_t)row0 * DM + 1536 + h * 128, DM);
        } else {
            int row0, nq, h, jlo, nk; KSrc ks, vs;
            if (u < U4) { const int v = u - U3, b = v >> 10, c = (v >> 4) & 63; h = v & 15; row0 = b * SEQ + c * 64; nq = 64; const int kv = h >> 3;
                const bf16* kb = Z + ((long)row0 - 128) * ZP + ZC_K + kv * 64;
                ks = KSrc{kb, ZP, 192, kb, ZP}; vs = KSrc{kb + (ZC_V - ZC_K), ZP, 192, kb + (ZC_V - ZC_K), ZP}; jlo = (c >= 2) ? 0 : 128 - 64 * c; nk = 192; }
            else { const int v = u - U4, b = v >> 4; h = v & 15; row0 = NROWP + b * NSS; nq = NSS; const int kv = h >> 3;
                const bf16* ck = (const bf16*)(ws + WS_CSK) + (size_t)((l * 8 + b) * 128) * 128 + kv * 64; const bf16* cv = (const bf16*)(ws + WS_CSV) + (size_t)((l * 8 + b) * 128) * 128 + kv * 64;
                const bf16* zk = Z + (size_t)row0 * ZP + ZC_K + kv * 64;
                ks = KSrc{ck, 128, 128, zk, ZP}; vs = KSrc{cv, 128, 128, zk + (ZC_V - ZC_K), ZP}; jlo = 0; nk = 144; }
            naive_attn<64, true>(S, INV, Z + (size_t)row0 * ZP + ZC_Q + h * 64, ZP, nq, ks, vs, jlo, nk, BT + h * 256, A.in[16][l * 16 + h] * LOG2E,
                                 Z + (size_t)row0 * ZP + ZC_GB + h * 64, ZP, Y + (size_t)row0 * DM + 512 + h * 64, DM);
        }
    }
}

typedef float f32x16 __attribute__((ext_vector_type(16)));
typedef short s16x4 __attribute__((ext_vector_type(4)));
__device__ __forceinline__ bf16x8 pack_bf16x8(float a0, float a1, float a2, float a3, float a4, float a5, float a6, float a7) {
    v4u w; w.x = pg8::cvt_pk_bf16(a0, a1); w.y = pg8::cvt_pk_bf16(a2, a3); w.z = pg8::cvt_pk_bf16(a4, a5); w.w = pg8::cvt_pk_bf16(a6, a7);
    return __builtin_bit_cast(bf16x8, w);
}
__device__ __forceinline__ bf16x8 join4(s16x4 lo, s16x4 hi) { return (bf16x8){lo[0], lo[1], lo[2], lo[3], hi[0], hi[1], hi[2], hi[3]}; }
__device__ __forceinline__ float ex2(float x) { return __builtin_amdgcn_exp2f(x); }

constexpr int SW_KP = 144, SW_VP = 408;
constexpr int SW_KS = 0, SW_VT = 192 * SW_KP, SW_BT = SW_VT + 64 * SW_VP, SW_END = SW_BT + 8 * 256 * 4;
__device__ __forceinline__ int swa_vt_off(int d, int key) { return d * SW_VP + ((((key >> 2) ^ ((d >> 3) & 7))) << 3) + (key & 3) * 2; }
struct SwaUnit { const bf16* q; int nq; KSrc ks, vs; int jlo, nk; const bf16* gate; bf16* out; int kvh; };

__device__ __forceinline__ void swa_unit(LAS unsigned char* L, const SwaUnit& U, const float* BT, const float* sinks) {
    const int tid = opaque_tid(), lane = tid & 63, wave = __builtin_amdgcn_readfirstlane(tid >> 6);
#pragma unroll
    for (int it = 0; it < 3; ++it) {
        const int t = tid + NTHREADS * it, row = t >> 3, c8 = t & 7;
        v4u v = (v4u){0u, 0u, 0u, 0u};
        if (row >= U.jlo && row < U.nk) v = *(const v4u*)(ks_row(U.ks, row) + c8 * 8);
        *(LAS v4u*)(L + SW_KS + row * SW_KP + c8 * 16) = v;
    }
#pragma unroll
    for (int it = 0; it < 2; ++it) {
        const int t = tid + NTHREADS * it;
        if (t < 768) {
            const int rp = t >> 3, c8 = t & 7, j0 = 2 * rp;
            v4u a = (v4u){0u, 0u, 0u, 0u}, b = (v4u){0u, 0u, 0u, 0u};
            if (j0 >= U.jlo && j0 < U.nk) a = *(const v4u*)(ks_row(U.vs, j0) + c8 * 8);
            if (j0 + 1 >= U.jlo && j0 + 1 < U.nk) b = *(const v4u*)(ks_row(U.vs, j0 + 1) + c8 * 8);
#pragma unroll
            for (int e = 0; e < 8; ++e) {
                const unsigned lo = (a[e >> 1] >> (16 * (e & 1))) & 0xffffu, hi = (b[e >> 1] >> (16 * (e & 1))) & 0xffffu;
                *(LAS unsigned*)(L + SW_VT + swa_vt_off(c8 * 8 + e, j0)) = lo | (hi << 16);
            }
        }
    }
    for (int i = tid; i < 8 * 256; i += NTHREADS) ((LAS float*)(L + SW_BT))[i] = BT[U.kvh * 8 * 256 + i];
    __syncthreads();
    const int i32 = lane & 31, hf = lane >> 5, g = wave;
    const float sink2 = sinks[U.kvh * 8 + g] * LOG2E;
    const LAS float* bt = (const LAS float*)(L + SW_BT) + g * 256;
#pragma unroll 1
    for (int qb = 0; qb < 2; ++qb) {
        if (qb * 32 >= U.nq) break;
        const int i = qb * 32 + i32, iq = (i < U.nq) ? i : 0;
        const bf16* qrow = U.q + (long)iq * ZP + g * 64;
        bf16x8 qf[4];
#pragma unroll
        for (int ds = 0; ds < 4; ++ds) qf[ds] = *(const bf16x8*)(qrow + 16 * ds + 8 * hf);
        f32x16 S[6];
#pragma unroll
        for (int kt = 0; kt < 6; ++kt) {
            f32x16 acc = {};
#pragma unroll
            for (int ds = 0; ds < 4; ++ds) {
                const bf16x8 kf = *(const LAS bf16x8*)(L + SW_KS + (kt * 32 + i32) * SW_KP + ds * 32 + hf * 16);
                acc = __builtin_amdgcn_mfma_f32_32x32x16_bf16(kf, qf[ds], acc, 0, 0, 0);
            }
            S[kt] = acc;
        }
        float m = sink2;
#pragma unroll
        for (int kt = 0; kt < 6; ++kt)
#pragma unroll
            for (int r = 0; r < 16; ++r) {
                const int j = kt * 32 + (r & 3) + 8 * (r >> 2) + 4 * hf;
                float s = S[kt][r] + bt[j - i + 63];
                if (j < U.jlo || j >= U.nk) s = -1e30f;
                S[kt][r] = s; m = fmaxf(m, s);
            }
        m = fmaxf(m, __shfl_xor(m, 32));
        float lsum = 0.f;
#pragma unroll
        for (int kt = 0; kt < 6; ++kt)
#pragma unroll
            for (int r = 0; r < 16; ++r) { const float p = ex2(S[kt][r] - m); S[kt][r] = p; lsum += p; }
        lsum += __shfl_xor(lsum, 32);
        const float inv = 1.0f / (lsum + ex2(sink2 - m));
        f32x16 O[2]; O[0] = (f32x16){}; O[1] = (f32x16){};
#pragma unroll
        for (int kt = 0; kt < 6; ++kt)
#pragma unroll
            for (int s = 0; s < 2; ++s) {
                const bf16x8 pf = pack_bf16x8(S[kt][8 * s + 0], S[kt][8 * s + 1], S[kt][8 * s + 2], S[kt][8 * s + 3], S[kt][8 * s + 4], S[kt][8 * s + 5], S[kt][8 * s + 6], S[kt][8 * s + 7]);
                const int key0 = kt * 32 + 16 * s + 4 * hf;
#pragma unroll
                for (int dt = 0; dt < 2; ++dt) {
                    const int d = dt * 32 + i32;
                    const s16x4 v0 = *(const LAS s16x4*)(L + SW_VT + swa_vt_off(d, key0)), v1 = *(const LAS s16x4*)(L + SW_VT + swa_vt_off(d, key0 + 8));
                    O[dt] = __builtin_amdgcn_mfma_f32_32x32x16_bf16(join4(v0, v1), pf, O[dt], 0, 0, 0);
                }
            }
        if (i < U.nq) {
            typedef unsigned u32x2v __attribute__((ext_vector_type(2)));
#pragma unroll
            for (int dt = 0; dt < 2; ++dt)
#pragma unroll
                for (int g4 = 0; g4 < 4; ++g4) {
                    const int d0 = dt * 32 + 8 * g4 + 4 * hf;
                    const u32x2v gv = *(const u32x2v*)(U.gate + (long)i * ZP + g * 64 + d0);
                    const float o0 = O[dt][4 * g4 + 0] * inv * __builtin_bit_cast(float, gv.x << 16), o1 = O[dt][4 * g4 + 1] * inv * __builtin_bit_cast(float, gv.x & 0xffff0000u);
                    const float o2 = O[dt][4 * g4 + 2] * inv * __builtin_bit_cast(float, gv.y << 16), o3 = O[dt][4 * g4 + 3] * inv * __builtin_bit_cast(float, gv.y & 0xffff0000u);
                    u32x2v w; w.x = pg8::cvt_pk_bf16(o0, o1); w.y = pg8::cvt_pk_bf16(o2, o3);
                    *(u32x2v*)(U.out + (long)i * DM + g * 64 + d0) = w;
                }
        }
    }
    __syncthreads();
}

constexpr int MA_KP = 272, MA_VP = 528;
constexpr int MA_KS = 0, MA_VT = 256 * MA_KP, MA_END = MA_VT + 128 * MA_VP;
__device__ __forceinline__ int ma_vt_off(int d, int key) { return d * MA_VP + ((((key >> 2) ^ ((d >> 3) & 15))) << 3) + (key & 3) * 2; }
struct MemUnit { const bf16* q; int nq; const bf16* k; const bf16* v; int pitch; const bf16* gate; bf16* out; };

__device__ __forceinline__ void mem_unit(LAS unsigned char* L, const MemUnit& U) {
    const int tid = opaque_tid(), lane = tid & 63, wave = __builtin_amdgcn_readfirstlane(tid >> 6);
#pragma unroll
    for (int it = 0; it < 8; ++it) {
        const int t = tid + NTHREADS * it, row = t >> 4, c8 = t & 15;
        *(LAS v4u*)(L + MA_KS + row * MA_KP + c8 * 16) = *(const v4u*)(U.k + (long)row * U.pitch + c8 * 8);
    }
#pragma unroll
    for (int it = 0; it < 4; ++it) {
        const int t = tid + NTHREADS * it, rp = t >> 4, c8 = t & 15, j0 = 2 * rp;
        const v4u a = *(const v4u*)(U.v + (long)j0 * U.pitch + c8 * 8), b = *(const v4u*)(U.v + (long)(j0 + 1) * U.pitch + c8 * 8);
#pragma unroll
        for (int e = 0; e < 8; ++e) {
            const unsigned lo = (a[e >> 1] >> (16 * (e & 1))) & 0xffffu, hi = (b[e >> 1] >> (16 * (e & 1))) & 0xffffu;
            *(LAS unsigned*)(L + MA_VT + ma_vt_off(c8 * 8 + e, j0)) = lo | (hi << 16);
        }
    }
    __syncthreads();
    const int i16 = lane & 15, q4 = lane >> 4;
#pragma unroll 1
    for (int grp = wave; grp * 16 < U.nq; grp += NWAVES) {
        const int i = grp * 16 + i16;
        const bf16* qrow = U.q + (long)i * ZP;
        bf16x8 qf[4];
#pragma unroll
        for (int ds = 0; ds < 4; ++ds) qf[ds] = *(const bf16x8*)(qrow + 32 * ds + 8 * q4);
        f32x4 S[16];
#pragma unroll
        for (int kt = 0; kt < 16; ++kt) {
            f32x4 acc = {};
#pragma unroll
            for (int ds = 0; ds < 4; ++ds) {
                const bf16x8 kf = *(const LAS bf16x8*)(L + MA_KS + (kt * 16 + i16) * MA_KP + ds * 64 + q4 * 16);
                acc = __builtin_amdgcn_mfma_f32_16x16x32_bf16(kf, qf[ds], acc, 0, 0, 0);
            }
            S[kt] = acc;
        }
        float m = -3.0e38f;
#pragma unroll
        for (int kt = 0; kt < 16; ++kt) m = fmaxf(fmaxf(m, fmaxf(S[kt][0], S[kt][1])), fmaxf(S[kt][2], S[kt][3]));
        m = fmaxf(m, __shfl_xor(m, 16)); m = fmaxf(m, __shfl_xor(m, 32));
        float lsum = 0.f;
#pragma unroll
        for (int kt = 0; kt < 16; ++kt)
#pragma unroll
            for (int r = 0; r < 4; ++r) { const float p = ex2(S[kt][r] - m); S[kt][r] = p; lsum += p; }
        lsum += __shfl_xor(lsum, 16); lsum += __shfl_xor(lsum, 32);
        const float inv = 1.0f / lsum;
        f32x4 O[8];
#pragma unroll
        for (int dt = 0; dt < 8; ++dt) O[dt] = (f32x4){0.f, 0.f, 0.f, 0.f};
#pragma unroll
        for (int st = 0; st < 8; ++st) {
            const bf16x8 pf = pack_bf16x8(S[2 * st][0], S[2 * st][1], S[2 * st][2], S[2 * st][3], S[2 * st + 1][0], S[2 * st + 1][1], S[2 * st + 1][2], S[2 * st + 1][3]);
            const int key0 = 32 * st + 4 * q4;
#pragma unroll
            for (int dt = 0; dt < 8; ++dt) {
                const int d = dt * 16 + i16;
                const s16x4 v0 = *(const LAS s16x4*)(L + MA_VT + ma_vt_off(d, key0)), v1 = *(const LAS s16x4*)(L + MA_VT + ma_vt_off(d, key0 + 16));
                O[dt] = __builtin_amdgcn_mfma_f32_16x16x32_bf16(join4(v0, v1), pf, O[dt], 0, 0, 0);
            }
        }
        {
            typedef unsigned u32x2v __attribute__((ext_vector_type(2)));
#pragma unroll
            for (int dt = 0; dt < 8; ++dt) {
                const int d0 = dt * 16 + 4 * q4;
                const u32x2v gv = *(const u32x2v*)(U.gate + (long)i * ZP + d0);
                const float o0 = O[dt][0] * inv * __builtin_bit_cast(float, gv.x << 16), o1 = O[dt][1] * inv * __builtin_bit_cast(float, gv.x & 0xffff0000u);
                const float o2 = O[dt][2] * inv * __builtin_bit_cast(float, gv.y << 16), o3 = O[dt][3] * inv * __builtin_bit_cast(float, gv.y & 0xffff0000u);
                u32x2v w; w.x = pg8::cvt_pk_bf16(o0, o1); w.y = pg8::cvt_pk_bf16(o2, o3);
                *(u32x2v*)(U.out + (long)i * DM + d0) = w;
            }
        }
    }
    __syncthreads();
}


typedef float cv_f32x2 __attribute__((ext_vector_type(2)));
template <int R> __device__ __forceinline__ void conv_rows(cv_f32x2 (&acc)[32], const cv_f32x2 (&w)[31], const bf16* Useq, const float* left, int tbase, int ch) {
    const int e = tbase - 30 + R;
    cv_f32x2 x;
    if (e >= 0) { const unsigned pv = *(const unsigned*)(Useq + (long)e * ZP + ch); x = (cv_f32x2){__builtin_bit_cast(float, pv << 16), __builtin_bit_cast(float, pv & 0xffff0000u)}; }
    else if (left) x = *(const cv_f32x2*)(left + (30 + e) * 512 + ch);
    else x = (cv_f32x2){0.f, 0.f};
    constexpr int TLO = (R > 30) ? R - 30 : 0, THI = (R < 31) ? R : 31;
#pragma unroll
    for (int tt = TLO; tt <= THI; ++tt) acc[tt] += w[R - tt] * x;
    if constexpr (R + 1 < 62) conv_rows<R + 1>(acc, w, Useq, left, tbase, ch);
}
constexpr int CV_P = 2064;
__device__ __forceinline__ void conv_unit(LAS unsigned char* L, const bf16* Useq, int t0, int nfr, const float* left, const float* cw, const float* cb, const float* lng, const float* lnb,
                                          const bf16* WpwT, const float* bpw, const bf16* gate, bf16* out) {
    typedef float f32x2 __attribute__((ext_vector_type(2)));
    const int tid = opaque_tid(), lane = tid & 63, wave = __builtin_amdgcn_readfirstlane(tid >> 6);
    {
        const int cp = tid & 255, fh = __builtin_amdgcn_readfirstlane(tid >> 8), ch = 2 * cp;
        f32x2 w[31];
#pragma unroll
        for (int j = 0; j < 31; ++j) w[j] = *(const f32x2*)(cw + j * 512 + ch);
        const f32x2 bias = *(const f32x2*)(cb + ch);
        f32x2 acc[32];
#pragma unroll
        for (int tt = 0; tt < 32; ++tt) acc[tt] = bias;
        const int tbase = t0 + 32 * fh;
        conv_rows<0>(acc, w, Useq, left, tbase, ch);
#pragma unroll
        for (int tt = 0; tt < 32; ++tt) { const int fr_ = 32 * fh + tt; *(LAS f32x2*)(L + fr_ * CV_P + ch * 4) = (fr_ < nfr) ? acc[tt] : (f32x2){0.f, 0.f}; }
    }
    __syncthreads();
    {
        const f32x4 g0 = *(const f32x4*)(lng + 8 * lane), g1 = *(const f32x4*)(lng + 8 * lane + 4), b0 = *(const f32x4*)(lnb + 8 * lane), b1 = *(const f32x4*)(lnb + 8 * lane + 4);
#pragma unroll 1
        for (int tt = wave; tt < 64; tt += NWAVES) {
            LAS unsigned char* row = L + tt * CV_P;
            f32x4 a = *(const LAS f32x4*)(row + 32 * lane), b = *(const LAS f32x4*)(row + 32 * lane + 16);
            const float mu = wave_sum(((a[0] + a[1]) + (a[2] + a[3])) + ((b[0] + b[1]) + (b[2] + b[3]))) * (1.0f / 512.0f);
            a = a - mu; b = b - mu;
            const float rstd = 1.0f / sqrtf(wave_sum(((a[0] * a[0] + a[1] * a[1]) + (a[2] * a[2] + a[3] * a[3])) + ((b[0] * b[0] + b[1] * b[1]) + (b[2] * b[2] + b[3] * b[3]))) * (1.0f / 512.0f) + 1e-6f);
            a = a * rstd * g0 + b0; b = b * rstd * g1 + b1;
            a = a * pg8::sigmoid4(a); b = b * pg8::sigmoid4(b);
            *(LAS v4u*)(row + 16 * lane) = __builtin_bit_cast(v4u, pg8::pack8(a, b));
        }
    }
    __syncthreads();
    {
        typedef unsigned u32x2v __attribute__((ext_vector_type(2)));
        const int i16 = lane & 15, q4 = lane >> 4;
        f32x4 acc[4][4];
#pragma unroll
        for (int rt = 0; rt < 4; ++rt)
#pragma unroll
            for (int nt = 0; nt < 4; ++nt) acc[rt][nt] = (f32x4){0.f, 0.f, 0.f, 0.f};
        const bf16* wbase = WpwT + (size_t)(64 * wave + i16) * 512 + 8 * q4;
#pragma unroll 2
        for (int ks = 0; ks < 16; ++ks) {
            bf16x8 wf[4], cf[4];
#pragma unroll
            for (int nt = 0; nt < 4; ++nt) wf[nt] = *(const bf16x8*)(wbase + nt * 16 * 512 + ks * 32);
#pragma unroll
            for (int rt = 0; rt < 4; ++rt) cf[rt] = *(const LAS bf16x8*)(L + (rt * 16 + i16) * CV_P + ks * 64 + q4 * 16);
#pragma unroll
            for (int rt = 0; rt < 4; ++rt)
#pragma unroll
                for (int nt = 0; nt < 4; ++nt) acc[rt][nt] = __builtin_amdgcn_mfma_f32_16x16x32_bf16(wf[nt], cf[rt], acc[rt][nt], 0, 0, 0);
        }
#pragma unroll
        for (int rt = 0; rt < 4; ++rt) {
            const int frame = rt * 16 + i16;
            if (frame < nfr) {
#pragma unroll
                for (int nt = 0; nt < 4; ++nt) {
                    const int n0 = 64 * wave + nt * 16 + 4 * q4;
                    const f32x4 bb = *(const f32x4*)(bpw + n0);
                    const u32x2v gv = *(const u32x2v*)(gate + (long)frame * ZP + n0);
                    const float o0 = (acc[rt][nt][0] + bb[0]) * __builtin_bit_cast(float, gv.x << 16), o1 = (acc[rt][nt][1] + bb[1]) * __builtin_bit_cast(float, gv.x & 0xffff0000u);
                    const float o2 = (acc[rt][nt][2] + bb[2]) * __builtin_bit_cast(float, gv.y << 16), o3 = (acc[rt][nt][3] + bb[3]) * __builtin_bit_cast(float, gv.y & 0xffff0000u);
                    u32x2v wv; wv.x = pg8::cvt_pk_bf16(o0, o1); wv.y = pg8::cvt_pk_bf16(o2, o3);
                    *(u32x2v*)(out + (long)frame * DM + n0) = wv;
                }
            }
        }
    }
    __syncthreads();
}

#ifndef USE_MFMA_ATTN
#define USE_MFMA_ATTN 1
#endif
#ifndef USE_MFMA_CONV
#define USE_MFMA_CONV 1
#endif
__device__ __forceinline__ void mixer_phase(Frame& F, const Args& A, int l) {
    unsigned char* ws = A.ws;
    float* S = (float*)F.glds;
    const bf16* Z = (const bf16*)(ws + WS_Z); bf16* Y = (bf16*)(ws + WS_YMIX);
    const float* BT = (const float*)(ws + WS_BT);
    constexpr int U0 = 128, U1 = U0 + 8, U2 = U1 + 128, U3 = U2 + 32, U4 = U3 + 256, U5 = U4 + 16;
#pragma unroll 1
    for (int u = blockIdx.x; u < U5; u += F.G) {
        if (u < U1) {
            int rowbase, t0, nfr; const float* left = nullptr;
            if (u < U0) { const int b = u >> 6, c = u & 63; rowbase = b * SEQ; t0 = c * 64; nfr = 64; }
            else { const int b = u - U0; rowbase = NROWP + b * NSS; t0 = 0; nfr = NSS; left = A.in[5] + (size_t)(l * 8 + b) * 30 * 512; }
#if USE_MFMA_CONV
            conv_unit(F.lds, Z + (size_t)rowbase * ZP + ZC_U, t0, nfr, left, A.in[10] + l * 31 * 512, A.in[11] + l * 512, A.in[12] + l * 512, A.in[13] + l * 512,
                      (const bf16*)(ws + WS_WPW) + (size_t)l * 512 * 512, A.in[15] + l * 512, Z + (size_t)(rowbase + t0) * ZP + ZC_GA, Y + (size_t)(rowbase + t0) * DM);
#else
            naive_conv(S, Z + (size_t)rowbase * ZP + ZC_U, t0, nfr, left, A.in[10] + l * 31 * 512, A.in[11] + l * 512, A.in[12] + l * 512, A.in[13] + l * 512,
                       A.in[14] + (size_t)l * 512 * 512, A.in[15] + l * 512, Z + (size_t)(rowbase + t0) * ZP + ZC_GA, Y + (size_t)(rowbase + t0) * DM);
#endif
        } else if (u < U3) {
            MemUnit M; int row0, h;
            if (u < U2) { const int v = u - U1, b = v >> 6, qblk = v & 15; h = (v >> 4) & 3; row0 = b * SEQ + qblk * 256; M.nq = 256;
                M.k = (const bf16*)(ws + WS_MKVP) + (size_t)(b * 256) * 4096 + l * 1024 + h * 128; M.v = M.k + 512; M.pitch = 4096; }
            else { const int v = u - U2, b = v >> 2; h = v & 3; row0 = NROWP + b * NSS; M.nq = NSS;
                M.k = (const bf16*)(ws + WS_CMK) + (size_t)((l * 8 + b) * 256) * 512 + h * 128; M.v = (const bf16*)(ws + WS_CMV) + (size_t)((l * 8 + b) * 256) * 512 + h * 128; M.pitch = 512; }
            M.q = Z + (size_t)row0 * ZP + ZC_CQ + h * 128; M.gate = Z + (size_t)row0 * ZP + ZC_GC + h * 128; M.out = Y + (size_t)row0 * DM + 1536 + h * 128;
            mem_unit(F.lds, M);
        } else {
            SwaUnit W; int row0, kv;
            if (u < U4) { const int v = u - U3, b = v >> 7, c = (v >> 1) & 63; kv = v & 1; row0 = b * SEQ + c * 64; W.nq = 64;
                const bf16* kb = Z + ((long)row0 - 128) * ZP + ZC_K + kv * 64;
                W.ks = KSrc{kb, ZP, 192, kb, ZP}; W.vs = KSrc{kb + (ZC_V - ZC_K), ZP, 192, kb + (ZC_V - ZC_K), ZP}; W.jlo = (c >= 2) ? 0 : 128 - 64 * c; W.nk = 192; }
            else { const int v = u - U4, b = v >> 1; kv = v & 1; row0 = NROWP + b * NSS; W.nq = NSS;
                const bf16* ck = (const bf16*)(ws + WS_CSK) + (size_t)((l * 8 + b) * 128) * 128 + kv * 64; const bf16* cv = (const bf16*)(ws + WS_CSV) + (size_t)((l * 8 + b) * 128) * 128 + kv * 64;
                const bf16* zk = Z + (size_t)row0 * ZP + ZC_K + kv * 64;
                W.ks = KSrc{ck, 128, 128, zk, ZP}; W.vs = KSrc{cv, 128, 128, zk + (ZC_V - ZC_K), ZP}; W.jlo = 0; W.nk = 144; }
            W.q = Z + (size_t)row0 * ZP + ZC_Q + kv * 512; W.gate = Z + (size_t)row0 * ZP + ZC_GB + kv * 512; W.out = Y + (size_t)row0 * DM + 512 + kv * 512; W.kvh = kv;
            swa_unit(F.lds, W, BT, A.in[16] + l * 16);
        }
    }
}

__device__ __forceinline__ void final_norm_phase(Frame& F, const Args& A) {
    const float* X = (const float*)(A.ws + WS_X); const float* SSQ = (const float*)(A.ws + WS_SSQ); const float* g = A.in[21];
    const int tid_ = opaque_tid(), lane = tid_ & 63, wave_ = __builtin_amdgcn_readfirstlane(tid_ >> 6);
    const int gw = F.vcu * NWAVES + wave_, NGW = F.G * NWAVES;
    f32x4 gv[8];
#pragma unroll
    for (int j = 0; j < 8; ++j) gv[j] = ((const f32x4*)g)[lane + 64 * j];
    for (int m = gw; m < NROW; m += NGW) {
        float s = (lane < 32) ? SSQ[(size_t)m * 32 + lane] : 0.f;
        s = wave_sum(s);
        const float rstd = 1.0f / sqrtf(s * (1.0f / DM) + 1e-6f);
        const f32x4* xr = (const f32x4*)(X + (size_t)m * DM) + lane;
        f32x4* o = (f32x4*)(A.out + (m < NROWP ? OFF_YP + (size_t)m * DM : OFF_YS + (size_t)(m - NROWP) * DM)) + lane;
#pragma unroll
        for (int j = 0; j < 8; ++j) o[64 * j] = xr[64 * j] * rstd * gv[j];
    }
}

constexpr int N_PHASES = 2 + 3 * DEPTH;
#ifndef MK_SINGLE
#define MK_SINGLE 1
#endif
__global__ void __launch_bounds__(NTHREADS, 2) mk_fwd(Args args) {
    extern __shared__ __attribute__((aligned(16))) unsigned char lds[];
    Frame F;
    F.lds = (LAS unsigned char*)lds; F.glds = lds;
    F.MISC = (volatile LAS unsigned*)(F.lds + MISC_OFF);
    F.tid = threadIdx.x; F.lane = F.tid & 63; F.wave = __builtin_amdgcn_readfirstlane(F.tid >> 6);
    F.G = gridDim.x; { const int bx = blockIdx.x; F.vcu = (F.G % 8 == 0) ? (bx % 8) * (F.G / 8) + bx / 8 : bx; }
    unsigned char* ws = args.ws;
    F.ctl = (gu32*)(ws + WS_CTL);
    for (int u = F.tid; u < (LDS_BYTES - LDSCTL_OFF) / 4; u += NTHREADS) ((LAS unsigned*)(F.lds + LDSCTL_OFF))[u] = 0u;
    __syncthreads();
    XcdBarrier bar; bar.bar = (unsigned*)(F.ctl + CW_BAR); bar.x = 0; bar.st = nullptr;
    const int lo = args.ph_lo, hi = args.ph_hi;
    const bool multi = (hi - lo) > 1;
    if (multi) bar = xcd_barrier_post((unsigned*)(F.ctl + CW_BAR), F.MISC + 8);
#define SEAM(k) do { if (lo <= (k) && (k) + 1 < hi) xcd_barrier(bar); } while (0)
#define IN(k) (lo <= (k) && (k) < hi)
    if (IN(0)) { p0_prologue(F, args); SEAM(0); }
    if (IN(1)) {
        unsigned char* wsl = ws; asm volatile("" : "+s"(wsl));
        pg8::Gemm g{(const pg8::bf16_t*)(wsl + WS_MEMN), (const pg8::bf16_t*)(wsl + WS_WMEM), 512, 4096, DM};
        pg8::StaticOrder S; S.init(512, 4096, F.G, (int)(F.G - 1 - blockIdx.x));
        pg8::EpiMemKV E{(pg8::bf16_t*)(wsl + WS_MKVP), args.out};
        pg8::gemm_phase<pg8::EpiMemKV, pg8::StaticOrder, true, true>(F.lds, g, S, E);
    }
#pragma unroll 1
    for (int l = 0; l < DEPTH; ++l) {
        const int p1 = 1 + 3 * l, p2 = p1 + 1, p3 = p1 + 2;
        unsigned char* wsl = ws; asm volatile("" : "+s"(wsl));
        if (IN(p1)) {
            pg8::Gemm g{(const pg8::bf16_t*)(wsl + WS_XB), (const pg8::bf16_t*)(wsl + WS_WIN) + (size_t)l * INDIM * DM, MPAD, INDIM, DM};
            pg8::StaticOrder S; S.init(MPAD, INDIM, F.G, (int)blockIdx.x);
            pg8::EpiIn E{(pg8::bf16_t*)(wsl + WS_Z), (const float*)(wsl + WS_SSQ), args.out, l};
            pg8::gemm_phase<pg8::EpiIn, pg8::StaticOrder, true, true>(F.lds, g, S, E);
            SEAM(p1);
        }
#if USE_MFMA_ATTN
        if (IN(p2)) { mixer_phase(F, args, l); SEAM(p2); }
#else
        if (IN(p2)) { naive_mixer_phase(F, args, l); SEAM(p2); }
#endif
        if (IN(p3)) {
            pg8::Gemm g{(const pg8::bf16_t*)(wsl + WS_YMIX), (const pg8::bf16_t*)(wsl + WS_WOUT) + (size_t)l * DM * DM, MPAD, DM, DM};
            pg8::StaticOrder S; S.init(MPAD, DM, F.G, (int)blockIdx.x);
            pg8::EpiOut E{(float*)(wsl + WS_X), (pg8::bf16_t*)(wsl + WS_XB), (float*)(wsl + WS_SSQ)};
            pg8::gemm_phase<pg8::EpiOut, pg8::StaticOrder, true, true>(F.lds, g, S, E);
            SEAM(p3);
        }
    }
    if (IN(N_PHASES - 1)) final_norm_phase(F, args);
#undef SEAM
#undef IN
}

extern "C" void kernel_launch(void* const* d_in, const int* in_sizes, int n_in, void* d_out, int out_size, void* d_ws, size_t ws_size, hipStream_t stream) {
    static int grid = 0;
    if (grid == 0) {
        if (n_in != 22 || out_size != (int)OUT_TOTAL || ws_size < WS_END) { fprintf(stderr, "kernel_launch: unexpected shapes: n_in %d out %d ws %zu\n", n_in, out_size, ws_size); grid = -1; return; }
        int dev = 0, cus = 0, per_cu = 0;
        if (hipGetDevice(&dev) != hipSuccess || hipDeviceGetAttribute(&cus, hipDeviceAttributeMultiprocessorCount, dev) != hipSuccess) { grid = -1; return; }
        if (hipFuncSetAttribute((const void*)mk_fwd, hipFuncAttributeMaxDynamicSharedMemorySize, LDS_BYTES) != hipSuccess) { fprintf(stderr, "kernel_launch: hipFuncSetAttribute failed\n"); grid = -1; return; }
        if (hipOccupancyMaxActiveBlocksPerMultiprocessor(&per_cu, (const void*)mk_fwd, NTHREADS, LDS_BYTES) != hipSuccess || per_cu < 1) { fprintf(stderr, "kernel_launch: occupancy query says %d blocks per CU\n", per_cu); (void)hipGetLastError(); grid = -1; return; }
        grid = cus;
    }
    if (grid < 0) return;
    (void)hipMemsetAsync((char*)d_ws + WS_CTL, 0, CTL_ZERO_BYTES, stream);
    Args a{};
    for (int i = 0; i < 22; ++i) a.in[i] = (const float*)d_in[i];
    a.out = (float*)d_out; a.ws = (unsigned char*)d_ws;
#if MK_SINGLE
    a.ph_lo = 0; a.ph_hi = N_PHASES;
    hipLaunchKernelGGL(mk_fwd, dim3(grid), dim3(NTHREADS), LDS_BYTES, stream, a);
#else
    for (int p = 0; p < N_PHASES; ++p) { a.ph_lo = p; a.ph_hi = p + 1; hipLaunchKernelGGL(mk_fwd, dim3(grid), dim3(NTHREADS), LDS_BYTES, stream, a); }
#endif
}
```

```cpp
#include <hip/hip_runtime.h>
#include <cstdio>
#include <cstdint>

namespace pg8 {
#define PG8_LAS __attribute__((address_space(3)))
typedef unsigned short bf16_t;
typedef short bf16x8 __attribute__((ext_vector_type(8)));
typedef float f32x4 __attribute__((ext_vector_type(4)));
typedef unsigned u32x4 __attribute__((ext_vector_type(4)));
constexpr int BM = 256, BK = 64, HALF = 128, HTB = HALF * BK * 2  , STAGE_BYTES = 8 * HTB, NXCD = 8, WGM = 8;

__host__ __device__ __forceinline__ int lds_byte(int r, int c) { const int st = (r >> 4) * 2 + (c >> 5), rr = r & 15, cc = c & 31, ob = rr * 64 + cc * 2; return st * 1024 + (ob ^ (((ob >> 9) & 1) << 5)); }
__host__ __device__ __forceinline__ void stage_rc(int b, int& R, int& C) { const int st = b / 1024, sb = b % 1024, swz = sb ^ (((sb >> 9) & 1) << 5); R = (st >> 1) * 16 + swz / 64; C = (st & 1) * 32 + (swz % 64) / 2; }
__host__ __device__ __forceinline__ int perm32(int rho) { const int n = rho >> 4, i = rho & 15; return 8 * (i >> 2) + 4 * n + (i & 3); }

struct Unit { int pm, pn, k0, nk, mode, slot, np; };
struct Gemm { const bf16_t* A; const bf16_t* Bt; int M, N, K; };

struct StaticOrder {
    int nM, nN, nwg, G, c;
    __host__ __device__ void init(int M, int N, int G_, int c_) { nM = M / BM; nN = N / BM; nwg = nM * nN; G = G_; c = c_; }
    __host__ __device__ bool next(int i, Unit& u) const {
        const long L = (long)i * G + c; if (L >= nwg) return false;
        int wgid = (int)L; { const int q = nwg / NXCD, r = nwg % NXCD, xcd = wgid % NXCD, off = wgid / NXCD; wgid = (xcd < r ? xcd * (q + 1) : r * (q + 1) + (xcd - r) * q) + off; }
        const int nig = WGM * nN, gid = wgid / nig, fm = gid * WGM, gsz = (nM - fm) < WGM ? (nM - fm) : WGM;
        u.pm = fm + ((wgid % nig) % gsz); u.pn = (wgid % nig) / gsz; u.k0 = 0; u.nk = 0; u.mode = 0; u.slot = 0; u.np = 0; return true;
    }
    __device__ __forceinline__ void a_ready(const Unit&) const {}
    __device__ __forceinline__ void done(const Unit&) const {}
};

__device__ __forceinline__ unsigned cvt_pk_bf16(float lo, float hi) { unsigned r; asm volatile("v_cvt_pk_bf16_f32 %0, %1, %2" : "=v"(r) : "v"(lo), "v"(hi)); return r; }
typedef float f32x2 __attribute__((ext_vector_type(2)));


#define PG8_GAS __attribute__((address_space(1)))
struct PartialReader {
    const PG8_GAS f32x4* p;
    template <int NP> __device__ __forceinline__ f32x4 next() {
        if constexpr (NP == 0) return (f32x4){0.f, 0.f, 0.f, 0.f};
        else {
            f32x4 x = p[0];
            if constexpr (NP > 1) x += p[16384];
            if constexpr (NP > 2) x += p[32768];
            p += 64; asm volatile("" : "+v"(p));
            return x;
        }
    }
    template <int NP> __device__ __forceinline__ void skip(int n) { if constexpr (NP > 0) { p += 64 * n; asm volatile("" : "+v"(p)); } }
};

constexpr int P_D = 2048, P_INDIM = 4864, P_NROW = 8320  , P_MPAD = 8448, P_NSSQ = 32;
constexpr long OFF_YP = 0, OFF_YS = 16777216, OFF_KP = 17039360, OFF_VP = 17170432, OFF_CP = 17301504, OFF_MKP = 17424384, OFF_MVP = 18472960,
               OFF_KS = 19521536, OFF_VS = 20045824, OFF_CS = 20570112, OUT_TOTAL = 21061632;
constexpr float QS_SWA = 0.125f * 1.4426950408889634f;
constexpr float QS_MEM = 0.08838834764831845f * 1.4426950408889634f;

__device__ __forceinline__ float sigmoid_f(float x) { return 1.0f / (1.0f + __expf(-x)); }
__device__ __forceinline__ f32x4 sigmoid4(f32x4 x) { return (f32x4){sigmoid_f(x[0]), sigmoid_f(x[1]), sigmoid_f(x[2]), sigmoid_f(x[3])}; }
__device__ __forceinline__ u32x4 pack8(f32x4 a, f32x4 b) { u32x4 w; w.x = cvt_pk_bf16(a[0], a[1]); w.y = cvt_pk_bf16(a[2], a[3]); w.z = cvt_pk_bf16(b[0], b[1]); w.w = cvt_pk_bf16(b[2], b[3]); return w; }

__device__ __forceinline__ void row_rstd(float (&rs)[2][4], const float* ssq, int rbase, int fq) {
    f32x4 pa[2][4], pb[2][4];
#pragma unroll
    for (int ai = 0; ai < 2; ++ai)
#pragma unroll
        for (int m = 0; m < 4; ++m) { const PG8_GAS f32x4* p = (const PG8_GAS f32x4*)(ssq + (size_t)(rbase + ai * HALF + m * 16) * P_NSSQ + fq * 8); pa[ai][m] = p[0]; pb[ai][m] = p[1]; }
#pragma unroll
    for (int ai = 0; ai < 2; ++ai)
#pragma unroll
        for (int m = 0; m < 4; ++m) {
            const f32x4 a = pa[ai][m], b = pb[ai][m];
            float s = ((a[0] + a[1]) + (a[2] + a[3])) + ((b[0] + b[1]) + (b[2] + b[3]));
            s += __shfl_xor(s, 16); s += __shfl_xor(s, 32);
            rs[ai][m] = 1.0f / sqrtf(s * (1.0f / (float)P_D) + 1e-6f);
        }
}

struct EpiIn {
    static constexpr bool PERM = true, AFTER_DRAIN = false;
    bf16_t* Z; const float* ssq; float* out; int layer;
    template <int HASP> __device__ __forceinline__ void run(const f32x4 (&acc)[2][2][4][2], const Unit& u, int wr, int wc, int fr, int fq, PartialReader& PR) const {
        { int t_ = threadIdx.x; asm volatile("" : "+v"(t_)); fr = t_ & 15; fq = (t_ >> 4) & 3; }
        const int pn = u.pn, rbase = u.pm * BM + wr * 64 + fr;
        bf16_t* Z = this->Z; const float* ssq = this->ssq; float* out = this->out;
        asm volatile("" : "+s"(Z), "+s"(ssq), "+s"(out));
        float rs[2][4];
        row_rstd(rs, ssq, rbase, fq);
        const bool tailtile = (u.pm == 15) || (u.pm == 31) || (u.pm == 32);
        const bool is_q = (pn >= 6 && pn <= 9), is_cq = (pn == 15 || pn == 16);
        const float qs = is_q ? QS_SWA : QS_MEM;
#pragma unroll
        for (int ai = 0; ai < 2; ++ai) {
            if (u.pm * BM + wr * 64 + ai * HALF >= P_NROW) { PR.template skip<HASP>(16); continue; }
#pragma unroll
            for (int m2 = 0; m2 < 4; m2 += 2) {
            f32x4 v[4][2][2];
#pragma unroll
            for (int m = m2; m < m2 + 2; ++m)
#pragma unroll
                for (int bj = 0; bj < 2; ++bj)
#pragma unroll
                    for (int n = 0; n < 2; ++n) { if constexpr (HASP == 0) v[m][bj][n] = acc[ai][bj][m][n]; else v[m][bj][n] = acc[ai][bj][m][n] + PR.template next<HASP>(); }
#pragma unroll
            for (int m = m2; m < m2 + 2; ++m) {
                const int row = rbase + ai * HALF + m * 16;
                const float r = rs[ai][m];
                if (pn < 4) {
                    const int ch0 = 128 * pn + 32 * wc + 8 * fq;
                    const f32x4 u0 = (v[m][0][0] * r) * sigmoid4(v[m][1][0] * r), u1 = (v[m][0][1] * r) * sigmoid4(v[m][1][1] * r);
                    *(PG8_GAS u32x4*)(Z + (size_t)row * P_INDIM + ch0) = pack8(u0, u1);
                    if (tailtile) {
                        float* dst = nullptr;
                        if (row < 8192) { const int t = row & 4095, b = row >> 12; if (t >= 4066) dst = out + OFF_CP + ((size_t)(layer * 2 + b) * 30 + (t - 4066)) * 512 + ch0; }
                        else { const int rr = row - 8192, b = rr >> 4, s = rr & 15; dst = out + OFF_CS + ((size_t)(layer * 8 + b) * 30 + 14 + s) * 512 + ch0; }
                        if (dst) { *(PG8_GAS f32x4*)dst = u0; *(PG8_GAS f32x4*)(dst + 4) = u1; }
                    }
                } else if (pn == 10) {
#pragma unroll
                    for (int bj = 0; bj < 2; ++bj) {
                        const f32x4 v0 = v[m][bj][0] * r, v1 = v[m][bj][1] * r;
                        const int c128 = 32 * wc + 8 * fq;
                        *(PG8_GAS u32x4*)(Z + (size_t)row * P_INDIM + 2560 + 128 * bj + c128) = pack8(v0, v1);
                        if (tailtile) {
                            float* dst = nullptr;
                            if (row < 8192) { const int t = row & 4095, b = row >> 12; if (t >= 3968) dst = out + (bj ? OFF_VP : OFF_KP) + ((size_t)(layer * 2 + b) * 128 + (t - 3968)) * 128 + c128; }
                            else { const int rr = row - 8192, b = rr >> 4, s = rr & 15; dst = out + (bj ? OFF_VS : OFF_KS) + ((size_t)(layer * 8 + b) * 128 + 112 + s) * 128 + c128; }
                            if (dst) { *(PG8_GAS f32x4*)dst = v0; *(PG8_GAS f32x4*)(dst + 4) = v1; }
                        }
                    }
                } else {
#pragma unroll
                    for (int bj = 0; bj < 2; ++bj) {
                        f32x4 v0 = v[m][bj][0] * r, v1 = v[m][bj][1] * r;
                        if (!(is_q || is_cq)) { v0 = v0 * sigmoid4(v0); v1 = v1 * sigmoid4(v1); } else { v0 = v0 * qs; v1 = v1 * qs; }
                        *(PG8_GAS u32x4*)(Z + (size_t)row * P_INDIM + pn * BM + 128 * bj + 32 * wc + 8 * fq) = pack8(v0, v1);
                    }
                }
            }
            }
        }
    }
};

struct EpiMemKV {
    static constexpr bool PERM = true, AFTER_DRAIN = false;
    bf16_t* MKV; float* out;
    template <int HASP> __device__ __forceinline__ void run(const f32x4 (&acc)[2][2][4][2], const Unit& u, int wr, int wc, int fr, int fq, PartialReader& PR) const {
        const int l = u.pn >> 2, kv = (u.pn >> 1) & 1, cb = (u.pn & 1) * 256;
        bf16_t* MKV = this->MKV; float* out = this->out; asm volatile("" : "+s"(MKV), "+s"(out));
        const int row0 = u.pm * BM + wr * 64 + fr, cl = 32 * wc + 8 * fq;
        bf16_t* zb = MKV + (size_t)row0 * 4096 + u.pn * BM + cl;
        float* ob = out + (kv ? OFF_MVP : OFF_MKP) + ((size_t)(l * 512 + row0)) * 512 + cb + cl;
#pragma unroll
        for (int ai = 0; ai < 2; ++ai)
#pragma unroll
            for (int m = 0; m < 4; ++m)
#pragma unroll
                for (int bj = 0; bj < 2; ++bj) {
                    const f32x4 v0 = acc[ai][bj][m][0], v1 = acc[ai][bj][m][1];
                    *(PG8_GAS u32x4*)(zb + (size_t)(ai * HALF + m * 16) * 4096 + 128 * bj) = pack8(v0, v1);
                    float* dst = ob + (size_t)(ai * HALF + m * 16) * 512 + 128 * bj;
                    *(PG8_GAS f32x4*)dst = v0; *(PG8_GAS f32x4*)(dst + 4) = v1;
                }
    }
};

struct EpiOut {
    static constexpr bool PERM = false, AFTER_DRAIN = false;
    float* X; bf16_t* XB; float* ssq; const float* rin_p; const float* rin_s;
    typedef unsigned u32x2v __attribute__((ext_vector_type(2)));
    __device__ __forceinline__ static void row_out(const f32x4 (&xn)[2][2], float* X, bf16_t* XB, float* ssq, int row, int colbase, int slot, int fq) {
        float q = 0.f;
#pragma unroll
        for (int bj = 0; bj < 2; ++bj)
#pragma unroll
            for (int n = 0; n < 2; ++n) {
                const size_t off = (size_t)row * P_D + colbase + bj * HALF + n * 16;
                *(PG8_GAS f32x4*)(X + off) = xn[bj][n];
                u32x2v w; w.x = cvt_pk_bf16(xn[bj][n][0], xn[bj][n][1]); w.y = cvt_pk_bf16(xn[bj][n][2], xn[bj][n][3]);
                *(PG8_GAS u32x2v*)(XB + off) = w;
                q += (xn[bj][n][0] * xn[bj][n][0] + xn[bj][n][1] * xn[bj][n][1]) + (xn[bj][n][2] * xn[bj][n][2] + xn[bj][n][3] * xn[bj][n][3]);
            }
        q += __shfl_xor(q, 16); q += __shfl_xor(q, 32);
        if (fq == 0) *(PG8_GAS float*)(ssq + (size_t)row * P_NSSQ + slot) = q;
    }
    template <int HASP> __device__ __forceinline__ void run(const f32x4 (&acc)[2][2][4][2], const Unit& u, int wr, int wc, int fr, int fq, PartialReader& PR) const {
        { int t_ = threadIdx.x; asm volatile("" : "+v"(t_)); fr = t_ & 15; fq = (t_ >> 4) & 3; }
        const int rbase = u.pm * BM + wr * 64 + fr, colbase = u.pn * BM + wc * 32 + fq * 4, slot = u.pn * 4 + wc;
        float* X = this->X; bf16_t* XB = this->XB; float* ssq = this->ssq; asm volatile("" : "+s"(X), "+s"(XB), "+s"(ssq));
        const float* rin = (u.pm == 32) ? rin_s : rin_p; asm volatile("" : "+s"(rin));
#pragma unroll
        for (int ai = 0; ai < 2; ++ai) {
            if (u.pm * BM + wr * 64 + ai * HALF >= P_NROW) { PR.template skip<HASP>(16); continue; }
            if constexpr (HASP == 0) {
                f32x4 rv[4][2][2];
#pragma unroll
                for (int m = 0; m < 4; ++m)
#pragma unroll
                    for (int bj = 0; bj < 2; ++bj)
#pragma unroll
                        for (int n = 0; n < 2; ++n) rv[m][bj][n] = *(const PG8_GAS f32x4*)(rin + (size_t)(rbase + ai * HALF + m * 16) * P_D + colbase + bj * HALF + n * 16);
#pragma unroll
                for (int m = 0; m < 4; ++m) {
                    f32x4 xn[2][2];
#pragma unroll
                    for (int bj = 0; bj < 2; ++bj)
#pragma unroll
                        for (int n = 0; n < 2; ++n) xn[bj][n] = rv[m][bj][n] + acc[ai][bj][m][n];
                    row_out(xn, X, XB, ssq, rbase + ai * HALF + m * 16, colbase, slot, fq);
                }
            } else {
#pragma unroll
                for (int m = 0; m < 4; ++m) {
                    f32x4 rv[2][2], pv[2][2], xn[2][2];
#pragma unroll
                    for (int bj = 0; bj < 2; ++bj)
#pragma unroll
                        for (int n = 0; n < 2; ++n) { rv[bj][n] = *(const PG8_GAS f32x4*)(rin + (size_t)(rbase + ai * HALF + m * 16) * P_D + colbase + bj * HALF + n * 16); pv[bj][n] = PR.template next<HASP>(); }
#pragma unroll
                    for (int bj = 0; bj < 2; ++bj)
#pragma unroll
                        for (int n = 0; n < 2; ++n) xn[bj][n] = rv[bj][n] + (acc[ai][bj][m][n] + pv[bj][n]);
                    row_out(xn, X, XB, ssq, rbase + ai * HALF + m * 16, colbase, slot, fq);
                }
            }
        }
    }
};

struct NoSplit {
    static constexpr int NP = 0;
    __device__ __forceinline__ void dump(const f32x4 (&)[2][2][4][2], const Unit&, int, int) const {}
    __device__ __forceinline__ PartialReader reader(const Unit&, int, int) const { PartialReader r; r.p = nullptr; return r; }
};
template <int NP_> struct SplitK {
    static constexpr int NP = NP_;
    float* slots; unsigned* flags;
    __device__ __forceinline__ void dump(const f32x4 (&acc)[2][2][4][2], const Unit& u, int wid, int lane) const {
        const __amdgpu_buffer_rsrc_t rs = __builtin_amdgcn_make_buffer_rsrc(slots, (short)0, 256 * 65536 * 4, 0x00020000);
        unsigned off = (unsigned)u.slot * 262144u + ((unsigned)wid * 32u * 64u + (unsigned)lane) * 16u;
#pragma unroll
        for (int a = 0; a < 2; ++a)
#pragma unroll
            for (int m = 0; m < 4; ++m)
#pragma unroll
                for (int b = 0; b < 2; ++b)
#pragma unroll
                    for (int n = 0; n < 2; ++n) {
                        __builtin_amdgcn_raw_buffer_store_b128(__builtin_bit_cast(u32x4, acc[a][b][m][n]), rs, off, 0,   16);
                        off += 1024u; asm volatile("" : "+v"(off)); }
        asm volatile("s_waitcnt vmcnt(0)" ::: "memory");
        if (lane == 0) __hip_atomic_fetch_add(flags + 16 * u.slot, 1u, __ATOMIC_RELAXED, __HIP_MEMORY_SCOPE_AGENT);
    }
    __device__ __forceinline__ PartialReader reader(const Unit& u, int wid, int lane) const {
#pragma unroll
        for (int q = 0; q < NP; ++q) { unsigned sp = 0;
            while ((unsigned)__builtin_amdgcn_readfirstlane(__hip_atomic_load(flags + 16 * (u.slot + q), __ATOMIC_RELAXED, __HIP_MEMORY_SCOPE_AGENT)) < 8u) { __builtin_amdgcn_s_sleep(2); if (++sp > (1u << 22)) break; } }
        __builtin_amdgcn_fence(__ATOMIC_ACQUIRE, "agent");
        asm volatile("s_waitcnt vmcnt(0)" ::: "memory");
        PartialReader r; r.p = (const PG8_GAS f32x4*)(slots + (size_t)u.slot * 65536) + ((size_t)wid * 32 * 64 + lane); return r;
    }
};
struct Hybrid {
    static constexpr int G = 256;
    int nM, nN, v, R, S, P;
    __device__ void init(int M, int N, int v_, int P_) { nM = M / BM; nN = N / BM; v = v_; P = P_; const int nu = nM * nN; R = nu / G; S = nu - R * G; }
    __device__ bool next(int i, Unit& u) const {
        const bool hasp = v < S * P; const int sp = v / P, q = v - sp * P;
        const bool dumper = hasp && q > 0, owner = hasp && q == 0;
        const int idx = i - (dumper ? 1 : 0);
        int ui; const int kpp = 32 / P;
        if (dumper && i == 0) { ui = R * G + sp; u.k0 = q * kpp; u.nk = kpp; u.mode = 1; u.slot = sp * (P - 1) + q - 1; u.np = 0; }
        else if (idx < R) { ui = idx * G + v; u.k0 = 0; u.nk = 0; u.mode = 0; u.slot = 0; u.np = 0; }
        else if (idx == R && owner) { ui = R * G + sp; u.k0 = 0; u.nk = kpp; u.mode = 2; u.slot = sp * (P - 1); u.np = P - 1; }
        else return false;
        const int nig = WGM * nN, gid = ui / nig, fm = gid * WGM, gsz = (nM - fm) < WGM ? (nM - fm) : WGM, r = ui % nig;
        u.pm = fm + r % gsz; u.pn = r / gsz; return true;
    }
    __device__ __forceinline__ void a_ready(const Unit&) const {}
    __device__ __forceinline__ void done(const Unit&) const {}
};
template <class Epi, class Sched, bool ALIGN_EPI = false, bool SP2 = false, class SKT = NoSplit>
__device__ __forceinline__ void gemm_phase(PG8_LAS unsigned char* lds, const Gemm g, const Sched& S, const Epi& E, const SKT SK = SKT()) {
    int tid_ = threadIdx.x; asm volatile("" : "+v"(tid_));
    const int tid = tid_, wid = __builtin_amdgcn_readfirstlane(tid >> 6), lane = tid & 63, wr = wid >> 2, wc = wid & 3, fr = lane & 15, fq = lane >> 4;
    const int K = g.K, ntf = K / BK;
    unsigned voffA[2], voffB[2];
#pragma unroll
    for (int i = 0; i < 2; ++i) { int R, C; stage_rc(tid * 16 + i * 8192, R, C); const int Rb = Epi::PERM ? ((R & ~31) + perm32(R & 31)) : R;
        voffA[i] = (unsigned)(R * K + C) * 2u; voffB[i] = (unsigned)(Rb * K + C) * 2u; }
    const size_t kstep = (size_t)(BK * 2);
    const size_t hstep = (size_t)HALF * K * 2;
    const size_t tstep = 2 * hstep;
    const unsigned ldsw = (unsigned)wid * 1024u;
    const int aoff = lds_byte(wr * 64 + fr, fq * 8), boff = lds_byte(wc * 32 + fr, fq * 8);
#define PG8_SA(b, h) (((b) * 2 + (h)) * HTB)
#define PG8_SB(b, h) ((4 + (b) * 2 + (h)) * HTB)
#define PG8_STAGE(bufoff, gbase, voff) do { _Pragma("unroll") for (int _i = 0; _i < 2; ++_i) \
        __builtin_amdgcn_global_load_lds((const unsigned*)((const char*)(gbase) + (voff)[_i]), (PG8_LAS unsigned*)(lds + (bufoff) + ldsw + _i * 8192), 16, 0, 0); } while (0)
#define PG8_LDA(dst, b, h) do { _Pragma("unroll") for (int m = 0; m < 4; ++m) _Pragma("unroll") for (int k = 0; k < 2; ++k) dst[m][k] = *(const PG8_LAS bf16x8*)(lds + PG8_SA(b, h) + aoff + m * 2048 + k * 1024); } while (0)
#define PG8_LDB(dst, b, h) do { _Pragma("unroll") for (int n = 0; n < 2; ++n) _Pragma("unroll") for (int k = 0; k < 2; ++k) dst[n][k] = *(const PG8_LAS bf16x8*)(lds + PG8_SB(b, h) + boff + n * 2048 + k * 1024); } while (0)
#define PG8_MMA(ai, bj, At, Bt) do { __builtin_amdgcn_s_setprio(1); _Pragma("unroll") for (int m = 0; m < 4; ++m) _Pragma("unroll") for (int n = 0; n < 2; ++n) _Pragma("unroll") for (int k = 0; k < 2; ++k) \
        acc[ai][bj][m][n] = __builtin_amdgcn_mfma_f32_16x16x32_bf16(Bt[n][k], At[m][k], acc[ai][bj][m][n], 0, 0, 0); __builtin_amdgcn_s_setprio(0); } while (0)
#define PG8_WAIT_V(n) asm volatile("s_waitcnt vmcnt(" #n ")" ::: "memory")
#define PG8_WAIT_L(n) asm volatile("s_waitcnt lgkmcnt(" #n ")" ::: "memory")
#define PG8_BAR __builtin_amdgcn_s_barrier()
#define PG8_SCHED __builtin_amdgcn_sched_barrier(0)
    Unit cur, nxt; int ui = 0;
    if (!S.next(0, cur)) return;
    f32x4 acc[2][2][4][2];
#pragma unroll
    for (int a = 0; a < 2; ++a)
#pragma unroll
        for (int b = 0; b < 2; ++b)
#pragma unroll
            for (int m = 0; m < 4; ++m)
#pragma unroll
                for (int n = 0; n < 2; ++n) acc[a][b][m][n] = (f32x4){0.f, 0.f, 0.f, 0.f};
    bf16x8 At[4][2], B0[2][2], B1[2][2];
    const char* cA = (const char*)g.A + (size_t)cur.pm * tstep + (size_t)cur.k0 * (BK * 2); const char* cB = (const char*)g.Bt + (size_t)cur.pn * tstep + (size_t)cur.k0 * (BK * 2);
    S.a_ready(cur);
    if constexpr (SP2) {
        PG8_STAGE(PG8_SB(0, 0), cB, voffB); PG8_STAGE(PG8_SB(0, 1), cB + hstep, voffB); PG8_STAGE(PG8_SA(0, 0), cA, voffA); PG8_STAGE(PG8_SA(0, 1), cA + hstep, voffA);
        if (wr == 1) PG8_BAR;
        PG8_WAIT_V(2); PG8_BAR;
        PG8_STAGE(PG8_SB(1, 0), cB + kstep, voffB); PG8_STAGE(PG8_SA(1, 0), cA + kstep, voffA); PG8_STAGE(PG8_SB(1, 1), cB + hstep + kstep, voffB);
        PG8_WAIT_V(6); PG8_BAR;
    } else {
        PG8_STAGE(PG8_SB(0, 0), cB, voffB); PG8_STAGE(PG8_SA(0, 0), cA, voffA); PG8_STAGE(PG8_SB(0, 1), cB + hstep, voffB); PG8_STAGE(PG8_SA(0, 1), cA + hstep, voffA);
        if (wr == 1) PG8_BAR;
        PG8_WAIT_V(4); PG8_BAR;
        PG8_STAGE(PG8_SB(1, 0), cB + kstep, voffB); PG8_STAGE(PG8_SA(1, 0), cA + kstep, voffA); PG8_STAGE(PG8_SB(1, 1), cB + hstep + kstep, voffB);
        PG8_WAIT_V(6); PG8_BAR;
    }
    for (;;) {
        const bool has_next = S.next(ui + 1, nxt);
        const char* nA = has_next ? (const char*)g.A + (size_t)nxt.pm * tstep + (size_t)nxt.k0 * (BK * 2) : cA; const char* nB = has_next ? (const char*)g.Bt + (size_t)nxt.pn * tstep + (size_t)nxt.k0 * (BK * 2) : cB;
        const int nt = cur.nk ? cur.nk : ntf;
        for (int t = 0; t < nt; t += 2) {
            const bool last = (t == nt - 2);
            const char* a1 = cA + (size_t)(t + 1) * kstep;
            const char* a2 = last ? nA : cA + (size_t)(t + 2) * kstep; const char* b2 = last ? nB : cB + (size_t)(t + 2) * kstep;
            const char* a3 = a2 + kstep; const char* b3 = b2 + kstep;
            if (last && has_next) S.a_ready(nxt);
            if constexpr (SP2) {
            PG8_LDB(B0, 0, 0); PG8_LDB(B1, 0, 1); PG8_SCHED; PG8_LDA(At, 0, 0); PG8_STAGE(PG8_SA(1, 1), a1 + hstep, voffA);
            PG8_WAIT_V(8); PG8_WAIT_L(0); PG8_BAR; PG8_MMA(0, 0, At, B0); PG8_MMA(0, 1, At, B1); PG8_BAR; PG8_SCHED;
            PG8_LDA(At, 0, 1); PG8_STAGE(PG8_SB(0, 0), b2, voffB); PG8_STAGE(PG8_SB(0, 1), b2 + hstep, voffB); PG8_STAGE(PG8_SA(0, 0), a2, voffA);
            PG8_WAIT_V(8); PG8_WAIT_L(0); PG8_BAR; PG8_MMA(1, 0, At, B0); PG8_MMA(1, 1, At, B1); PG8_BAR; PG8_SCHED;
            PG8_LDB(B0, 1, 0); PG8_LDB(B1, 1, 1); PG8_SCHED; PG8_LDA(At, 1, 0); PG8_STAGE(PG8_SA(0, 1), a2 + hstep, voffA);
            PG8_WAIT_V(8); PG8_WAIT_L(0); PG8_BAR; PG8_MMA(0, 0, At, B0); PG8_MMA(0, 1, At, B1); PG8_BAR; PG8_SCHED;
            PG8_LDA(At, 1, 1); PG8_STAGE(PG8_SB(1, 0), b3, voffB); PG8_STAGE(PG8_SB(1, 1), b3 + hstep, voffB); PG8_STAGE(PG8_SA(1, 0), a3, voffA);
            PG8_WAIT_V(8); PG8_WAIT_L(0); PG8_BAR; PG8_MMA(1, 0, At, B0); PG8_MMA(1, 1, At, B1); PG8_BAR; PG8_SCHED;
            } else {
            PG8_LDB(B0, 0, 0); PG8_SCHED; PG8_LDA(At, 0, 0); PG8_STAGE(PG8_SA(1, 1), a1 + hstep, voffA);
            PG8_WAIT_L(8); PG8_BAR; PG8_WAIT_L(0); PG8_MMA(0, 0, At, B0); PG8_BAR; PG8_SCHED;
            PG8_LDB(B1, 0, 1); PG8_STAGE(PG8_SB(0, 0), b2, voffB);
            PG8_BAR; PG8_WAIT_L(0); PG8_MMA(0, 1, At, B1); PG8_BAR;
            PG8_LDA(At, 0, 1); PG8_STAGE(PG8_SA(0, 0), a2, voffA);
            PG8_BAR; PG8_WAIT_L(0); PG8_MMA(1, 0, At, B0); PG8_BAR; PG8_SCHED;
            PG8_STAGE(PG8_SB(0, 1), b2 + hstep, voffB);
            PG8_WAIT_V(6); PG8_BAR; PG8_MMA(1, 1, At, B1); PG8_BAR;
            PG8_LDB(B0, 1, 0); PG8_SCHED; PG8_LDA(At, 1, 0); PG8_STAGE(PG8_SA(0, 1), a2 + hstep, voffA);
            PG8_WAIT_L(8); PG8_BAR; PG8_WAIT_L(0); PG8_MMA(0, 0, At, B0); PG8_BAR; PG8_SCHED;
            PG8_LDB(B1, 1, 1); PG8_STAGE(PG8_SB(1, 0), b3, voffB);
            PG8_BAR; PG8_WAIT_L(0); PG8_MMA(0, 1, At, B1); PG8_BAR;
            PG8_LDA(At, 1, 1); PG8_STAGE(PG8_SA(1, 0), a3, voffA);
            PG8_BAR; PG8_WAIT_L(0); PG8_MMA(1, 0, At, B0); PG8_BAR; PG8_SCHED;
            PG8_STAGE(PG8_SB(1, 1), b3 + hstep, voffB);
            PG8_WAIT_V(6); PG8_BAR; PG8_MMA(1, 1, At, B1); PG8_BAR;
            }
        }
        if constexpr (ALIGN_EPI) { if (wr == 0) PG8_BAR; }
        if constexpr (!Epi::AFTER_DRAIN) { if (cur.mode == 1) SK.dump(acc, cur, wid, lane); else if (SKT::NP > 0 && cur.mode == 2) { PartialReader PR = SK.reader(cur, wid, lane); E.template run<SKT::NP>(acc, cur, wr, wc, fr, fq, PR); } else { PartialReader PR; PR.p = nullptr; E.template run<0>(acc, cur, wr, wc, fr, fq, PR); } S.done(cur); }
        if (!has_next) break;
#pragma unroll
        for (int a = 0; a < 2; ++a)
#pragma unroll
            for (int b = 0; b < 2; ++b)
#pragma unroll
                for (int m = 0; m < 4; ++m)
#pragma unroll
                    for (int n = 0; n < 2; ++n) acc[a][b][m][n] = (f32x4){0.f, 0.f, 0.f, 0.f};
        cur = nxt; cA = nA; cB = nB; ++ui;
        if constexpr (ALIGN_EPI) { if (wr == 1) PG8_BAR; }
    }
    PG8_WAIT_V(0);
    if constexpr (!ALIGN_EPI) { if (wr == 0) PG8_BAR; }
    PG8_BAR;
    if constexpr (Epi::AFTER_DRAIN) { E.fused(acc, cur, wr, wc, fr, fq, lds, wid, lane); S.done(cur); }
#undef PG8_SA
#undef PG8_SB
#undef PG8_STAGE
#undef PG8_LDA
#undef PG8_LDB
#undef PG8_MMA
#undef PG8_WAIT_V
#undef PG8_WAIT_L
#undef PG8_BAR
#undef PG8_SCHED
}
}


constexpr int NWAVES = 8, NTHREADS = 512;
constexpr int DM = 2048, SEQ = 4096, NBP = 2, NROWP = 8192, NBS = 8, NSS = 16, NROWS = 128, NROW = 8320, MPAD = 8448, INDIM = 4864, DEPTH = 4;
constexpr int ZP = INDIM;
constexpr int ZC_U = 0, ZC_GA = 1024, ZC_Q = 1536, ZC_K = 2560, ZC_V = 2688, ZC_GB = 2816, ZC_CQ = 3840, ZC_GC = 4352;
constexpr float LOG2E = 1.4426950408889634f;
using pg8::OFF_YP; using pg8::OFF_YS; using pg8::OFF_KP; using pg8::OFF_VP; using pg8::OFF_CP; using pg8::OFF_MKP; using pg8::OFF_MVP; using pg8::OFF_KS; using pg8::OFF_VS; using pg8::OFF_CS; using pg8::OUT_TOTAL;

constexpr size_t MiB = 1u << 20;
constexpr size_t WS_CTL = 0, CTL_ZERO_BYTES = 1 * MiB;
constexpr size_t WS_BT = 1 * MiB;
constexpr size_t WS_SSQ = 2 * MiB;
constexpr size_t WS_WIN = 4 * MiB;
constexpr size_t WS_WOUT = 80 * MiB;
constexpr size_t WS_WMEM = 112 * MiB;
constexpr size_t WS_WPW = 128 * MiB;
constexpr size_t WS_MEMN = 130 * MiB;
constexpr size_t WS_MKVP = 132 * MiB;
constexpr size_t WS_CMK = 136 * MiB, WS_CMV = 144 * MiB;
constexpr size_t WS_CSK = 152 * MiB, WS_CSV = 153 * MiB;
constexpr size_t WS_XB = 154 * MiB;
constexpr size_t WS_X = 187 * MiB;
constexpr size_t WS_Z = 253 * MiB;
constexpr size_t WS_YMIX = 332 * MiB;
constexpr size_t WS_DUMP = 365 * MiB;
constexpr size_t WS_END = 429 * MiB;
constexpr int CW_BAR = 4096, CW_SK = 65536;

constexpr int RING_BYTES = 131072;
constexpr int LDSCTL_OFF = 158720, MISC_OFF = LDSCTL_OFF + 320;
constexpr int LDS_BYTES = 159744;


#define GAS __attribute__((address_space(1)))
#define LAS __attribute__((address_space(3)))
typedef unsigned short bf16;
typedef unsigned v4u __attribute__((ext_vector_type(4)));
typedef float f32x4 __attribute__((ext_vector_type(4)));
typedef short bf16x8 __attribute__((ext_vector_type(8)));
typedef GAS unsigned gu32;
typedef GAS unsigned long long gu64;
#define RLX_AGENT __ATOMIC_RELAXED, __HIP_MEMORY_SCOPE_AGENT
#define LDS_WAIT() asm volatile("s_waitcnt lgkmcnt(0)" ::: "memory")
#define VM_WAIT() asm volatile("s_waitcnt vmcnt(0)" ::: "memory")
__device__ __forceinline__ unsigned long long rt() { return __builtin_amdgcn_s_memrealtime(); }
__device__ __forceinline__ unsigned f2bf(float f) { unsigned u = __builtin_bit_cast(unsigned, f); return (u + 0x7fffu + ((u >> 16) & 1u)) >> 16; }
__device__ __forceinline__ unsigned pk2(float lo, float hi) { return f2bf(lo) | (f2bf(hi) << 16); }

#define XB_TMO      128
#define XB_XCNT(j)  (256  + 64 * (j))
#define XB_XSUB(j)  (1280 + 64 * (j))
#define XB_XGEN(j)  (2304 + 64 * (j))
#define XB_TOP      3328
#define XB_TOPGEN   3392
#define XCD_BAR_WORDS 3456
#define XB_SPIN_CAP (1u << 18)

__device__ __forceinline__ unsigned xb_ld(unsigned* p)              { return __hip_atomic_load(p, __ATOMIC_RELAXED, __HIP_MEMORY_SCOPE_AGENT); }
__device__ __forceinline__ unsigned xb_add(unsigned* p, unsigned v) { return __hip_atomic_fetch_add(p, v, __ATOMIC_RELAXED, __HIP_MEMORY_SCOPE_AGENT); }
__device__ __forceinline__ unsigned xb_xcc_id() { return (unsigned)__builtin_amdgcn_s_getreg((3 << 11) | 20) & 0xFu; }
#define XB_SPIN(cond, bar) do { unsigned _sp = 0; while (cond) { __builtin_amdgcn_s_sleep(1); \
    if ((++_sp & 255u) == 0u) { if (xb_ld(&(bar)[XB_TMO])) break; if (_sp > XB_SPIN_CAP) { atomicAdd(&(bar)[XB_TMO], 1u); break; } } } } while (0)

struct XcdBarrier {
    unsigned* bar; unsigned x;
    volatile LAS unsigned* st;
};

__device__ __forceinline__ XcdBarrier xcd_barrier_post(unsigned* bar, volatile LAS unsigned* st) {
    XcdBarrier b; b.bar = bar; b.x = xb_xcc_id(); b.st = st;
    if (threadIdx.x == 0) (void)xb_add(&bar[XB_XCNT(b.x)], 1u);
    return b;
}
__device__ __forceinline__ void xcd_barrier_complete(unsigned* bar, unsigned x, unsigned& nloc, unsigned& nx) {
    const unsigned G = gridDim.x * gridDim.y * gridDim.z;
    unsigned sum, cnt, mine, sp = 0u;
    for (;;) {
        sum = 0u; cnt = 0u; mine = 0u;
#pragma unroll
        for (unsigned j = 0; j < 16; ++j) { const unsigned c = xb_ld(&bar[XB_XCNT(j)]); sum += c; cnt += (c > 0u) ? 1u : 0u; mine = (j == x) ? c : mine; }
        if (sum == G) break;
        __builtin_amdgcn_s_sleep(1);
        if ((++sp & 255u) == 0u) { if (xb_ld(&bar[XB_TMO])) break; if (sp > XB_SPIN_CAP) { atomicAdd(&bar[XB_TMO], 1u); break; } }
    }
    nloc = mine > 0u ? mine : 1u; nx = cnt > 0u ? cnt : 1u;
}

__device__ __forceinline__ void xcd_barrier(const XcdBarrier& b) {
    asm volatile("s_waitcnt vmcnt(0)" ::: "memory");
    __syncthreads();
    int xb_tid = threadIdx.x; asm volatile("" : "+v"(xb_tid));
    if (xb_tid == 0) {
        unsigned* bar = b.bar;
        __builtin_amdgcn_s_waitcnt(0);
        unsigned nloc = b.st[0], nx = b.st[1];
        if (nloc == 0u) { xcd_barrier_complete(bar, b.x, nloc, nx); b.st[0] = nloc; b.st[1] = nx; }
        const unsigned old = xb_add(&bar[XB_XSUB(b.x)], 1u);
        const unsigned gen = old / nloc;
        if (old + 1u == (gen + 1u) * nloc) {
            __builtin_amdgcn_fence(__ATOMIC_RELEASE, "agent");
            asm volatile("s_waitcnt vmcnt(0)" ::: "memory");
            const unsigned og = xb_add(&bar[XB_TOP], 1u);
            const unsigned tg = og / nx;
            if (og + 1u == (tg + 1u) * nx) xb_add(&bar[XB_TOPGEN], 1u);
            else XB_SPIN(xb_ld(&bar[XB_TOPGEN]) == tg, bar);
            __builtin_amdgcn_fence(__ATOMIC_ACQUIRE, "agent");
            xb_add(&bar[XB_XGEN(b.x)], 1u);
            asm volatile("s_waitcnt vmcnt(0)" ::: "memory");
        } else {
            XB_SPIN(xb_ld(&bar[XB_XGEN(b.x)]) == gen, bar);
            __builtin_amdgcn_fence(__ATOMIC_ACQUIRE, "agent");
            asm volatile("s_waitcnt vmcnt(0)" ::: "memory");
        }
    }
    __syncthreads();
}


struct Args { const float* in[22]; float* out; unsigned char* ws; int ph_lo, ph_hi; int mix_mask, pflags; };
struct Frame {
    LAS unsigned char* lds; unsigned char* glds;
    volatile LAS unsigned* MISC;
    gu32* ctl;
    int tid, lane, wave, vcu, G;
};
__device__ __forceinline__ float wave_sum(float v) {
#pragma unroll
    for (int o = 1; o < 64; o <<= 1) v += __shfl_xor(v, o);
    return v;
}
__device__ __forceinline__ float wave_max(float v) {
#pragma unroll
    for (int o = 1; o < 64; o <<= 1) v = fmaxf(v, __shfl_xor(v, o));
    return v;
}
__device__ __forceinline__ int opaque_tid() { int t = threadIdx.x; asm volatile("" : "+v"(t)); return t; }
__device__ __forceinline__ float bf2f(bf16 v) { return __builtin_bit_cast(float, (unsigned)v << 16); }
__device__ __forceinline__ float rbf(float f) { return __builtin_bit_cast(float, f2bf(f) << 16); }

__device__ __forceinline__ void p0_transpose_item(const float* W, int K, int N, const float* g, bf16* WT, int k0, int n0, int dst_row0, LAS float* scr, int lane) {
    const int kq = lane >> 4, n4 = (lane & 15) * 4;
    f32x4 v[16];
#pragma unroll
    for (int i = 0; i < 16; ++i) v[i] = *(const GAS f32x4*)(W + (size_t)(k0 + 4 * i + kq) * N + n0 + n4);
    if (g) {
#pragma unroll
        for (int i = 0; i < 16; ++i) v[i] = v[i] * g[k0 + 4 * i + kq];
    }
#pragma unroll
    for (int i = 0; i < 16; ++i) { LAS float* d = scr + (4 * i + kq) * 65 + n4; d[0] = v[i].x; d[1] = v[i].y; d[2] = v[i].z; d[3] = v[i].w; }
    LDS_WAIT(); asm volatile("" ::: "memory");
    const int c = lane & 7;
#pragma unroll
    for (int s8 = 0; s8 < 8; ++s8) { const int n = 8 * s8 + (lane >> 3); const LAS float* s = scr + (8 * c) * 65 + n;
        v4u o; o.x = pk2(s[0 * 65], s[1 * 65]); o.y = pk2(s[2 * 65], s[3 * 65]); o.z = pk2(s[4 * 65], s[5 * 65]); o.w = pk2(s[6 * 65], s[7 * 65]);
        *(GAS v4u*)(WT + (size_t)(dst_row0 + n) * K + k0 + 8 * c) = o; }
    LDS_WAIT(); asm volatile("" ::: "memory");
}
__device__ __forceinline__ int t5_bucket(int rel) {
    const int side = rel > 0 ? 16 : 0, n = rel < 0 ? -rel : rel;
    const int large = 8 + (n >= 12) + (n >= 16) + (n >= 23) + (n >= 32) + (n >= 46) + (n >= 64) + (n >= 91);
    return side + (n < 8 ? n : large);
}
__device__ __forceinline__ void p0_prologue(Frame& F, const Args& A) {
    unsigned char* ws = A.ws;
    const int tid_ = opaque_tid(), lane = tid_ & 63, wave_ = __builtin_amdgcn_readfirstlane(tid_ >> 6);
    const int gw = F.vcu * NWAVES + wave_, NGW = F.G * NWAVES;
    LAS float* scr = (LAS float*)(F.lds + wave_ * 17408);
    constexpr int I_IN = 32 * 76, I_OUT = 32 * 32, I_MEM = 32 * 16, I_PW = 8 * 8;
    constexpr int NITEMS = DEPTH * (I_IN + I_OUT + I_MEM + I_PW);
#pragma unroll 1
    for (int it = gw; it < NITEMS; it += NGW) {
        int r = it;
        if (r < DEPTH * I_IN) { const int l = r / I_IN, q = r % I_IN, kb = q / 76, nb = q % 76, n0 = nb * 64;
            int dst; if (n0 < 512) dst = 256 * (n0 >> 7) + (n0 & 127); else if (n0 < 1024) dst = 256 * ((n0 - 512) >> 7) + 128 + (n0 & 127); else dst = n0;
            p0_transpose_item(A.in[9] + (size_t)l * DM * INDIM, DM, INDIM, A.in[8] + l * DM, (bf16*)(ws + WS_WIN) + (size_t)l * INDIM * DM, kb * 64, n0, dst, scr, lane); continue; }
        r -= DEPTH * I_IN;
        if (r < DEPTH * I_OUT) { const int l = r / I_OUT, q = r % I_OUT, kb = q / 32, nb = q % 32;
            p0_transpose_item(A.in[20] + (size_t)l * DM * DM, DM, DM, nullptr, (bf16*)(ws + WS_WOUT) + (size_t)l * DM * DM, kb * 64, nb * 64, nb * 64, scr, lane); continue; }
        r -= DEPTH * I_OUT;
        if (r < DEPTH * I_MEM) { const int l = r / I_MEM, q = r % I_MEM, kb = q / 16, nb = q % 16;
            p0_transpose_item(A.in[18] + (size_t)l * DM * 1024, DM, 1024, A.in[17] + l * DM, (bf16*)(ws + WS_WMEM) + (size_t)l * 1024 * DM, kb * 64, nb * 64, nb * 64, scr, lane); continue; }
        r -= DEPTH * I_MEM;
        { const int l = r / I_PW, q = r % I_PW, kb = q / 8, nb = q % 8;
            p0_transpose_item(A.in[14] + (size_t)l * 512 * 512, 512, 512, nullptr, (bf16*)(ws + WS_WPW) + (size_t)l * 512 * 512, kb * 64, nb * 64, nb * 64, scr, lane); }
    }
    bf16* XB = (bf16*)(ws + WS_XB); float* SSQ = (float*)(ws + WS_SSQ);
    for (int m = gw; m < MPAD; m += NGW) {
        GAS unsigned long long* o8 = (GAS unsigned long long*)(XB + (size_t)m * DM) + lane;
        if (m >= NROW) {
#pragma unroll
            for (int j = 0; j < 8; ++j) o8[64 * j] = 0ull;
            continue;
        }
        const float* src = (m < NROWP) ? A.in[0] + (size_t)m * DM : A.in[1] + (size_t)(m - NROWP) * DM;
        const GAS f32x4* xr = (const GAS f32x4*)src + lane;
        float s = 0.f;
#pragma unroll
        for (int j = 0; j < 8; ++j) { const f32x4 v = xr[64 * j]; s += (v.x * v.x + v.y * v.y) + (v.z * v.z + v.w * v.w);
            o8[64 * j] = (unsigned long long)pk2(v.x, v.y) | ((unsigned long long)pk2(v.z, v.w) << 32); }
        s = wave_sum(s);
        if (lane < 32) SSQ[(size_t)m * 32 + lane] = (lane == 0) ? s : 0.f;
    }
    for (int m = gw; m < 512; m += NGW) {
        const GAS f32x4* xr = (const GAS f32x4*)(A.in[2] + (size_t)m * DM) + lane;
        f32x4 v[8]; float s = 0.f;
#pragma unroll
        for (int j = 0; j < 8; ++j) { v[j] = xr[64 * j]; s += (v[j].x * v[j].x + v[j].y * v[j].y) + (v[j].z * v[j].z + v[j].w * v[j].w); }
        const float rstd = 1.0f / sqrtf(wave_sum(s) * (1.0f / DM) + 1e-6f);
        GAS unsigned long long* o8 = (GAS unsigned long long*)((bf16*)(ws + WS_MEMN) + (size_t)m * DM) + lane;
#pragma unroll
        for (int j = 0; j < 8; ++j) o8[64 * j] = (unsigned long long)pk2(v[j].x * rstd, v[j].y * rstd) | ((unsigned long long)pk2(v[j].z * rstd, v[j].w * rstd) << 32);
    }
    const int gt = gw * 64 + lane, NGT = NGW * 64;
    {
        const f32x4* sk = (const f32x4*)A.in[6]; const f32x4* sv = (const f32x4*)A.in[7];
        unsigned long long* dk = (unsigned long long*)(ws + WS_CMK); unsigned long long* dv = (unsigned long long*)(ws + WS_CMV);
        for (int i = gt; i < 1048576; i += NGT) { const f32x4 a = sk[i], b = sv[i];
            dk[i] = (unsigned long long)pk2(a.x, a.y) | ((unsigned long long)pk2(a.z, a.w) << 32);
            dv[i] = (unsigned long long)pk2(b.x, b.y) | ((unsigned long long)pk2(b.z, b.w) << 32); }
        const f32x4* ck = (const f32x4*)A.in[3]; const f32x4* cv = (const f32x4*)A.in[4];
        unsigned long long* ek = (unsigned long long*)(ws + WS_CSK); unsigned long long* ev = (unsigned long long*)(ws + WS_CSV);
        for (int i = gt; i < 131072; i += NGT) { const f32x4 a = ck[i], b = cv[i];
            ek[i] = (unsigned long long)pk2(a.x, a.y) | ((unsigned long long)pk2(a.z, a.w) << 32);
            ev[i] = (unsigned long long)pk2(b.x, b.y) | ((unsigned long long)pk2(b.z, b.w) << 32);
            const int lb = i >> 12, rem = i & 4095, row = rem >> 5, c4 = rem & 31;
            if (row >= 16) { const size_t o = ((size_t)lb * 128 + (row - 16)) * 128 + c4 * 4;
                *(f32x4*)(A.out + OFF_KS + o) = a; *(f32x4*)(A.out + OFF_VS + o) = b; } }
        const f32x4* cc = (const f32x4*)A.in[5];
        for (int i = gt; i < 32 * 30 * 128; i += NGT) { const int lb = i / 3840, rem = i % 3840, row = rem >> 7, c4 = rem & 127;
            if (row >= 16) *(f32x4*)(A.out + OFF_CS + ((size_t)lb * 30 + (row - 16)) * 512 + c4 * 4) = cc[i]; }
        float* BT = (float*)(ws + WS_BT);
        for (int i = gt; i < 16 * 256; i += NGT) { const int h = i >> 8, idx = i & 255; const int rel = idx - 191;
            BT[i] = (idx < 255) ? A.in[19][t5_bucket(rel) * 16 + h] * LOG2E : 0.f; }
    }
}

struct KSrc { const bf16* p0; int pitch0; int n0; const bf16* p1; int pitch1; };
__device__ __forceinline__ const bf16* ks_row(const KSrc& s, int j) { return j < s.n0 ? s.p0 + (long)j * s.pitch0 : s.p1 + (long)(j - s.n0) * s.pitch1; }

template <int HD, bool SWA>
__device__ __forceinline__ void naive_attn(float* S, float* INV, const bf16* Q, int qpitch, int nq, KSrc ks, KSrc vs, int jlo, int nk,
                                           const float* btab, float sink2, const bf16* gate, int gpitch, bf16* out, int opitch) {
    const int tid = opaque_tid(), lane = tid & 63, wave = tid >> 6;
#pragma unroll 1
    for (int idx = tid; idx < nq * nk; idx += NTHREADS) {
        const int i = idx / nk, j = idx - i * nk;
        float s;
        if (j < jlo) s = -1e30f;
        else {
            const bf16* q = Q + (long)i * qpitch; const bf16* k = ks_row(ks, j);
            float a = 0.f;
#pragma unroll 2
            for (int d = 0; d < HD; d += 8) {
                const v4u qv = *(const v4u*)(q + d), kv = *(const v4u*)(k + d);
                a += __builtin_bit_cast(float, qv.x << 16) * __builtin_bit_cast(float, kv.x << 16) + __builtin_bit_cast(float, qv.x & 0xffff0000u) * __builtin_bit_cast(float, kv.x & 0xffff0000u);
                a += __builtin_bit_cast(float, qv.y << 16) * __builtin_bit_cast(float, kv.y << 16) + __builtin_bit_cast(float, qv.y & 0xffff0000u) * __builtin_bit_cast(float, kv.y & 0xffff0000u);
                a += __builtin_bit_cast(float, qv.z << 16) * __builtin_bit_cast(float, kv.z << 16) + __builtin_bit_cast(float, qv.z & 0xffff0000u) * __builtin_bit_cast(float, kv.z & 0xffff0000u);
                a += __builtin_bit_cast(float, qv.w << 16) * __builtin_bit_cast(float, kv.w << 16) + __builtin_bit_cast(float, qv.w & 0xffff0000u) * __builtin_bit_cast(float, kv.w & 0xffff0000u);
            }
            s = a; if (SWA) s += btab[j - i + 63];
        }
        S[i * 257 + j] = s;
    }
    __syncthreads();
    for (int i = wave; i < nq; i += NWAVES) {
        float m = SWA ? sink2 : -3.0e38f;
        for (int j = lane; j < nk; j += 64) m = fmaxf(m, S[i * 257 + j]);
        m = wave_max(m);
        float sum = 0.f;
        for (int j = lane; j < nk; j += 64) { const float p = exp2f(S[i * 257 + j] - m); sum += p; S[i * 257 + j] = rbf(p); }
        sum = wave_sum(sum);
        if (SWA) sum += exp2f(sink2 - m);
        if (lane == 0) INV[i] = 1.0f / sum;
    }
    __syncthreads();
#pragma unroll 1
    for (int idx = tid; idx < nq * HD; idx += NTHREADS) {
        const int i = idx / HD, d = idx % HD;
        float o = 0.f;
#pragma unroll 4
        for (int j = jlo; j < nk; ++j) o += S[i * 257 + j] * bf2f(ks_row(vs, j)[d]);
        o *= INV[i];
        o *= bf2f(gate[(long)i * gpitch + d]);
        out[(long)i * opitch + d] = (bf16)f2bf(o);
    }
    __syncthreads();
}

__device__ __forceinline__ void naive_conv(float* C, const bf16* Useq, int t0, int nfr, const float* left, const float* cw, const float* cb, const float* lng, const float* lnb,
                                           const float* wpw  , const float* bpw, const bf16* gate  , bf16* out  ) {
    const int tid = opaque_tid(), lane = tid & 63, wave = tid >> 6;
    {
        const int ch = tid;
        float w[31];
#pragma unroll
        for (int j = 0; j < 31; ++j) w[j] = cw[j * 512 + ch];
        const float b = cb[ch];
#pragma unroll 1
        for (int tt = 0; tt < 64; ++tt) {
            float a = 0.f;
            if (tt < nfr) {
                a = b;
#pragma unroll
                for (int j = 0; j < 31; ++j) { const int e = t0 + tt - 30 + j;
                    const float uv = (e >= 0) ? bf2f(Useq[(long)e * ZP + ch]) : (left ? left[(30 + e) * 512 + ch] : 0.f);
                    a += w[j] * uv; }
            }
            C[tt * 516 + ch] = a;
        }
    }
    __syncthreads();
    for (int tt = wave; tt < 64; tt += NWAVES) {
        float v[8]; float s = 0.f;
#pragma unroll
        for (int j = 0; j < 8; ++j) { v[j] = C[tt * 516 + lane + 64 * j]; s += v[j]; }
        const float mu = wave_sum(s) * (1.0f / 512.0f); float q = 0.f;
#pragma unroll
        for (int j = 0; j < 8; ++j) { v[j] -= mu; q += v[j] * v[j]; }
        const float rstd = 1.0f / sqrtf(wave_sum(q) * (1.0f / 512.0f) + 1e-6f);
#pragma unroll
        for (int j = 0; j < 8; ++j) { const int ch = lane + 64 * j; const float y = v[j] * rstd * lng[ch] + lnb[ch]; C[tt * 516 + ch] = rbf(y / (1.0f + __expf(-y))); }
    }
    __syncthreads();
    {
        const int n = tid;
        const float bb = bpw[n];
#pragma unroll 1
        for (int tg = 0; tg < 64; tg += 16) {
            if (tg >= nfr) break;
            float acc[16];
#pragma unroll
            for (int tt = 0; tt < 16; ++tt) acc[tt] = 0.f;
#pragma unroll 1
            for (int k = 0; k < 512; k += 4) {
                const float w0 = rbf(wpw[(size_t)(k + 0) * 512 + n]), w1 = rbf(wpw[(size_t)(k + 1) * 512 + n]), w2 = rbf(wpw[(size_t)(k + 2) * 512 + n]), w3 = rbf(wpw[(size_t)(k + 3) * 512 + n]);
#pragma unroll
                for (int tt = 0; tt < 16; ++tt) { const f32x4 c = *(const f32x4*)(C + (tg + tt) * 516 + k); acc[tt] += (c.x * w0 + c.y * w1) + (c.z * w2 + c.w * w3); }
            }
#pragma unroll
            for (int tt = 0; tt < 16; ++tt) if (tg + tt < nfr) out[(long)(tg + tt) * DM + n] = (bf16)f2bf((acc[tt] + bb) * bf2f(gate[(long)(tg + tt) * ZP + n]));
        }
    }
    __syncthreads();
}

__device__ __forceinline__ void naive_mixer_phase(Frame& F, const Args& A, int l) {
    unsigned char* ws = A.ws;
    float* S = (float*)F.glds;
    float* INV = S + 64 * 257;
    const bf16* Z = (const bf16*)(ws + WS_Z); bf16* Y = (bf16*)(ws + WS_YMIX);
    const float* BT = (const float*)(ws + WS_BT);
    constexpr int U0 = 128, U1 = U0 + 8, U2 = U1 + 512, U3 = U2 + 32, U4 = U3 + 2048, U5 = U4 + 128;
    for (int u = blockIdx.x; u < U5; u += F.G) {
        if (!((A.mix_mask >> (u < U1 ? 0 : (u < U3 ? 1 : 2))) & 1)) continue;
        if (u < U1) {
            int rowbase, t0, nfr; const float* left = nullptr;
            if (u < U0) { const int b = u >> 6, c = u & 63; rowbase = b * SEQ; t0 = c * 64; nfr = 64; }
            else { const int b = u - U0; rowbase = NROWP + b * NSS; t0 = 0; nfr = NSS; left = A.in[5] + (size_t)(l * 8 + b) * 30 * 512; }
            naive_conv(S, Z + (size_t)rowbase * ZP + ZC_U, t0, nfr, left, A.in[10] + l * 31 * 512, A.in[11] + l * 512, A.in[12] + l * 512, A.in[13] + l * 512,
                       A.in[14] + (size_t)l * 512 * 512, A.in[15] + l * 512, Z + (size_t)(rowbase + t0) * ZP + ZC_GA, Y + (size_t)(rowbase + t0) * DM);
        } else if (u < U3) {
            int row0, nq, h; KSrc ks, vs;
            if (u < U2) { const int v = u - U1, b = v >> 8, h_ = (v >> 6) & 3, qt = v & 63; h = h_; row0 = b * SEQ + qt * 64; nq = 64;
                const bf16* kb = (const bf16*)(ws + WS_MKVP) + (size_t)(b * 256) * 4096 + l * 1024 + h * 128;
                ks = KSrc{kb, 4096, 256, kb, 4096}; vs = KSrc{kb + 512, 4096, 256, kb + 512, 4096}; }
            else { const int v = u - U2, b = v >> 2; h = v & 3; row0 = NROWP + b * NSS; nq = NSS;
                const bf16* kb = (const bf16*)(ws + WS_CMK) + (size_t)((l * 8 + b) * 256) * 512 + h * 128; const bf16* vb = (const bf16*)(ws + WS_CMV) + (size_t)((l * 8 + b) * 256) * 512 + h * 128;
                ks = KSrc{kb, 512, 256, kb, 512}; vs = KSrc{vb, 512, 256, vb, 512}; }
            naive_attn<128, false>(S, INV, Z + (size_t)row0 * ZP + ZC_CQ + h * 128, ZP, nq, ks, vs, 0, 256, nullptr, 0.f,
                                   Z + (size_t)row0 * ZP + ZC_GC + h * 128, ZP, Y + (size_t)row0 * DM + 1536 + h * 128, DM);
        } else {
            int row0, nq, h, jlo, nk; KSrc ks, vs;
            if (u < U4) { const int v = u - U3, b = v >> 10, c = (v >> 4) & 63; h = v & 15; row0 = b * SEQ + c * 64; nq = 64; const int kv = h >> 3;
                const bf16* kb = Z + ((long)row0 - 128) * ZP + ZC_K + kv * 64;
                ks = KSrc{kb, ZP, 192, kb, ZP}; vs = KSrc{kb + (ZC_V - ZC_K), ZP, 192, kb + (ZC_V - ZC_K), ZP}; jlo = (c >= 2) ? 0 : 128 - 64 * c; nk = 192; }
            else { const int v = u - U4, b = v >> 4; h = v & 15; row0 = NROWP + b * NSS; nq = NSS; const int kv = h >> 3;
                const bf16* ck = (const bf16*)(ws + WS_CSK) + (size_t)((l * 8 + b) * 128) * 128 + kv * 64; const bf16* cv = (const bf16*)(ws + WS_CSV) + (size_t)((l * 8 + b) * 128) * 128 + kv * 64;
                const bf16* zk = Z + (size_t)row0 * ZP + ZC_K + kv * 64;
                ks = KSrc{ck, 128, 128, zk, ZP}; vs = KSrc{cv, 128, 128, zk + (ZC_V - ZC_K), ZP}; jlo = 0; nk = 144; }
            naive_attn<64, true>(S, INV, Z + (size_t)row0 * ZP + ZC_Q + h * 64, ZP, nq, ks, vs, jlo, nk, BT + h * 256, A.in[16][l * 16 + h] * LOG2E,
                                 Z + (size_t)row0 * ZP + ZC_GB + h * 64, ZP, Y + (size_t)row0 * DM + 512 + h * 64, DM);
        }
    }
}

typedef float f32x16 __attribute__((ext_vector_type(16)));
typedef short s16x4 __attribute__((ext_vector_type(4)));
__device__ __forceinline__ bf16x8 pack_bf16x8(float a0, float a1, float a2, float a3, float a4, float a5, float a6, float a7) {
    v4u w; w.x = pg8::cvt_pk_bf16(a0, a1); w.y = pg8::cvt_pk_bf16(a2, a3); w.z = pg8::cvt_pk_bf16(a4, a5); w.w = pg8::cvt_pk_bf16(a6, a7);
    return __builtin_bit_cast(bf16x8, w);
}
__device__ __forceinline__ bf16x8 join4(s16x4 lo, s16x4 hi) { return (bf16x8){lo[0], lo[1], lo[2], lo[3], hi[0], hi[1], hi[2], hi[3]}; }
__device__ __forceinline__ float ex2(float x) { return __builtin_amdgcn_exp2f(x); }

constexpr int SW_KP = 144, SW_VP = 408;
constexpr int SW_KS = 0, SW_VT = 192 * SW_KP, SW_BT = SW_VT + 64 * SW_VP, SW_END = SW_BT + 8 * 256 * 4;
__device__ __forceinline__ int swa_vt_off(int d, int key) { return d * SW_VP + ((((key >> 2) ^ ((d >> 3) & 7))) << 3) + (key & 3) * 2; }
struct SwaUnit { const bf16* q; int nq; KSrc ks, vs; int jlo, nk; const bf16* gate; bf16* out; int kvh; };

__device__ __forceinline__ void swa_unit(LAS unsigned char* L, const SwaUnit& U, const float* BT, const float* sinks) {
    const int tid = opaque_tid(), lane = tid & 63, wave = __builtin_amdgcn_readfirstlane(tid >> 6);
    typedef unsigned u32x2v __attribute__((ext_vector_type(2)));
    const int i32 = lane & 31, hf = lane >> 5, g = wave;
    v4u kreg[3], va[2], vb[2]; float btv[4]; bf16x8 qf[2][4]; u32x2v gv[2][2][4];
#pragma unroll
    for (int it = 0; it < 3; ++it) {
        const int t = tid + NTHREADS * it, row = t >> 3, c8 = t & 7;
        kreg[it] = (v4u){0u, 0u, 0u, 0u};
        if (row >= U.jlo && row < U.nk) kreg[it] = *(const v4u*)(ks_row(U.ks, row) + c8 * 8);
    }
#pragma unroll
    for (int it = 0; it < 2; ++it) {
        const int t = tid + NTHREADS * it, rp = t >> 3, c8 = t & 7, j0 = 2 * rp;
        va[it] = (v4u){0u, 0u, 0u, 0u}; vb[it] = (v4u){0u, 0u, 0u, 0u};
        if (t < 768) {
            if (j0 >= U.jlo && j0 < U.nk) va[it] = *(const v4u*)(ks_row(U.vs, j0) + c8 * 8);
            if (j0 + 1 >= U.jlo && j0 + 1 < U.nk) vb[it] = *(const v4u*)(ks_row(U.vs, j0 + 1) + c8 * 8);
        }
    }
#pragma unroll
    for (int it = 0; it < 4; ++it) btv[it] = BT[U.kvh * 8 * 256 + tid + NTHREADS * it];
#pragma unroll
    for (int qb = 0; qb < 2; ++qb) {
        const int i = qb * 32 + i32, iq = (i < U.nq) ? i : 0;
        const bf16* qrow = U.q + (long)iq * ZP + g * 64;
#pragma unroll
        for (int ds = 0; ds < 4; ++ds) qf[qb][ds] = *(const bf16x8*)(qrow + 16 * ds + 8 * hf);
#pragma unroll
        for (int dt = 0; dt < 2; ++dt)
#pragma unroll
            for (int g4 = 0; g4 < 4; ++g4) gv[qb][dt][g4] = *(const u32x2v*)(U.gate + (long)iq * ZP + g * 64 + dt * 32 + 8 * g4 + 4 * hf);
    }
    const float sink2 = sinks[U.kvh * 8 + g] * LOG2E;
#pragma unroll
    for (int it = 0; it < 3; ++it) { const int t = tid + NTHREADS * it, row = t >> 3, c8 = t & 7; *(LAS v4u*)(L + SW_KS + row * SW_KP + c8 * 16) = kreg[it]; }
#pragma unroll
    for (int it = 0; it < 2; ++it) {
        const int t = tid + NTHREADS * it, rp = t >> 3, c8 = t & 7, j0 = 2 * rp;
        if (t < 768) {
#pragma unroll
            for (int e = 0; e < 8; ++e) {
                const unsigned lo = (va[it][e >> 1] >> (16 * (e & 1))) & 0xffffu, hi = (vb[it][e >> 1] >> (16 * (e & 1))) & 0xffffu;
                *(LAS unsigned*)(L + SW_VT + swa_vt_off(c8 * 8 + e, j0)) = lo | (hi << 16);
            }
        }
    }
#pragma unroll
    for (int it = 0; it < 4; ++it) ((LAS float*)(L + SW_BT))[tid + NTHREADS * it] = btv[it];
    __syncthreads();
    const LAS float* bt = (const LAS float*)(L + SW_BT) + g * 256;
#pragma unroll
    for (int qb = 0; qb < 2; ++qb) {
        if (qb * 32 < U.nq) {
        const int i = qb * 32 + i32;
        f32x16 S[6];
        {
            bf16x8 kf[2][4];
#pragma unroll
            for (int ds = 0; ds < 4; ++ds) kf[0][ds] = *(const LAS bf16x8*)(L + SW_KS + (0 * 32 + i32) * SW_KP + ds * 32 + hf * 16);
#pragma unroll
            for (int kt = 0; kt < 6; ++kt) {
                if (kt + 1 < 6) {
#pragma unroll
                    for (int ds = 0; ds < 4; ++ds) kf[(kt + 1) & 1][ds] = *(const LAS bf16x8*)(L + SW_KS + ((kt + 1) * 32 + i32) * SW_KP + ds * 32 + hf * 16);
                }
                f32x16 acc = {};
#pragma unroll
                for (int ds = 0; ds < 4; ++ds) acc = __builtin_amdgcn_mfma_f32_32x32x16_bf16(kf[kt & 1][ds], qf[qb][ds], acc, 0, 0, 0);
                S[kt] = acc;
            }
        }
        float m = sink2;
#pragma unroll
        for (int kt = 0; kt < 6; ++kt)
#pragma unroll
            for (int r = 0; r < 16; ++r) {
                const int j = kt * 32 + (r & 3) + 8 * (r >> 2) + 4 * hf;
                float s = S[kt][r] + bt[j - i + 63];
                if (j < U.jlo || j >= U.nk) s = -1e30f;
                S[kt][r] = s; m = fmaxf(m, s);
            }
        m = fmaxf(m, __shfl_xor(m, 32));
        float lsum = 0.f;
#pragma unroll
        for (int kt = 0; kt < 6; ++kt)
#pragma unroll
            for (int r = 0; r < 16; ++r) { const float p = ex2(S[kt][r] - m); S[kt][r] = p; lsum += p; }
        lsum += __shfl_xor(lsum, 32);
        const float inv = 1.0f / (lsum + ex2(sink2 - m));
        f32x16 O[2]; O[0] = (f32x16){}; O[1] = (f32x16){};
        {
            s16x4 vq[2][2][2][2];
#pragma unroll
            for (int s2 = 0; s2 < 2; ++s2)
#pragma unroll
                for (int dt = 0; dt < 2; ++dt) { const int d = dt * 32 + i32, key0 = 16 * s2 + 4 * hf;
                    vq[0][s2][dt][0] = *(const LAS s16x4*)(L + SW_VT + swa_vt_off(d, key0)); vq[0][s2][dt][1] = *(const LAS s16x4*)(L + SW_VT + swa_vt_off(d, key0 + 8)); }
#pragma unroll
            for (int kt = 0; kt < 6; ++kt) {
                if (kt + 1 < 6) {
#pragma unroll
                    for (int s2 = 0; s2 < 2; ++s2)
#pragma unroll
                        for (int dt = 0; dt < 2; ++dt) { const int d = dt * 32 + i32, key0 = (kt + 1) * 32 + 16 * s2 + 4 * hf;
                            vq[(kt + 1) & 1][s2][dt][0] = *(const LAS s16x4*)(L + SW_VT + swa_vt_off(d, key0)); vq[(kt + 1) & 1][s2][dt][1] = *(const LAS s16x4*)(L + SW_VT + swa_vt_off(d, key0 + 8)); }
                }
#pragma unroll
                for (int s2 = 0; s2 < 2; ++s2) {
                    const bf16x8 pf = pack_bf16x8(S[kt][8 * s2 + 0], S[kt][8 * s2 + 1], S[kt][8 * s2 + 2], S[kt][8 * s2 + 3], S[kt][8 * s2 + 4], S[kt][8 * s2 + 5], S[kt][8 * s2 + 6], S[kt][8 * s2 + 7]);
#pragma unroll
                    for (int dt = 0; dt < 2; ++dt) O[dt] = __builtin_amdgcn_mfma_f32_32x32x16_bf16(join4(vq[kt & 1][s2][dt][0], vq[kt & 1][s2][dt][1]), pf, O[dt], 0, 0, 0);
                }
            }
        }
        if (i < U.nq) {
#pragma unroll
            for (int dt = 0; dt < 2; ++dt)
#pragma unroll
                for (int g4 = 0; g4 < 4; ++g4) {
                    const int d0 = dt * 32 + 8 * g4 + 4 * hf;
                    const u32x2v gg = gv[qb][dt][g4];
                    const float o0 = O[dt][4 * g4 + 0] * inv * __builtin_bit_cast(float, gg.x << 16), o1 = O[dt][4 * g4 + 1] * inv * __builtin_bit_cast(float, gg.x & 0xffff0000u);
                    const float o2 = O[dt][4 * g4 + 2] * inv * __builtin_bit_cast(float, gg.y << 16), o3 = O[dt][4 * g4 + 3] * inv * __builtin_bit_cast(float, gg.y & 0xffff0000u);
                    u32x2v w; w.x = pg8::cvt_pk_bf16(o0, o1); w.y = pg8::cvt_pk_bf16(o2, o3);
                    *(u32x2v*)(U.out + (long)i * DM + g * 64 + d0) = w;
                }
        }
        }
    }
    __syncthreads();
}

constexpr int MA_KP = 272, MA_VP = 528;
constexpr int MA_KS = 0, MA_VT = 256 * MA_KP, MA_END = MA_VT + 128 * MA_VP;
__device__ __forceinline__ int ma_vt_off(int d, int key) { return d * MA_VP + ((((key >> 2) ^ ((d >> 3) & 15))) << 3) + (key & 3) * 2; }
struct MemUnit { const bf16* q; int nq; const bf16* k; const bf16* v; int pitch; const bf16* gate; bf16* out; };

__device__ __forceinline__ void mem_unit(LAS unsigned char* L, const MemUnit& U) {
    typedef unsigned u32x2v __attribute__((ext_vector_type(2)));
    const int tid = opaque_tid(), lane = tid & 63, wave = __builtin_amdgcn_readfirstlane(tid >> 6);
    const int i16 = lane & 15, q4 = lane >> 4;
    bf16x8 qf[2][4]; u32x2v gv[2][8];
#pragma unroll
    for (int gi = 0; gi < 2; ++gi) {
        const int grp = wave + NWAVES * gi, i = (grp * 16 < U.nq) ? grp * 16 + i16 : i16;
        const bf16* qrow = U.q + (long)i * ZP;
#pragma unroll
        for (int ds = 0; ds < 4; ++ds) qf[gi][ds] = *(const bf16x8*)(qrow + 32 * ds + 8 * q4);
#pragma unroll
        for (int dt = 0; dt < 8; ++dt) gv[gi][dt] = *(const u32x2v*)(U.gate + (long)i * ZP + dt * 16 + 4 * q4);
    }
    {
        v4u kr[8];
#pragma unroll
        for (int it = 0; it < 8; ++it) { const int t = tid + NTHREADS * it, row = t >> 4, c8 = t & 15; kr[it] = *(const v4u*)(U.k + (long)row * U.pitch + c8 * 8); }
#pragma unroll
        for (int it = 0; it < 8; ++it) { const int t = tid + NTHREADS * it, row = t >> 4, c8 = t & 15; *(LAS v4u*)(L + MA_KS + row * MA_KP + c8 * 16) = kr[it]; }
    }
    {
        v4u va[4], vb[4];
#pragma unroll
        for (int it = 0; it < 4; ++it) { const int t = tid + NTHREADS * it, rp = t >> 4, c8 = t & 15, j0 = 2 * rp;
            va[it] = *(const v4u*)(U.v + (long)j0 * U.pitch + c8 * 8); vb[it] = *(const v4u*)(U.v + (long)(j0 + 1) * U.pitch + c8 * 8); }
#pragma unroll
        for (int it = 0; it < 4; ++it) { const int t = tid + NTHREADS * it, rp = t >> 4, c8 = t & 15, j0 = 2 * rp;
#pragma unroll
            for (int e = 0; e < 8; ++e) {
                const unsigned lo = (va[it][e >> 1] >> (16 * (e & 1))) & 0xffffu, hi = (vb[it][e >> 1] >> (16 * (e & 1))) & 0xffffu;
                *(LAS unsigned*)(L + MA_VT + ma_vt_off(c8 * 8 + e, j0)) = lo | (hi << 16);
            } }
    }
    __syncthreads();
#pragma unroll
    for (int gi = 0; gi < 2; ++gi) {
        const int grp = wave + NWAVES * gi;
        if (grp * 16 < U.nq) {
        const int i = grp * 16 + i16;
        f32x4 S[16];
        {
            bf16x8 kf[2][2][4];
#pragma unroll
            for (int t2 = 0; t2 < 2; ++t2)
#pragma unroll
                for (int ds = 0; ds < 4; ++ds) kf[0][t2][ds] = *(const LAS bf16x8*)(L + MA_KS + (t2 * 16 + i16) * MA_KP + ds * 64 + q4 * 16);
#pragma unroll
            for (int kp = 0; kp < 8; ++kp) {
                if (kp + 1 < 8) {
#pragma unroll
                    for (int t2 = 0; t2 < 2; ++t2)
#pragma unroll
                        for (int ds = 0; ds < 4; ++ds) kf[(kp + 1) & 1][t2][ds] = *(const LAS bf16x8*)(L + MA_KS + (((kp + 1) * 2 + t2) * 16 + i16) * MA_KP + ds * 64 + q4 * 16);
                }
#pragma unroll
                for (int t2 = 0; t2 < 2; ++t2) {
                    f32x4 acc = {};
#pragma unroll
                    for (int ds = 0; ds < 4; ++ds) acc = __builtin_amdgcn_mfma_f32_16x16x32_bf16(kf[kp & 1][t2][ds], qf[gi][ds], acc, 0, 0, 0);
                    S[kp * 2 + t2] = acc;
                }
            }
        }
        float m = -3.0e38f;
#pragma unroll
        for (int kt = 0; kt < 16; ++kt) m = fmaxf(fmaxf(m, fmaxf(S[kt][0], S[kt][1])), fmaxf(S[kt][2], S[kt][3]));
        m = fmaxf(m, __shfl_xor(m, 16)); m = fmaxf(m, __shfl_xor(m, 32));
        float lsum = 0.f;
#pragma unroll
        for (int kt = 0; kt < 16; ++kt)
#pragma unroll
            for (int r = 0; r < 4; ++r) { const float p = ex2(S[kt][r] - m); S[kt][r] = p; lsum += p; }
        lsum += __shfl_xor(lsum, 16); lsum += __shfl_xor(lsum, 32);
        const float inv = 1.0f / lsum;
        f32x4 O[8];
#pragma unroll
        for (int dt = 0; dt < 8; ++dt) O[dt] = (f32x4){0.f, 0.f, 0.f, 0.f};
        {
            s16x4 vq[2][8][2];
#pragma unroll
            for (int dt = 0; dt < 8; ++dt) { const int d = dt * 16 + i16, key0 = 4 * q4;
                vq[0][dt][0] = *(const LAS s16x4*)(L + MA_VT + ma_vt_off(d, key0)); vq[0][dt][1] = *(const LAS s16x4*)(L + MA_VT + ma_vt_off(d, key0 + 16)); }
#pragma unroll
            for (int st = 0; st < 8; ++st) {
                if (st + 1 < 8) {
#pragma unroll
                    for (int dt = 0; dt < 8; ++dt) { const int d = dt * 16 + i16, key0 = 32 * (st + 1) + 4 * q4;
                        vq[(st + 1) & 1][dt][0] = *(const LAS s16x4*)(L + MA_VT + ma_vt_off(d, key0)); vq[(st + 1) & 1][dt][1] = *(const LAS s16x4*)(L + MA_VT + ma_vt_off(d, key0 + 16)); }
                }
                const bf16x8 pf = pack_bf16x8(S[2 * st][0], S[2 * st][1], S[2 * st][2], S[2 * st][3], S[2 * st + 1][0], S[2 * st + 1][1], S[2 * st + 1][2], S[2 * st + 1][3]);
#pragma unroll
                for (int dt = 0; dt < 8; ++dt) O[dt] = __builtin_amdgcn_mfma_f32_16x16x32_bf16(join4(vq[st & 1][dt][0], vq[st & 1][dt][1]), pf, O[dt], 0, 0, 0);
            }
        }
#pragma unroll
        for (int dt = 0; dt < 8; ++dt) {
            const int d0 = dt * 16 + 4 * q4;
            const u32x2v gg = gv[gi][dt];
            const float o0 = O[dt][0] * inv * __builtin_bit_cast(float, gg.x << 16), o1 = O[dt][1] * inv * __builtin_bit_cast(float, gg.x & 0xffff0000u);
            const float o2 = O[dt][2] * inv * __builtin_bit_cast(float, gg.y << 16), o3 = O[dt][3] * inv * __builtin_bit_cast(float, gg.y & 0xffff0000u);
            u32x2v w; w.x = pg8::cvt_pk_bf16(o0, o1); w.y = pg8::cvt_pk_bf16(o2, o3);
            *(u32x2v*)(U.out + (long)i * DM + d0) = w;
        }
        }
    }
    __syncthreads();
}

typedef float cv_f32x2 __attribute__((ext_vector_type(2)));
template <int R> __device__ __forceinline__ void conv_rows(cv_f32x2 (&acc)[32], const cv_f32x2 (&w)[31], const unsigned (&raw)[62], bool neg, const float* left, int ch) {
    cv_f32x2 x = (cv_f32x2){__builtin_bit_cast(float, raw[R] << 16), __builtin_bit_cast(float, raw[R] & 0xffff0000u)};
    if constexpr (R < 30) { if (neg) { if (left) x = *(const cv_f32x2*)(left + R * 512 + ch); else x = (cv_f32x2){0.f, 0.f}; } }
    constexpr int TLO = (R > 30) ? R - 30 : 0, THI = (R < 31) ? R : 31;
#pragma unroll
    for (int tt = TLO; tt <= THI; ++tt) acc[tt] += w[R - tt] * x;
    if constexpr (R + 1 < 62) conv_rows<R + 1>(acc, w, raw, neg, left, ch);
}
constexpr int CV_P = 2064;
__device__ __forceinline__ void conv_unit(LAS unsigned char* L, const bf16* Useq, int t0, int nfr, const float* left, const float* cw, const float* cb, const float* lng, const float* lnb,
                                          const bf16* WpwT, const float* bpw, const bf16* gate, bf16* out) {
    typedef float f32x2 __attribute__((ext_vector_type(2)));
    const int tid = opaque_tid(), lane = tid & 63, wave = __builtin_amdgcn_readfirstlane(tid >> 6);
    {
        const int cp = tid & 255, fh = __builtin_amdgcn_readfirstlane(tid >> 8), ch = 2 * cp;
        f32x2 w[31];
#pragma unroll
        for (int j = 0; j < 31; ++j) w[j] = *(const f32x2*)(cw + j * 512 + ch);
        const f32x2 bias = *(const f32x2*)(cb + ch);
        f32x2 acc[32];
#pragma unroll
        for (int tt = 0; tt < 32; ++tt) acc[tt] = bias;
        const int tbase = t0 + 32 * fh;
        unsigned raw[62];
#pragma unroll
        for (int r = 0; r < 62; ++r) { const int e = tbase - 30 + r; raw[r] = *(const unsigned*)(Useq + (long)(e > 0 ? e : 0) * ZP + ch); }
        conv_rows<0>(acc, w, raw, tbase == 0, left, ch);
#pragma unroll
        for (int tt = 0; tt < 32; ++tt) { const int fr_ = 32 * fh + tt; *(LAS f32x2*)(L + fr_ * CV_P + ch * 4) = (fr_ < nfr) ? acc[tt] : (f32x2){0.f, 0.f}; }
    }
    __syncthreads();
    {
        const f32x4 g0 = *(const f32x4*)(lng + 8 * lane), g1 = *(const f32x4*)(lng + 8 * lane + 4), b0 = *(const f32x4*)(lnb + 8 * lane), b1 = *(const f32x4*)(lnb + 8 * lane + 4);
#pragma unroll 1
        for (int tt = wave; tt < 64; tt += NWAVES) {
            LAS unsigned char* row = L + tt * CV_P;
            f32x4 a = *(const LAS f32x4*)(row + 32 * lane), b = *(const LAS f32x4*)(row + 32 * lane + 16);
            const float mu = wave_sum(((a[0] + a[1]) + (a[2] + a[3])) + ((b[0] + b[1]) + (b[2] + b[3]))) * (1.0f / 512.0f);
            a = a - mu; b = b - mu;
            const float rstd = 1.0f / sqrtf(wave_sum(((a[0] * a[0] + a[1] * a[1]) + (a[2] * a[2] + a[3] * a[3])) + ((b[0] * b[0] + b[1] * b[1]) + (b[2] * b[2] + b[3] * b[3]))) * (1.0f / 512.0f) + 1e-6f);
            a = a * rstd * g0 + b0; b = b * rstd * g1 + b1;
            a = a * pg8::sigmoid4(a); b = b * pg8::sigmoid4(b);
            *(LAS v4u*)(row + 16 * lane) = __builtin_bit_cast(v4u, pg8::pack8(a, b));
        }
    }
    __syncthreads();
    {
        typedef unsigned u32x2v __attribute__((ext_vector_type(2)));
        const int i16 = lane & 15, q4 = lane >> 4;
        f32x4 acc[4][4];
#pragma unroll
        for (int rt = 0; rt < 4; ++rt)
#pragma unroll
            for (int nt = 0; nt < 4; ++nt) acc[rt][nt] = (f32x4){0.f, 0.f, 0.f, 0.f};
        const bf16* wbase = WpwT + (size_t)(64 * wave + i16) * 512 + 8 * q4;
        {
            bf16x8 wf[4][4], cf[2][4];
#pragma unroll
            for (int k4 = 0; k4 < 4; ++k4)
#pragma unroll
                for (int nt = 0; nt < 4; ++nt) wf[k4][nt] = *(const bf16x8*)(wbase + nt * 16 * 512 + k4 * 32);
#pragma unroll
            for (int rt = 0; rt < 4; ++rt) cf[0][rt] = *(const LAS bf16x8*)(L + (rt * 16 + i16) * CV_P + q4 * 16);
#pragma unroll
            for (int ks = 0; ks < 16; ++ks) {
                if (ks + 1 < 16) {
#pragma unroll
                    for (int rt = 0; rt < 4; ++rt) cf[(ks + 1) & 1][rt] = *(const LAS bf16x8*)(L + (rt * 16 + i16) * CV_P + (ks + 1) * 64 + q4 * 16);
                }
#pragma unroll
                for (int rt = 0; rt < 4; ++rt)
#pragma unroll
                    for (int nt = 0; nt < 4; ++nt) acc[rt][nt] = __builtin_amdgcn_mfma_f32_16x16x32_bf16(wf[ks & 3][nt], cf[ks & 1][rt], acc[rt][nt], 0, 0, 0);
                if (ks + 4 < 16) {
#pragma unroll
                    for (int nt = 0; nt < 4; ++nt) wf[ks & 3][nt] = *(const bf16x8*)(wbase + nt * 16 * 512 + (ks + 4) * 32);
                }
            }
        }
#pragma unroll
        for (int rt = 0; rt < 4; ++rt) {
            const int frame = rt * 16 + i16;
            if (frame < nfr) {
#pragma unroll
                for (int nt = 0; nt < 4; ++nt) {
                    const int n0 = 64 * wave + nt * 16 + 4 * q4;
                    const f32x4 bb = *(const f32x4*)(bpw + n0);
                    const u32x2v gv = *(const u32x2v*)(gate + (long)frame * ZP + n0);
                    const float o0 = (acc[rt][nt][0] + bb[0]) * __builtin_bit_cast(float, gv.x << 16), o1 = (acc[rt][nt][1] + bb[1]) * __builtin_bit_cast(float, gv.x & 0xffff0000u);
                    const float o2 = (acc[rt][nt][2] + bb[2]) * __builtin_bit_cast(float, gv.y << 16), o3 = (acc[rt][nt][3] + bb[3]) * __builtin_bit_cast(float, gv.y & 0xffff0000u);
                    u32x2v wv; wv.x = pg8::cvt_pk_bf16(o0, o1); wv.y = pg8::cvt_pk_bf16(o2, o3);
                    *(u32x2v*)(out + (long)frame * DM + n0) = wv;
                }
            }
        }
    }
    __syncthreads();
}

#ifndef USE_MFMA_ATTN
#define USE_MFMA_ATTN 1
#endif
#ifndef USE_MFMA_CONV
#define USE_MFMA_CONV 1
#endif
__device__ __forceinline__ void mixer_phase(Frame& F, const Args& A, int l) {
    unsigned char* ws = A.ws;
    float* S = (float*)F.glds;
    const bf16* Z = (const bf16*)(ws + WS_Z); bf16* Y = (bf16*)(ws + WS_YMIX);
    const float* BT = (const float*)(ws + WS_BT);
    constexpr int U0 = 128, U1 = U0 + 8, U2 = U1 + 128, U3 = U2 + 32, U4 = U3 + 256, U5 = U4 + 16;
#pragma unroll 1
    for (int u = blockIdx.x; u < U5; u += F.G) {
        if (!((A.mix_mask >> (u < U1 ? 0 : (u < U3 ? 1 : 2))) & 1)) continue;
        if (u < U1) {
            int rowbase, t0, nfr; const float* left = nullptr;
            if (u < U0) { const int b = u >> 6, c = u & 63; rowbase = b * SEQ; t0 = c * 64; nfr = 64; }
            else { const int b = u - U0; rowbase = NROWP + b * NSS; t0 = 0; nfr = NSS; left = A.in[5] + (size_t)(l * 8 + b) * 30 * 512; }
#if USE_MFMA_CONV
            conv_unit(F.lds, Z + (size_t)rowbase * ZP + ZC_U, t0, nfr, left, A.in[10] + l * 31 * 512, A.in[11] + l * 512, A.in[12] + l * 512, A.in[13] + l * 512,
                      (const bf16*)(ws + WS_WPW) + (size_t)l * 512 * 512, A.in[15] + l * 512, Z + (size_t)(rowbase + t0) * ZP + ZC_GA, Y + (size_t)(rowbase + t0) * DM);
#else
            naive_conv(S, Z + (size_t)rowbase * ZP + ZC_U, t0, nfr, left, A.in[10] + l * 31 * 512, A.in[11] + l * 512, A.in[12] + l * 512, A.in[13] + l * 512,
                       A.in[14] + (size_t)l * 512 * 512, A.in[15] + l * 512, Z + (size_t)(rowbase + t0) * ZP + ZC_GA, Y + (size_t)(rowbase + t0) * DM);
#endif
        } else if (u < U3) {
            MemUnit M; int row0, h;
            if (u < U2) { const int v = u - U1, b = v >> 6, qblk = v & 15; h = (v >> 4) & 3; row0 = b * SEQ + qblk * 256; M.nq = 256;
                M.k = (const bf16*)(ws + WS_MKVP) + (size_t)(b * 256) * 4096 + l * 1024 + h * 128; M.v = M.k + 512; M.pitch = 4096; }
            else { const int v = u - U2, b = v >> 2; h = v & 3; row0 = NROWP + b * NSS; M.nq = NSS;
                M.k = (const bf16*)(ws + WS_CMK) + (size_t)((l * 8 + b) * 256) * 512 + h * 128; M.v = (const bf16*)(ws + WS_CMV) + (size_t)((l * 8 + b) * 256) * 512 + h * 128; M.pitch = 512; }
            M.q = Z + (size_t)row0 * ZP + ZC_CQ + h * 128; M.gate = Z + (size_t)row0 * ZP + ZC_GC + h * 128; M.out = Y + (size_t)row0 * DM + 1536 + h * 128;
            mem_unit(F.lds, M);
        } else {
            SwaUnit W; int row0, kv;
            if (u < U4) { const int v = u - U3, b = v >> 7, c = (v >> 1) & 63; kv = v & 1; row0 = b * SEQ + c * 64; W.nq = 64;
                const bf16* kb = Z + ((long)row0 - 128) * ZP + ZC_K + kv * 64;
                W.ks = KSrc{kb, ZP, 192, kb, ZP}; W.vs = KSrc{kb + (ZC_V - ZC_K), ZP, 192, kb + (ZC_V - ZC_K), ZP}; W.jlo = (c >= 2) ? 0 : 128 - 64 * c; W.nk = 192; }
            else { const int v = u - U4, b = v >> 1; kv = v & 1; row0 = NROWP + b * NSS; W.nq = NSS;
                const bf16* ck = (const bf16*)(ws + WS_CSK) + (size_t)((l * 8 + b) * 128) * 128 + kv * 64; const bf16* cv = (const bf16*)(ws + WS_CSV) + (size_t)((l * 8 + b) * 128) * 128 + kv * 64;
                const bf16* zk = Z + (size_t)row0 * ZP + ZC_K + kv * 64;
                W.ks = KSrc{ck, 128, 128, zk, ZP}; W.vs = KSrc{cv, 128, 128, zk + (ZC_V - ZC_K), ZP}; W.jlo = 0; W.nk = 144; }
            W.q = Z + (size_t)row0 * ZP + ZC_Q + kv * 512; W.gate = Z + (size_t)row0 * ZP + ZC_GB + kv * 512; W.out = Y + (size_t)row0 * DM + 512 + kv * 512; W.kvh = kv;
            swa_unit(F.lds, W, BT, A.in[16] + l * 16);
        }
    }
}

__device__ __forceinline__ void final_norm_phase(Frame& F, const Args& A) {
    const float* X = (const float*)(A.ws + WS_X); const float* SSQ = (const float*)(A.ws + WS_SSQ); const float* g = A.in[21];
    const int tid_ = opaque_tid(), lane = tid_ & 63, wave_ = __builtin_amdgcn_readfirstlane(tid_ >> 6);
    const int gw = F.vcu * NWAVES + wave_, NGW = F.G * NWAVES;
    f32x4 gv[8];
#pragma unroll
    for (int j = 0; j < 8; ++j) gv[j] = ((const f32x4*)g)[lane + 64 * j];
    for (int m = gw; m < NROW; m += NGW) {
        float s = (lane < 32) ? SSQ[(size_t)m * 32 + lane] : 0.f;
        s = wave_sum(s);
        const float rstd = 1.0f / sqrtf(s * (1.0f / DM) + 1e-6f);
        const f32x4* xr = (const f32x4*)(X + (size_t)m * DM) + lane;
        f32x4* o = (f32x4*)(A.out + (m < NROWP ? OFF_YP + (size_t)m * DM : OFF_YS + (size_t)(m - NROWP) * DM)) + lane;
#pragma unroll
        for (int j = 0; j < 8; ++j) o[64 * j] = xr[64 * j] * rstd * gv[j];
    }
}

constexpr int N_PHASES = 2 + 3 * DEPTH;
#ifndef MK_SINGLE
#define MK_SINGLE 1
#endif
__global__ void __launch_bounds__(NTHREADS, 2) mk_fwd(Args args) {
    extern __shared__ __attribute__((aligned(16))) unsigned char lds[];
    Frame F;
    F.lds = (LAS unsigned char*)lds; F.glds = lds;
    F.MISC = (volatile LAS unsigned*)(F.lds + MISC_OFF);
    F.tid = threadIdx.x; F.lane = F.tid & 63; F.wave = __builtin_amdgcn_readfirstlane(F.tid >> 6);
    F.G = gridDim.x; { const int bx = blockIdx.x; F.vcu = (F.G % 8 == 0) ? (bx % 8) * (F.G / 8) + bx / 8 : bx; }
    unsigned char* ws = args.ws;
    F.ctl = (gu32*)(ws + WS_CTL);
    for (int u = F.tid; u < (LDS_BYTES - LDSCTL_OFF) / 4; u += NTHREADS) ((LAS unsigned*)(F.lds + LDSCTL_OFF))[u] = 0u;
    __syncthreads();
    XcdBarrier bar; bar.bar = (unsigned*)(F.ctl + CW_BAR); bar.x = 0; bar.st = nullptr;
    const int lo = args.ph_lo, hi = args.ph_hi;
    const bool multi = (hi - lo) > 1;
    if (multi) bar = xcd_barrier_post((unsigned*)(F.ctl + CW_BAR), F.MISC + 8);
#define SEAM(k) do { if (lo <= (k) && (k) + 1 < hi) xcd_barrier(bar); } while (0)
#define IN(k) (lo <= (k) && (k) < hi)
    if (IN(0)) { p0_prologue(F, args); SEAM(0); }
    if (IN(1)) {
        unsigned char* wsl = ws; asm volatile("" : "+s"(wsl));
        pg8::Gemm g{(const pg8::bf16_t*)(wsl + WS_MEMN), (const pg8::bf16_t*)(wsl + WS_WMEM), 512, 4096, DM};
        pg8::StaticOrder S; S.init(512, 4096, F.G, (int)(F.G - 1 - blockIdx.x));
        pg8::EpiMemKV E{(pg8::bf16_t*)(wsl + WS_MKVP), args.out};
        pg8::gemm_phase<pg8::EpiMemKV, pg8::StaticOrder, true, true>(F.lds, g, S, E);
    }
#pragma unroll 1
    for (int l = 0; l < DEPTH; ++l) {
        const int p1 = 1 + 3 * l, p2 = p1 + 1, p3 = p1 + 2;
        unsigned char* wsl = ws; int bxl = blockIdx.x; asm volatile("" : "+s"(wsl), "+s"(bxl));
        if (IN(p1)) {
            pg8::Gemm g{(const pg8::bf16_t*)(wsl + WS_XB), (const pg8::bf16_t*)(wsl + WS_WIN) + (size_t)l * INDIM * DM, MPAD, INDIM, DM};
            int vc1 = F.vcu; asm volatile("" : "+s"(vc1));
            pg8::Hybrid S; S.init(MPAD, INDIM, vc1, 2);
            pg8::EpiIn E{(pg8::bf16_t*)(wsl + WS_Z), (const float*)(wsl + WS_SSQ), args.out, l};
            pg8::SplitK<1> SK{(float*)(wsl + WS_DUMP), (unsigned*)(wsl + WS_CTL) + CW_SK + (l * 2 + 0) * 4096};
            pg8::gemm_phase<pg8::EpiIn, pg8::Hybrid, true, true, pg8::SplitK<1>>(F.lds, g, S, E, SK);
            SEAM(p1);
        }
#if USE_MFMA_ATTN
        if (IN(p2)) { mixer_phase(F, args, l); SEAM(p2); }
#else
        if (IN(p2)) { naive_mixer_phase(F, args, l); SEAM(p2); }
#endif
        if (IN(p3)) {
            pg8::Gemm g{(const pg8::bf16_t*)(wsl + WS_YMIX), (const pg8::bf16_t*)(wsl + WS_WOUT) + (size_t)l * DM * DM, MPAD, DM, DM};
            int vcl = F.vcu; asm volatile("" : "+s"(vcl));
            pg8::Hybrid S; S.init(MPAD, DM, vcl, 4);
            const float* Xc = (const float*)(wsl + WS_X);
            pg8::EpiOut E{(float*)(wsl + WS_X), (pg8::bf16_t*)(wsl + WS_XB), (float*)(wsl + WS_SSQ), l == 0 ? args.in[0] : Xc, l == 0 ? args.in[1] - (size_t)NROWP * DM : Xc};
            pg8::SplitK<3> SK{(float*)(wsl + WS_DUMP), (unsigned*)(wsl + WS_CTL) + CW_SK + (l * 2 + 1) * 4096};
            pg8::gemm_phase<pg8::EpiOut, pg8::Hybrid, true, true, pg8::SplitK<3>>(F.lds, g, S, E, SK);
            SEAM(p3);
        }
    }
    if (IN(N_PHASES - 1)) final_norm_phase(F, args);
#undef SEAM
#undef IN
}

extern "C" void kernel_launch(void* const* d_in, const int* in_sizes, int n_in, void* d_out, int out_size, void* d_ws, size_t ws_size, hipStream_t stream) {
    static int grid = 0;
    if (grid == 0) {
        if (n_in != 22 || out_size != (int)OUT_TOTAL || ws_size < WS_END) { fprintf(stderr, "kernel_launch: unexpected shapes: n_in %d out %d ws %zu\n", n_in, out_size, ws_size); grid = -1; return; }
        int dev = 0, cus = 0, per_cu = 0;
        if (hipGetDevice(&dev) != hipSuccess || hipDeviceGetAttribute(&cus, hipDeviceAttributeMultiprocessorCount, dev) != hipSuccess) { grid = -1; return; }
        if (hipFuncSetAttribute((const void*)mk_fwd, hipFuncAttributeMaxDynamicSharedMemorySize, LDS_BYTES) != hipSuccess) { fprintf(stderr, "kernel_launch: hipFuncSetAttribute failed\n"); grid = -1; return; }
        if (hipOccupancyMaxActiveBlocksPerMultiprocessor(&per_cu, (const void*)mk_fwd, NTHREADS, LDS_BYTES) != hipSuccess || per_cu < 1) { fprintf(stderr, "kernel_launch: occupancy query says %d blocks per CU\n", per_cu); (void)hipGetLastError(); grid = -1; return; }
        if (cus != 256) { fprintf(stderr, "kernel_launch: built for a 256-CU device, found %d CUs\n", cus); grid = -1; return; }
        grid = cus;
    }
    if (grid < 0) return;
    (void)hipMemsetAsync((char*)d_ws + WS_CTL, 0, CTL_ZERO_BYTES, stream);
    Args a{};
    for (int i = 0; i < 22; ++i) a.in[i] = (const float*)d_in[i];
    a.out = (float*)d_out; a.ws = (unsigned char*)d_ws;
#if MK_SINGLE
    a.mix_mask = 7;
#ifdef PROBE_PREFIX
#ifdef PROBE_MASK
    a.mix_mask = PROBE_MASK;
#endif
#ifdef PROBE_FLAGS
    a.pflags = PROBE_FLAGS;
#endif
    a.ph_lo = 0; a.ph_hi = PROBE_PREFIX;
    hipLaunchKernelGGL(mk_fwd, dim3(grid), dim3(NTHREADS), LDS_BYTES, stream, a);
    (void)hipMemsetAsync((char*)d_ws + WS_CTL, 0, CTL_ZERO_BYTES, stream);
    a.mix_mask = 7; a.pflags = 0;
#endif
    a.ph_lo = 0; a.ph_hi = N_PHASES;
    hipLaunchKernelGGL(mk_fwd, dim3(grid), dim3(NTHREADS), LDS_BYTES, stream, a);
#else
    for (int p = 0; p < N_PHASES; ++p) { a.ph_lo = p; a.ph_hi = p + 1; hipLaunchKernelGGL(mk_fwd, dim3(grid), dim3(NTHREADS), LDS_BYTES, stream, a); }
#endif
}
```

```cpp
#include <hip/hip_runtime.h>
#include <cstdio>
#include <cstdint>

namespace pg8 {
#define PG8_LAS __attribute__((address_space(3)))
typedef unsigned short bf16_t;
typedef short bf16x8 __attribute__((ext_vector_type(8)));
typedef float f32x4 __attribute__((ext_vector_type(4)));
typedef unsigned u32x4 __attribute__((ext_vector_type(4)));
constexpr int BM = 256, BK = 64, HALF = 128, HTB = HALF * BK * 2  , STAGE_BYTES = 8 * HTB, NXCD = 8, WGM = 8;

__host__ __device__ __forceinline__ int lds_byte(int r, int c) { const int st = (r >> 4) * 2 + (c >> 5), rr = r & 15, cc = c & 31, ob = rr * 64 + cc * 2; return st * 1024 + (ob ^ (((ob >> 9) & 1) << 5)); }
__host__ __device__ __forceinline__ void stage_rc(int b, int& R, int& C) { const int st = b / 1024, sb = b % 1024, swz = sb ^ (((sb >> 9) & 1) << 5); R = (st >> 1) * 16 + swz / 64; C = (st & 1) * 32 + (swz % 64) / 2; }
__host__ __device__ __forceinline__ int perm32(int rho) { const int n = rho >> 4, i = rho & 15; return 8 * (i >> 2) + 4 * n + (i & 3); }

struct Unit { int pm, pn, k0, nk, mode, slot, np; };
struct Gemm { const bf16_t* A; const bf16_t* Bt; int M, N, K; };

struct StaticOrder {
    int nM, nN, nwg, G, c;
    __host__ __device__ void init(int M, int N, int G_, int c_) { nM = M / BM; nN = N / BM; nwg = nM * nN; G = G_; c = c_; }
    __host__ __device__ bool next(int i, Unit& u) const {
        const long L = (long)i * G + c; if (L >= nwg) return false;
        int wgid = (int)L; { const int q = nwg / NXCD, r = nwg % NXCD, xcd = wgid % NXCD, off = wgid / NXCD; wgid = (xcd < r ? xcd * (q + 1) : r * (q + 1) + (xcd - r) * q) + off; }
        const int nig = WGM * nN, gid = wgid / nig, fm = gid * WGM, gsz = (nM - fm) < WGM ? (nM - fm) : WGM;
        u.pm = fm + ((wgid % nig) % gsz); u.pn = (wgid % nig) / gsz; u.k0 = 0; u.nk = 0; u.mode = 0; u.slot = 0; u.np = 0; return true;
    }
    __device__ __forceinline__ void a_ready(const Unit&) const {}
    __device__ __forceinline__ void done(const Unit&) const {}
};

__device__ __forceinline__ unsigned cvt_pk_bf16(float lo, float hi) { unsigned r; asm volatile("v_cvt_pk_bf16_f32 %0, %1, %2" : "=v"(r) : "v"(lo), "v"(hi)); return r; }
typedef float f32x2 __attribute__((ext_vector_type(2)));


#define PG8_GAS __attribute__((address_space(1)))
struct PartialReader {
    const PG8_GAS f32x4* p;
    template <int NP> __device__ __forceinline__ f32x4 next() {
        if constexpr (NP == 0) return (f32x4){0.f, 0.f, 0.f, 0.f};
        else {
            f32x4 x = p[0];
            if constexpr (NP > 1) x += p[16384];
            if constexpr (NP > 2) x += p[32768];
            p += 64; asm volatile("" : "+v"(p));
            return x;
        }
    }
    template <int NP> __device__ __forceinline__ void skip(int n) { if constexpr (NP > 0) { p += 64 * n; asm volatile("" : "+v"(p)); } }
};

constexpr int P_D = 2048, P_INDIM = 4864, P_NROW = 8320  , P_MPAD = 8448, P_NSSQ = 32;
constexpr long OFF_YP = 0, OFF_YS = 16777216, OFF_KP = 17039360, OFF_VP = 17170432, OFF_CP = 17301504, OFF_MKP = 17424384, OFF_MVP = 18472960,
               OFF_KS = 19521536, OFF_VS = 20045824, OFF_CS = 20570112, OUT_TOTAL = 21061632;
constexpr float QS_SWA = 0.125f * 1.4426950408889634f;
constexpr float QS_MEM = 0.08838834764831845f * 1.4426950408889634f;

__device__ __forceinline__ float sigmoid_f(float x) { return __builtin_amdgcn_rcpf(1.0f + __builtin_amdgcn_exp2f(x * -1.4426950408889634f)); }
__device__ __forceinline__ f32x4 sigmoid4(f32x4 x) { return (f32x4){sigmoid_f(x[0]), sigmoid_f(x[1]), sigmoid_f(x[2]), sigmoid_f(x[3])}; }
__device__ __forceinline__ u32x4 pack8(f32x4 a, f32x4 b) { u32x4 w; w.x = cvt_pk_bf16(a[0], a[1]); w.y = cvt_pk_bf16(a[2], a[3]); w.z = cvt_pk_bf16(b[0], b[1]); w.w = cvt_pk_bf16(b[2], b[3]); return w; }

__device__ __forceinline__ void row_rstd(float (&rs)[2][4], const float* ssq, int rbase, int fq) {
    f32x4 pa[2][4], pb[2][4];
#pragma unroll
    for (int ai = 0; ai < 2; ++ai)
#pragma unroll
        for (int m = 0; m < 4; ++m) { const PG8_GAS f32x4* p = (const PG8_GAS f32x4*)(ssq + (size_t)(rbase + ai * HALF + m * 16) * P_NSSQ + fq * 8); pa[ai][m] = p[0]; pb[ai][m] = p[1]; }
#pragma unroll
    for (int ai = 0; ai < 2; ++ai)
#pragma unroll
        for (int m = 0; m < 4; ++m) {
            const f32x4 a = pa[ai][m], b = pb[ai][m];
            float s = ((a[0] + a[1]) + (a[2] + a[3])) + ((b[0] + b[1]) + (b[2] + b[3]));
            s += __shfl_xor(s, 16); s += __shfl_xor(s, 32);
            rs[ai][m] = __builtin_amdgcn_rsqf(s * (1.0f / (float)P_D) + 1e-6f);
        }
}

struct EpiIn {
    static constexpr bool PERM = true, AFTER_DRAIN = false;
    bf16_t* Z; const float* ssq; float* out; int layer;
    template <int HASP> __device__ __forceinline__ void run(const f32x4 (&acc)[2][2][4][2], const Unit& u, int wr, int wc, int fr, int fq, PartialReader& PR) const {
        { int t_ = threadIdx.x; asm volatile("" : "+v"(t_)); fr = t_ & 15; fq = (t_ >> 4) & 3; }
        const int pn = u.pn, rbase = u.pm * BM + wr * 64 + fr;
        bf16_t* Z = this->Z; const float* ssq = this->ssq; float* out = this->out;
        asm volatile("" : "+s"(Z), "+s"(ssq), "+s"(out));
        float rs[2][4];
        row_rstd(rs, ssq, rbase, fq);
        const bool tailtile = (u.pm == 15) || (u.pm == 31) || (u.pm == 32);
        const bool is_q = (pn >= 6 && pn <= 9), is_cq = (pn == 15 || pn == 16);
        const float qs = is_q ? QS_SWA : QS_MEM;
#pragma unroll
        for (int ai = 0; ai < 2; ++ai) {
            if (u.pm * BM + wr * 64 + ai * HALF >= P_NROW) { PR.template skip<HASP>(16); continue; }
#pragma unroll
            for (int m2 = 0; m2 < 4; m2 += 2) {
            f32x4 v[4][2][2];
#pragma unroll
            for (int m = m2; m < m2 + 2; ++m)
#pragma unroll
                for (int bj = 0; bj < 2; ++bj)
#pragma unroll
                    for (int n = 0; n < 2; ++n) { if constexpr (HASP == 0) v[m][bj][n] = acc[ai][bj][m][n]; else v[m][bj][n] = acc[ai][bj][m][n] + PR.template next<HASP>(); }
#pragma unroll
            for (int m = m2; m < m2 + 2; ++m) {
                const int row = rbase + ai * HALF + m * 16;
                const float r = rs[ai][m];
                if (pn < 4) {
                    const int ch0 = 128 * pn + 32 * wc + 8 * fq;
                    const f32x4 u0 = (v[m][0][0] * r) * sigmoid4(v[m][1][0] * r), u1 = (v[m][0][1] * r) * sigmoid4(v[m][1][1] * r);
                    *(PG8_GAS u32x4*)(Z + (size_t)row * P_INDIM + ch0) = pack8(u0, u1);
                    if (tailtile) {
                        float* dst = nullptr;
                        if (row < 8192) { const int t = row & 4095, b = row >> 12; if (t >= 4066) dst = out + OFF_CP + ((size_t)(layer * 2 + b) * 30 + (t - 4066)) * 512 + ch0; }
                        else { const int rr = row - 8192, b = rr >> 4, s = rr & 15; dst = out + OFF_CS + ((size_t)(layer * 8 + b) * 30 + 14 + s) * 512 + ch0; }
                        if (dst) { *(PG8_GAS f32x4*)dst = u0; *(PG8_GAS f32x4*)(dst + 4) = u1; }
                    }
                } else if (pn == 10) {
#pragma unroll
                    for (int bj = 0; bj < 2; ++bj) {
                        const f32x4 v0 = v[m][bj][0] * r, v1 = v[m][bj][1] * r;
                        const int c128 = 32 * wc + 8 * fq;
                        *(PG8_GAS u32x4*)(Z + (size_t)row * P_INDIM + 2560 + 128 * bj + c128) = pack8(v0, v1);
                        if (tailtile) {
                            float* dst = nullptr;
                            if (row < 8192) { const int t = row & 4095, b = row >> 12; if (t >= 3968) dst = out + (bj ? OFF_VP : OFF_KP) + ((size_t)(layer * 2 + b) * 128 + (t - 3968)) * 128 + c128; }
                            else { const int rr = row - 8192, b = rr >> 4, s = rr & 15; dst = out + (bj ? OFF_VS : OFF_KS) + ((size_t)(layer * 8 + b) * 128 + 112 + s) * 128 + c128; }
                            if (dst) { *(PG8_GAS f32x4*)dst = v0; *(PG8_GAS f32x4*)(dst + 4) = v1; }
                        }
                    }
                } else {
#pragma unroll
                    for (int bj = 0; bj < 2; ++bj) {
                        f32x4 v0 = v[m][bj][0] * r, v1 = v[m][bj][1] * r;
                        if (!(is_q || is_cq)) { v0 = v0 * sigmoid4(v0); v1 = v1 * sigmoid4(v1); } else { v0 = v0 * qs; v1 = v1 * qs; }
                        *(PG8_GAS u32x4*)(Z + (size_t)row * P_INDIM + pn * BM + 128 * bj + 32 * wc + 8 * fq) = pack8(v0, v1);
                    }
                }
            }
            }
        }
    }
};

struct EpiMemKV {
    static constexpr bool PERM = true, AFTER_DRAIN = false;
    bf16_t* MKV; float* out;
    template <int HASP> __device__ __forceinline__ void run(const f32x4 (&acc)[2][2][4][2], const Unit& u, int wr, int wc, int fr, int fq, PartialReader& PR) const {
        const int l = u.pn >> 2, kv = (u.pn >> 1) & 1, cb = (u.pn & 1) * 256;
        bf16_t* MKV = this->MKV; float* out = this->out; asm volatile("" : "+s"(MKV), "+s"(out));
        const int row0 = u.pm * BM + wr * 64 + fr, cl = 32 * wc + 8 * fq;
        bf16_t* zb = MKV + (size_t)row0 * 4096 + u.pn * BM + cl;
        float* ob = out + (kv ? OFF_MVP : OFF_MKP) + ((size_t)(l * 512 + row0)) * 512 + cb + cl;
#pragma unroll
        for (int ai = 0; ai < 2; ++ai)
#pragma unroll
            for (int m = 0; m < 4; ++m)
#pragma unroll
                for (int bj = 0; bj < 2; ++bj) {
                    const f32x4 v0 = acc[ai][bj][m][0], v1 = acc[ai][bj][m][1];
                    *(PG8_GAS u32x4*)(zb + (size_t)(ai * HALF + m * 16) * 4096 + 128 * bj) = pack8(v0, v1);
                    float* dst = ob + (size_t)(ai * HALF + m * 16) * 512 + 128 * bj;
                    *(PG8_GAS f32x4*)dst = v0; *(PG8_GAS f32x4*)(dst + 4) = v1;
                }
    }
};

struct EpiOut {
    static constexpr bool PERM = false, AFTER_DRAIN = false;
    float* X; bf16_t* XB; float* ssq; const float* rin_p; const float* rin_s;
    typedef unsigned u32x2v __attribute__((ext_vector_type(2)));
    __device__ __forceinline__ static void row_out(const f32x4 (&xn)[2][2], float* X, bf16_t* XB, float* ssq, int row, int colbase, int slot, int fq) {
        float q = 0.f;
#pragma unroll
        for (int bj = 0; bj < 2; ++bj)
#pragma unroll
            for (int n = 0; n < 2; ++n) {
                const size_t off = (size_t)row * P_D + colbase + bj * HALF + n * 16;
                *(PG8_GAS f32x4*)(X + off) = xn[bj][n];
                u32x2v w; w.x = cvt_pk_bf16(xn[bj][n][0], xn[bj][n][1]); w.y = cvt_pk_bf16(xn[bj][n][2], xn[bj][n][3]);
                *(PG8_GAS u32x2v*)(XB + off) = w;
                q += (xn[bj][n][0] * xn[bj][n][0] + xn[bj][n][1] * xn[bj][n][1]) + (xn[bj][n][2] * xn[bj][n][2] + xn[bj][n][3] * xn[bj][n][3]);
            }
        q += __shfl_xor(q, 16); q += __shfl_xor(q, 32);
        if (fq == 0) *(PG8_GAS float*)(ssq + (size_t)row * P_NSSQ + slot) = q;
    }
    template <int HASP> __device__ __forceinline__ void run(const f32x4 (&acc)[2][2][4][2], const Unit& u, int wr, int wc, int fr, int fq, PartialReader& PR) const {
        { int t_ = threadIdx.x; asm volatile("" : "+v"(t_)); fr = t_ & 15; fq = (t_ >> 4) & 3; }
        const int rbase = u.pm * BM + wr * 64 + fr, colbase = u.pn * BM + wc * 32 + fq * 4, slot = u.pn * 4 + wc;
        float* X = this->X; bf16_t* XB = this->XB; float* ssq = this->ssq; asm volatile("" : "+s"(X), "+s"(XB), "+s"(ssq));
        const float* rin = (u.pm == 32) ? rin_s : rin_p; asm volatile("" : "+s"(rin));
#pragma unroll
        for (int ai = 0; ai < 2; ++ai) {
            if (u.pm * BM + wr * 64 + ai * HALF >= P_NROW) { PR.template skip<HASP>(16); continue; }
            if constexpr (HASP == 0) {
                f32x4 rv[4][2][2];
#pragma unroll
                for (int m = 0; m < 4; ++m)
#pragma unroll
                    for (int bj = 0; bj < 2; ++bj)
#pragma unroll
                        for (int n = 0; n < 2; ++n) rv[m][bj][n] = *(const PG8_GAS f32x4*)(rin + (size_t)(rbase + ai * HALF + m * 16) * P_D + colbase + bj * HALF + n * 16);
#pragma unroll
                for (int m = 0; m < 4; ++m) {
                    f32x4 xn[2][2];
#pragma unroll
                    for (int bj = 0; bj < 2; ++bj)
#pragma unroll
                        for (int n = 0; n < 2; ++n) xn[bj][n] = rv[m][bj][n] + acc[ai][bj][m][n];
                    row_out(xn, X, XB, ssq, rbase + ai * HALF + m * 16, colbase, slot, fq);
                }
            } else {
#pragma unroll
                for (int m = 0; m < 4; ++m) {
                    f32x4 rv[2][2], pv[2][2], xn[2][2];
#pragma unroll
                    for (int bj = 0; bj < 2; ++bj)
#pragma unroll
                        for (int n = 0; n < 2; ++n) { rv[bj][n] = *(const PG8_GAS f32x4*)(rin + (size_t)(rbase + ai * HALF + m * 16) * P_D + colbase + bj * HALF + n * 16); pv[bj][n] = PR.template next<HASP>(); }
#pragma unroll
                    for (int bj = 0; bj < 2; ++bj)
#pragma unroll
                        for (int n = 0; n < 2; ++n) xn[bj][n] = rv[bj][n] + (acc[ai][bj][m][n] + pv[bj][n]);
                    row_out(xn, X, XB, ssq, rbase + ai * HALF + m * 16, colbase, slot, fq);
                }
            }
        }
    }
};

struct NoSplit {
    static constexpr int NP = 0;
    __device__ __forceinline__ void dump(const f32x4 (&)[2][2][4][2], const Unit&, int, int) const {}
    __device__ __forceinline__ PartialReader reader(const Unit&, int, int) const { PartialReader r; r.p = nullptr; return r; }
};
template <int NP_> struct SplitK {
    static constexpr int NP = NP_;
    float* slots; unsigned* flags;
    __device__ __forceinline__ void dump(const f32x4 (&acc)[2][2][4][2], const Unit& u, int wid, int lane) const {
        const __amdgpu_buffer_rsrc_t rs = __builtin_amdgcn_make_buffer_rsrc(slots, (short)0, 256 * 65536 * 4, 0x00020000);
        unsigned off = (unsigned)u.slot * 262144u + ((unsigned)wid * 32u * 64u + (unsigned)lane) * 16u;
#pragma unroll
        for (int a = 0; a < 2; ++a)
#pragma unroll
            for (int m = 0; m < 4; ++m)
#pragma unroll
                for (int b = 0; b < 2; ++b)
#pragma unroll
                    for (int n = 0; n < 2; ++n) {
                        __builtin_amdgcn_raw_buffer_store_b128(__builtin_bit_cast(u32x4, acc[a][b][m][n]), rs, off, 0,   16);
                        off += 1024u; asm volatile("" : "+v"(off)); }
        asm volatile("s_waitcnt vmcnt(0)" ::: "memory");
        if (lane == 0) __hip_atomic_fetch_add(flags + 16 * u.slot, 1u, __ATOMIC_RELAXED, __HIP_MEMORY_SCOPE_AGENT);
    }
    __device__ __forceinline__ PartialReader reader(const Unit& u, int wid, int lane) const {
#pragma unroll
        for (int q = 0; q < NP; ++q) { unsigned sp = 0;
            while ((unsigned)__builtin_amdgcn_readfirstlane(__hip_atomic_load(flags + 16 * (u.slot + q), __ATOMIC_RELAXED, __HIP_MEMORY_SCOPE_AGENT)) < 8u) { __builtin_amdgcn_s_sleep(2); if (++sp > (1u << 22)) break; } }
        __builtin_amdgcn_fence(__ATOMIC_ACQUIRE, "agent");
        asm volatile("s_waitcnt vmcnt(0)" ::: "memory");
        PartialReader r; r.p = (const PG8_GAS f32x4*)(slots + (size_t)u.slot * 65536) + ((size_t)wid * 32 * 64 + lane); return r;
    }
};
struct Hybrid {
    static constexpr int G = 256;
    int nM, nN, v, R, S, P;
    __device__ void init(int M, int N, int v_, int P_) { nM = M / BM; nN = N / BM; v = v_; P = P_; const int nu = nM * nN; R = nu / G; S = nu - R * G; }
    __device__ bool next(int i, Unit& u) const {
        const bool hasp = v < S * P; const int sp = v / P, q = v - sp * P;
        const bool dumper = hasp && q > 0, owner = hasp && q == 0;
        const int idx = i - (dumper ? 1 : 0);
        int ui;
        const int kb0 = (P == 2) ? (q == 0 ? 0 : 8) : (q == 0 ? 0 : 8 * q - 4), kb1 = (P == 2) ? (q == 0 ? 8 : 32) : (q == 3 ? 32 : 8 * q + 4);
        if (dumper && i == 0) { ui = R * G + sp; u.k0 = kb0; u.nk = kb1 - kb0; u.mode = 1; u.slot = sp * (P - 1) + q - 1; u.np = 0; }
        else if (idx < R) { ui = idx * G + v; u.k0 = 0; u.nk = 0; u.mode = 0; u.slot = 0; u.np = 0; }
        else if (idx == R && owner) { ui = R * G + sp; u.k0 = 0; u.nk = kb1; u.mode = 2; u.slot = sp * (P - 1); u.np = P - 1; }
        else return false;
        const int nig = WGM * nN, gid = ui / nig, fm = gid * WGM, gsz = (nM - fm) < WGM ? (nM - fm) : WGM, r = ui % nig;
        u.pm = fm + r % gsz; u.pn = r / gsz; return true;
    }
    __device__ __forceinline__ void a_ready(const Unit&) const {}
    __device__ __forceinline__ void done(const Unit&) const {}
};
template <class Epi, class Sched, bool ALIGN_EPI = false, bool SP2 = false, class SKT = NoSplit>
__device__ __forceinline__ void gemm_phase(PG8_LAS unsigned char* lds, const Gemm g, const Sched& S, const Epi& E, const SKT SK = SKT()) {
    int tid_ = threadIdx.x; asm volatile("" : "+v"(tid_));
    const int tid = tid_, wid = __builtin_amdgcn_readfirstlane(tid >> 6), lane = tid & 63, wr = wid >> 2, wc = wid & 3, fr = lane & 15, fq = lane >> 4;
    const int K = g.K, ntf = K / BK;
    unsigned voffA[2], voffB[2];
#pragma unroll
    for (int i = 0; i < 2; ++i) { int R, C; stage_rc(tid * 16 + i * 8192, R, C); const int Rb = Epi::PERM ? ((R & ~31) + perm32(R & 31)) : R;
        voffA[i] = (unsigned)(R * K + C) * 2u; voffB[i] = (unsigned)(Rb * K + C) * 2u; }
    const size_t kstep = (size_t)(BK * 2);
    const size_t hstep = (size_t)HALF * K * 2;
    const size_t tstep = 2 * hstep;
    const unsigned ldsw = (unsigned)wid * 1024u;
    const int aoff = lds_byte(wr * 64 + fr, fq * 8), boff = lds_byte(wc * 32 + fr, fq * 8);
#define PG8_SA(b, h) (((b) * 2 + (h)) * HTB)
#define PG8_SB(b, h) ((4 + (b) * 2 + (h)) * HTB)
#define PG8_STAGE(bufoff, gbase, voff) do { _Pragma("unroll") for (int _i = 0; _i < 2; ++_i) \
        __builtin_amdgcn_global_load_lds((const unsigned*)((const char*)(gbase) + (voff)[_i]), (PG8_LAS unsigned*)(lds + (bufoff) + ldsw + _i * 8192), 16, 0, 0); } while (0)
#define PG8_LDA(dst, b, h) do { _Pragma("unroll") for (int m = 0; m < 4; ++m) _Pragma("unroll") for (int k = 0; k < 2; ++k) dst[m][k] = *(const PG8_LAS bf16x8*)(lds + PG8_SA(b, h) + aoff + m * 2048 + k * 1024); } while (0)
#define PG8_LDB(dst, b, h) do { _Pragma("unroll") for (int n = 0; n < 2; ++n) _Pragma("unroll") for (int k = 0; k < 2; ++k) dst[n][k] = *(const PG8_LAS bf16x8*)(lds + PG8_SB(b, h) + boff + n * 2048 + k * 1024); } while (0)
#define PG8_MMA(ai, bj, At, Bt) do { __builtin_amdgcn_s_setprio(1); _Pragma("unroll") for (int m = 0; m < 4; ++m) _Pragma("unroll") for (int n = 0; n < 2; ++n) _Pragma("unroll") for (int k = 0; k < 2; ++k) \
        acc[ai][bj][m][n] = __builtin_amdgcn_mfma_f32_16x16x32_bf16(Bt[n][k], At[m][k], acc[ai][bj][m][n], 0, 0, 0); __builtin_amdgcn_s_setprio(0); } while (0)
#define PG8_WAIT_V(n) asm volatile("s_waitcnt vmcnt(" #n ")" ::: "memory")
#define PG8_WAIT_L(n) asm volatile("s_waitcnt lgkmcnt(" #n ")" ::: "memory")
#define PG8_BAR __builtin_amdgcn_s_barrier()
#define PG8_SCHED __builtin_amdgcn_sched_barrier(0)
    Unit cur, nxt; int ui = 0;
    if (!S.next(0, cur)) return;
    f32x4 acc[2][2][4][2];
#pragma unroll
    for (int a = 0; a < 2; ++a)
#pragma unroll
        for (int b = 0; b < 2; ++b)
#pragma unroll
            for (int m = 0; m < 4; ++m)
#pragma unroll
                for (int n = 0; n < 2; ++n) acc[a][b][m][n] = (f32x4){0.f, 0.f, 0.f, 0.f};
    bf16x8 At[4][2], B0[2][2], B1[2][2];
    const char* cA = (const char*)g.A + (size_t)cur.pm * tstep + (size_t)cur.k0 * (BK * 2); const char* cB = (const char*)g.Bt + (size_t)cur.pn * tstep + (size_t)cur.k0 * (BK * 2);
    S.a_ready(cur);
    if constexpr (SP2) {
        PG8_STAGE(PG8_SB(0, 0), cB, voffB); PG8_STAGE(PG8_SB(0, 1), cB + hstep, voffB); PG8_STAGE(PG8_SA(0, 0), cA, voffA); PG8_STAGE(PG8_SA(0, 1), cA + hstep, voffA);
        if (wr == 1) PG8_BAR;
        PG8_WAIT_V(2); PG8_BAR;
        PG8_STAGE(PG8_SB(1, 0), cB + kstep, voffB); PG8_STAGE(PG8_SA(1, 0), cA + kstep, voffA); PG8_STAGE(PG8_SB(1, 1), cB + hstep + kstep, voffB);
        PG8_WAIT_V(6); PG8_BAR;
    } else {
        PG8_STAGE(PG8_SB(0, 0), cB, voffB); PG8_STAGE(PG8_SA(0, 0), cA, voffA); PG8_STAGE(PG8_SB(0, 1), cB + hstep, voffB); PG8_STAGE(PG8_SA(0, 1), cA + hstep, voffA);
        if (wr == 1) PG8_BAR;
        PG8_WAIT_V(4); PG8_BAR;
        PG8_STAGE(PG8_SB(1, 0), cB + kstep, voffB); PG8_STAGE(PG8_SA(1, 0), cA + kstep, voffA); PG8_STAGE(PG8_SB(1, 1), cB + hstep + kstep, voffB);
        PG8_WAIT_V(6); PG8_BAR;
    }
    for (;;) {
        const bool has_next = S.next(ui + 1, nxt);
        const char* nA = has_next ? (const char*)g.A + (size_t)nxt.pm * tstep + (size_t)nxt.k0 * (BK * 2) : cA; const char* nB = has_next ? (const char*)g.Bt + (size_t)nxt.pn * tstep + (size_t)nxt.k0 * (BK * 2) : cB;
        const int nt = cur.nk ? cur.nk : ntf;
        for (int t = 0; t < nt; t += 2) {
            const bool last = (t == nt - 2);
            const char* a1 = cA + (size_t)(t + 1) * kstep;
            const char* a2 = last ? nA : cA + (size_t)(t + 2) * kstep; const char* b2 = last ? nB : cB + (size_t)(t + 2) * kstep;
            const char* a3 = a2 + kstep; const char* b3 = b2 + kstep;
            if (last && has_next) S.a_ready(nxt);
            if constexpr (SP2) {
            PG8_LDB(B0, 0, 0); PG8_LDB(B1, 0, 1); PG8_SCHED; PG8_LDA(At, 0, 0); PG8_STAGE(PG8_SA(1, 1), a1 + hstep, voffA);
            PG8_WAIT_V(8); PG8_WAIT_L(0); PG8_BAR; PG8_MMA(0, 0, At, B0); PG8_MMA(0, 1, At, B1); PG8_BAR; PG8_SCHED;
            PG8_LDA(At, 0, 1); PG8_STAGE(PG8_SB(0, 0), b2, voffB); PG8_STAGE(PG8_SB(0, 1), b2 + hstep, voffB); PG8_STAGE(PG8_SA(0, 0), a2, voffA);
            PG8_WAIT_V(8); PG8_WAIT_L(0); PG8_BAR; PG8_MMA(1, 0, At, B0); PG8_MMA(1, 1, At, B1); PG8_BAR; PG8_SCHED;
            PG8_LDB(B0, 1, 0); PG8_LDB(B1, 1, 1); PG8_SCHED; PG8_LDA(At, 1, 0); PG8_STAGE(PG8_SA(0, 1), a2 + hstep, voffA);
            PG8_WAIT_V(8); PG8_WAIT_L(0); PG8_BAR; PG8_MMA(0, 0, At, B0); PG8_MMA(0, 1, At, B1); PG8_BAR; PG8_SCHED;
            PG8_LDA(At, 1, 1); PG8_STAGE(PG8_SB(1, 0), b3, voffB); PG8_STAGE(PG8_SB(1, 1), b3 + hstep, voffB); PG8_STAGE(PG8_SA(1, 0), a3, voffA);
            PG8_WAIT_V(8); PG8_WAIT_L(0); PG8_BAR; PG8_MMA(1, 0, At, B0); PG8_MMA(1, 1, At, B1); PG8_BAR; PG8_SCHED;
            } else {
            PG8_LDB(B0, 0, 0); PG8_SCHED; PG8_LDA(At, 0, 0); PG8_STAGE(PG8_SA(1, 1), a1 + hstep, voffA);
            PG8_WAIT_L(8); PG8_BAR; PG8_WAIT_L(0); PG8_MMA(0, 0, At, B0); PG8_BAR; PG8_SCHED;
            PG8_LDB(B1, 0, 1); PG8_STAGE(PG8_SB(0, 0), b2, voffB);
            PG8_BAR; PG8_WAIT_L(0); PG8_MMA(0, 1, At, B1); PG8_BAR;
            PG8_LDA(At, 0, 1); PG8_STAGE(PG8_SA(0, 0), a2, voffA);
            PG8_BAR; PG8_WAIT_L(0); PG8_MMA(1, 0, At, B0); PG8_BAR; PG8_SCHED;
            PG8_STAGE(PG8_SB(0, 1), b2 + hstep, voffB);
            PG8_WAIT_V(6); PG8_BAR; PG8_MMA(1, 1, At, B1); PG8_BAR;
            PG8_LDB(B0, 1, 0); PG8_SCHED; PG8_LDA(At, 1, 0); PG8_STAGE(PG8_SA(0, 1), a2 + hstep, voffA);
            PG8_WAIT_L(8); PG8_BAR; PG8_WAIT_L(0); PG8_MMA(0, 0, At, B0); PG8_BAR; PG8_SCHED;
            PG8_LDB(B1, 1, 1); PG8_STAGE(PG8_SB(1, 0), b3, voffB);
            PG8_BAR; PG8_WAIT_L(0); PG8_MMA(0, 1, At, B1); PG8_BAR;
            PG8_LDA(At, 1, 1); PG8_STAGE(PG8_SA(1, 0), a3, voffA);
            PG8_BAR; PG8_WAIT_L(0); PG8_MMA(1, 0, At, B0); PG8_BAR; PG8_SCHED;
            PG8_STAGE(PG8_SB(1, 1), b3 + hstep, voffB);
            PG8_WAIT_V(6); PG8_BAR; PG8_MMA(1, 1, At, B1); PG8_BAR;
            }
        }
        if constexpr (ALIGN_EPI) { if (wr == 0) PG8_BAR; }
        if constexpr (!Epi::AFTER_DRAIN) { if (cur.mode == 1) SK.dump(acc, cur, wid, lane); else if (SKT::NP > 0 && cur.mode == 2) { PartialReader PR = SK.reader(cur, wid, lane); E.template run<SKT::NP>(acc, cur, wr, wc, fr, fq, PR); } else { PartialReader PR; PR.p = nullptr; E.template run<0>(acc, cur, wr, wc, fr, fq, PR); } S.done(cur); }
        if (!has_next) break;
#pragma unroll
        for (int a = 0; a < 2; ++a)
#pragma unroll
            for (int b = 0; b < 2; ++b)
#pragma unroll
                for (int m = 0; m < 4; ++m)
#pragma unroll
                    for (int n = 0; n < 2; ++n) acc[a][b][m][n] = (f32x4){0.f, 0.f, 0.f, 0.f};
        cur = nxt; cA = nA; cB = nB; ++ui;
        if constexpr (ALIGN_EPI) { if (wr == 1) PG8_BAR; }
    }
    PG8_WAIT_V(0);
    if constexpr (!ALIGN_EPI) { if (wr == 0) PG8_BAR; }
    PG8_BAR;
    if constexpr (Epi::AFTER_DRAIN) { E.fused(acc, cur, wr, wc, fr, fq, lds, wid, lane); S.done(cur); }
#undef PG8_SA
#undef PG8_SB
#undef PG8_STAGE
#undef PG8_LDA
#undef PG8_LDB
#undef PG8_MMA
#undef PG8_WAIT_V
#undef PG8_WAIT_L
#undef PG8_BAR
#undef PG8_SCHED
}
}


constexpr int NWAVES = 8, NTHREADS = 512;
constexpr int DM = 2048, SEQ = 4096, NBP = 2, NROWP = 8192, NBS = 8, NSS = 16, NROWS = 128, NROW = 8320, MPAD = 8448, INDIM = 4864, DEPTH = 4;
constexpr int ZP = INDIM;
constexpr int ZC_U = 0, ZC_GA = 1024, ZC_Q = 1536, ZC_K = 2560, ZC_V = 2688, ZC_GB = 2816, ZC_CQ = 3840, ZC_GC = 4352;
constexpr float LOG2E = 1.4426950408889634f;
using pg8::OFF_YP; using pg8::OFF_YS; using pg8::OFF_KP; using pg8::OFF_VP; using pg8::OFF_CP; using pg8::OFF_MKP; using pg8::OFF_MVP; using pg8::OFF_KS; using pg8::OFF_VS; using pg8::OFF_CS; using pg8::OUT_TOTAL;

constexpr size_t MiB = 1u << 20;
constexpr size_t WS_CTL = 0, CTL_ZERO_BYTES = 1 * MiB;
constexpr size_t WS_BT = 1 * MiB;
constexpr size_t WS_SSQ = 2 * MiB;
constexpr size_t WS_WIN = 4 * MiB;
constexpr size_t WS_WOUT = 80 * MiB;
constexpr size_t WS_WMEM = 112 * MiB;
constexpr size_t WS_WPW = 128 * MiB;
constexpr size_t WS_MEMN = 130 * MiB;
constexpr size_t WS_MKVP = 132 * MiB;
constexpr size_t WS_CMK = 136 * MiB, WS_CMV = 144 * MiB;
constexpr size_t WS_CSK = 152 * MiB, WS_CSV = 153 * MiB;
constexpr size_t WS_XB = 154 * MiB;
constexpr size_t WS_X = 187 * MiB;
constexpr size_t WS_Z = 253 * MiB;
constexpr size_t WS_YMIX = 332 * MiB;
constexpr size_t WS_DUMP = 365 * MiB;
constexpr size_t WS_END = 429 * MiB;
constexpr int CW_BAR = 4096, CW_SK = 65536;

constexpr int RING_BYTES = 131072;
constexpr int LDSCTL_OFF = 158720, MISC_OFF = LDSCTL_OFF + 320;
constexpr int LDS_BYTES = 159744;


#define GAS __attribute__((address_space(1)))
#define LAS __attribute__((address_space(3)))
typedef unsigned short bf16;
typedef unsigned v4u __attribute__((ext_vector_type(4)));
typedef float f32x4 __attribute__((ext_vector_type(4)));
typedef short bf16x8 __attribute__((ext_vector_type(8)));
typedef GAS unsigned gu32;
typedef GAS unsigned long long gu64;
#define RLX_AGENT __ATOMIC_RELAXED, __HIP_MEMORY_SCOPE_AGENT
#define LDS_WAIT() asm volatile("s_waitcnt lgkmcnt(0)" ::: "memory")
#define VM_WAIT() asm volatile("s_waitcnt vmcnt(0)" ::: "memory")
__device__ __forceinline__ unsigned long long rt() { return __builtin_amdgcn_s_memrealtime(); }
__device__ __forceinline__ unsigned f2bf(float f) { unsigned u = __builtin_bit_cast(unsigned, f); return (u + 0x7fffu + ((u >> 16) & 1u)) >> 16; }
__device__ __forceinline__ unsigned pk2(float lo, float hi) { return f2bf(lo) | (f2bf(hi) << 16); }

#define XB_TMO      128
#define XB_XCNT(j)  (256  + 64 * (j))
#define XB_XSUB(j)  (1280 + 64 * (j))
#define XB_XGEN(j)  (2304 + 64 * (j))
#define XB_TOP      3328
#define XB_TOPGEN   3392
#define XCD_BAR_WORDS 3456
#define XB_SPIN_CAP (1u << 18)

__device__ __forceinline__ unsigned xb_ld(unsigned* p)              { return __hip_atomic_load(p, __ATOMIC_RELAXED, __HIP_MEMORY_SCOPE_AGENT); }
__device__ __forceinline__ unsigned xb_add(unsigned* p, unsigned v) { return __hip_atomic_fetch_add(p, v, __ATOMIC_RELAXED, __HIP_MEMORY_SCOPE_AGENT); }
__device__ __forceinline__ unsigned xb_xcc_id() { return (unsigned)__builtin_amdgcn_s_getreg((3 << 11) | 20) & 0xFu; }
#define XB_SPIN(cond, bar) do { unsigned _sp = 0; while (cond) { __builtin_amdgcn_s_sleep(1); \
    if ((++_sp & 255u) == 0u) { if (xb_ld(&(bar)[XB_TMO])) break; if (_sp > XB_SPIN_CAP) { atomicAdd(&(bar)[XB_TMO], 1u); break; } } } } while (0)

struct XcdBarrier {
    unsigned* bar; unsigned x;
    volatile LAS unsigned* st;
};

__device__ __forceinline__ XcdBarrier xcd_barrier_post(unsigned* bar, volatile LAS unsigned* st) {
    XcdBarrier b; b.bar = bar; b.x = xb_xcc_id(); b.st = st;
    if (threadIdx.x == 0) (void)xb_add(&bar[XB_XCNT(b.x)], 1u);
    return b;
}
__device__ __forceinline__ void xcd_barrier_complete(unsigned* bar, unsigned x, unsigned& nloc, unsigned& nx) {
    const unsigned G = gridDim.x * gridDim.y * gridDim.z;
    unsigned sum, cnt, mine, sp = 0u;
    for (;;) {
        sum = 0u; cnt = 0u; mine = 0u;
#pragma unroll
        for (unsigned j = 0; j < 16; ++j) { const unsigned c = xb_ld(&bar[XB_XCNT(j)]); sum += c; cnt += (c > 0u) ? 1u : 0u; mine = (j == x) ? c : mine; }
        if (sum == G) break;
        __builtin_amdgcn_s_sleep(1);
        if ((++sp & 255u) == 0u) { if (xb_ld(&bar[XB_TMO])) break; if (sp > XB_SPIN_CAP) { atomicAdd(&bar[XB_TMO], 1u); break; } }
    }
    nloc = mine > 0u ? mine : 1u; nx = cnt > 0u ? cnt : 1u;
}

__device__ __forceinline__ void xcd_barrier(const XcdBarrier& b) {
    asm volatile("s_waitcnt vmcnt(0)" ::: "memory");
    __syncthreads();
    int xb_tid = threadIdx.x; asm volatile("" : "+v"(xb_tid));
    if (xb_tid == 0) {
        unsigned* bar = b.bar;
        __builtin_amdgcn_s_waitcnt(0);
        unsigned nloc = b.st[0], nx = b.st[1];
        if (nloc == 0u) { xcd_barrier_complete(bar, b.x, nloc, nx); b.st[0] = nloc; b.st[1] = nx; }
        const unsigned old = xb_add(&bar[XB_XSUB(b.x)], 1u);
        const unsigned gen = old / nloc;
        if (old + 1u == (gen + 1u) * nloc) {
            __builtin_amdgcn_fence(__ATOMIC_RELEASE, "agent");
            asm volatile("s_waitcnt vmcnt(0)" ::: "memory");
            const unsigned og = xb_add(&bar[XB_TOP], 1u);
            const unsigned tg = og / nx;
            if (og + 1u == (tg + 1u) * nx) xb_add(&bar[XB_TOPGEN], 1u);
            else XB_SPIN(xb_ld(&bar[XB_TOPGEN]) == tg, bar);
            __builtin_amdgcn_fence(__ATOMIC_ACQUIRE, "agent");
            xb_add(&bar[XB_XGEN(b.x)], 1u);
            asm volatile("s_waitcnt vmcnt(0)" ::: "memory");
        } else {
            XB_SPIN(xb_ld(&bar[XB_XGEN(b.x)]) == gen, bar);
            __builtin_amdgcn_fence(__ATOMIC_ACQUIRE, "agent");
            asm volatile("s_waitcnt vmcnt(0)" ::: "memory");
        }
    }
    __syncthreads();
}


struct Args { const float* in[22]; float* out; unsigned char* ws; int ph_lo, ph_hi; int mix_mask, pflags; };
struct Frame {
    LAS unsigned char* lds; unsigned char* glds;
    volatile LAS unsigned* MISC;
    gu32* ctl;
    int tid, lane, wave, vcu, G;
};
__device__ __forceinline__ float wave_sum(float v) {
#pragma unroll
    for (int o = 1; o < 64; o <<= 1) v += __shfl_xor(v, o);
    return v;
}
__device__ __forceinline__ float wave_max(float v) {
#pragma unroll
    for (int o = 1; o < 64; o <<= 1) v = fmaxf(v, __shfl_xor(v, o));
    return v;
}
__device__ __forceinline__ int opaque_tid() { int t = threadIdx.x; asm volatile("" : "+v"(t)); return t; }
__device__ __forceinline__ float bf2f(bf16 v) { return __builtin_bit_cast(float, (unsigned)v << 16); }
__device__ __forceinline__ float rbf(float f) { return __builtin_bit_cast(float, f2bf(f) << 16); }

__device__ __forceinline__ void p0_transpose_item(const float* W, int K, int N, const float* g, bf16* WT, int k0, int n0, int dst_row0, LAS float* scr, int lane) {
    const int kq = lane >> 4, n4 = (lane & 15) * 4;
    f32x4 v[16];
#pragma unroll
    for (int i = 0; i < 16; ++i) v[i] = *(const GAS f32x4*)(W + (size_t)(k0 + 4 * i + kq) * N + n0 + n4);
    if (g) {
#pragma unroll
        for (int i = 0; i < 16; ++i) v[i] = v[i] * g[k0 + 4 * i + kq];
    }
#pragma unroll
    for (int i = 0; i < 16; ++i) { LAS float* d = scr + (4 * i + kq) * 65 + n4; d[0] = v[i].x; d[1] = v[i].y; d[2] = v[i].z; d[3] = v[i].w; }
    LDS_WAIT(); asm volatile("" ::: "memory");
    const int c = lane & 7;
#pragma unroll
    for (int s8 = 0; s8 < 8; ++s8) { const int n = 8 * s8 + (lane >> 3); const LAS float* s = scr + (8 * c) * 65 + n;
        v4u o; o.x = pk2(s[0 * 65], s[1 * 65]); o.y = pk2(s[2 * 65], s[3 * 65]); o.z = pk2(s[4 * 65], s[5 * 65]); o.w = pk2(s[6 * 65], s[7 * 65]);
        *(GAS v4u*)(WT + (size_t)(dst_row0 + n) * K + k0 + 8 * c) = o; }
    LDS_WAIT(); asm volatile("" ::: "memory");
}
__device__ __forceinline__ int t5_bucket(int rel) {
    const int side = rel > 0 ? 16 : 0, n = rel < 0 ? -rel : rel;
    const int large = 8 + (n >= 12) + (n >= 16) + (n >= 23) + (n >= 32) + (n >= 46) + (n >= 64) + (n >= 91);
    return side + (n < 8 ? n : large);
}
__device__ __forceinline__ void p0_prologue(Frame& F, const Args& A) {
    unsigned char* ws = A.ws;
    const int tid_ = opaque_tid(), lane = tid_ & 63, wave_ = __builtin_amdgcn_readfirstlane(tid_ >> 6);
    const int gw = F.vcu * NWAVES + wave_, NGW = F.G * NWAVES;
    LAS float* scr = (LAS float*)(F.lds + wave_ * 17408);
    constexpr int I_IN = 32 * 76, I_OUT = 32 * 32, I_MEM = 32 * 16, I_PW = 8 * 8;
    constexpr int NITEMS = DEPTH * (I_IN + I_OUT + I_MEM + I_PW);
#pragma unroll 1
    for (int it = gw; it < NITEMS; it += NGW) {
        int r = it;
        if (r < DEPTH * I_IN) { const int l = r / I_IN, q = r % I_IN, kb = q / 76, nb = q % 76, n0 = nb * 64;
            int dst; if (n0 < 512) dst = 256 * (n0 >> 7) + (n0 & 127); else if (n0 < 1024) dst = 256 * ((n0 - 512) >> 7) + 128 + (n0 & 127); else dst = n0;
            p0_transpose_item(A.in[9] + (size_t)l * DM * INDIM, DM, INDIM, A.in[8] + l * DM, (bf16*)(ws + WS_WIN) + (size_t)l * INDIM * DM, kb * 64, n0, dst, scr, lane); continue; }
        r -= DEPTH * I_IN;
        if (r < DEPTH * I_OUT) { const int l = r / I_OUT, q = r % I_OUT, kb = q / 32, nb = q % 32;
            p0_transpose_item(A.in[20] + (size_t)l * DM * DM, DM, DM, nullptr, (bf16*)(ws + WS_WOUT) + (size_t)l * DM * DM, kb * 64, nb * 64, nb * 64, scr, lane); continue; }
        r -= DEPTH * I_OUT;
        if (r < DEPTH * I_MEM) { const int l = r / I_MEM, q = r % I_MEM, kb = q / 16, nb = q % 16;
            p0_transpose_item(A.in[18] + (size_t)l * DM * 1024, DM, 1024, A.in[17] + l * DM, (bf16*)(ws + WS_WMEM) + (size_t)l * 1024 * DM, kb * 64, nb * 64, nb * 64, scr, lane); continue; }
        r -= DEPTH * I_MEM;
        { const int l = r / I_PW, q = r % I_PW, kb = q / 8, nb = q % 8;
            p0_transpose_item(A.in[14] + (size_t)l * 512 * 512, 512, 512, nullptr, (bf16*)(ws + WS_WPW) + (size_t)l * 512 * 512, kb * 64, nb * 64, nb * 64, scr, lane); }
    }
    bf16* XB = (bf16*)(ws + WS_XB); float* SSQ = (float*)(ws + WS_SSQ);
    for (int m = gw; m < MPAD; m += NGW) {
        GAS unsigned long long* o8 = (GAS unsigned long long*)(XB + (size_t)m * DM) + lane;
        if (m >= NROW) {
#pragma unroll
            for (int j = 0; j < 8; ++j) o8[64 * j] = 0ull;
            continue;
        }
        const float* src = (m < NROWP) ? A.in[0] + (size_t)m * DM : A.in[1] + (size_t)(m - NROWP) * DM;
        const GAS f32x4* xr = (const GAS f32x4*)src + lane;
        float s = 0.f;
#pragma unroll
        for (int j = 0; j < 8; ++j) { const f32x4 v = xr[64 * j]; s += (v.x * v.x + v.y * v.y) + (v.z * v.z + v.w * v.w);
            o8[64 * j] = (unsigned long long)pk2(v.x, v.y) | ((unsigned long long)pk2(v.z, v.w) << 32); }
        s = wave_sum(s);
        if (lane < 32) SSQ[(size_t)m * 32 + lane] = (lane == 0) ? s : 0.f;
    }
    for (int m = gw; m < 512; m += NGW) {
        const GAS f32x4* xr = (const GAS f32x4*)(A.in[2] + (size_t)m * DM) + lane;
        f32x4 v[8]; float s = 0.f;
#pragma unroll
        for (int j = 0; j < 8; ++j) { v[j] = xr[64 * j]; s += (v[j].x * v[j].x + v[j].y * v[j].y) + (v[j].z * v[j].z + v[j].w * v[j].w); }
        const float rstd = 1.0f / sqrtf(wave_sum(s) * (1.0f / DM) + 1e-6f);
        GAS unsigned long long* o8 = (GAS unsigned long long*)((bf16*)(ws + WS_MEMN) + (size_t)m * DM) + lane;
#pragma unroll
        for (int j = 0; j < 8; ++j) o8[64 * j] = (unsigned long long)pk2(v[j].x * rstd, v[j].y * rstd) | ((unsigned long long)pk2(v[j].z * rstd, v[j].w * rstd) << 32);
    }
    const int gt = gw * 64 + lane, NGT = NGW * 64;
    {
        const f32x4* sk = (const f32x4*)A.in[6]; const f32x4* sv = (const f32x4*)A.in[7];
        unsigned long long* dk = (unsigned long long*)(ws + WS_CMK); unsigned long long* dv = (unsigned long long*)(ws + WS_CMV);
        for (int i = gt; i < 1048576; i += NGT) { const f32x4 a = sk[i], b = sv[i];
            dk[i] = (unsigned long long)pk2(a.x, a.y) | ((unsigned long long)pk2(a.z, a.w) << 32);
            dv[i] = (unsigned long long)pk2(b.x, b.y) | ((unsigned long long)pk2(b.z, b.w) << 32); }
        const f32x4* ck = (const f32x4*)A.in[3]; const f32x4* cv = (const f32x4*)A.in[4];
        unsigned long long* ek = (unsigned long long*)(ws + WS_CSK); unsigned long long* ev = (unsigned long long*)(ws + WS_CSV);
        for (int i = gt; i < 131072; i += NGT) { const f32x4 a = ck[i], b = cv[i];
            ek[i] = (unsigned long long)pk2(a.x, a.y) | ((unsigned long long)pk2(a.z, a.w) << 32);
            ev[i] = (unsigned long long)pk2(b.x, b.y) | ((unsigned long long)pk2(b.z, b.w) << 32);
            const int lb = i >> 12, rem = i & 4095, row = rem >> 5, c4 = rem & 31;
            if (row >= 16) { const size_t o = ((size_t)lb * 128 + (row - 16)) * 128 + c4 * 4;
                *(f32x4*)(A.out + OFF_KS + o) = a; *(f32x4*)(A.out + OFF_VS + o) = b; } }
        const f32x4* cc = (const f32x4*)A.in[5];
        for (int i = gt; i < 32 * 30 * 128; i += NGT) { const int lb = i / 3840, rem = i % 3840, row = rem >> 7, c4 = rem & 127;
            if (row >= 16) *(f32x4*)(A.out + OFF_CS + ((size_t)lb * 30 + (row - 16)) * 512 + c4 * 4) = cc[i]; }
        float* BT = (float*)(ws + WS_BT);
        for (int i = gt; i < 16 * 256; i += NGT) { const int h = i >> 8, idx = i & 255; const int rel = idx - 191;
            BT[i] = (idx < 255) ? A.in[19][t5_bucket(rel) * 16 + h] * LOG2E : 0.f; }
    }
}

struct KSrc { const bf16* p0; int pitch0; int n0; const bf16* p1; int pitch1; };
__device__ __forceinline__ const bf16* ks_row(const KSrc& s, int j) { return j < s.n0 ? s.p0 + (long)j * s.pitch0 : s.p1 + (long)(j - s.n0) * s.pitch1; }

template <int HD, bool SWA>
__device__ __forceinline__ void naive_attn(float* S, float* INV, const bf16* Q, int qpitch, int nq, KSrc ks, KSrc vs, int jlo, int nk,
                                           const float* btab, float sink2, const bf16* gate, int gpitch, bf16* out, int opitch) {
    const int tid = opaque_tid(), lane = tid & 63, wave = tid >> 6;
#pragma unroll 1
    for (int idx = tid; idx < nq * nk; idx += NTHREADS) {
        const int i = idx / nk, j = idx - i * nk;
        float s;
        if (j < jlo) s = -1e30f;
        else {
            const bf16* q = Q + (long)i * qpitch; const bf16* k = ks_row(ks, j);
            float a = 0.f;
#pragma unroll 2
            for (int d = 0; d < HD; d += 8) {
                const v4u qv = *(const v4u*)(q + d), kv = *(const v4u*)(k + d);
                a += __builtin_bit_cast(float, qv.x << 16) * __builtin_bit_cast(float, kv.x << 16) + __builtin_bit_cast(float, qv.x & 0xffff0000u) * __builtin_bit_cast(float, kv.x & 0xffff0000u);
                a += __builtin_bit_cast(float, qv.y << 16) * __builtin_bit_cast(float, kv.y << 16) + __builtin_bit_cast(float, qv.y & 0xffff0000u) * __builtin_bit_cast(float, kv.y & 0xffff0000u);
                a += __builtin_bit_cast(float, qv.z << 16) * __builtin_bit_cast(float, kv.z << 16) + __builtin_bit_cast(float, qv.z & 0xffff0000u) * __builtin_bit_cast(float, kv.z & 0xffff0000u);
                a += __builtin_bit_cast(float, qv.w << 16) * __builtin_bit_cast(float, kv.w << 16) + __builtin_bit_cast(float, qv.w & 0xffff0000u) * __builtin_bit_cast(float, kv.w & 0xffff0000u);
            }
            s = a; if (SWA) s += btab[j - i + 63];
        }
        S[i * 257 + j] = s;
    }
    __syncthreads();
    for (int i = wave; i < nq; i += NWAVES) {
        float m = SWA ? sink2 : -3.0e38f;
        for (int j = lane; j < nk; j += 64) m = fmaxf(m, S[i * 257 + j]);
        m = wave_max(m);
        float sum = 0.f;
        for (int j = lane; j < nk; j += 64) { const float p = exp2f(S[i * 257 + j] - m); sum += p; S[i * 257 + j] = rbf(p); }
        sum = wave_sum(sum);
        if (SWA) sum += exp2f(sink2 - m);
        if (lane == 0) INV[i] = 1.0f / sum;
    }
    __syncthreads();
#pragma unroll 1
    for (int idx = tid; idx < nq * HD; idx += NTHREADS) {
        const int i = idx / HD, d = idx % HD;
        float o = 0.f;
#pragma unroll 4
        for (int j = jlo; j < nk; ++j) o += S[i * 257 + j] * bf2f(ks_row(vs, j)[d]);
        o *= INV[i];
        o *= bf2f(gate[(long)i * gpitch + d]);
        out[(long)i * opitch + d] = (bf16)f2bf(o);
    }
    __syncthreads();
}

__device__ __forceinline__ void naive_conv(float* C, const bf16* Useq, int t0, int nfr, const float* left, const float* cw, const float* cb, const float* lng, const float* lnb,
                                           const float* wpw  , const float* bpw, const bf16* gate  , bf16* out  ) {
    const int tid = opaque_tid(), lane = tid & 63, wave = tid >> 6;
    {
        const int ch = tid;
        float w[31];
#pragma unroll
        for (int j = 0; j < 31; ++j) w[j] = cw[j * 512 + ch];
        const float b = cb[ch];
#pragma unroll 1
        for (int tt = 0; tt < 64; ++tt) {
            float a = 0.f;
            if (tt < nfr) {
                a = b;
#pragma unroll
                for (int j = 0; j < 31; ++j) { const int e = t0 + tt - 30 + j;
                    const float uv = (e >= 0) ? bf2f(Useq[(long)e * ZP + ch]) : (left ? left[(30 + e) * 512 + ch] : 0.f);
                    a += w[j] * uv; }
            }
            C[tt * 516 + ch] = a;
        }
    }
    __syncthreads();
    for (int tt = wave; tt < 64; tt += NWAVES) {
        float v[8]; float s = 0.f;
#pragma unroll
        for (int j = 0; j < 8; ++j) { v[j] = C[tt * 516 + lane + 64 * j]; s += v[j]; }
        const float mu = wave_sum(s) * (1.0f / 512.0f); float q = 0.f;
#pragma unroll
        for (int j = 0; j < 8; ++j) { v[j] -= mu; q += v[j] * v[j]; }
        const float rstd = 1.0f / sqrtf(wave_sum(q) * (1.0f / 512.0f) + 1e-6f);
#pragma unroll
        for (int j = 0; j < 8; ++j) { const int ch = lane + 64 * j; const float y = v[j] * rstd * lng[ch] + lnb[ch]; C[tt * 516 + ch] = rbf(y / (1.0f + __expf(-y))); }
    }
    __syncthreads();
    {
        const int n = tid;
        const float bb = bpw[n];
#pragma unroll 1
        for (int tg = 0; tg < 64; tg += 16) {
            if (tg >= nfr) break;
            float acc[16];
#pragma unroll
            for (int tt = 0; tt < 16; ++tt) acc[tt] = 0.f;
#pragma unroll 1
            for (int k = 0; k < 512; k += 4) {
                const float w0 = rbf(wpw[(size_t)(k + 0) * 512 + n]), w1 = rbf(wpw[(size_t)(k + 1) * 512 + n]), w2 = rbf(wpw[(size_t)(k + 2) * 512 + n]), w3 = rbf(wpw[(size_t)(k + 3) * 512 + n]);
#pragma unroll
                for (int tt = 0; tt < 16; ++tt) { const f32x4 c = *(const f32x4*)(C + (tg + tt) * 516 + k); acc[tt] += (c.x * w0 + c.y * w1) + (c.z * w2 + c.w * w3); }
            }
#pragma unroll
            for (int tt = 0; tt < 16; ++tt) if (tg + tt < nfr) out[(long)(tg + tt) * DM + n] = (bf16)f2bf((acc[tt] + bb) * bf2f(gate[(long)(tg + tt) * ZP + n]));
        }
    }
    __syncthreads();
}

__device__ __forceinline__ void naive_mixer_phase(Frame& F, const Args& A, int l) {
    unsigned char* ws = A.ws;
    float* S = (float*)F.glds;
    float* INV = S + 64 * 257;
    const bf16* Z = (const bf16*)(ws + WS_Z); bf16* Y = (bf16*)(ws + WS_YMIX);
    const float* BT = (const float*)(ws + WS_BT);
    constexpr int U0 = 128, U1 = U0 + 8, U2 = U1 + 512, U3 = U2 + 32, U4 = U3 + 2048, U5 = U4 + 128;
    for (int u = blockIdx.x; u < U5; u += F.G) {
        if (!((A.mix_mask >> (u < U1 ? 0 : (u < U3 ? 1 : 2))) & 1)) continue;
        if (u < U1) {
            int rowbase, t0, nfr; const float* left = nullptr;
            if (u < U0) { const int b = u >> 6, c = u & 63; rowbase = b * SEQ; t0 = c * 64; nfr = 64; }
            else { const int b = u - U0; rowbase = NROWP + b * NSS; t0 = 0; nfr = NSS; left = A.in[5] + (size_t)(l * 8 + b) * 30 * 512; }
            naive_conv(S, Z + (size_t)rowbase * ZP + ZC_U, t0, nfr, left, A.in[10] + l * 31 * 512, A.in[11] + l * 512, A.in[12] + l * 512, A.in[13] + l * 512,
                       A.in[14] + (size_t)l * 512 * 512, A.in[15] + l * 512, Z + (size_t)(rowbase + t0) * ZP + ZC_GA, Y + (size_t)(rowbase + t0) * DM);
        } else if (u < U3) {
            int row0, nq, h; KSrc ks, vs;
            if (u < U2) { const int v = u - U1, b = v >> 8, h_ = (v >> 6) & 3, qt = v & 63; h = h_; row0 = b * SEQ + qt * 64; nq = 64;
                const bf16* kb = (const bf16*)(ws + WS_MKVP) + (size_t)(b * 256) * 4096 + l * 1024 + h * 128;
                ks = KSrc{kb, 4096, 256, kb, 4096}; vs = KSrc{kb + 512, 4096, 256, kb + 512, 4096}; }
            else { const int v = u - U2, b = v >> 2; h = v & 3; row0 = NROWP + b * NSS; nq = NSS;
                const bf16* kb = (const bf16*)(ws + WS_CMK) + (size_t)((l * 8 + b) * 256) * 512 + h * 128; const bf16* vb = (const bf16*)(ws + WS_CMV) + (size_t)((l * 8 + b) * 256) * 512 + h * 128;
                ks = KSrc{kb, 512, 256, kb, 512}; vs = KSrc{vb, 512, 256, vb, 512}; }
            naive_attn<128, false>(S, INV, Z + (size_t)row0 * ZP + ZC_CQ + h * 128, ZP, nq, ks, vs, 0, 256, nullptr, 0.f,
                                   Z + (size_t)row0 * ZP + ZC_GC + h * 128, ZP, Y + (size_t)row0 * DM + 1536 + h * 128, DM);
        } else {
            int row0, nq, h, jlo, nk; KSrc ks, vs;
            if (u < U4) { const int v = u - U3, b = v >> 10, c = (v >> 4) & 63; h = v & 15; row0 = b * SEQ + c * 64; nq = 64; const int kv = h >> 3;
                const bf16* kb = Z + ((long)row0 - 128) * ZP + ZC_K + kv * 64;
                ks = KSrc{kb, ZP, 192, kb, ZP}; vs = KSrc{kb + (ZC_V - ZC_K), ZP, 192, kb + (ZC_V - ZC_K), ZP}; jlo = (c >= 2) ? 0 : 128 - 64 * c; nk = 192; }
            else { const int v = u - U4, b = v >> 4; h = v & 15; row0 = NROWP + b * NSS; nq = NSS; const int kv = h >> 3;
                const bf16* ck = (const bf16*)(ws + WS_CSK) + (size_t)((l * 8 + b) * 128) * 128 + kv * 64; const bf16* cv = (const bf16*)(ws + WS_CSV) + (size_t)((l * 8 + b) * 128) * 128 + kv * 64;
                const bf16* zk = Z + (size_t)row0 * ZP + ZC_K + kv * 64;
                ks = KSrc{ck, 128, 128, zk, ZP}; vs = KSrc{cv, 128, 128, zk + (ZC_V - ZC_K), ZP}; jlo = 0; nk = 144; }
            naive_attn<64, true>(S, INV, Z + (size_t)row0 * ZP + ZC_Q + h * 64, ZP, nq, ks, vs, jlo, nk, BT + h * 256, A.in[16][l * 16 + h] * LOG2E,
                                 Z + (size_t)row0 * ZP + ZC_GB + h * 64, ZP, Y + (size_t)row0 * DM + 512 + h * 64, DM);
        }
    }
}

typedef float f32x16 __attribute__((ext_vector_type(16)));
typedef short s16x4 __attribute__((ext_vector_type(4)));
__device__ __forceinline__ bf16x8 pack_bf16x8(float a0, float a1, float a2, float a3, float a4, float a5, float a6, float a7) {
    v4u w; w.x = pg8::cvt_pk_bf16(a0, a1); w.y = pg8::cvt_pk_bf16(a2, a3); w.z = pg8::cvt_pk_bf16(a4, a5); w.w = pg8::cvt_pk_bf16(a6, a7);
    return __builtin_bit_cast(bf16x8, w);
}
__device__ __forceinline__ bf16x8 join4(s16x4 lo, s16x4 hi) { return (bf16x8){lo[0], lo[1], lo[2], lo[3], hi[0], hi[1], hi[2], hi[3]}; }
__device__ __forceinline__ float ex2(float x) { return __builtin_amdgcn_exp2f(x); }

constexpr int SW_KP = 144, SW_VP = 408;
constexpr int SW_KS = 0, SW_VT = 192 * SW_KP, SW_BT = SW_VT + 64 * SW_VP, SW_END = SW_BT + 8 * 256 * 4;
__device__ __forceinline__ int swa_vt_off(int d, int key) { return d * SW_VP + ((((key >> 2) ^ ((d >> 3) & 7))) << 3) + (key & 3) * 2; }
struct SwaUnit { const bf16* q; int nq; KSrc ks, vs; int jlo, nk; const bf16* gate; bf16* out; int kvh; };

__device__ __forceinline__ void swa_unit(LAS unsigned char* L, const SwaUnit& U, const float* BT, const float* sinks) {
    const int tid = opaque_tid(), lane = tid & 63, wave = __builtin_amdgcn_readfirstlane(tid >> 6);
    typedef unsigned u32x2v __attribute__((ext_vector_type(2)));
    const int i32 = lane & 31, hf = lane >> 5, g = wave;
    v4u kreg[3], va[2], vb[2]; float btv[4]; bf16x8 qf[2][4]; u32x2v gv[2][2][4];
#pragma unroll
    for (int it = 0; it < 3; ++it) {
        const int t = tid + NTHREADS * it, row = t >> 3, c8 = t & 7;
        kreg[it] = (v4u){0u, 0u, 0u, 0u};
        if (row >= U.jlo && row < U.nk) kreg[it] = *(const v4u*)(ks_row(U.ks, row) + c8 * 8);
    }
#pragma unroll
    for (int it = 0; it < 2; ++it) {
        const int t = tid + NTHREADS * it, rp = t >> 3, c8 = t & 7, j0 = 2 * rp;
        va[it] = (v4u){0u, 0u, 0u, 0u}; vb[it] = (v4u){0u, 0u, 0u, 0u};
        if (t < 768) {
            if (j0 >= U.jlo && j0 < U.nk) va[it] = *(const v4u*)(ks_row(U.vs, j0) + c8 * 8);
            if (j0 + 1 >= U.jlo && j0 + 1 < U.nk) vb[it] = *(const v4u*)(ks_row(U.vs, j0 + 1) + c8 * 8);
        }
    }
#pragma unroll
    for (int it = 0; it < 4; ++it) btv[it] = BT[U.kvh * 8 * 256 + tid + NTHREADS * it];
#pragma unroll
    for (int qb = 0; qb < 2; ++qb) {
        const int i = qb * 32 + i32, iq = (i < U.nq) ? i : 0;
        const bf16* qrow = U.q + (long)iq * ZP + g * 64;
#pragma unroll
        for (int ds = 0; ds < 4; ++ds) qf[qb][ds] = *(const bf16x8*)(qrow + 16 * ds + 8 * hf);
#pragma unroll
        for (int dt = 0; dt < 2; ++dt)
#pragma unroll
            for (int g4 = 0; g4 < 4; ++g4) gv[qb][dt][g4] = *(const u32x2v*)(U.gate + (long)iq * ZP + g * 64 + dt * 32 + 8 * g4 + 4 * hf);
    }
    const float sink2 = sinks[U.kvh * 8 + g] * LOG2E;
#pragma unroll
    for (int it = 0; it < 3; ++it) { const int t = tid + NTHREADS * it, row = t >> 3, c8 = t & 7; *(LAS v4u*)(L + SW_KS + row * SW_KP + c8 * 16) = kreg[it]; }
#pragma unroll
    for (int it = 0; it < 2; ++it) {
        const int t = tid + NTHREADS * it, rp = t >> 3, c8 = t & 7, j0 = 2 * rp;
        if (t < 768) {
#pragma unroll
            for (int e = 0; e < 8; ++e) {
                const unsigned lo = (va[it][e >> 1] >> (16 * (e & 1))) & 0xffffu, hi = (vb[it][e >> 1] >> (16 * (e & 1))) & 0xffffu;
                *(LAS unsigned*)(L + SW_VT + swa_vt_off(c8 * 8 + e, j0)) = lo | (hi << 16);
            }
        }
    }
#pragma unroll
    for (int it = 0; it < 4; ++it) ((LAS float*)(L + SW_BT))[tid + NTHREADS * it] = btv[it];
    __syncthreads();
    const LAS float* bt = (const LAS float*)(L + SW_BT) + g * 256;
#pragma unroll
    for (int qb = 0; qb < 2; ++qb) {
        if (qb * 32 < U.nq) {
        const int i = qb * 32 + i32;
        f32x16 S[6];
        {
            bf16x8 kf[2][4];
#pragma unroll
            for (int ds = 0; ds < 4; ++ds) kf[0][ds] = *(const LAS bf16x8*)(L + SW_KS + (0 * 32 + i32) * SW_KP + ds * 32 + hf * 16);
#pragma unroll
            for (int kt = 0; kt < 6; ++kt) {
                if (kt + 1 < 6) {
#pragma unroll
                    for (int ds = 0; ds < 4; ++ds) kf[(kt + 1) & 1][ds] = *(const LAS bf16x8*)(L + SW_KS + ((kt + 1) * 32 + i32) * SW_KP + ds * 32 + hf * 16);
                }
                f32x16 acc = {};
#pragma unroll
                for (int ds = 0; ds < 4; ++ds) acc = __builtin_amdgcn_mfma_f32_32x32x16_bf16(kf[kt & 1][ds], qf[qb][ds], acc, 0, 0, 0);
                S[kt] = acc;
            }
        }
        float m = sink2;
#pragma unroll
        for (int kt = 0; kt < 6; ++kt)
#pragma unroll
            for (int r = 0; r < 16; ++r) {
                const int j = kt * 32 + (r & 3) + 8 * (r >> 2) + 4 * hf;
                float s = S[kt][r] + bt[j - i + 63];
                if (j < U.jlo || j >= U.nk) s = -1e30f;
                S[kt][r] = s; m = fmaxf(m, s);
            }
        m = fmaxf(m, __shfl_xor(m, 32));
        float lsum = 0.f;
#pragma unroll
        for (int kt = 0; kt < 6; ++kt)
#pragma unroll
            for (int r = 0; r < 16; ++r) { const float p = ex2(S[kt][r] - m); S[kt][r] = p; lsum += p; }
        lsum += __shfl_xor(lsum, 32);
        const float inv = 1.0f / (lsum + ex2(sink2 - m));
        f32x16 O[2]; O[0] = (f32x16){}; O[1] = (f32x16){};
        {
            s16x4 vq[2][2][2][2];
#pragma unroll
            for (int s2 = 0; s2 < 2; ++s2)
#pragma unroll
                for (int dt = 0; dt < 2; ++dt) { const int d = dt * 32 + i32, key0 = 16 * s2 + 4 * hf;
                    vq[0][s2][dt][0] = *(const LAS s16x4*)(L + SW_VT + swa_vt_off(d, key0)); vq[0][s2][dt][1] = *(const LAS s16x4*)(L + SW_VT + swa_vt_off(d, key0 + 8)); }
#pragma unroll
            for (int kt = 0; kt < 6; ++kt) {
                if (kt + 1 < 6) {
#pragma unroll
                    for (int s2 = 0; s2 < 2; ++s2)
#pragma unroll
                        for (int dt = 0; dt < 2; ++dt) { const int d = dt * 32 + i32, key0 = (kt + 1) * 32 + 16 * s2 + 4 * hf;
                            vq[(kt + 1) & 1][s2][dt][0] = *(const LAS s16x4*)(L + SW_VT + swa_vt_off(d, key0)); vq[(kt + 1) & 1][s2][dt][1] = *(const LAS s16x4*)(L + SW_VT + swa_vt_off(d, key0 + 8)); }
                }
#pragma unroll
                for (int s2 = 0; s2 < 2; ++s2) {
                    const bf16x8 pf = pack_bf16x8(S[kt][8 * s2 + 0], S[kt][8 * s2 + 1], S[kt][8 * s2 + 2], S[kt][8 * s2 + 3], S[kt][8 * s2 + 4], S[kt][8 * s2 + 5], S[kt][8 * s2 + 6], S[kt][8 * s2 + 7]);
#pragma unroll
                    for (int dt = 0; dt < 2; ++dt) O[dt] = __builtin_amdgcn_mfma_f32_32x32x16_bf16(join4(vq[kt & 1][s2][dt][0], vq[kt & 1][s2][dt][1]), pf, O[dt], 0, 0, 0);
                }
            }
        }
        if (i < U.nq) {
#pragma unroll
            for (int dt = 0; dt < 2; ++dt)
#pragma unroll
                for (int g4 = 0; g4 < 4; ++g4) {
                    const int d0 = dt * 32 + 8 * g4 + 4 * hf;
                    const u32x2v gg = gv[qb][dt][g4];
                    const float o0 = O[dt][4 * g4 + 0] * inv * __builtin_bit_cast(float, gg.x << 16), o1 = O[dt][4 * g4 + 1] * inv * __builtin_bit_cast(float, gg.x & 0xffff0000u);
                    const float o2 = O[dt][4 * g4 + 2] * inv * __builtin_bit_cast(float, gg.y << 16), o3 = O[dt][4 * g4 + 3] * inv * __builtin_bit_cast(float, gg.y & 0xffff0000u);
                    u32x2v w; w.x = pg8::cvt_pk_bf16(o0, o1); w.y = pg8::cvt_pk_bf16(o2, o3);
                    *(u32x2v*)(U.out + (long)i * DM + g * 64 + d0) = w;
                }
        }
        }
    }
    __syncthreads();
}

constexpr int MA_KP = 272, MA_VP = 528;
constexpr int MA_KS = 0, MA_VT = 256 * MA_KP, MA_END = MA_VT + 128 * MA_VP;
__device__ __forceinline__ int ma_vt_off(int d, int key) { return d * MA_VP + ((((key >> 2) ^ ((d >> 3) & 15))) << 3) + (key & 3) * 2; }
struct MemUnit { const bf16* q; int nq; const bf16* k; const bf16* v; int pitch; const bf16* gate; bf16* out; };

__device__ __forceinline__ void mem_unit(LAS unsigned char* L, const MemUnit& U) {
    typedef unsigned u32x2v __attribute__((ext_vector_type(2)));
    const int tid = opaque_tid(), lane = tid & 63, wave = __builtin_amdgcn_readfirstlane(tid >> 6);
    const int i16 = lane & 15, q4 = lane >> 4;
    bf16x8 qf[2][4]; u32x2v gv[2][8];
#pragma unroll
    for (int gi = 0; gi < 2; ++gi) {
        const int grp = wave + NWAVES * gi, i = (grp * 16 < U.nq) ? grp * 16 + i16 : i16;
        const bf16* qrow = U.q + (long)i * ZP;
#pragma unroll
        for (int ds = 0; ds < 4; ++ds) qf[gi][ds] = *(const bf16x8*)(qrow + 32 * ds + 8 * q4);
#pragma unroll
        for (int dt = 0; dt < 8; ++dt) gv[gi][dt] = *(const u32x2v*)(U.gate + (long)i * ZP + dt * 16 + 4 * q4);
    }
    {
        v4u kr[8];
#pragma unroll
        for (int it = 0; it < 8; ++it) { const int t = tid + NTHREADS * it, row = t >> 4, c8 = t & 15; kr[it] = *(const v4u*)(U.k + (long)row * U.pitch + c8 * 8); }
#pragma unroll
        for (int it = 0; it < 8; ++it) { const int t = tid + NTHREADS * it, row = t >> 4, c8 = t & 15; *(LAS v4u*)(L + MA_KS + row * MA_KP + c8 * 16) = kr[it]; }
    }
    {
        v4u va[4], vb[4];
#pragma unroll
        for (int it = 0; it < 4; ++it) { const int t = tid + NTHREADS * it, rp = t >> 4, c8 = t & 15, j0 = 2 * rp;
            va[it] = *(const v4u*)(U.v + (long)j0 * U.pitch + c8 * 8); vb[it] = *(const v4u*)(U.v + (long)(j0 + 1) * U.pitch + c8 * 8); }
#pragma unroll
        for (int it = 0; it < 4; ++it) { const int t = tid + NTHREADS * it, rp = t >> 4, c8 = t & 15, j0 = 2 * rp;
#pragma unroll
            for (int e = 0; e < 8; ++e) {
                const unsigned lo = (va[it][e >> 1] >> (16 * (e & 1))) & 0xffffu, hi = (vb[it][e >> 1] >> (16 * (e & 1))) & 0xffffu;
                *(LAS unsigned*)(L + MA_VT + ma_vt_off(c8 * 8 + e, j0)) = lo | (hi << 16);
            } }
    }
    __syncthreads();
#pragma unroll
    for (int gi = 0; gi < 2; ++gi) {
        const int grp = wave + NWAVES * gi;
        if (grp * 16 < U.nq) {
        const int i = grp * 16 + i16;
        f32x4 S[16];
        {
            bf16x8 kf[2][2][4];
#pragma unroll
            for (int t2 = 0; t2 < 2; ++t2)
#pragma unroll
                for (int ds = 0; ds < 4; ++ds) kf[0][t2][ds] = *(const LAS bf16x8*)(L + MA_KS + (t2 * 16 + i16) * MA_KP + ds * 64 + q4 * 16);
#pragma unroll
            for (int kp = 0; kp < 8; ++kp) {
                if (kp + 1 < 8) {
#pragma unroll
                    for (int t2 = 0; t2 < 2; ++t2)
#pragma unroll
                        for (int ds = 0; ds < 4; ++ds) kf[(kp + 1) & 1][t2][ds] = *(const LAS bf16x8*)(L + MA_KS + (((kp + 1) * 2 + t2) * 16 + i16) * MA_KP + ds * 64 + q4 * 16);
                }
#pragma unroll
                for (int t2 = 0; t2 < 2; ++t2) {
                    f32x4 acc = {};
#pragma unroll
                    for (int ds = 0; ds < 4; ++ds) acc = __builtin_amdgcn_mfma_f32_16x16x32_bf16(kf[kp & 1][t2][ds], qf[gi][ds], acc, 0, 0, 0);
                    S[kp * 2 + t2] = acc;
                }
            }
        }
        float m = -3.0e38f;
#pragma unroll
        for (int kt = 0; kt < 16; ++kt) m = fmaxf(fmaxf(m, fmaxf(S[kt][0], S[kt][1])), fmaxf(S[kt][2], S[kt][3]));
        m = fmaxf(m, __shfl_xor(m, 16)); m = fmaxf(m, __shfl_xor(m, 32));
        float lsum = 0.f;
#pragma unroll
        for (int kt = 0; kt < 16; ++kt)
#pragma unroll
            for (int r = 0; r < 4; ++r) { const float p = ex2(S[kt][r] - m); S[kt][r] = p; lsum += p; }
        lsum += __shfl_xor(lsum, 16); lsum += __shfl_xor(lsum, 32);
        const float inv = 1.0f / lsum;
        f32x4 O[8];
#pragma unroll
        for (int dt = 0; dt < 8; ++dt) O[dt] = (f32x4){0.f, 0.f, 0.f, 0.f};
        {
            s16x4 vq[2][8][2];
#pragma unroll
            for (int dt = 0; dt < 8; ++dt) { const int d = dt * 16 + i16, key0 = 4 * q4;
                vq[0][dt][0] = *(const LAS s16x4*)(L + MA_VT + ma_vt_off(d, key0)); vq[0][dt][1] = *(const LAS s16x4*)(L + MA_VT + ma_vt_off(d, key0 + 16)); }
#pragma unroll
            for (int st = 0; st < 8; ++st) {
                if (st + 1 < 8) {
#pragma unroll
                    for (int dt = 0; dt < 8; ++dt) { const int d = dt * 16 + i16, key0 = 32 * (st + 1) + 4 * q4;
                        vq[(st + 1) & 1][dt][0] = *(const LAS s16x4*)(L + MA_VT + ma_vt_off(d, key0)); vq[(st + 1) & 1][dt][1] = *(const LAS s16x4*)(L + MA_VT + ma_vt_off(d, key0 + 16)); }
                }
                const bf16x8 pf = pack_bf16x8(S[2 * st][0], S[2 * st][1], S[2 * st][2], S[2 * st][3], S[2 * st + 1][0], S[2 * st + 1][1], S[2 * st + 1][2], S[2 * st + 1][3]);
#pragma unroll
                for (int dt = 0; dt < 8; ++dt) O[dt] = __builtin_amdgcn_mfma_f32_16x16x32_bf16(join4(vq[st & 1][dt][0], vq[st & 1][dt][1]), pf, O[dt], 0, 0, 0);
            }
        }
#pragma unroll
        for (int dt = 0; dt < 8; ++dt) {
            const int d0 = dt * 16 + 4 * q4;
            const u32x2v gg = gv[gi][dt];
            const float o0 = O[dt][0] * inv * __builtin_bit_cast(float, gg.x << 16), o1 = O[dt][1] * inv * __builtin_bit_cast(float, gg.x & 0xffff0000u);
            const float o2 = O[dt][2] * inv * __builtin_bit_cast(float, gg.y << 16), o3 = O[dt][3] * inv * __builtin_bit_cast(float, gg.y & 0xffff0000u);
            u32x2v w; w.x = pg8::cvt_pk_bf16(o0, o1); w.y = pg8::cvt_pk_bf16(o2, o3);
            *(u32x2v*)(U.out + (long)i * DM + d0) = w;
        }
        }
    }
    __syncthreads();
}

typedef float cv_f32x2 __attribute__((ext_vector_type(2)));
template <int R> __device__ __forceinline__ void conv_rows(cv_f32x2 (&acc)[32], const cv_f32x2 (&w)[31], const unsigned (&raw)[62], bool neg, const float* left, int ch) {
    cv_f32x2 x = (cv_f32x2){__builtin_bit_cast(float, raw[R] << 16), __builtin_bit_cast(float, raw[R] & 0xffff0000u)};
    constexpr int TLO = (R > 30) ? R - 30 : 0, THI = (R < 31) ? R : 31;
#pragma unroll
    for (int tt = TLO; tt <= THI; ++tt) acc[tt] += w[R - tt] * x;
    if constexpr (R + 1 < 62) conv_rows<R + 1>(acc, w, raw, neg, left, ch);
}
constexpr int CV_P = 2064;
__device__ __forceinline__ void conv_unit(LAS unsigned char* L, const bf16* Useq, int t0, int nfr, const float* left, const float* cw, const float* cb, const float* lng, const float* lnb,
                                          const bf16* WpwT, const float* bpw, const bf16* gate, bf16* out) {
    typedef float f32x2 __attribute__((ext_vector_type(2)));
    const int tid = opaque_tid(), lane = tid & 63, wave = __builtin_amdgcn_readfirstlane(tid >> 6);
    {
        const int cp = tid & 255, fh = __builtin_amdgcn_readfirstlane(tid >> 8), ch = 2 * cp;
        f32x2 w[31];
#pragma unroll
        for (int j = 0; j < 31; ++j) w[j] = *(const f32x2*)(cw + j * 512 + ch);
        const f32x2 bias = *(const f32x2*)(cb + ch);
        f32x2 acc[32];
#pragma unroll
        for (int tt = 0; tt < 32; ++tt) acc[tt] = bias;
        const int tbase = t0 + 32 * fh;
        unsigned raw[62];
        if (tbase == 0) {
#pragma unroll
            for (int r = 0; r < 30; ++r) raw[r] = 0u;
            if (left) {
                cv_f32x2 lf[30];
#pragma unroll
                for (int r = 0; r < 30; ++r) lf[r] = *(const cv_f32x2*)(left + r * 512 + ch);
#pragma unroll
                for (int r = 0; r < 30; ++r) raw[r] = pg8::cvt_pk_bf16(lf[r].x, lf[r].y);
            }
#pragma unroll
            for (int r = 30; r < 62; ++r) raw[r] = *(const unsigned*)(Useq + (long)(r - 30) * ZP + ch);
        } else {
#pragma unroll
            for (int r = 0; r < 62; ++r) raw[r] = *(const unsigned*)(Useq + (long)(tbase - 30 + r) * ZP + ch);
        }
        conv_rows<0>(acc, w, raw, false, left, ch);
#pragma unroll
        for (int tt = 0; tt < 32; ++tt) { const int fr_ = 32 * fh + tt; *(LAS f32x2*)(L + fr_ * CV_P + ch * 4) = (fr_ < nfr) ? acc[tt] : (f32x2){0.f, 0.f}; }
    }
    __syncthreads();
    {
        const f32x4 g0 = *(const f32x4*)(lng + 8 * lane), g1 = *(const f32x4*)(lng + 8 * lane + 4), b0 = *(const f32x4*)(lnb + 8 * lane), b1 = *(const f32x4*)(lnb + 8 * lane + 4);
        f32x4 a[8], b[8]; float sm[8];
#pragma unroll
        for (int f = 0; f < 8; ++f) { const LAS unsigned char* row = L + (wave + NWAVES * f) * CV_P; a[f] = *(const LAS f32x4*)(row + 32 * lane); b[f] = *(const LAS f32x4*)(row + 32 * lane + 16);
            sm[f] = ((a[f][0] + a[f][1]) + (a[f][2] + a[f][3])) + ((b[f][0] + b[f][1]) + (b[f][2] + b[f][3])); }
#pragma unroll
        for (int o = 1; o < 64; o <<= 1)
#pragma unroll
            for (int f = 0; f < 8; ++f) sm[f] += __shfl_xor(sm[f], o);
#pragma unroll
        for (int f = 0; f < 8; ++f) { const float mu = sm[f] * (1.0f / 512.0f); a[f] = a[f] - mu; b[f] = b[f] - mu;
            sm[f] = ((a[f][0] * a[f][0] + a[f][1] * a[f][1]) + (a[f][2] * a[f][2] + a[f][3] * a[f][3])) + ((b[f][0] * b[f][0] + b[f][1] * b[f][1]) + (b[f][2] * b[f][2] + b[f][3] * b[f][3])); }
#pragma unroll
        for (int o = 1; o < 64; o <<= 1)
#pragma unroll
            for (int f = 0; f < 8; ++f) sm[f] += __shfl_xor(sm[f], o);
#pragma unroll
        for (int f = 0; f < 8; ++f) { const float rstd = __builtin_amdgcn_rsqf(sm[f] * (1.0f / 512.0f) + 1e-6f);
            f32x4 ya = a[f] * rstd * g0 + b0, yb = b[f] * rstd * g1 + b1;
            ya = ya * pg8::sigmoid4(ya); yb = yb * pg8::sigmoid4(yb);
            *(LAS v4u*)(L + (wave + NWAVES * f) * CV_P + 16 * lane) = __builtin_bit_cast(v4u, pg8::pack8(ya, yb)); }
    }
    __syncthreads();
    {
        typedef unsigned u32x2v __attribute__((ext_vector_type(2)));
        const int i16 = lane & 15, q4 = lane >> 4;
        f32x4 acc[4][4];
#pragma unroll
        for (int rt = 0; rt < 4; ++rt)
#pragma unroll
            for (int nt = 0; nt < 4; ++nt) acc[rt][nt] = (f32x4){0.f, 0.f, 0.f, 0.f};
        const bf16* wbase = WpwT + (size_t)(64 * wave + i16) * 512 + 8 * q4;
        {
            constexpr int WD = 8;
            bf16x8 wf[WD][4], cf[2][4];
#pragma unroll
            for (int k4 = 0; k4 < WD; ++k4)
#pragma unroll
                for (int nt = 0; nt < 4; ++nt) wf[k4][nt] = *(const bf16x8*)(wbase + nt * 16 * 512 + k4 * 32);
            __builtin_amdgcn_sched_barrier(0);
#pragma unroll
            for (int rt = 0; rt < 4; ++rt) cf[0][rt] = *(const LAS bf16x8*)(L + (rt * 16 + i16) * CV_P + q4 * 16);
#pragma unroll
            for (int ks = 0; ks < 16; ++ks) {
                if (ks + 1 < 16) {
#pragma unroll
                    for (int rt = 0; rt < 4; ++rt) cf[(ks + 1) & 1][rt] = *(const LAS bf16x8*)(L + (rt * 16 + i16) * CV_P + (ks + 1) * 64 + q4 * 16);
                }
#pragma unroll
                for (int rt = 0; rt < 4; ++rt)
#pragma unroll
                    for (int nt = 0; nt < 4; ++nt) acc[rt][nt] = __builtin_amdgcn_mfma_f32_16x16x32_bf16(wf[ks % WD][nt], cf[ks & 1][rt], acc[rt][nt], 0, 0, 0);
                if (ks + WD < 16) {
#pragma unroll
                    for (int nt = 0; nt < 4; ++nt) wf[ks % WD][nt] = *(const bf16x8*)(wbase + nt * 16 * 512 + (ks + WD) * 32);
                }
                __builtin_amdgcn_sched_barrier(0);
            }
        }
        f32x4 bb[4]; u32x2v gvv[4][4];
#pragma unroll
        for (int nt = 0; nt < 4; ++nt) bb[nt] = *(const f32x4*)(bpw + 64 * wave + nt * 16 + 4 * q4);
#pragma unroll
        for (int rt = 0; rt < 4; ++rt) { const int frame = rt * 16 + i16, fl = frame < nfr ? frame : 0;
#pragma unroll
            for (int nt = 0; nt < 4; ++nt) gvv[rt][nt] = *(const u32x2v*)(gate + (long)fl * ZP + 64 * wave + nt * 16 + 4 * q4); }
#pragma unroll
        for (int rt = 0; rt < 4; ++rt) {
            const int frame = rt * 16 + i16;
            if (frame < nfr) {
#pragma unroll
                for (int nt = 0; nt < 4; ++nt) {
                    const int n0 = 64 * wave + nt * 16 + 4 * q4;
                    const u32x2v gv = gvv[rt][nt];
                    const float o0 = (acc[rt][nt][0] + bb[nt][0]) * __builtin_bit_cast(float, gv.x << 16), o1 = (acc[rt][nt][1] + bb[nt][1]) * __builtin_bit_cast(float, gv.x & 0xffff0000u);
                    const float o2 = (acc[rt][nt][2] + bb[nt][2]) * __builtin_bit_cast(float, gv.y << 16), o3 = (acc[rt][nt][3] + bb[nt][3]) * __builtin_bit_cast(float, gv.y & 0xffff0000u);
                    u32x2v wv; wv.x = pg8::cvt_pk_bf16(o0, o1); wv.y = pg8::cvt_pk_bf16(o2, o3);
                    *(u32x2v*)(out + (long)frame * DM + n0) = wv;
                }
            }
        }
    }
    __syncthreads();
}

#ifndef USE_MFMA_ATTN
#define USE_MFMA_ATTN 1
#endif
#ifndef USE_MFMA_CONV
#define USE_MFMA_CONV 1
#endif
__device__ __forceinline__ void mixer_phase(Frame& F, const Args& A, int l) {
    unsigned char* ws = A.ws;
    float* S = (float*)F.glds;
    const bf16* Z = (const bf16*)(ws + WS_Z); bf16* Y = (bf16*)(ws + WS_YMIX);
    const float* BT = (const float*)(ws + WS_BT);
    constexpr int U0 = 128, U1 = U0 + 8, U2 = U1 + 128, U3 = U2 + 32, U4 = U3 + 256, U5 = U4 + 16;
    const int bx = blockIdx.x;
#pragma unroll 1
    for (int slot = 0; slot < 3; ++slot) {
        int u;
        if (slot == 0) u = (bx < 128) ? bx : U1 + (bx - 128);
        else if (slot == 1) u = U3 + bx;
        else { const int e = bx - 128; if (e < 0 || e >= 56) break; u = (e < 8) ? U0 + e : (e < 40 ? U2 + (e - 8) : U4 + (e - 40)); }
        if (!((A.mix_mask >> (u < U1 ? 0 : (u < U3 ? 1 : 2))) & 1)) continue;
        if (u < U1) {
            int rowbase, t0, nfr; const float* left = nullptr;
            if (u < U0) { const int b = u >> 6, c = u & 63; rowbase = b * SEQ; t0 = c * 64; nfr = 64; }
            else { const int b = u - U0; rowbase = NROWP + b * NSS; t0 = 0; nfr = NSS; left = A.in[5] + (size_t)(l * 8 + b) * 30 * 512; }
#if USE_MFMA_CONV
            conv_unit(F.lds, Z + (size_t)rowbase * ZP + ZC_U, t0, nfr, left, A.in[10] + l * 31 * 512, A.in[11] + l * 512, A.in[12] + l * 512, A.in[13] + l * 512,
                      (const bf16*)(ws + WS_WPW) + (size_t)l * 512 * 512, A.in[15] + l * 512, Z + (size_t)(rowbase + t0) * ZP + ZC_GA, Y + (size_t)(rowbase + t0) * DM);
#else
            naive_conv(S, Z + (size_t)rowbase * ZP + ZC_U, t0, nfr, left, A.in[10] + l * 31 * 512, A.in[11] + l * 512, A.in[12] + l * 512, A.in[13] + l * 512,
                       A.in[14] + (size_t)l * 512 * 512, A.in[15] + l * 512, Z + (size_t)(rowbase + t0) * ZP + ZC_GA, Y + (size_t)(rowbase + t0) * DM);
#endif
        } else if (u < U3) {
            MemUnit M; int row0, h;
            if (u < U2) { const int v = u - U1, b = v >> 6, qblk = v & 15; h = (v >> 4) & 3; row0 = b * SEQ + qblk * 256; M.nq = 256;
                M.k = (const bf16*)(ws + WS_MKVP) + (size_t)(b * 256) * 4096 + l * 1024 + h * 128; M.v = M.k + 512; M.pitch = 4096; }
            else { const int v = u - U2, b = v >> 2; h = v & 3; row0 = NROWP + b * NSS; M.nq = NSS;
                M.k = (const bf16*)(ws + WS_CMK) + (size_t)((l * 8 + b) * 256) * 512 + h * 128; M.v = (const bf16*)(ws + WS_CMV) + (size_t)((l * 8 + b) * 256) * 512 + h * 128; M.pitch = 512; }
            M.q = Z + (size_t)row0 * ZP + ZC_CQ + h * 128; M.gate = Z + (size_t)row0 * ZP + ZC_GC + h * 128; M.out = Y + (size_t)row0 * DM + 1536 + h * 128;
            mem_unit(F.lds, M);
        } else {
            SwaUnit W; int row0, kv;
            if (u < U4) { const int v = u - U3, b = v >> 7, c = (v >> 1) & 63; kv = v & 1; row0 = b * SEQ + c * 64; W.nq = 64;
                const bf16* kb = Z + ((long)row0 - 128) * ZP + ZC_K + kv * 64;
                W.ks = KSrc{kb, ZP, 192, kb, ZP}; W.vs = KSrc{kb + (ZC_V - ZC_K), ZP, 192, kb + (ZC_V - ZC_K), ZP}; W.jlo = (c >= 2) ? 0 : 128 - 64 * c; W.nk = 192; }
            else { const int v = u - U4, b = v >> 1; kv = v & 1; row0 = NROWP + b * NSS; W.nq = NSS;
                const bf16* ck = (const bf16*)(ws + WS_CSK) + (size_t)((l * 8 + b) * 128) * 128 + kv * 64; const bf16* cv = (const bf16*)(ws + WS_CSV) + (size_t)((l * 8 + b) * 128) * 128 + kv * 64;
                const bf16* zk = Z + (size_t)row0 * ZP + ZC_K + kv * 64;
                W.ks = KSrc{ck, 128, 128, zk, ZP}; W.vs = KSrc{cv, 128, 128, zk + (ZC_V - ZC_K), ZP}; W.jlo = 0; W.nk = 144; }
            W.q = Z + (size_t)row0 * ZP + ZC_Q + kv * 512; W.gate = Z + (size_t)row0 * ZP + ZC_GB + kv * 512; W.out = Y + (size_t)row0 * DM + 512 + kv * 512; W.kvh = kv;
            swa_unit(F.lds, W, BT, A.in[16] + l * 16);
        }
    }
}

__device__ __forceinline__ void final_norm_phase(Frame& F, const Args& A) {
    const float* X = (const float*)(A.ws + WS_X); const float* SSQ = (const float*)(A.ws + WS_SSQ); const float* g = A.in[21];
    const int tid_ = opaque_tid(), lane = tid_ & 63, wave_ = __builtin_amdgcn_readfirstlane(tid_ >> 6);
    const int gw = F.vcu * NWAVES + wave_, NGW = F.G * NWAVES;
    f32x4 gv[8];
#pragma unroll
    for (int j = 0; j < 8; ++j) gv[j] = ((const f32x4*)g)[lane + 64 * j];
    for (int m = gw; m < NROW; m += NGW) {
        float s = (lane < 32) ? SSQ[(size_t)m * 32 + lane] : 0.f;
        s = wave_sum(s);
        const float rstd = 1.0f / sqrtf(s * (1.0f / DM) + 1e-6f);
        const f32x4* xr = (const f32x4*)(X + (size_t)m * DM) + lane;
        f32x4* o = (f32x4*)(A.out + (m < NROWP ? OFF_YP + (size_t)m * DM : OFF_YS + (size_t)(m - NROWP) * DM)) + lane;
#pragma unroll
        for (int j = 0; j < 8; ++j) o[64 * j] = xr[64 * j] * rstd * gv[j];
    }
}

constexpr int N_PHASES = 2 + 3 * DEPTH;
#ifndef MK_SINGLE
#define MK_SINGLE 1
#endif
__global__ void __launch_bounds__(NTHREADS, 2) mk_fwd(Args args) {
    extern __shared__ __attribute__((aligned(16))) unsigned char lds[];
    Frame F;
    F.lds = (LAS unsigned char*)lds; F.glds = lds;
    F.MISC = (volatile LAS unsigned*)(F.lds + MISC_OFF);
    F.tid = threadIdx.x; F.lane = F.tid & 63; F.wave = __builtin_amdgcn_readfirstlane(F.tid >> 6);
    F.G = gridDim.x; { const int bx = blockIdx.x; F.vcu = (F.G % 8 == 0) ? (bx % 8) * (F.G / 8) + bx / 8 : bx; }
    unsigned char* ws = args.ws;
    F.ctl = (gu32*)(ws + WS_CTL);
    for (int u = F.tid; u < (LDS_BYTES - LDSCTL_OFF) / 4; u += NTHREADS) ((LAS unsigned*)(F.lds + LDSCTL_OFF))[u] = 0u;
    __syncthreads();
    XcdBarrier bar; bar.bar = (unsigned*)(F.ctl + CW_BAR); bar.x = 0; bar.st = nullptr;
    const int lo = args.ph_lo, hi = args.ph_hi;
    const bool multi = (hi - lo) > 1;
    if (multi) bar = xcd_barrier_post((unsigned*)(F.ctl + CW_BAR), F.MISC + 8);
#define SEAM(k) do { if (lo <= (k) && (k) + 1 < hi) xcd_barrier(bar); } while (0)
#define IN(k) (lo <= (k) && (k) < hi)
    if (IN(0)) { p0_prologue(F, args); SEAM(0); }
    if (IN(1)) {
        unsigned char* wsl = ws; asm volatile("" : "+s"(wsl));
        pg8::Gemm g{(const pg8::bf16_t*)(wsl + WS_MEMN), (const pg8::bf16_t*)(wsl + WS_WMEM), 512, 4096, DM};
        pg8::StaticOrder S; S.init(512, 4096, F.G, (int)(F.G - 1 - blockIdx.x));
        pg8::EpiMemKV E{(pg8::bf16_t*)(wsl + WS_MKVP), args.out};
        pg8::gemm_phase<pg8::EpiMemKV, pg8::StaticOrder, true, true>(F.lds, g, S, E);
    }
#pragma unroll 1
    for (int l = 0; l < DEPTH; ++l) {
        const int p1 = 1 + 3 * l, p2 = p1 + 1, p3 = p1 + 2;
        unsigned char* wsl = ws; int bxl = blockIdx.x; asm volatile("" : "+s"(wsl), "+s"(bxl));
        if (IN(p1)) {
            pg8::Gemm g{(const pg8::bf16_t*)(wsl + WS_XB), (const pg8::bf16_t*)(wsl + WS_WIN) + (size_t)l * INDIM * DM, MPAD, INDIM, DM};
            int vc1 = F.vcu; asm volatile("" : "+s"(vc1));
            pg8::Hybrid S; S.init(MPAD, INDIM, vc1, 2);
            pg8::EpiIn E{(pg8::bf16_t*)(wsl + WS_Z), (const float*)(wsl + WS_SSQ), args.out, l};
            pg8::SplitK<1> SK{(float*)(wsl + WS_DUMP), (unsigned*)(wsl + WS_CTL) + CW_SK + (l * 2 + 0) * 4096};
            pg8::gemm_phase<pg8::EpiIn, pg8::Hybrid, true, true, pg8::SplitK<1>>(F.lds, g, S, E, SK);
            SEAM(p1);
        }
#if USE_MFMA_ATTN
        if (IN(p2)) { mixer_phase(F, args, l); SEAM(p2); }
#else
        if (IN(p2)) { naive_mixer_phase(F, args, l); SEAM(p2); }
#endif
        if (IN(p3)) {
            pg8::Gemm g{(const pg8::bf16_t*)(wsl + WS_YMIX), (const pg8::bf16_t*)(wsl + WS_WOUT) + (size_t)l * DM * DM, MPAD, DM, DM};
            int vcl = F.vcu; asm volatile("" : "+s"(vcl));
            pg8::Hybrid S; S.init(MPAD, DM, vcl, 4);
            const float* Xc = (const float*)(wsl + WS_X);
            pg8::EpiOut E{(float*)(wsl + WS_X), (pg8::bf16_t*)(wsl + WS_XB), (float*)(wsl + WS_SSQ), l == 0 ? args.in[0] : Xc, l == 0 ? args.in[1] - (size_t)NROWP * DM : Xc};
            pg8::SplitK<3> SK{(float*)(wsl + WS_DUMP), (unsigned*)(wsl + WS_CTL) + CW_SK + (l * 2 + 1) * 4096};
            pg8::gemm_phase<pg8::EpiOut, pg8::Hybrid, true, true, pg8::SplitK<3>>(F.lds, g, S, E, SK);
            SEAM(p3);
        }
    }
    if (IN(N_PHASES - 1)) final_norm_phase(F, args);
#undef SEAM
#undef IN
}

extern "C" void kernel_launch(void* const* d_in, const int* in_sizes, int n_in, void* d_out, int out_size, void* d_ws, size_t ws_size, hipStream_t stream) {
    static int grid = 0;
    if (grid == 0) {
        if (n_in != 22 || out_size != (int)OUT_TOTAL || ws_size < WS_END) { fprintf(stderr, "kernel_launch: unexpected shapes: n_in %d out %d ws %zu\n", n_in, out_size, ws_size); grid = -1; return; }
        int dev = 0, cus = 0, per_cu = 0;
        if (hipGetDevice(&dev) != hipSuccess || hipDeviceGetAttribute(&cus, hipDeviceAttributeMultiprocessorCount, dev) != hipSuccess) { grid = -1; return; }
        if (hipFuncSetAttribute((const void*)mk_fwd, hipFuncAttributeMaxDynamicSharedMemorySize, LDS_BYTES) != hipSuccess) { fprintf(stderr, "kernel_launch: hipFuncSetAttribute failed\n"); grid = -1; return; }
        if (hipOccupancyMaxActiveBlocksPerMultiprocessor(&per_cu, (const void*)mk_fwd, NTHREADS, LDS_BYTES) != hipSuccess || per_cu < 1) { fprintf(stderr, "kernel_launch: occupancy query says %d blocks per CU\n", per_cu); (void)hipGetLastError(); grid = -1; return; }
        if (cus != 256) { fprintf(stderr, "kernel_launch: built for a 256-CU device, found %d CUs\n", cus); grid = -1; return; }
        grid = cus;
    }
    if (grid < 0) return;
    (void)hipMemsetAsync((char*)d_ws + WS_CTL, 0, CTL_ZERO_BYTES, stream);
    Args a{};
    for (int i = 0; i < 22; ++i) a.in[i] = (const float*)d_in[i];
    a.out = (float*)d_out; a.ws = (unsigned char*)d_ws;
#if MK_SINGLE
    a.mix_mask = 7;
#ifdef PROBE_PREFIX
#ifdef PROBE_MASK
    a.mix_mask = PROBE_MASK;
#endif
#ifdef PROBE_FLAGS
    a.pflags = PROBE_FLAGS;
#endif
    a.ph_lo = 0; a.ph_hi = PROBE_PREFIX;
    hipLaunchKernelGGL(mk_fwd, dim3(grid), dim3(NTHREADS), LDS_BYTES, stream, a);
    (void)hipMemsetAsync((char*)d_ws + WS_CTL, 0, CTL_ZERO_BYTES, stream);
    a.mix_mask = 7; a.pflags = 0;
#endif
    a.ph_lo = 0; a.ph_hi = N_PHASES;
    hipLaunchKernelGGL(mk_fwd, dim3(grid), dim3(NTHREADS), LDS_BYTES, stream, a);
#else
    for (int p = 0; p < N_PHASES; ++p) { a.ph_lo = p; a.ph_hi = p + 1; hipLaunchKernelGGL(mk_fwd, dim3(grid), dim3(NTHREADS), LDS_BYTES, stream, a); }
#endif
}
```

```cpp
#include <hip/hip_runtime.h>
#include <cstdio>
#include <cstdint>

namespace pg8 {
#define PG8_LAS __attribute__((address_space(3)))
typedef unsigned short bf16_t;
typedef short bf16x8 __attribute__((ext_vector_type(8)));
typedef float f32x4 __attribute__((ext_vector_type(4)));
typedef unsigned u32x4 __attribute__((ext_vector_type(4)));
constexpr int BM = 256, BK = 64, HALF = 128, HTB = HALF * BK * 2  , STAGE_BYTES = 8 * HTB, NXCD = 8, WGM = 8;

__host__ __device__ __forceinline__ int lds_byte(int r, int c) { const int st = (r >> 4) * 2 + (c >> 5), rr = r & 15, cc = c & 31, ob = rr * 64 + cc * 2; return st * 1024 + (ob ^ (((ob >> 9) & 1) << 5)); }
__host__ __device__ __forceinline__ void stage_rc(int b, int& R, int& C) { const int st = b / 1024, sb = b % 1024, swz = sb ^ (((sb >> 9) & 1) << 5); R = (st >> 1) * 16 + swz / 64; C = (st & 1) * 32 + (swz % 64) / 2; }
__host__ __device__ __forceinline__ int perm32(int rho) { const int n = rho >> 4, i = rho & 15; return 8 * (i >> 2) + 4 * n + (i & 3); }

struct Unit { int pm, pn, k0, nk, mode, slot, np; };
struct Gemm { const bf16_t* A; const bf16_t* Bt; int M, N, K; };

struct StaticOrder {
    int nM, nN, nwg, G, c;
    __host__ __device__ void init(int M, int N, int G_, int c_) { nM = M / BM; nN = N / BM; nwg = nM * nN; G = G_; c = c_; }
    __host__ __device__ bool next(int i, Unit& u) const {
        const long L = (long)i * G + c; if (L >= nwg) return false;
        int wgid = (int)L; { const int q = nwg / NXCD, r = nwg % NXCD, xcd = wgid % NXCD, off = wgid / NXCD; wgid = (xcd < r ? xcd * (q + 1) : r * (q + 1) + (xcd - r) * q) + off; }
        const int nig = WGM * nN, gid = wgid / nig, fm = gid * WGM, gsz = (nM - fm) < WGM ? (nM - fm) : WGM;
        u.pm = fm + ((wgid % nig) % gsz); u.pn = (wgid % nig) / gsz; u.k0 = 0; u.nk = 0; u.mode = 0; u.slot = 0; u.np = 0; return true;
    }
    __device__ __forceinline__ void a_ready(const Unit&) const {}
    __device__ __forceinline__ void done(const Unit&) const {}
};

__device__ __forceinline__ unsigned cvt_pk_bf16(float lo, float hi) { unsigned r; asm volatile("v_cvt_pk_bf16_f32 %0, %1, %2" : "=v"(r) : "v"(lo), "v"(hi)); return r; }
typedef float f32x2 __attribute__((ext_vector_type(2)));


#define PG8_GAS __attribute__((address_space(1)))
struct PartialReader {
    const PG8_GAS f32x4* p;
    template <int NP> __device__ __forceinline__ f32x4 next() {
        if constexpr (NP == 0) return (f32x4){0.f, 0.f, 0.f, 0.f};
        else {
            f32x4 x = p[0];
            if constexpr (NP > 1) x += p[16384];
            if constexpr (NP > 2) x += p[32768];
            p += 64; asm volatile("" : "+v"(p));
            return x;
        }
    }
    template <int NP> __device__ __forceinline__ void skip(int n) { if constexpr (NP > 0) { p += 64 * n; asm volatile("" : "+v"(p)); } }
};

constexpr int P_D = 2048, P_INDIM = 4864, P_NROW = 8320  , P_MPAD = 8448, P_NSSQ = 32;
constexpr long OFF_YP = 0, OFF_YS = 16777216, OFF_KP = 17039360, OFF_VP = 17170432, OFF_CP = 17301504, OFF_MKP = 17424384, OFF_MVP = 18472960,
               OFF_KS = 19521536, OFF_VS = 20045824, OFF_CS = 20570112, OUT_TOTAL = 21061632;
constexpr float QS_SWA = 0.125f * 1.4426950408889634f;
constexpr float QS_MEM = 0.08838834764831845f * 1.4426950408889634f;

__device__ __forceinline__ float sigmoid_f(float x) { return __builtin_amdgcn_rcpf(1.0f + __builtin_amdgcn_exp2f(x * -1.4426950408889634f)); }
__device__ __forceinline__ f32x4 sigmoid4(f32x4 x) { return (f32x4){sigmoid_f(x[0]), sigmoid_f(x[1]), sigmoid_f(x[2]), sigmoid_f(x[3])}; }
__device__ __forceinline__ u32x4 pack8(f32x4 a, f32x4 b) { u32x4 w; w.x = cvt_pk_bf16(a[0], a[1]); w.y = cvt_pk_bf16(a[2], a[3]); w.z = cvt_pk_bf16(b[0], b[1]); w.w = cvt_pk_bf16(b[2], b[3]); return w; }

__device__ __forceinline__ void row_rstd(float (&rs)[2][4], const float* ssq, int rbase, int fq) {
    f32x4 pa[2][4], pb[2][4];
#pragma unroll
    for (int ai = 0; ai < 2; ++ai)
#pragma unroll
        for (int m = 0; m < 4; ++m) { const PG8_GAS f32x4* p = (const PG8_GAS f32x4*)(ssq + (size_t)(rbase + ai * HALF + m * 16) * P_NSSQ + fq * 8); pa[ai][m] = p[0]; pb[ai][m] = p[1]; }
#pragma unroll
    for (int ai = 0; ai < 2; ++ai)
#pragma unroll
        for (int m = 0; m < 4; ++m) {
            const f32x4 a = pa[ai][m], b = pb[ai][m];
            float s = ((a[0] + a[1]) + (a[2] + a[3])) + ((b[0] + b[1]) + (b[2] + b[3]));
            s += __shfl_xor(s, 16); s += __shfl_xor(s, 32);
            rs[ai][m] = __builtin_amdgcn_rsqf(s * (1.0f / (float)P_D) + 1e-6f);
        }
}

struct EpiIn {
    static constexpr bool PERM = true, AFTER_DRAIN = false;
    bf16_t* Z; const float* ssq; float* out; int layer;
    template <int HASP> __device__ __forceinline__ void run(const f32x4 (&acc)[2][2][4][2], const Unit& u, int wr, int wc, int fr, int fq, PartialReader& PR) const {
        { int t_ = threadIdx.x; asm volatile("" : "+v"(t_)); fr = t_ & 15; fq = (t_ >> 4) & 3; }
        const int pn = u.pn, rbase = u.pm * BM + wr * 64 + fr;
        bf16_t* Z = this->Z; const float* ssq = this->ssq; float* out = this->out;
        asm volatile("" : "+s"(Z), "+s"(ssq), "+s"(out));
        float rs[2][4];
        row_rstd(rs, ssq, rbase, fq);
        const bool tailtile = (u.pm == 15) || (u.pm == 31) || (u.pm == 32);
        const bool is_q = (pn >= 6 && pn <= 9), is_cq = (pn == 15 || pn == 16);
        const float qs = is_q ? QS_SWA : QS_MEM;
#pragma unroll
        for (int ai = 0; ai < 2; ++ai) {
            if (u.pm * BM + wr * 64 + ai * HALF >= P_NROW) { PR.template skip<HASP>(16); continue; }
#pragma unroll
            for (int m2 = 0; m2 < 4; m2 += 2) {
            f32x4 v[4][2][2];
#pragma unroll
            for (int m = m2; m < m2 + 2; ++m)
#pragma unroll
                for (int bj = 0; bj < 2; ++bj)
#pragma unroll
                    for (int n = 0; n < 2; ++n) { if constexpr (HASP == 0) v[m][bj][n] = acc[ai][bj][m][n]; else v[m][bj][n] = acc[ai][bj][m][n] + PR.template next<HASP>(); }
#pragma unroll
            for (int m = m2; m < m2 + 2; ++m) {
                const int row = rbase + ai * HALF + m * 16;
                const float r = rs[ai][m];
                if (pn < 4) {
                    const int ch0 = 128 * pn + 32 * wc + 8 * fq;
                    const f32x4 u0 = (v[m][0][0] * r) * sigmoid4(v[m][1][0] * r), u1 = (v[m][0][1] * r) * sigmoid4(v[m][1][1] * r);
                    *(PG8_GAS u32x4*)(Z + (size_t)row * P_INDIM + ch0) = pack8(u0, u1);
                    if (tailtile) {
                        float* dst = nullptr;
                        if (row < 8192) { const int t = row & 4095, b = row >> 12; if (t >= 4066) dst = out + OFF_CP + ((size_t)(layer * 2 + b) * 30 + (t - 4066)) * 512 + ch0; }
                        else { const int rr = row - 8192, b = rr >> 4, s = rr & 15; dst = out + OFF_CS + ((size_t)(layer * 8 + b) * 30 + 14 + s) * 512 + ch0; }
                        if (dst) { *(PG8_GAS f32x4*)dst = u0; *(PG8_GAS f32x4*)(dst + 4) = u1; }
                    }
                } else if (pn == 10) {
#pragma unroll
                    for (int bj = 0; bj < 2; ++bj) {
                        const f32x4 v0 = v[m][bj][0] * r, v1 = v[m][bj][1] * r;
                        const int c128 = 32 * wc + 8 * fq;
                        *(PG8_GAS u32x4*)(Z + (size_t)row * P_INDIM + 2560 + 128 * bj + c128) = pack8(v0, v1);
                        if (tailtile) {
                            float* dst = nullptr;
                            if (row < 8192) { const int t = row & 4095, b = row >> 12; if (t >= 3968) dst = out + (bj ? OFF_VP : OFF_KP) + ((size_t)(layer * 2 + b) * 128 + (t - 3968)) * 128 + c128; }
                            else { const int rr = row - 8192, b = rr >> 4, s = rr & 15; dst = out + (bj ? OFF_VS : OFF_KS) + ((size_t)(layer * 8 + b) * 128 + 112 + s) * 128 + c128; }
                            if (dst) { *(PG8_GAS f32x4*)dst = v0; *(PG8_GAS f32x4*)(dst + 4) = v1; }
                        }
                    }
                } else {
#pragma unroll
                    for (int bj = 0; bj < 2; ++bj) {
                        f32x4 v0 = v[m][bj][0] * r, v1 = v[m][bj][1] * r;
                        if (!(is_q || is_cq)) { v0 = v0 * sigmoid4(v0); v1 = v1 * sigmoid4(v1); } else { v0 = v0 * qs; v1 = v1 * qs; }
                        *(PG8_GAS u32x4*)(Z + (size_t)row * P_INDIM + pn * BM + 128 * bj + 32 * wc + 8 * fq) = pack8(v0, v1);
                    }
                }
            }
            }
        }
    }
};

struct EpiMemKV {
    static constexpr bool PERM = true, AFTER_DRAIN = false;
    bf16_t* MKV; float* out;
    template <int HASP> __device__ __forceinline__ void run(const f32x4 (&acc)[2][2][4][2], const Unit& u, int wr, int wc, int fr, int fq, PartialReader& PR) const {
        const int l = u.pn >> 2, kv = (u.pn >> 1) & 1, cb = (u.pn & 1) * 256;
        bf16_t* MKV = this->MKV; float* out = this->out; asm volatile("" : "+s"(MKV), "+s"(out));
        const int row0 = u.pm * BM + wr * 64 + fr, cl = 32 * wc + 8 * fq;
        bf16_t* zb = MKV + (size_t)row0 * 4096 + u.pn * BM + cl;
        float* ob = out + (kv ? OFF_MVP : OFF_MKP) + ((size_t)(l * 512 + row0)) * 512 + cb + cl;
#pragma unroll
        for (int ai = 0; ai < 2; ++ai)
#pragma unroll
            for (int m = 0; m < 4; ++m)
#pragma unroll
                for (int bj = 0; bj < 2; ++bj) {
                    const f32x4 v0 = acc[ai][bj][m][0], v1 = acc[ai][bj][m][1];
                    *(PG8_GAS u32x4*)(zb + (size_t)(ai * HALF + m * 16) * 4096 + 128 * bj) = pack8(v0, v1);
                    float* dst = ob + (size_t)(ai * HALF + m * 16) * 512 + 128 * bj;
                    *(PG8_GAS f32x4*)dst = v0; *(PG8_GAS f32x4*)(dst + 4) = v1;
                }
    }
};

struct EpiOut {
    static constexpr bool PERM = false, AFTER_DRAIN = false;
    float* X; bf16_t* XB; float* ssq; const float* rin_p; const float* rin_s;
    typedef unsigned u32x2v __attribute__((ext_vector_type(2)));
    __device__ __forceinline__ static void row_out(const f32x4 (&xn)[2][2], float* X, bf16_t* XB, float* ssq, int row, int colbase, int slot, int fq) {
        float q = 0.f;
#pragma unroll
        for (int bj = 0; bj < 2; ++bj)
#pragma unroll
            for (int n = 0; n < 2; ++n) {
                const size_t off = (size_t)row * P_D + colbase + bj * HALF + n * 16;
                *(PG8_GAS f32x4*)(X + off) = xn[bj][n];
                u32x2v w; w.x = cvt_pk_bf16(xn[bj][n][0], xn[bj][n][1]); w.y = cvt_pk_bf16(xn[bj][n][2], xn[bj][n][3]);
                *(PG8_GAS u32x2v*)(XB + off) = w;
                q += (xn[bj][n][0] * xn[bj][n][0] + xn[bj][n][1] * xn[bj][n][1]) + (xn[bj][n][2] * xn[bj][n][2] + xn[bj][n][3] * xn[bj][n][3]);
            }
        q += __shfl_xor(q, 16); q += __shfl_xor(q, 32);
        if (fq == 0) *(PG8_GAS float*)(ssq + (size_t)row * P_NSSQ + slot) = q;
    }
    template <int HASP> __device__ __forceinline__ void run(const f32x4 (&acc)[2][2][4][2], const Unit& u, int wr, int wc, int fr, int fq, PartialReader& PR) const {
        { int t_ = threadIdx.x; asm volatile("" : "+v"(t_)); fr = t_ & 15; fq = (t_ >> 4) & 3; }
        const int rbase = u.pm * BM + wr * 64 + fr, colbase = u.pn * BM + wc * 32 + fq * 4, slot = u.pn * 4 + wc;
        float* X = this->X; bf16_t* XB = this->XB; float* ssq = this->ssq; asm volatile("" : "+s"(X), "+s"(XB), "+s"(ssq));
        const float* rin = (u.pm == 32) ? rin_s : rin_p; asm volatile("" : "+s"(rin));
#pragma unroll
        for (int ai = 0; ai < 2; ++ai) {
            if (u.pm * BM + wr * 64 + ai * HALF >= P_NROW) { PR.template skip<HASP>(16); continue; }
            if constexpr (HASP == 0) {
                f32x4 rv[4][2][2];
#pragma unroll
                for (int m = 0; m < 4; ++m)
#pragma unroll
                    for (int bj = 0; bj < 2; ++bj)
#pragma unroll
                        for (int n = 0; n < 2; ++n) rv[m][bj][n] = *(const PG8_GAS f32x4*)(rin + (size_t)(rbase + ai * HALF + m * 16) * P_D + colbase + bj * HALF + n * 16);
#pragma unroll
                for (int m = 0; m < 4; ++m) {
                    f32x4 xn[2][2];
#pragma unroll
                    for (int bj = 0; bj < 2; ++bj)
#pragma unroll
                        for (int n = 0; n < 2; ++n) xn[bj][n] = rv[m][bj][n] + acc[ai][bj][m][n];
                    row_out(xn, X, XB, ssq, rbase + ai * HALF + m * 16, colbase, slot, fq);
                }
            } else {
#pragma unroll
                for (int m = 0; m < 4; ++m) {
                    f32x4 rv[2][2], pv[2][2], xn[2][2];
#pragma unroll
                    for (int bj = 0; bj < 2; ++bj)
#pragma unroll
                        for (int n = 0; n < 2; ++n) { rv[bj][n] = *(const PG8_GAS f32x4*)(rin + (size_t)(rbase + ai * HALF + m * 16) * P_D + colbase + bj * HALF + n * 16); pv[bj][n] = PR.template next<HASP>(); }
#pragma unroll
                    for (int bj = 0; bj < 2; ++bj)
#pragma unroll
                        for (int n = 0; n < 2; ++n) xn[bj][n] = rv[bj][n] + (acc[ai][bj][m][n] + pv[bj][n]);
                    row_out(xn, X, XB, ssq, rbase + ai * HALF + m * 16, colbase, slot, fq);
                }
            }
        }
    }
};

struct NoSplit {
    static constexpr int NP = 0;
    __device__ __forceinline__ void dump(const f32x4 (&)[2][2][4][2], const Unit&, int, int) const {}
    __device__ __forceinline__ PartialReader reader(const Unit&, int, int) const { PartialReader r; r.p = nullptr; return r; }
};
template <int NP_> struct SplitK {
    static constexpr int NP = NP_;
    float* slots; unsigned* flags;
    __device__ __forceinline__ void dump(const f32x4 (&acc)[2][2][4][2], const Unit& u, int wid, int lane) const {
        const __amdgpu_buffer_rsrc_t rs = __builtin_amdgcn_make_buffer_rsrc(slots, (short)0, 256 * 65536 * 4, 0x00020000);
        unsigned off = (unsigned)u.slot * 262144u + ((unsigned)wid * 32u * 64u + (unsigned)lane) * 16u;
#pragma unroll
        for (int a = 0; a < 2; ++a)
#pragma unroll
            for (int m = 0; m < 4; ++m)
#pragma unroll
                for (int b = 0; b < 2; ++b)
#pragma unroll
                    for (int n = 0; n < 2; ++n) {
                        __builtin_amdgcn_raw_buffer_store_b128(__builtin_bit_cast(u32x4, acc[a][b][m][n]), rs, off, 0,   16);
                        off += 1024u; asm volatile("" : "+v"(off)); }
        asm volatile("s_waitcnt vmcnt(0)" ::: "memory");
        if (lane == 0) __hip_atomic_fetch_add(flags + 16 * u.slot, 1u, __ATOMIC_RELAXED, __HIP_MEMORY_SCOPE_AGENT);
    }
    __device__ __forceinline__ PartialReader reader(const Unit& u, int wid, int lane) const {
#pragma unroll
        for (int q = 0; q < NP; ++q) { unsigned sp = 0;
            while ((unsigned)__builtin_amdgcn_readfirstlane(__hip_atomic_load(flags + 16 * (u.slot + q), __ATOMIC_RELAXED, __HIP_MEMORY_SCOPE_AGENT)) < 8u) { __builtin_amdgcn_s_sleep(2); if (++sp > (1u << 22)) break; } }
        __builtin_amdgcn_fence(__ATOMIC_ACQUIRE, "agent");
        asm volatile("s_waitcnt vmcnt(0)" ::: "memory");
        PartialReader r; r.p = (const PG8_GAS f32x4*)(slots + (size_t)u.slot * 65536) + ((size_t)wid * 32 * 64 + lane); return r;
    }
};
struct Hybrid {
    static constexpr int G = 256;
    int nM, nN, v, R, S, P;
    __device__ void init(int M, int N, int v_, int P_) { nM = M / BM; nN = N / BM; v = v_; P = P_; const int nu = nM * nN; R = nu / G; S = nu - R * G; }
    __device__ bool next(int i, Unit& u) const {
        const bool hasp = v < S * P; const int sp = v / P, q = v - sp * P;
        const bool dumper = hasp && q > 0, owner = hasp && q == 0;
        const int idx = i - (dumper ? 1 : 0);
        int ui;
        const int kb0 = (P == 2) ? (q == 0 ? 0 : 8) : (q == 0 ? 0 : 8 * q - 4), kb1 = (P == 2) ? (q == 0 ? 8 : 32) : (q == 3 ? 32 : 8 * q + 4);
        if (dumper && i == 0) { ui = R * G + sp; u.k0 = kb0; u.nk = kb1 - kb0; u.mode = 1; u.slot = sp * (P - 1) + q - 1; u.np = 0; }
        else if (idx < R) { ui = idx * G + v; u.k0 = 0; u.nk = 0; u.mode = 0; u.slot = 0; u.np = 0; }
        else if (idx == R && owner) { ui = R * G + sp; u.k0 = 0; u.nk = kb1; u.mode = 2; u.slot = sp * (P - 1); u.np = P - 1; }
        else return false;
        const int nig = WGM * nN, gid = ui / nig, fm = gid * WGM, gsz = (nM - fm) < WGM ? (nM - fm) : WGM, r = ui % nig;
        u.pm = fm + r % gsz; u.pn = r / gsz; return true;
    }
    __device__ __forceinline__ void a_ready(const Unit&) const {}
    __device__ __forceinline__ void done(const Unit&) const {}
};
template <class Epi, class Sched, bool ALIGN_EPI = false, bool SP2 = false, class SKT = NoSplit>
__device__ __forceinline__ void gemm_phase(PG8_LAS unsigned char* lds, const Gemm g, const Sched& S, const Epi& E, const SKT SK = SKT()) {
    int tid_ = threadIdx.x; asm volatile("" : "+v"(tid_));
    const int tid = tid_, wid = __builtin_amdgcn_readfirstlane(tid >> 6), lane = tid & 63, wr = wid >> 2, wc = wid & 3, fr = lane & 15, fq = lane >> 4;
    const int K = g.K, ntf = K / BK;
    unsigned voffA[2], voffB[2];
#pragma unroll
    for (int i = 0; i < 2; ++i) { int R, C; stage_rc(tid * 16 + i * 8192, R, C); const int Rb = Epi::PERM ? ((R & ~31) + perm32(R & 31)) : R;
        voffA[i] = (unsigned)(R * K + C) * 2u; voffB[i] = (unsigned)(Rb * K + C) * 2u; }
    const size_t kstep = (size_t)(BK * 2);
    const size_t hstep = (size_t)HALF * K * 2;
    const size_t tstep = 2 * hstep;
    const unsigned ldsw = (unsigned)wid * 1024u;
    const int aoff = lds_byte(wr * 64 + fr, fq * 8), boff = lds_byte(wc * 32 + fr, fq * 8);
#define PG8_SA(b, h) (((b) * 2 + (h)) * HTB)
#define PG8_SB(b, h) ((4 + (b) * 2 + (h)) * HTB)
#define PG8_STAGE(bufoff, gbase, voff) do { _Pragma("unroll") for (int _i = 0; _i < 2; ++_i) \
        __builtin_amdgcn_global_load_lds((const unsigned*)((const char*)(gbase) + (voff)[_i]), (PG8_LAS unsigned*)(lds + (bufoff) + ldsw + _i * 8192), 16, 0, 0); } while (0)
#define PG8_LDA(dst, b, h) do { _Pragma("unroll") for (int m = 0; m < 4; ++m) _Pragma("unroll") for (int k = 0; k < 2; ++k) dst[m][k] = *(const PG8_LAS bf16x8*)(lds + PG8_SA(b, h) + aoff + m * 2048 + k * 1024); } while (0)
#define PG8_LDB(dst, b, h) do { _Pragma("unroll") for (int n = 0; n < 2; ++n) _Pragma("unroll") for (int k = 0; k < 2; ++k) dst[n][k] = *(const PG8_LAS bf16x8*)(lds + PG8_SB(b, h) + boff + n * 2048 + k * 1024); } while (0)
#define PG8_MMA(ai, bj, At, Bt) do { __builtin_amdgcn_s_setprio(1); _Pragma("unroll") for (int m = 0; m < 4; ++m) _Pragma("unroll") for (int n = 0; n < 2; ++n) _Pragma("unroll") for (int k = 0; k < 2; ++k) \
        acc[ai][bj][m][n] = __builtin_amdgcn_mfma_f32_16x16x32_bf16(Bt[n][k], At[m][k], acc[ai][bj][m][n], 0, 0, 0); __builtin_amdgcn_s_setprio(0); } while (0)
#define PG8_WAIT_V(n) asm volatile("s_waitcnt vmcnt(" #n ")" ::: "memory")
#define PG8_WAIT_L(n) asm volatile("s_waitcnt lgkmcnt(" #n ")" ::: "memory")
#define PG8_BAR __builtin_amdgcn_s_barrier()
#define PG8_SCHED __builtin_amdgcn_sched_barrier(0)
    Unit cur, nxt; int ui = 0;
    if (!S.next(0, cur)) return;
    f32x4 acc[2][2][4][2];
#pragma unroll
    for (int a = 0; a < 2; ++a)
#pragma unroll
        for (int b = 0; b < 2; ++b)
#pragma unroll
            for (int m = 0; m < 4; ++m)
#pragma unroll
                for (int n = 0; n < 2; ++n) acc[a][b][m][n] = (f32x4){0.f, 0.f, 0.f, 0.f};
    bf16x8 At[4][2], B0[2][2], B1[2][2];
    const char* cA = (const char*)g.A + (size_t)cur.pm * tstep + (size_t)cur.k0 * (BK * 2); const char* cB = (const char*)g.Bt + (size_t)cur.pn * tstep + (size_t)cur.k0 * (BK * 2);
    S.a_ready(cur);
    if constexpr (SP2) {
        PG8_STAGE(PG8_SB(0, 0), cB, voffB); PG8_STAGE(PG8_SB(0, 1), cB + hstep, voffB); PG8_STAGE(PG8_SA(0, 0), cA, voffA); PG8_STAGE(PG8_SA(0, 1), cA + hstep, voffA);
        if (wr == 1) PG8_BAR;
        PG8_WAIT_V(2); PG8_BAR;
        PG8_STAGE(PG8_SB(1, 0), cB + kstep, voffB); PG8_STAGE(PG8_SA(1, 0), cA + kstep, voffA); PG8_STAGE(PG8_SB(1, 1), cB + hstep + kstep, voffB);
        PG8_WAIT_V(6); PG8_BAR;
    } else {
        PG8_STAGE(PG8_SB(0, 0), cB, voffB); PG8_STAGE(PG8_SA(0, 0), cA, voffA); PG8_STAGE(PG8_SB(0, 1), cB + hstep, voffB); PG8_STAGE(PG8_SA(0, 1), cA + hstep, voffA);
        if (wr == 1) PG8_BAR;
        PG8_WAIT_V(4); PG8_BAR;
        PG8_STAGE(PG8_SB(1, 0), cB + kstep, voffB); PG8_STAGE(PG8_SA(1, 0), cA + kstep, voffA); PG8_STAGE(PG8_SB(1, 1), cB + hstep + kstep, voffB);
        PG8_WAIT_V(6); PG8_BAR;
    }
    for (;;) {
        const bool has_next = S.next(ui + 1, nxt);
        const char* nA = has_next ? (const char*)g.A + (size_t)nxt.pm * tstep + (size_t)nxt.k0 * (BK * 2) : cA; const char* nB = has_next ? (const char*)g.Bt + (size_t)nxt.pn * tstep + (size_t)nxt.k0 * (BK * 2) : cB;
        const int nt = cur.nk ? cur.nk : ntf;
        for (int t = 0; t < nt; t += 2) {
            const bool last = (t == nt - 2);
            const char* a1 = cA + (size_t)(t + 1) * kstep;
            const char* a2 = last ? nA : cA + (size_t)(t + 2) * kstep; const char* b2 = last ? nB : cB + (size_t)(t + 2) * kstep;
            const char* a3 = a2 + kstep; const char* b3 = b2 + kstep;
            if (last && has_next) S.a_ready(nxt);
            if constexpr (SP2) {
            PG8_LDB(B0, 0, 0); PG8_LDB(B1, 0, 1); PG8_SCHED; PG8_LDA(At, 0, 0); PG8_STAGE(PG8_SA(1, 1), a1 + hstep, voffA);
            PG8_WAIT_V(8); PG8_WAIT_L(0); PG8_BAR; PG8_MMA(0, 0, At, B0); PG8_MMA(0, 1, At, B1); PG8_BAR; PG8_SCHED;
            PG8_LDA(At, 0, 1); PG8_STAGE(PG8_SB(0, 0), b2, voffB); PG8_STAGE(PG8_SB(0, 1), b2 + hstep, voffB); PG8_STAGE(PG8_SA(0, 0), a2, voffA);
            PG8_WAIT_V(8); PG8_WAIT_L(0); PG8_BAR; PG8_MMA(1, 0, At, B0); PG8_MMA(1, 1, At, B1); PG8_BAR; PG8_SCHED;
            PG8_LDB(B0, 1, 0); PG8_LDB(B1, 1, 1); PG8_SCHED; PG8_LDA(At, 1, 0); PG8_STAGE(PG8_SA(0, 1), a2 + hstep, voffA);
            PG8_WAIT_V(8); PG8_WAIT_L(0); PG8_BAR; PG8_MMA(0, 0, At, B0); PG8_MMA(0, 1, At, B1); PG8_BAR; PG8_SCHED;
            PG8_LDA(At, 1, 1); PG8_STAGE(PG8_SB(1, 0), b3, voffB); PG8_STAGE(PG8_SB(1, 1), b3 + hstep, voffB); PG8_STAGE(PG8_SA(1, 0), a3, voffA);
            PG8_WAIT_V(8); PG8_WAIT_L(0); PG8_BAR; PG8_MMA(1, 0, At, B0); PG8_MMA(1, 1, At, B1); PG8_BAR; PG8_SCHED;
            } else {
            PG8_LDB(B0, 0, 0); PG8_SCHED; PG8_LDA(At, 0, 0); PG8_STAGE(PG8_SA(1, 1), a1 + hstep, voffA);
            PG8_WAIT_L(8); PG8_BAR; PG8_WAIT_L(0); PG8_MMA(0, 0, At, B0); PG8_BAR; PG8_SCHED;
            PG8_LDB(B1, 0, 1); PG8_STAGE(PG8_SB(0, 0), b2, voffB);
            PG8_BAR; PG8_WAIT_L(0); PG8_MMA(0, 1, At, B1); PG8_BAR;
            PG8_LDA(At, 0, 1); PG8_STAGE(PG8_SA(0, 0), a2, voffA);
            PG8_BAR; PG8_WAIT_L(0); PG8_MMA(1, 0, At, B0); PG8_BAR; PG8_SCHED;
            PG8_STAGE(PG8_SB(0, 1), b2 + hstep, voffB);
            PG8_WAIT_V(6); PG8_BAR; PG8_MMA(1, 1, At, B1); PG8_BAR;
            PG8_LDB(B0, 1, 0); PG8_SCHED; PG8_LDA(At, 1, 0); PG8_STAGE(PG8_SA(0, 1), a2 + hstep, voffA);
            PG8_WAIT_L(8); PG8_BAR; PG8_WAIT_L(0); PG8_MMA(0, 0, At, B0); PG8_BAR; PG8_SCHED;
            PG8_LDB(B1, 1, 1); PG8_STAGE(PG8_SB(1, 0), b3, voffB);
            PG8_BAR; PG8_WAIT_L(0); PG8_MMA(0, 1, At, B1); PG8_BAR;
            PG8_LDA(At, 1, 1); PG8_STAGE(PG8_SA(1, 0), a3, voffA);
            PG8_BAR; PG8_WAIT_L(0); PG8_MMA(1, 0, At, B0); PG8_BAR; PG8_SCHED;
            PG8_STAGE(PG8_SB(1, 1), b3 + hstep, voffB);
            PG8_WAIT_V(6); PG8_BAR; PG8_MMA(1, 1, At, B1); PG8_BAR;
            }
        }
        if constexpr (ALIGN_EPI) { if (wr == 0) PG8_BAR; }
        if constexpr (!Epi::AFTER_DRAIN) { if (cur.mode == 1) SK.dump(acc, cur, wid, lane); else if (SKT::NP > 0 && cur.mode == 2) { PartialReader PR = SK.reader(cur, wid, lane); E.template run<SKT::NP>(acc, cur, wr, wc, fr, fq, PR); } else { PartialReader PR; PR.p = nullptr; E.template run<0>(acc, cur, wr, wc, fr, fq, PR); } S.done(cur); }
        if (!has_next) break;
#pragma unroll
        for (int a = 0; a < 2; ++a)
#pragma unroll
            for (int b = 0; b < 2; ++b)
#pragma unroll
                for (int m = 0; m < 4; ++m)
#pragma unroll
                    for (int n = 0; n < 2; ++n) acc[a][b][m][n] = (f32x4){0.f, 0.f, 0.f, 0.f};
        cur = nxt; cA = nA; cB = nB; ++ui;
        if constexpr (ALIGN_EPI) { if (wr == 1) PG8_BAR; }
    }
    PG8_WAIT_V(0);
    if constexpr (!ALIGN_EPI) { if (wr == 0) PG8_BAR; }
    PG8_BAR;
    if constexpr (Epi::AFTER_DRAIN) { E.fused(acc, cur, wr, wc, fr, fq, lds, wid, lane); S.done(cur); }
#undef PG8_SA
#undef PG8_SB
#undef PG8_STAGE
#undef PG8_LDA
#undef PG8_LDB
#undef PG8_MMA
#undef PG8_WAIT_V
#undef PG8_WAIT_L
#undef PG8_BAR
#undef PG8_SCHED
}
}


constexpr int NWAVES = 8, NTHREADS = 512;
constexpr int DM = 2048, SEQ = 4096, NBP = 2, NROWP = 8192, NBS = 8, NSS = 16, NROWS = 128, NROW = 8320, MPAD = 8448, INDIM = 4864, DEPTH = 4;
constexpr int ZP = INDIM;
constexpr int ZC_U = 0, ZC_GA = 1024, ZC_Q = 1536, ZC_K = 2560, ZC_V = 2688, ZC_GB = 2816, ZC_CQ = 3840, ZC_GC = 4352;
constexpr float LOG2E = 1.4426950408889634f;
using pg8::OFF_YP; using pg8::OFF_YS; using pg8::OFF_KP; using pg8::OFF_VP; using pg8::OFF_CP; using pg8::OFF_MKP; using pg8::OFF_MVP; using pg8::OFF_KS; using pg8::OFF_VS; using pg8::OFF_CS; using pg8::OUT_TOTAL;

constexpr size_t MiB = 1u << 20;
constexpr size_t WS_CTL = 0, CTL_ZERO_BYTES = 1 * MiB;
constexpr size_t WS_BT = 1 * MiB;
constexpr size_t WS_SSQ = 2 * MiB;
constexpr size_t WS_WIN = 4 * MiB;
constexpr size_t WS_WOUT = 80 * MiB;
constexpr size_t WS_WMEM = 112 * MiB;
constexpr size_t WS_WPW = 128 * MiB;
constexpr size_t WS_MEMN = 130 * MiB;
constexpr size_t WS_MKVP = 132 * MiB;
constexpr size_t WS_CMK = 136 * MiB, WS_CMV = 144 * MiB;
constexpr size_t WS_CSK = 152 * MiB, WS_CSV = 153 * MiB;
constexpr size_t WS_XB = 154 * MiB;
constexpr size_t WS_X = 187 * MiB;
constexpr size_t WS_Z = 253 * MiB;
constexpr size_t WS_YMIX = 332 * MiB;
constexpr size_t WS_DUMP = 365 * MiB;
constexpr size_t WS_END = 429 * MiB;
constexpr int CW_BAR = 4096, CW_SK = 65536;

constexpr int RING_BYTES = 131072;
constexpr int LDSCTL_OFF = 158720, MISC_OFF = LDSCTL_OFF + 320;
constexpr int LDS_BYTES = 159744;


#define GAS __attribute__((address_space(1)))
#define LAS __attribute__((address_space(3)))
typedef unsigned short bf16;
typedef unsigned v4u __attribute__((ext_vector_type(4)));
typedef float f32x4 __attribute__((ext_vector_type(4)));
typedef short bf16x8 __attribute__((ext_vector_type(8)));
typedef GAS unsigned gu32;
typedef GAS unsigned long long gu64;
#define RLX_AGENT __ATOMIC_RELAXED, __HIP_MEMORY_SCOPE_AGENT
#define LDS_WAIT() asm volatile("s_waitcnt lgkmcnt(0)" ::: "memory")
#define VM_WAIT() asm volatile("s_waitcnt vmcnt(0)" ::: "memory")
__device__ __forceinline__ unsigned long long rt() { return __builtin_amdgcn_s_memrealtime(); }
__device__ __forceinline__ unsigned f2bf(float f) { unsigned u = __builtin_bit_cast(unsigned, f); return (u + 0x7fffu + ((u >> 16) & 1u)) >> 16; }
__device__ __forceinline__ unsigned pk2(float lo, float hi) { return f2bf(lo) | (f2bf(hi) << 16); }

#define XB_TMO      128
#define XB_XCNT(j)  (256  + 64 * (j))
#define XB_XSUB(j)  (1280 + 64 * (j))
#define XB_XGEN(j)  (2304 + 64 * (j))
#define XB_TOP      3328
#define XB_TOPGEN   3392
#define XCD_BAR_WORDS 3456
#define XB_SPIN_CAP (1u << 18)

__device__ __forceinline__ unsigned xb_ld(unsigned* p)              { return __hip_atomic_load(p, __ATOMIC_RELAXED, __HIP_MEMORY_SCOPE_AGENT); }
__device__ __forceinline__ unsigned xb_add(unsigned* p, unsigned v) { return __hip_atomic_fetch_add(p, v, __ATOMIC_RELAXED, __HIP_MEMORY_SCOPE_AGENT); }
__device__ __forceinline__ unsigned xb_xcc_id() { return (unsigned)__builtin_amdgcn_s_getreg((3 << 11) | 20) & 0xFu; }
#define XB_SPIN(cond, bar) do { unsigned _sp = 0; while (cond) { __builtin_amdgcn_s_sleep(1); \
    if ((++_sp & 255u) == 0u) { if (xb_ld(&(bar)[XB_TMO])) break; if (_sp > XB_SPIN_CAP) { atomicAdd(&(bar)[XB_TMO], 1u); break; } } } } while (0)

struct XcdBarrier {
    unsigned* bar; unsigned x;
    volatile LAS unsigned* st;
};

__device__ __forceinline__ XcdBarrier xcd_barrier_post(unsigned* bar, volatile LAS unsigned* st) {
    XcdBarrier b; b.bar = bar; b.x = xb_xcc_id(); b.st = st;
    if (threadIdx.x == 0) (void)xb_add(&bar[XB_XCNT(b.x)], 1u);
    return b;
}
__device__ __forceinline__ void xcd_barrier_complete(unsigned* bar, unsigned x, unsigned& nloc, unsigned& nx) {
    const unsigned G = gridDim.x * gridDim.y * gridDim.z;
    unsigned sum, cnt, mine, sp = 0u;
    for (;;) {
        sum = 0u; cnt = 0u; mine = 0u;
#pragma unroll
        for (unsigned j = 0; j < 16; ++j) { const unsigned c = xb_ld(&bar[XB_XCNT(j)]); sum += c; cnt += (c > 0u) ? 1u : 0u; mine = (j == x) ? c : mine; }
        if (sum == G) break;
        __builtin_amdgcn_s_sleep(1);
        if ((++sp & 255u) == 0u) { if (xb_ld(&bar[XB_TMO])) break; if (sp > XB_SPIN_CAP) { atomicAdd(&bar[XB_TMO], 1u); break; } }
    }
    nloc = mine > 0u ? mine : 1u; nx = cnt > 0u ? cnt : 1u;
}

__device__ __forceinline__ void xcd_barrier(const XcdBarrier& b) {
    asm volatile("s_waitcnt vmcnt(0)" ::: "memory");
    __syncthreads();
    int xb_tid = threadIdx.x; asm volatile("" : "+v"(xb_tid));
    if (xb_tid == 0) {
        unsigned* bar = b.bar;
        __builtin_amdgcn_s_waitcnt(0);
        unsigned nloc = b.st[0], nx = b.st[1];
        if (nloc == 0u) { xcd_barrier_complete(bar, b.x, nloc, nx); b.st[0] = nloc; b.st[1] = nx; }
        const unsigned old = xb_add(&bar[XB_XSUB(b.x)], 1u);
        const unsigned gen = old / nloc;
        if (old + 1u == (gen + 1u) * nloc) {
            __builtin_amdgcn_fence(__ATOMIC_RELEASE, "agent");
            asm volatile("s_waitcnt vmcnt(0)" ::: "memory");
            const unsigned og = xb_add(&bar[XB_TOP], 1u);
            const unsigned tg = og / nx;
            if (og + 1u == (tg + 1u) * nx) xb_add(&bar[XB_TOPGEN], 1u);
            else XB_SPIN(xb_ld(&bar[XB_TOPGEN]) == tg, bar);
            __builtin_amdgcn_fence(__ATOMIC_ACQUIRE, "agent");
            xb_add(&bar[XB_XGEN(b.x)], 1u);
            asm volatile("s_waitcnt vmcnt(0)" ::: "memory");
        } else {
            XB_SPIN(xb_ld(&bar[XB_XGEN(b.x)]) == gen, bar);
            __builtin_amdgcn_fence(__ATOMIC_ACQUIRE, "agent");
            asm volatile("s_waitcnt vmcnt(0)" ::: "memory");
        }
    }
    __syncthreads();
}


struct Args { const float* in[22]; float* out; unsigned char* ws; int ph_lo, ph_hi; int mix_mask, pflags; };
struct Frame {
    LAS unsigned char* lds; unsigned char* glds;
    volatile LAS unsigned* MISC;
    gu32* ctl;
    int tid, lane, wave, vcu, G;
};
__device__ __forceinline__ float wave_sum(float v) {
#pragma unroll
    for (int o = 1; o < 64; o <<= 1) v += __shfl_xor(v, o);
    return v;
}
__device__ __forceinline__ float wave_max(float v) {
#pragma unroll
    for (int o = 1; o < 64; o <<= 1) v = fmaxf(v, __shfl_xor(v, o));
    return v;
}
__device__ __forceinline__ int opaque_tid() { int t = threadIdx.x; asm volatile("" : "+v"(t)); return t; }
__device__ __forceinline__ float bf2f(bf16 v) { return __builtin_bit_cast(float, (unsigned)v << 16); }
__device__ __forceinline__ float rbf(float f) { return __builtin_bit_cast(float, f2bf(f) << 16); }

__device__ __forceinline__ void p0_transpose_item(const float* W, int K, int N, const float* g, bf16* WT, int k0, int n0, int dst_row0, LAS float* scr, int lane) {
    const int kq = lane >> 4, n4 = (lane & 15) * 4;
    f32x4 v[16];
#pragma unroll
    for (int i = 0; i < 16; ++i) v[i] = *(const GAS f32x4*)(W + (size_t)(k0 + 4 * i + kq) * N + n0 + n4);
    if (g) {
#pragma unroll
        for (int i = 0; i < 16; ++i) v[i] = v[i] * g[k0 + 4 * i + kq];
    }
#pragma unroll
    for (int i = 0; i < 16; ++i) { LAS float* d = scr + (4 * i + kq) * 65 + n4; d[0] = v[i].x; d[1] = v[i].y; d[2] = v[i].z; d[3] = v[i].w; }
    LDS_WAIT(); asm volatile("" ::: "memory");
    const int c = lane & 7;
#pragma unroll
    for (int s8 = 0; s8 < 8; ++s8) { const int n = 8 * s8 + (lane >> 3); const LAS float* s = scr + (8 * c) * 65 + n;
        v4u o; o.x = pk2(s[0 * 65], s[1 * 65]); o.y = pk2(s[2 * 65], s[3 * 65]); o.z = pk2(s[4 * 65], s[5 * 65]); o.w = pk2(s[6 * 65], s[7 * 65]);
        *(GAS v4u*)(WT + (size_t)(dst_row0 + n) * K + k0 + 8 * c) = o; }
    LDS_WAIT(); asm volatile("" ::: "memory");
}
__device__ __forceinline__ int t5_bucket(int rel) {
    const int side = rel > 0 ? 16 : 0, n = rel < 0 ? -rel : rel;
    const int large = 8 + (n >= 12) + (n >= 16) + (n >= 23) + (n >= 32) + (n >= 46) + (n >= 64) + (n >= 91);
    return side + (n < 8 ? n : large);
}
__device__ __forceinline__ void p0_prologue(Frame& F, const Args& A) {
    unsigned char* ws = A.ws;
    const int tid_ = opaque_tid(), lane = tid_ & 63, wave_ = __builtin_amdgcn_readfirstlane(tid_ >> 6);
    const int gw = F.vcu * NWAVES + wave_, NGW = F.G * NWAVES;
    LAS float* scr = (LAS float*)(F.lds + wave_ * 17408);
    constexpr int I_IN = 32 * 76, I_OUT = 32 * 32, I_MEM = 32 * 16, I_PW = 8 * 8;
    constexpr int NITEMS = DEPTH * (I_IN + I_OUT + I_MEM + I_PW);
#pragma unroll 1
    for (int it = gw; it < NITEMS; it += NGW) {
        int r = it;
        if (r < DEPTH * I_IN) { const int l = r / I_IN, q = r % I_IN, kb = q / 76, nb = q % 76, n0 = nb * 64;
            int dst; if (n0 < 512) dst = 256 * (n0 >> 7) + (n0 & 127); else if (n0 < 1024) dst = 256 * ((n0 - 512) >> 7) + 128 + (n0 & 127); else dst = n0;
            p0_transpose_item(A.in[9] + (size_t)l * DM * INDIM, DM, INDIM, A.in[8] + l * DM, (bf16*)(ws + WS_WIN) + (size_t)l * INDIM * DM, kb * 64, n0, dst, scr, lane); continue; }
        r -= DEPTH * I_IN;
        if (r < DEPTH * I_OUT) { const int l = r / I_OUT, q = r % I_OUT, kb = q / 32, nb = q % 32;
            p0_transpose_item(A.in[20] + (size_t)l * DM * DM, DM, DM, nullptr, (bf16*)(ws + WS_WOUT) + (size_t)l * DM * DM, kb * 64, nb * 64, nb * 64, scr, lane); continue; }
        r -= DEPTH * I_OUT;
        if (r < DEPTH * I_MEM) { const int l = r / I_MEM, q = r % I_MEM, kb = q / 16, nb = q % 16;
            p0_transpose_item(A.in[18] + (size_t)l * DM * 1024, DM, 1024, A.in[17] + l * DM, (bf16*)(ws + WS_WMEM) + (size_t)l * 1024 * DM, kb * 64, nb * 64, nb * 64, scr, lane); continue; }
        r -= DEPTH * I_MEM;
        { const int l = r / I_PW, q = r % I_PW, kb = q / 8, nb = q % 8;
            p0_transpose_item(A.in[14] + (size_t)l * 512 * 512, 512, 512, nullptr, (bf16*)(ws + WS_WPW) + (size_t)l * 512 * 512, kb * 64, nb * 64, nb * 64, scr, lane); }
    }
    bf16* XB = (bf16*)(ws + WS_XB); float* SSQ = (float*)(ws + WS_SSQ);
    for (int m = gw; m < MPAD; m += NGW) {
        GAS unsigned long long* o8 = (GAS unsigned long long*)(XB + (size_t)m * DM) + lane;
        if (m >= NROW) {
#pragma unroll
            for (int j = 0; j < 8; ++j) o8[64 * j] = 0ull;
            continue;
        }
        const float* src = (m < NROWP) ? A.in[0] + (size_t)m * DM : A.in[1] + (size_t)(m - NROWP) * DM;
        const GAS f32x4* xr = (const GAS f32x4*)src + lane;
        float s = 0.f;
#pragma unroll
        for (int j = 0; j < 8; ++j) { const f32x4 v = xr[64 * j]; s += (v.x * v.x + v.y * v.y) + (v.z * v.z + v.w * v.w);
            o8[64 * j] = (unsigned long long)pk2(v.x, v.y) | ((unsigned long long)pk2(v.z, v.w) << 32); }
        s = wave_sum(s);
        if (lane < 32) SSQ[(size_t)m * 32 + lane] = (lane == 0) ? s : 0.f;
    }
    for (int m = gw; m < 512; m += NGW) {
        const GAS f32x4* xr = (const GAS f32x4*)(A.in[2] + (size_t)m * DM) + lane;
        f32x4 v[8]; float s = 0.f;
#pragma unroll
        for (int j = 0; j < 8; ++j) { v[j] = xr[64 * j]; s += (v[j].x * v[j].x + v[j].y * v[j].y) + (v[j].z * v[j].z + v[j].w * v[j].w); }
        const float rstd = 1.0f / sqrtf(wave_sum(s) * (1.0f / DM) + 1e-6f);
        GAS unsigned long long* o8 = (GAS unsigned long long*)((bf16*)(ws + WS_MEMN) + (size_t)m * DM) + lane;
#pragma unroll
        for (int j = 0; j < 8; ++j) o8[64 * j] = (unsigned long long)pk2(v[j].x * rstd, v[j].y * rstd) | ((unsigned long long)pk2(v[j].z * rstd, v[j].w * rstd) << 32);
    }
    const int gt = gw * 64 + lane, NGT = NGW * 64;
    {
        const f32x4* sk = (const f32x4*)A.in[6]; const f32x4* sv = (const f32x4*)A.in[7];
        unsigned long long* dk = (unsigned long long*)(ws + WS_CMK); unsigned long long* dv = (unsigned long long*)(ws + WS_CMV);
        for (int i = gt; i < 1048576; i += NGT) { const f32x4 a = sk[i], b = sv[i];
            dk[i] = (unsigned long long)pk2(a.x, a.y) | ((unsigned long long)pk2(a.z, a.w) << 32);
            dv[i] = (unsigned long long)pk2(b.x, b.y) | ((unsigned long long)pk2(b.z, b.w) << 32); }
        const f32x4* ck = (const f32x4*)A.in[3]; const f32x4* cv = (const f32x4*)A.in[4];
        unsigned long long* ek = (unsigned long long*)(ws + WS_CSK); unsigned long long* ev = (unsigned long long*)(ws + WS_CSV);
        for (int i = gt; i < 131072; i += NGT) { const f32x4 a = ck[i], b = cv[i];
            ek[i] = (unsigned long long)pk2(a.x, a.y) | ((unsigned long long)pk2(a.z, a.w) << 32);
            ev[i] = (unsigned long long)pk2(b.x, b.y) | ((unsigned long long)pk2(b.z, b.w) << 32);
            const int lb = i >> 12, rem = i & 4095, row = rem >> 5, c4 = rem & 31;
            if (row >= 16) { const size_t o = ((size_t)lb * 128 + (row - 16)) * 128 + c4 * 4;
                *(f32x4*)(A.out + OFF_KS + o) = a; *(f32x4*)(A.out + OFF_VS + o) = b; } }
        const f32x4* cc = (const f32x4*)A.in[5];
        for (int i = gt; i < 32 * 30 * 128; i += NGT) { const int lb = i / 3840, rem = i % 3840, row = rem >> 7, c4 = rem & 127;
            if (row >= 16) *(f32x4*)(A.out + OFF_CS + ((size_t)lb * 30 + (row - 16)) * 512 + c4 * 4) = cc[i]; }
        float* BT = (float*)(ws + WS_BT);
        for (int i = gt; i < 16 * 256; i += NGT) { const int h = i >> 8, idx = i & 255; const int rel = idx - 191;
            BT[i] = (idx < 255) ? A.in[19][t5_bucket(rel) * 16 + h] * LOG2E : 0.f; }
    }
}

struct KSrc { const bf16* p0; int pitch0; int n0; const bf16* p1; int pitch1; };
__device__ __forceinline__ const bf16* ks_row(const KSrc& s, int j) { return j < s.n0 ? s.p0 + (long)j * s.pitch0 : s.p1 + (long)(j - s.n0) * s.pitch1; }

template <int HD, bool SWA>
__device__ __forceinline__ void naive_attn(float* S, float* INV, const bf16* Q, int qpitch, int nq, KSrc ks, KSrc vs, int jlo, int nk,
                                           const float* btab, float sink2, const bf16* gate, int gpitch, bf16* out, int opitch) {
    const int tid = opaque_tid(), lane = tid & 63, wave = tid >> 6;
#pragma unroll 1
    for (int idx = tid; idx < nq * nk; idx += NTHREADS) {
        const int i = idx / nk, j = idx - i * nk;
        float s;
        if (j < jlo) s = -1e30f;
        else {
            const bf16* q = Q + (long)i * qpitch; const bf16* k = ks_row(ks, j);
            float a = 0.f;
#pragma unroll 2
            for (int d = 0; d < HD; d += 8) {
                const v4u qv = *(const v4u*)(q + d), kv = *(const v4u*)(k + d);
                a += __builtin_bit_cast(float, qv.x << 16) * __builtin_bit_cast(float, kv.x << 16) + __builtin_bit_cast(float, qv.x & 0xffff0000u) * __builtin_bit_cast(float, kv.x & 0xffff0000u);
                a += __builtin_bit_cast(float, qv.y << 16) * __builtin_bit_cast(float, kv.y << 16) + __builtin_bit_cast(float, qv.y & 0xffff0000u) * __builtin_bit_cast(float, kv.y & 0xffff0000u);
                a += __builtin_bit_cast(float, qv.z << 16) * __builtin_bit_cast(float, kv.z << 16) + __builtin_bit_cast(float, qv.z & 0xffff0000u) * __builtin_bit_cast(float, kv.z & 0xffff0000u);
                a += __builtin_bit_cast(float, qv.w << 16) * __builtin_bit_cast(float, kv.w << 16) + __builtin_bit_cast(float, qv.w & 0xffff0000u) * __builtin_bit_cast(float, kv.w & 0xffff0000u);
            }
            s = a; if (SWA) s += btab[j - i + 63];
        }
        S[i * 257 + j] = s;
    }
    __syncthreads();
    for (int i = wave; i < nq; i += NWAVES) {
        float m = SWA ? sink2 : -3.0e38f;
        for (int j = lane; j < nk; j += 64) m = fmaxf(m, S[i * 257 + j]);
        m = wave_max(m);
        float sum = 0.f;
        for (int j = lane; j < nk; j += 64) { const float p = exp2f(S[i * 257 + j] - m); sum += p; S[i * 257 + j] = rbf(p); }
        sum = wave_sum(sum);
        if (SWA) sum += exp2f(sink2 - m);
        if (lane == 0) INV[i] = 1.0f / sum;
    }
    __syncthreads();
#pragma unroll 1
    for (int idx = tid; idx < nq * HD; idx += NTHREADS) {
        const int i = idx / HD, d = idx % HD;
        float o = 0.f;
#pragma unroll 4
        for (int j = jlo; j < nk; ++j) o += S[i * 257 + j] * bf2f(ks_row(vs, j)[d]);
        o *= INV[i];
        o *= bf2f(gate[(long)i * gpitch + d]);
        out[(long)i * opitch + d] = (bf16)f2bf(o);
    }
    __syncthreads();
}

__device__ __forceinline__ void naive_conv(float* C, const bf16* Useq, int t0, int nfr, const float* left, const float* cw, const float* cb, const float* lng, const float* lnb,
                                           const float* wpw  , const float* bpw, const bf16* gate  , bf16* out  ) {
    const int tid = opaque_tid(), lane = tid & 63, wave = tid >> 6;
    {
        const int ch = tid;
        float w[31];
#pragma unroll
        for (int j = 0; j < 31; ++j) w[j] = cw[j * 512 + ch];
        const float b = cb[ch];
#pragma unroll 1
        for (int tt = 0; tt < 64; ++tt) {
            float a = 0.f;
            if (tt < nfr) {
                a = b;
#pragma unroll
                for (int j = 0; j < 31; ++j) { const int e = t0 + tt - 30 + j;
                    const float uv = (e >= 0) ? bf2f(Useq[(long)e * ZP + ch]) : (left ? left[(30 + e) * 512 + ch] : 0.f);
                    a += w[j] * uv; }
            }
            C[tt * 516 + ch] = a;
        }
    }
    __syncthreads();
    for (int tt = wave; tt < 64; tt += NWAVES) {
        float v[8]; float s = 0.f;
#pragma unroll
        for (int j = 0; j < 8; ++j) { v[j] = C[tt * 516 + lane + 64 * j]; s += v[j]; }
        const float mu = wave_sum(s) * (1.0f / 512.0f); float q = 0.f;
#pragma unroll
        for (int j = 0; j < 8; ++j) { v[j] -= mu; q += v[j] * v[j]; }
        const float rstd = 1.0f / sqrtf(wave_sum(q) * (1.0f / 512.0f) + 1e-6f);
#pragma unroll
        for (int j = 0; j < 8; ++j) { const int ch = lane + 64 * j; const float y = v[j] * rstd * lng[ch] + lnb[ch]; C[tt * 516 + ch] = rbf(y / (1.0f + __expf(-y))); }
    }
    __syncthreads();
    {
        const int n = tid;
        const float bb = bpw[n];
#pragma unroll 1
        for (int tg = 0; tg < 64; tg += 16) {
            if (tg >= nfr) break;
            float acc[16];
#pragma unroll
            for (int tt = 0; tt < 16; ++tt) acc[tt] = 0.f;
#pragma unroll 1
            for (int k = 0; k < 512; k += 4) {
                const float w0 = rbf(wpw[(size_t)(k + 0) * 512 + n]), w1 = rbf(wpw[(size_t)(k + 1) * 512 + n]), w2 = rbf(wpw[(size_t)(k + 2) * 512 + n]), w3 = rbf(wpw[(size_t)(k + 3) * 512 + n]);
#pragma unroll
                for (int tt = 0; tt < 16; ++tt) { const f32x4 c = *(const f32x4*)(C + (tg + tt) * 516 + k); acc[tt] += (c.x * w0 + c.y * w1) + (c.z * w2 + c.w * w3); }
            }
#pragma unroll
            for (int tt = 0; tt < 16; ++tt) if (tg + tt < nfr) out[(long)(tg + tt) * DM + n] = (bf16)f2bf((acc[tt] + bb) * bf2f(gate[(long)(tg + tt) * ZP + n]));
        }
    }
    __syncthreads();
}

__device__ __forceinline__ void naive_mixer_phase(Frame& F, const Args& A, int l) {
    unsigned char* ws = A.ws;
    float* S = (float*)F.glds;
    float* INV = S + 64 * 257;
    const bf16* Z = (const bf16*)(ws + WS_Z); bf16* Y = (bf16*)(ws + WS_YMIX);
    const float* BT = (const float*)(ws + WS_BT);
    constexpr int U0 = 128, U1 = U0 + 8, U2 = U1 + 512, U3 = U2 + 32, U4 = U3 + 2048, U5 = U4 + 128;
    for (int u = blockIdx.x; u < U5; u += F.G) {
        if (!((A.mix_mask >> (u < U1 ? 0 : (u < U3 ? 1 : 2))) & 1)) continue;
        if (u < U1) {
            int rowbase, t0, nfr; const float* left = nullptr;
            if (u < U0) { const int b = u >> 6, c = u & 63; rowbase = b * SEQ; t0 = c * 64; nfr = 64; }
            else { const int b = u - U0; rowbase = NROWP + b * NSS; t0 = 0; nfr = NSS; left = A.in[5] + (size_t)(l * 8 + b) * 30 * 512; }
            naive_conv(S, Z + (size_t)rowbase * ZP + ZC_U, t0, nfr, left, A.in[10] + l * 31 * 512, A.in[11] + l * 512, A.in[12] + l * 512, A.in[13] + l * 512,
                       A.in[14] + (size_t)l * 512 * 512, A.in[15] + l * 512, Z + (size_t)(rowbase + t0) * ZP + ZC_GA, Y + (size_t)(rowbase + t0) * DM);
        } else if (u < U3) {
            int row0, nq, h; KSrc ks, vs;
            if (u < U2) { const int v = u - U1, b = v >> 8, h_ = (v >> 6) & 3, qt = v & 63; h = h_; row0 = b * SEQ + qt * 64; nq = 64;
                const bf16* kb = (const bf16*)(ws + WS_MKVP) + (size_t)(b * 256) * 4096 + l * 1024 + h * 128;
                ks = KSrc{kb, 4096, 256, kb, 4096}; vs = KSrc{kb + 512, 4096, 256, kb + 512, 4096}; }
            else { const int v = u - U2, b = v >> 2; h = v & 3; row0 = NROWP + b * NSS; nq = NSS;
                const bf16* kb = (const bf16*)(ws + WS_CMK) + (size_t)((l * 8 + b) * 256) * 512 + h * 128; const bf16* vb = (const bf16*)(ws + WS_CMV) + (size_t)((l * 8 + b) * 256) * 512 + h * 128;
                ks = KSrc{kb, 512, 256, kb, 512}; vs = KSrc{vb, 512, 256, vb, 512}; }
            naive_attn<128, false>(S, INV, Z + (size_t)row0 * ZP + ZC_CQ + h * 128, ZP, nq, ks, vs, 0, 256, nullptr, 0.f,
                                   Z + (size_t)row0 * ZP + ZC_GC + h * 128, ZP, Y + (size_t)row0 * DM + 1536 + h * 128, DM);
        } else {
            int row0, nq, h, jlo, nk; KSrc ks, vs;
            if (u < U4) { const int v = u - U3, b = v >> 10, c = (v >> 4) & 63; h = v & 15; row0 = b * SEQ + c * 64; nq = 64; const int kv = h >> 3;
                const bf16* kb = Z + ((long)row0 - 128) * ZP + ZC_K + kv * 64;
                ks = KSrc{kb, ZP, 192, kb, ZP}; vs = KSrc{kb + (ZC_V - ZC_K), ZP, 192, kb + (ZC_V - ZC_K), ZP}; jlo = (c >= 2) ? 0 : 128 - 64 * c; nk = 192; }
            else { const int v = u - U4, b = v >> 4; h = v & 15; row0 = NROWP + b * NSS; nq = NSS; const int kv = h >> 3;
                const bf16* ck = (const bf16*)(ws + WS_CSK) + (size_t)((l * 8 + b) * 128) * 128 + kv * 64; const bf16* cv = (const bf16*)(ws + WS_CSV) + (size_t)((l * 8 + b) * 128) * 128 + kv * 64;
                const bf16* zk = Z + (size_t)row0 * ZP + ZC_K + kv * 64;
                ks = KSrc{ck, 128, 128, zk, ZP}; vs = KSrc{cv, 128, 128, zk + (ZC_V - ZC_K), ZP}; jlo = 0; nk = 144; }
            naive_attn<64, true>(S, INV, Z + (size_t)row0 * ZP + ZC_Q + h * 64, ZP, nq, ks, vs, jlo, nk, BT + h * 256, A.in[16][l * 16 + h] * LOG2E,
                                 Z + (size_t)row0 * ZP + ZC_GB + h * 64, ZP, Y + (size_t)row0 * DM + 512 + h * 64, DM);
        }
    }
}

typedef float f32x16 __attribute__((ext_vector_type(16)));
typedef short s16x4 __attribute__((ext_vector_type(4)));
__device__ __forceinline__ bf16x8 pack_bf16x8(float a0, float a1, float a2, float a3, float a4, float a5, float a6, float a7) {
    v4u w; w.x = pg8::cvt_pk_bf16(a0, a1); w.y = pg8::cvt_pk_bf16(a2, a3); w.z = pg8::cvt_pk_bf16(a4, a5); w.w = pg8::cvt_pk_bf16(a6, a7);
    return __builtin_bit_cast(bf16x8, w);
}
__device__ __forceinline__ bf16x8 join4(s16x4 lo, s16x4 hi) { return (bf16x8){lo[0], lo[1], lo[2], lo[3], hi[0], hi[1], hi[2], hi[3]}; }
__device__ __forceinline__ float ex2(float x) { return __builtin_amdgcn_exp2f(x); }

constexpr int SW_KP = 144, SW_VP = 408;
constexpr int SW_KS = 0, SW_VT = 192 * SW_KP, SW_BT = SW_VT + 64 * SW_VP, SW_END = SW_BT + 8 * 256 * 4;
__device__ __forceinline__ int swa_vt_off(int d, int key) { return d * SW_VP + ((((key >> 2) ^ ((d >> 3) & 7))) << 3) + (key & 3) * 2; }
struct SwaUnit { const bf16* q; int nq; KSrc ks, vs; int jlo, nk; const bf16* gate; bf16* out; int kvh; };

__device__ __forceinline__ void swa_unit(LAS unsigned char* L, const SwaUnit& U, const float* BT, const float* sinks) {
    const int tid = opaque_tid(), lane = tid & 63, wave = __builtin_amdgcn_readfirstlane(tid >> 6);
    typedef unsigned u32x2v __attribute__((ext_vector_type(2)));
    const int i32 = lane & 31, hf = lane >> 5, g = wave;
    v4u kreg[3], va[2], vb[2]; float btv[4]; bf16x8 qf[2][4]; u32x2v gv[2][2][4];
#pragma unroll
    for (int it = 0; it < 3; ++it) {
        const int t = tid + NTHREADS * it, row = t >> 3, c8 = t & 7;
        kreg[it] = (v4u){0u, 0u, 0u, 0u};
        if (row >= U.jlo && row < U.nk) kreg[it] = *(const v4u*)(ks_row(U.ks, row) + c8 * 8);
    }
#pragma unroll
    for (int it = 0; it < 2; ++it) {
        const int t = tid + NTHREADS * it, rp = t >> 3, c8 = t & 7, j0 = 2 * rp;
        va[it] = (v4u){0u, 0u, 0u, 0u}; vb[it] = (v4u){0u, 0u, 0u, 0u};
        if (t < 768) {
            if (j0 >= U.jlo && j0 < U.nk) va[it] = *(const v4u*)(ks_row(U.vs, j0) + c8 * 8);
            if (j0 + 1 >= U.jlo && j0 + 1 < U.nk) vb[it] = *(const v4u*)(ks_row(U.vs, j0 + 1) + c8 * 8);
        }
    }
#pragma unroll
    for (int it = 0; it < 4; ++it) btv[it] = BT[U.kvh * 8 * 256 + tid + NTHREADS * it];
#pragma unroll
    for (int qb = 0; qb < 2; ++qb) {
        const int i = qb * 32 + i32, iq = (i < U.nq) ? i : 0;
        const bf16* qrow = U.q + (long)iq * ZP + g * 64;
#pragma unroll
        for (int ds = 0; ds < 4; ++ds) qf[qb][ds] = *(const bf16x8*)(qrow + 16 * ds + 8 * hf);
#pragma unroll
        for (int dt = 0; dt < 2; ++dt)
#pragma unroll
            for (int g4 = 0; g4 < 4; ++g4) gv[qb][dt][g4] = *(const u32x2v*)(U.gate + (long)iq * ZP + g * 64 + dt * 32 + 8 * g4 + 4 * hf);
    }
    const float sink2 = sinks[U.kvh * 8 + g] * LOG2E;
#pragma unroll
    for (int it = 0; it < 3; ++it) { const int t = tid + NTHREADS * it, row = t >> 3, c8 = t & 7; *(LAS v4u*)(L + SW_KS + row * SW_KP + c8 * 16) = kreg[it]; }
#pragma unroll
    for (int it = 0; it < 2; ++it) {
        const int t = tid + NTHREADS * it, rp = t >> 3, c8 = t & 7, j0 = 2 * rp;
        if (t < 768) {
#pragma unroll
            for (int e = 0; e < 8; ++e) {
                const unsigned lo = (va[it][e >> 1] >> (16 * (e & 1))) & 0xffffu, hi = (vb[it][e >> 1] >> (16 * (e & 1))) & 0xffffu;
                *(LAS unsigned*)(L + SW_VT + swa_vt_off(c8 * 8 + e, j0)) = lo | (hi << 16);
            }
        }
    }
#pragma unroll
    for (int it = 0; it < 4; ++it) ((LAS float*)(L + SW_BT))[tid + NTHREADS * it] = btv[it];
    __syncthreads();
    const LAS float* bt = (const LAS float*)(L + SW_BT) + g * 256;
#pragma unroll
    for (int qb = 0; qb < 2; ++qb) {
        if (qb * 32 < U.nq) {
        const int i = qb * 32 + i32;
        f32x16 S[6];
        {
            bf16x8 kf[2][4];
#pragma unroll
            for (int ds = 0; ds < 4; ++ds) kf[0][ds] = *(const LAS bf16x8*)(L + SW_KS + (0 * 32 + i32) * SW_KP + ds * 32 + hf * 16);
#pragma unroll
            for (int kt = 0; kt < 6; ++kt) {
                if (kt + 1 < 6) {
#pragma unroll
                    for (int ds = 0; ds < 4; ++ds) kf[(kt + 1) & 1][ds] = *(const LAS bf16x8*)(L + SW_KS + ((kt + 1) * 32 + i32) * SW_KP + ds * 32 + hf * 16);
                }
                f32x16 acc = {};
#pragma unroll
                for (int ds = 0; ds < 4; ++ds) acc = __builtin_amdgcn_mfma_f32_32x32x16_bf16(kf[kt & 1][ds], qf[qb][ds], acc, 0, 0, 0);
                S[kt] = acc;
            }
        }
        float m = sink2;
#pragma unroll
        for (int kt = 0; kt < 6; ++kt)
#pragma unroll
            for (int r = 0; r < 16; ++r) {
                const int j = kt * 32 + (r & 3) + 8 * (r >> 2) + 4 * hf;
                float s = S[kt][r] + bt[j - i + 63];
                if (j < U.jlo || j >= U.nk) s = -1e30f;
                S[kt][r] = s; m = fmaxf(m, s);
            }
        m = fmaxf(m, __shfl_xor(m, 32));
        float lsum = 0.f;
#pragma unroll
        for (int kt = 0; kt < 6; ++kt)
#pragma unroll
            for (int r = 0; r < 16; ++r) { const float p = ex2(S[kt][r] - m); S[kt][r] = p; lsum += p; }
        lsum += __shfl_xor(lsum, 32);
        const float inv = 1.0f / (lsum + ex2(sink2 - m));
        f32x16 O[2]; O[0] = (f32x16){}; O[1] = (f32x16){};
        {
            s16x4 vq[2][2][2][2];
#pragma unroll
            for (int s2 = 0; s2 < 2; ++s2)
#pragma unroll
                for (int dt = 0; dt < 2; ++dt) { const int d = dt * 32 + i32, key0 = 16 * s2 + 4 * hf;
                    vq[0][s2][dt][0] = *(const LAS s16x4*)(L + SW_VT + swa_vt_off(d, key0)); vq[0][s2][dt][1] = *(const LAS s16x4*)(L + SW_VT + swa_vt_off(d, key0 + 8)); }
#pragma unroll
            for (int kt = 0; kt < 6; ++kt) {
                if (kt + 1 < 6) {
#pragma unroll
                    for (int s2 = 0; s2 < 2; ++s2)
#pragma unroll
                        for (int dt = 0; dt < 2; ++dt) { const int d = dt * 32 + i32, key0 = (kt + 1) * 32 + 16 * s2 + 4 * hf;
                            vq[(kt + 1) & 1][s2][dt][0] = *(const LAS s16x4*)(L + SW_VT + swa_vt_off(d, key0)); vq[(kt + 1) & 1][s2][dt][1] = *(const LAS s16x4*)(L + SW_VT + swa_vt_off(d, key0 + 8)); }
                }
#pragma unroll
                for (int s2 = 0; s2 < 2; ++s2) {
                    const bf16x8 pf = pack_bf16x8(S[kt][8 * s2 + 0], S[kt][8 * s2 + 1], S[kt][8 * s2 + 2], S[kt][8 * s2 + 3], S[kt][8 * s2 + 4], S[kt][8 * s2 + 5], S[kt][8 * s2 + 6], S[kt][8 * s2 + 7]);
#pragma unroll
                    for (int dt = 0; dt < 2; ++dt) O[dt] = __builtin_amdgcn_mfma_f32_32x32x16_bf16(join4(vq[kt & 1][s2][dt][0], vq[kt & 1][s2][dt][1]), pf, O[dt], 0, 0, 0);
                }
            }
        }
        if (i < U.nq) {
#pragma unroll
            for (int dt = 0; dt < 2; ++dt)
#pragma unroll
                for (int g4 = 0; g4 < 4; ++g4) {
                    const int d0 = dt * 32 + 8 * g4 + 4 * hf;
                    const u32x2v gg = gv[qb][dt][g4];
                    const float o0 = O[dt][4 * g4 + 0] * inv * __builtin_bit_cast(float, gg.x << 16), o1 = O[dt][4 * g4 + 1] * inv * __builtin_bit_cast(float, gg.x & 0xffff0000u);
                    const float o2 = O[dt][4 * g4 + 2] * inv * __builtin_bit_cast(float, gg.y << 16), o3 = O[dt][4 * g4 + 3] * inv * __builtin_bit_cast(float, gg.y & 0xffff0000u);
                    u32x2v w; w.x = pg8::cvt_pk_bf16(o0, o1); w.y = pg8::cvt_pk_bf16(o2, o3);
                    *(u32x2v*)(U.out + (long)i * DM + g * 64 + d0) = w;
                }
        }
        }
    }
    __syncthreads();
}

constexpr int MA_KP = 272, MA_VP = 528;
constexpr int MA_KS = 0, MA_VT = 256 * MA_KP, MA_END = MA_VT + 128 * MA_VP;
__device__ __forceinline__ int ma_vt_off(int d, int key) { return d * MA_VP + ((((key >> 2) ^ ((d >> 3) & 15))) << 3) + (key & 3) * 2; }
struct MemUnit { const bf16* q; int nq; const bf16* k; const bf16* v; int pitch; const bf16* gate; bf16* out; };

__device__ __forceinline__ void mem_unit(LAS unsigned char* L, const MemUnit& U) {
    typedef unsigned u32x2v __attribute__((ext_vector_type(2)));
    const int tid = opaque_tid(), lane = tid & 63, wave = __builtin_amdgcn_readfirstlane(tid >> 6);
    const int i16 = lane & 15, q4 = lane >> 4;
    bf16x8 qf[2][4]; u32x2v gv[2][8];
#pragma unroll
    for (int gi = 0; gi < 2; ++gi) {
        const int grp = wave + NWAVES * gi, i = (grp * 16 < U.nq) ? grp * 16 + i16 : i16;
        const bf16* qrow = U.q + (long)i * ZP;
#pragma unroll
        for (int ds = 0; ds < 4; ++ds) qf[gi][ds] = *(const bf16x8*)(qrow + 32 * ds + 8 * q4);
#pragma unroll
        for (int dt = 0; dt < 8; ++dt) gv[gi][dt] = *(const u32x2v*)(U.gate + (long)i * ZP + dt * 16 + 4 * q4);
    }
    {
        v4u kr[8];
#pragma unroll
        for (int it = 0; it < 8; ++it) { const int t = tid + NTHREADS * it, row = t >> 4, c8 = t & 15; kr[it] = *(const v4u*)(U.k + (long)row * U.pitch + c8 * 8); }
#pragma unroll
        for (int it = 0; it < 8; ++it) { const int t = tid + NTHREADS * it, row = t >> 4, c8 = t & 15; *(LAS v4u*)(L + MA_KS + row * MA_KP + c8 * 16) = kr[it]; }
    }
    {
        v4u va[4], vb[4];
#pragma unroll
        for (int it = 0; it < 4; ++it) { const int t = tid + NTHREADS * it, rp = t >> 4, c8 = t & 15, j0 = 2 * rp;
            va[it] = *(const v4u*)(U.v + (long)j0 * U.pitch + c8 * 8); vb[it] = *(const v4u*)(U.v + (long)(j0 + 1) * U.pitch + c8 * 8); }
#pragma unroll
        for (int it = 0; it < 4; ++it) { const int t = tid + NTHREADS * it, rp = t >> 4, c8 = t & 15, j0 = 2 * rp;
#pragma unroll
            for (int e = 0; e < 8; ++e) {
                const unsigned lo = (va[it][e >> 1] >> (16 * (e & 1))) & 0xffffu, hi = (vb[it][e >> 1] >> (16 * (e & 1))) & 0xffffu;
                *(LAS unsigned*)(L + MA_VT + ma_vt_off(c8 * 8 + e, j0)) = lo | (hi << 16);
            } }
    }
    __syncthreads();
#pragma unroll
    for (int gi = 0; gi < 2; ++gi) {
        const int grp = wave + NWAVES * gi;
        if (grp * 16 < U.nq) {
        const int i = grp * 16 + i16;
        f32x4 S[16];
        {
            bf16x8 kf[2][2][4];
#pragma unroll
            for (int t2 = 0; t2 < 2; ++t2)
#pragma unroll
                for (int ds = 0; ds < 4; ++ds) kf[0][t2][ds] = *(const LAS bf16x8*)(L + MA_KS + (t2 * 16 + i16) * MA_KP + ds * 64 + q4 * 16);
#pragma unroll
            for (int kp = 0; kp < 8; ++kp) {
                if (kp + 1 < 8) {
#pragma unroll
                    for (int t2 = 0; t2 < 2; ++t2)
#pragma unroll
                        for (int ds = 0; ds < 4; ++ds) kf[(kp + 1) & 1][t2][ds] = *(const LAS bf16x8*)(L + MA_KS + (((kp + 1) * 2 + t2) * 16 + i16) * MA_KP + ds * 64 + q4 * 16);
                }
#pragma unroll
                for (int t2 = 0; t2 < 2; ++t2) {
                    f32x4 acc = {};
#pragma unroll
                    for (int ds = 0; ds < 4; ++ds) acc = __builtin_amdgcn_mfma_f32_16x16x32_bf16(kf[kp & 1][t2][ds], qf[gi][ds], acc, 0, 0, 0);
                    S[kp * 2 + t2] = acc;
                }
            }
        }
        float m = -3.0e38f;
#pragma unroll
        for (int kt = 0; kt < 16; ++kt) m = fmaxf(fmaxf(m, fmaxf(S[kt][0], S[kt][1])), fmaxf(S[kt][2], S[kt][3]));
        m = fmaxf(m, __shfl_xor(m, 16)); m = fmaxf(m, __shfl_xor(m, 32));
        float lsum = 0.f;
#pragma unroll
        for (int kt = 0; kt < 16; ++kt)
#pragma unroll
            for (int r = 0; r < 4; ++r) { const float p = ex2(S[kt][r] - m); S[kt][r] = p; lsum += p; }
        lsum += __shfl_xor(lsum, 16); lsum += __shfl_xor(lsum, 32);
        const float inv = 1.0f / lsum;
        f32x4 O[8];
#pragma unroll
        for (int dt = 0; dt < 8; ++dt) O[dt] = (f32x4){0.f, 0.f, 0.f, 0.f};
        {
            s16x4 vq[2][8][2];
#pragma unroll
            for (int dt = 0; dt < 8; ++dt) { const int d = dt * 16 + i16, key0 = 4 * q4;
                vq[0][dt][0] = *(const LAS s16x4*)(L + MA_VT + ma_vt_off(d, key0)); vq[0][dt][1] = *(const LAS s16x4*)(L + MA_VT + ma_vt_off(d, key0 + 16)); }
#pragma unroll
            for (int st = 0; st < 8; ++st) {
                if (st + 1 < 8) {
#pragma unroll
                    for (int dt = 0; dt < 8; ++dt) { const int d = dt * 16 + i16, key0 = 32 * (st + 1) + 4 * q4;
                        vq[(st + 1) & 1][dt][0] = *(const LAS s16x4*)(L + MA_VT + ma_vt_off(d, key0)); vq[(st + 1) & 1][dt][1] = *(const LAS s16x4*)(L + MA_VT + ma_vt_off(d, key0 + 16)); }
                }
                const bf16x8 pf = pack_bf16x8(S[2 * st][0], S[2 * st][1], S[2 * st][2], S[2 * st][3], S[2 * st + 1][0], S[2 * st + 1][1], S[2 * st + 1][2], S[2 * st + 1][3]);
#pragma unroll
                for (int dt = 0; dt < 8; ++dt) O[dt] = __builtin_amdgcn_mfma_f32_16x16x32_bf16(join4(vq[st & 1][dt][0], vq[st & 1][dt][1]), pf, O[dt], 0, 0, 0);
            }
        }
#pragma unroll
        for (int dt = 0; dt < 8; ++dt) {
            const int d0 = dt * 16 + 4 * q4;
            const u32x2v gg = gv[gi][dt];
            const float o0 = O[dt][0] * inv * __builtin_bit_cast(float, gg.x << 16), o1 = O[dt][1] * inv * __builtin_bit_cast(float, gg.x & 0xffff0000u);
            const float o2 = O[dt][2] * inv * __builtin_bit_cast(float, gg.y << 16), o3 = O[dt][3] * inv * __builtin_bit_cast(float, gg.y & 0xffff0000u);
            u32x2v w; w.x = pg8::cvt_pk_bf16(o0, o1); w.y = pg8::cvt_pk_bf16(o2, o3);
            *(u32x2v*)(U.out + (long)i * DM + d0) = w;
        }
        }
    }
    __syncthreads();
}

typedef float cv_f32x2 __attribute__((ext_vector_type(2)));
template <int R> __device__ __forceinline__ void conv_rows(cv_f32x2 (&acc)[32], const cv_f32x2 (&w)[31], const unsigned (&raw)[62], bool neg, const float* left, int ch) {
    cv_f32x2 x = (cv_f32x2){__builtin_bit_cast(float, raw[R] << 16), __builtin_bit_cast(float, raw[R] & 0xffff0000u)};
    constexpr int TLO = (R > 30) ? R - 30 : 0, THI = (R < 31) ? R : 31;
#pragma unroll
    for (int tt = TLO; tt <= THI; ++tt) acc[tt] += w[R - tt] * x;
    if constexpr (R + 1 < 62) conv_rows<R + 1>(acc, w, raw, neg, left, ch);
}
constexpr int CV_P = 2064;
__device__ __forceinline__ void conv_unit(LAS unsigned char* L, const bf16* Useq, int t0, int nfr, const float* left, const float* cw, const float* cb, const float* lng, const float* lnb,
                                          const bf16* WpwT, const float* bpw, const bf16* gate, bf16* out) {
    typedef float f32x2 __attribute__((ext_vector_type(2)));
    const int tid = opaque_tid(), lane = tid & 63, wave = __builtin_amdgcn_readfirstlane(tid >> 6);
    {
        const int cp = tid & 255, fh = __builtin_amdgcn_readfirstlane(tid >> 8), ch = 2 * cp;
        f32x2 w[31];
#pragma unroll
        for (int j = 0; j < 31; ++j) w[j] = *(const f32x2*)(cw + j * 512 + ch);
        const f32x2 bias = *(const f32x2*)(cb + ch);
        f32x2 acc[32];
#pragma unroll
        for (int tt = 0; tt < 32; ++tt) acc[tt] = bias;
        const int tbase = t0 + 32 * fh;
        unsigned raw[62];
        if (tbase == 0) {
#pragma unroll
            for (int r = 0; r < 30; ++r) raw[r] = 0u;
            if (left) {
                cv_f32x2 lf[30];
#pragma unroll
                for (int r = 0; r < 30; ++r) lf[r] = *(const cv_f32x2*)(left + r * 512 + ch);
#pragma unroll
                for (int r = 0; r < 30; ++r) raw[r] = pg8::cvt_pk_bf16(lf[r].x, lf[r].y);
            }
#pragma unroll
            for (int r = 30; r < 62; ++r) raw[r] = *(const unsigned*)(Useq + (long)(r - 30) * ZP + ch);
        } else {
#pragma unroll
            for (int r = 0; r < 62; ++r) raw[r] = *(const unsigned*)(Useq + (long)(tbase - 30 + r) * ZP + ch);
        }
        conv_rows<0>(acc, w, raw, false, left, ch);
#pragma unroll
        for (int tt = 0; tt < 32; ++tt) { const int fr_ = 32 * fh + tt; *(LAS f32x2*)(L + fr_ * CV_P + ch * 4) = (fr_ < nfr) ? acc[tt] : (f32x2){0.f, 0.f}; }
    }
    __syncthreads();
    {
        const f32x4 g0 = *(const f32x4*)(lng + 8 * lane), g1 = *(const f32x4*)(lng + 8 * lane + 4), b0 = *(const f32x4*)(lnb + 8 * lane), b1 = *(const f32x4*)(lnb + 8 * lane + 4);
        f32x4 a[8], b[8]; float sm[8];
#pragma unroll
        for (int f = 0; f < 8; ++f) { const LAS unsigned char* row = L + (wave + NWAVES * f) * CV_P; a[f] = *(const LAS f32x4*)(row + 32 * lane); b[f] = *(const LAS f32x4*)(row + 32 * lane + 16);
            sm[f] = ((a[f][0] + a[f][1]) + (a[f][2] + a[f][3])) + ((b[f][0] + b[f][1]) + (b[f][2] + b[f][3])); }
#pragma unroll
        for (int o = 1; o < 64; o <<= 1)
#pragma unroll
            for (int f = 0; f < 8; ++f) sm[f] += __shfl_xor(sm[f], o);
#pragma unroll
        for (int f = 0; f < 8; ++f) { const float mu = sm[f] * (1.0f / 512.0f); a[f] = a[f] - mu; b[f] = b[f] - mu;
            sm[f] = ((a[f][0] * a[f][0] + a[f][1] * a[f][1]) + (a[f][2] * a[f][2] + a[f][3] * a[f][3])) + ((b[f][0] * b[f][0] + b[f][1] * b[f][1]) + (b[f][2] * b[f][2] + b[f][3] * b[f][3])); }
#pragma unroll
        for (int o = 1; o < 64; o <<= 1)
#pragma unroll
            for (int f = 0; f < 8; ++f) sm[f] += __shfl_xor(sm[f], o);
#pragma unroll
        for (int f = 0; f < 8; ++f) { const float rstd = __builtin_amdgcn_rsqf(sm[f] * (1.0f / 512.0f) + 1e-6f);
            f32x4 ya = a[f] * rstd * g0 + b0, yb = b[f] * rstd * g1 + b1;
            ya = ya * pg8::sigmoid4(ya); yb = yb * pg8::sigmoid4(yb);
            *(LAS v4u*)(L + (wave + NWAVES * f) * CV_P + 16 * lane) = __builtin_bit_cast(v4u, pg8::pack8(ya, yb)); }
    }
    __syncthreads();
    {
        typedef unsigned u32x2v __attribute__((ext_vector_type(2)));
        const int i16 = lane & 15, q4 = lane >> 4;
        f32x4 acc[4][4];
#pragma unroll
        for (int rt = 0; rt < 4; ++rt)
#pragma unroll
            for (int nt = 0; nt < 4; ++nt) acc[rt][nt] = (f32x4){0.f, 0.f, 0.f, 0.f};
        const bf16* wbase = WpwT + (size_t)(64 * wave + i16) * 512 + 8 * q4;
        {
            constexpr int WD = 8;
            bf16x8 wf[WD][4], cf[2][4];
#pragma unroll
            for (int k4 = 0; k4 < WD; ++k4)
#pragma unroll
                for (int nt = 0; nt < 4; ++nt) wf[k4][nt] = *(const bf16x8*)(wbase + nt * 16 * 512 + k4 * 32);
            __builtin_amdgcn_sched_barrier(0);
#pragma unroll
            for (int rt = 0; rt < 4; ++rt) cf[0][rt] = *(const LAS bf16x8*)(L + (rt * 16 + i16) * CV_P + q4 * 16);
#pragma unroll
            for (int ks = 0; ks < 16; ++ks) {
                if (ks + 1 < 16) {
#pragma unroll
                    for (int rt = 0; rt < 4; ++rt) cf[(ks + 1) & 1][rt] = *(const LAS bf16x8*)(L + (rt * 16 + i16) * CV_P + (ks + 1) * 64 + q4 * 16);
                }
#pragma unroll
                for (int rt = 0; rt < 4; ++rt)
#pragma unroll
                    for (int nt = 0; nt < 4; ++nt) acc[rt][nt] = __builtin_amdgcn_mfma_f32_16x16x32_bf16(wf[ks % WD][nt], cf[ks & 1][rt], acc[rt][nt], 0, 0, 0);
                if (ks + WD < 16) {
#pragma unroll
                    for (int nt = 0; nt < 4; ++nt) wf[ks % WD][nt] = *(const bf16x8*)(wbase + nt * 16 * 512 + (ks + WD) * 32);
                }
                __builtin_amdgcn_sched_barrier(0);
            }
        }
        f32x4 bb[4]; u32x2v gvv[4][4];
#pragma unroll
        for (int nt = 0; nt < 4; ++nt) bb[nt] = *(const f32x4*)(bpw + 64 * wave + nt * 16 + 4 * q4);
#pragma unroll
        for (int rt = 0; rt < 4; ++rt) { const int frame = rt * 16 + i16, fl = frame < nfr ? frame : 0;
#pragma unroll
            for (int nt = 0; nt < 4; ++nt) gvv[rt][nt] = *(const u32x2v*)(gate + (long)fl * ZP + 64 * wave + nt * 16 + 4 * q4); }
#pragma unroll
        for (int rt = 0; rt < 4; ++rt) {
            const int frame = rt * 16 + i16;
            if (frame < nfr) {
#pragma unroll
                for (int nt = 0; nt < 4; ++nt) {
                    const int n0 = 64 * wave + nt * 16 + 4 * q4;
                    const u32x2v gv = gvv[rt][nt];
                    const float o0 = (acc[rt][nt][0] + bb[nt][0]) * __builtin_bit_cast(float, gv.x << 16), o1 = (acc[rt][nt][1] + bb[nt][1]) * __builtin_bit_cast(float, gv.x & 0xffff0000u);
                    const float o2 = (acc[rt][nt][2] + bb[nt][2]) * __builtin_bit_cast(float, gv.y << 16), o3 = (acc[rt][nt][3] + bb[nt][3]) * __builtin_bit_cast(float, gv.y & 0xffff0000u);
                    u32x2v wv; wv.x = pg8::cvt_pk_bf16(o0, o1); wv.y = pg8::cvt_pk_bf16(o2, o3);
                    *(u32x2v*)(out + (long)frame * DM + n0) = wv;
                }
            }
        }
    }
    __syncthreads();
}

#ifndef USE_MFMA_ATTN
#define USE_MFMA_ATTN 1
#endif
#ifndef USE_MFMA_CONV
#define USE_MFMA_CONV 1
#endif
__device__ __forceinline__ void mixer_phase(Frame& F, const Args& A, int l) {
    unsigned char* ws = A.ws;
    float* S = (float*)F.glds;
    const bf16* Z = (const bf16*)(ws + WS_Z); bf16* Y = (bf16*)(ws + WS_YMIX);
    const float* BT = (const float*)(ws + WS_BT);
    constexpr int U0 = 128, U1 = U0 + 8, U2 = U1 + 128, U3 = U2 + 32, U4 = U3 + 256, U5 = U4 + 16;
    const int bx = blockIdx.x;
#pragma unroll 1
    for (int slot = 0; slot < 3; ++slot) {
        int u;
        if (slot == 0) u = (bx < 128) ? bx : U1 + (bx - 128);
        else if (slot == 1) { if (bx >= 128 && bx < 136) continue; u = U3 + bx; }
        else { const int e = bx - 128;
            if (bx >= 248) u = U3 + (bx - 120);
            else if (e < 0 || e >= 56) break;
            else u = (e < 8) ? U0 + e : (e < 40 ? U2 + (e - 8) : U4 + (e - 40)); }
        if (!((A.mix_mask >> (u < U1 ? 0 : (u < U3 ? 1 : 2))) & 1)) continue;
        if (u < U1) {
            int rowbase, t0, nfr; const float* left = nullptr;
            if (u < U0) { const int b = u >> 6, c = u & 63; rowbase = b * SEQ; t0 = c * 64; nfr = 64; }
            else { const int b = u - U0; rowbase = NROWP + b * NSS; t0 = 0; nfr = NSS; left = A.in[5] + (size_t)(l * 8 + b) * 30 * 512; }
#if USE_MFMA_CONV
            conv_unit(F.lds, Z + (size_t)rowbase * ZP + ZC_U, t0, nfr, left, A.in[10] + l * 31 * 512, A.in[11] + l * 512, A.in[12] + l * 512, A.in[13] + l * 512,
                      (const bf16*)(ws + WS_WPW) + (size_t)l * 512 * 512, A.in[15] + l * 512, Z + (size_t)(rowbase + t0) * ZP + ZC_GA, Y + (size_t)(rowbase + t0) * DM);
#else
            naive_conv(S, Z + (size_t)rowbase * ZP + ZC_U, t0, nfr, left, A.in[10] + l * 31 * 512, A.in[11] + l * 512, A.in[12] + l * 512, A.in[13] + l * 512,
                       A.in[14] + (size_t)l * 512 * 512, A.in[15] + l * 512, Z + (size_t)(rowbase + t0) * ZP + ZC_GA, Y + (size_t)(rowbase + t0) * DM);
#endif
        } else if (u < U3) {
            MemUnit M; int row0, h;
            if (u < U2) { const int v = u - U1, b = v >> 6, qblk = v & 15; h = (v >> 4) & 3; row0 = b * SEQ + qblk * 256; M.nq = 256;
                M.k = (const bf16*)(ws + WS_MKVP) + (size_t)(b * 256) * 4096 + l * 1024 + h * 128; M.v = M.k + 512; M.pitch = 4096; }
            else { const int v = u - U2, b = v >> 2; h = v & 3; row0 = NROWP + b * NSS; M.nq = NSS;
                M.k = (const bf16*)(ws + WS_CMK) + (size_t)((l * 8 + b) * 256) * 512 + h * 128; M.v = (const bf16*)(ws + WS_CMV) + (size_t)((l * 8 + b) * 256) * 512 + h * 128; M.pitch = 512; }
            M.q = Z + (size_t)row0 * ZP + ZC_CQ + h * 128; M.gate = Z + (size_t)row0 * ZP + ZC_GC + h * 128; M.out = Y + (size_t)row0 * DM + 1536 + h * 128;
            mem_unit(F.lds, M);
        } else {
            SwaUnit W; int row0, kv;
            if (u < U4) { const int v = u - U3, b = v >> 7, c = (v >> 1) & 63; kv = v & 1; row0 = b * SEQ + c * 64; W.nq = 64;
                const bf16* kb = Z + ((long)row0 - 128) * ZP + ZC_K + kv * 64;
                W.ks = KSrc{kb, ZP, 192, kb, ZP}; W.vs = KSrc{kb + (ZC_V - ZC_K), ZP, 192, kb + (ZC_V - ZC_K), ZP}; W.jlo = (c >= 2) ? 0 : 128 - 64 * c; W.nk = 192; }
            else { const int v = u - U4, b = v >> 1; kv = v & 1; row0 = NROWP + b * NSS; W.nq = NSS;
                const bf16* ck = (const bf16*)(ws + WS_CSK) + (size_t)((l * 8 + b) * 128) * 128 + kv * 64; const bf16* cv = (const bf16*)(ws + WS_CSV) + (size_t)((l * 8 + b) * 128) * 128 + kv * 64;
                const bf16* zk = Z + (size_t)row0 * ZP + ZC_K + kv * 64;
                W.ks = KSrc{ck, 128, 128, zk, ZP}; W.vs = KSrc{cv, 128, 128, zk + (ZC_V - ZC_K), ZP}; W.jlo = 0; W.nk = 144; }
            W.q = Z + (size_t)row0 * ZP + ZC_Q + kv * 512; W.gate = Z + (size_t)row0 * ZP + ZC_GB + kv * 512; W.out = Y + (size_t)row0 * DM + 512 + kv * 512; W.kvh = kv;
            swa_unit(F.lds, W, BT, A.in[16] + l * 16);
        }
    }
}

__device__ __forceinline__ void final_norm_phase(Frame& F, const Args& A) {
    const float* X = (const float*)(A.ws + WS_X); const float* SSQ = (const float*)(A.ws + WS_SSQ); const float* g = A.in[21];
    const int tid_ = opaque_tid(), lane = tid_ & 63, wave_ = __builtin_amdgcn_readfirstlane(tid_ >> 6);
    const int gw = F.vcu * NWAVES + wave_, NGW = F.G * NWAVES;
    f32x4 gv[8];
#pragma unroll
    for (int j = 0; j < 8; ++j) gv[j] = ((const f32x4*)g)[lane + 64 * j];
    for (int m = gw; m < NROW; m += NGW) {
        float s = (lane < 32) ? SSQ[(size_t)m * 32 + lane] : 0.f;
        s = wave_sum(s);
        const float rstd = 1.0f / sqrtf(s * (1.0f / DM) + 1e-6f);
        const f32x4* xr = (const f32x4*)(X + (size_t)m * DM) + lane;
        f32x4* o = (f32x4*)(A.out + (m < NROWP ? OFF_YP + (size_t)m * DM : OFF_YS + (size_t)(m - NROWP) * DM)) + lane;
#pragma unroll
        for (int j = 0; j < 8; ++j) o[64 * j] = xr[64 * j] * rstd * gv[j];
    }
}

constexpr int N_PHASES = 2 + 3 * DEPTH;
#ifndef MK_SINGLE
#define MK_SINGLE 1
#endif
__global__ void __launch_bounds__(NTHREADS, 2) mk_fwd(Args args) {
    extern __shared__ __attribute__((aligned(16))) unsigned char lds[];
    Frame F;
    F.lds = (LAS unsigned char*)lds; F.glds = lds;
    F.MISC = (volatile LAS unsigned*)(F.lds + MISC_OFF);
    F.tid = threadIdx.x; F.lane = F.tid & 63; F.wave = __builtin_amdgcn_readfirstlane(F.tid >> 6);
    F.G = gridDim.x; { const int bx = blockIdx.x; F.vcu = (F.G % 8 == 0) ? (bx % 8) * (F.G / 8) + bx / 8 : bx; }
    unsigned char* ws = args.ws;
    F.ctl = (gu32*)(ws + WS_CTL);
    for (int u = F.tid; u < (LDS_BYTES - LDSCTL_OFF) / 4; u += NTHREADS) ((LAS unsigned*)(F.lds + LDSCTL_OFF))[u] = 0u;
    __syncthreads();
    XcdBarrier bar; bar.bar = (unsigned*)(F.ctl + CW_BAR); bar.x = 0; bar.st = nullptr;
    const int lo = args.ph_lo, hi = args.ph_hi;
    const bool multi = (hi - lo) > 1;
    if (multi) bar = xcd_barrier_post((unsigned*)(F.ctl + CW_BAR), F.MISC + 8);
#define SEAM(k) do { if (lo <= (k) && (k) + 1 < hi) xcd_barrier(bar); } while (0)
#define IN(k) (lo <= (k) && (k) < hi)
    if (IN(0)) { p0_prologue(F, args); SEAM(0); }
    if (IN(1)) {
        unsigned char* wsl = ws; asm volatile("" : "+s"(wsl));
        pg8::Gemm g{(const pg8::bf16_t*)(wsl + WS_MEMN), (const pg8::bf16_t*)(wsl + WS_WMEM), 512, 4096, DM};
        pg8::StaticOrder S; S.init(512, 4096, F.G, (int)(F.G - 1 - blockIdx.x));
        pg8::EpiMemKV E{(pg8::bf16_t*)(wsl + WS_MKVP), args.out};
        pg8::gemm_phase<pg8::EpiMemKV, pg8::StaticOrder, true, true>(F.lds, g, S, E);
    }
#pragma unroll 1
    for (int l = 0; l < DEPTH; ++l) {
        const int p1 = 1 + 3 * l, p2 = p1 + 1, p3 = p1 + 2;
        unsigned char* wsl = ws; int bxl = blockIdx.x; asm volatile("" : "+s"(wsl), "+s"(bxl));
        if (IN(p1)) {
            pg8::Gemm g{(const pg8::bf16_t*)(wsl + WS_XB), (const pg8::bf16_t*)(wsl + WS_WIN) + (size_t)l * INDIM * DM, MPAD, INDIM, DM};
            int vc1 = F.vcu; asm volatile("" : "+s"(vc1));
            pg8::Hybrid S; S.init(MPAD, INDIM, vc1, 2);
            pg8::EpiIn E{(pg8::bf16_t*)(wsl + WS_Z), (const float*)(wsl + WS_SSQ), args.out, l};
            pg8::SplitK<1> SK{(float*)(wsl + WS_DUMP), (unsigned*)(wsl + WS_CTL) + CW_SK + (l * 2 + 0) * 4096};
            pg8::gemm_phase<pg8::EpiIn, pg8::Hybrid, true, true, pg8::SplitK<1>>(F.lds, g, S, E, SK);
            SEAM(p1);
        }
#if USE_MFMA_ATTN
        if (IN(p2)) { mixer_phase(F, args, l); SEAM(p2); }
#else
        if (IN(p2)) { naive_mixer_phase(F, args, l); SEAM(p2); }
#endif
        if (IN(p3)) {
            pg8::Gemm g{(const pg8::bf16_t*)(wsl + WS_YMIX), (const pg8::bf16_t*)(wsl + WS_WOUT) + (size_t)l * DM * DM, MPAD, DM, DM};
            int vcl = F.vcu; asm volatile("" : "+s"(vcl));
            pg8::Hybrid S; S.init(MPAD, DM, vcl, 4);
            const float* Xc = (const float*)(wsl + WS_X);
            pg8::EpiOut E{(float*)(wsl + WS_X), (pg8::bf16_t*)(wsl + WS_XB), (float*)(wsl + WS_SSQ), l == 0 ? args.in[0] : Xc, l == 0 ? args.in[1] - (size_t)NROWP * DM : Xc};
            pg8::SplitK<3> SK{(float*)(wsl + WS_DUMP), (unsigned*)(wsl + WS_CTL) + CW_SK + (l * 2 + 1) * 4096};
            pg8::gemm_phase<pg8::EpiOut, pg8::Hybrid, true, true, pg8::SplitK<3>>(F.lds, g, S, E, SK);
            SEAM(p3);
        }
    }
    if (IN(N_PHASES - 1)) final_norm_phase(F, args);
#undef SEAM
#undef IN
}

extern "C" void kernel_launch(void* const* d_in, const int* in_sizes, int n_in, void* d_out, int out_size, void* d_ws, size_t ws_size, hipStream_t stream) {
    static int grid = 0;
    if (grid == 0) {
        if (n_in != 22 || out_size != (int)OUT_TOTAL || ws_size < WS_END) { fprintf(stderr, "kernel_launch: unexpected shapes: n_in %d out %d ws %zu\n", n_in, out_size, ws_size); grid = -1; return; }
        int dev = 0, cus = 0, per_cu = 0;
        if (hipGetDevice(&dev) != hipSuccess || hipDeviceGetAttribute(&cus, hipDeviceAttributeMultiprocessorCount, dev) != hipSuccess) { grid = -1; return; }
        if (hipFuncSetAttribute((const void*)mk_fwd, hipFuncAttributeMaxDynamicSharedMemorySize, LDS_BYTES) != hipSuccess) { fprintf(stderr, "kernel_launch: hipFuncSetAttribute failed\n"); grid = -1; return; }
        if (hipOccupancyMaxActiveBlocksPerMultiprocessor(&per_cu, (const void*)mk_fwd, NTHREADS, LDS_BYTES) != hipSuccess || per_cu < 1) { fprintf(stderr, "kernel_launch: occupancy query says %d blocks per CU\n", per_cu); (void)hipGetLastError(); grid = -1; return; }
        if (cus != 256) { fprintf(stderr, "kernel_launch: built for a 256-CU device, found %d CUs\n", cus); grid = -1; return; }
        grid = cus;
    }
    if (grid < 0) return;
    (void)hipMemsetAsync((char*)d_ws + WS_CTL, 0, CTL_ZERO_BYTES, stream);
    Args a{};
    for (int i = 0; i < 22; ++i) a.in[i] = (const float*)d_in[i];
    a.out = (float*)d_out; a.ws = (unsigned char*)d_ws;
#if MK_SINGLE
    a.mix_mask = 7;
#ifdef PROBE_PREFIX
#ifdef PROBE_MASK
    a.mix_mask = PROBE_MASK;
#endif
#ifdef PROBE_FLAGS
    a.pflags = PROBE_FLAGS;
#endif
    a.ph_lo = 0; a.ph_hi = PROBE_PREFIX;
    hipLaunchKernelGGL(mk_fwd, dim3(grid), dim3(NTHREADS), LDS_BYTES, stream, a);
    (void)hipMemsetAsync((char*)d_ws + WS_CTL, 0, CTL_ZERO_BYTES, stream);
    a.mix_mask = 7; a.pflags = 0;
#endif
    a.ph_lo = 0; a.ph_hi = N_PHASES;
    hipLaunchKernelGGL(mk_fwd, dim3(grid), dim3(NTHREADS), LDS_BYTES, stream, a);
#else
    for (int p = 0; p < N_PHASES; ++p) { a.ph_lo = p; a.ph_hi = p + 1; hipLaunchKernelGGL(mk_fwd, dim3(grid), dim3(NTHREADS), LDS_BYTES, stream, a); }
#endif
}
```

```cpp
#include <hip/hip_runtime.h>
#include <cstdio>
#include <cstdint>

namespace pg8 {
#define PG8_LAS __attribute__((address_space(3)))
typedef unsigned short bf16_t;
typedef short bf16x8 __attribute__((ext_vector_type(8)));
typedef float f32x4 __attribute__((ext_vector_type(4)));
typedef unsigned u32x4 __attribute__((ext_vector_type(4)));
constexpr int BM = 256, BK = 64, HALF = 128, HTB = HALF * BK * 2  , STAGE_BYTES = 8 * HTB, NXCD = 8, WGM = 8;

__host__ __device__ __forceinline__ int lds_byte(int r, int c) { const int st = (r >> 4) * 2 + (c >> 5), rr = r & 15, cc = c & 31, ob = rr * 64 + cc * 2; return st * 1024 + (ob ^ (((ob >> 9) & 1) << 5)); }
__host__ __device__ __forceinline__ void stage_rc(int b, int& R, int& C) { const int st = b / 1024, sb = b % 1024, swz = sb ^ (((sb >> 9) & 1) << 5); R = (st >> 1) * 16 + swz / 64; C = (st & 1) * 32 + (swz % 64) / 2; }
__host__ __device__ __forceinline__ int perm32(int rho) { const int n = rho >> 4, i = rho & 15; return 8 * (i >> 2) + 4 * n + (i & 3); }

struct Unit { int pm, pn, k0, nk, mode, slot, np; };
struct Gemm { const bf16_t* A; const bf16_t* Bt; int M, N, K; };

struct StaticOrder {
    int nM, nN, nwg, G, c;
    __host__ __device__ void init(int M, int N, int G_, int c_) { nM = M / BM; nN = N / BM; nwg = nM * nN; G = G_; c = c_; }
    __host__ __device__ bool next(int i, Unit& u) const {
        const long L = (long)i * G + c; if (L >= nwg) return false;
        int wgid = (int)L; { const int q = nwg / NXCD, r = nwg % NXCD, xcd = wgid % NXCD, off = wgid / NXCD; wgid = (xcd < r ? xcd * (q + 1) : r * (q + 1) + (xcd - r) * q) + off; }
        const int nig = WGM * nN, gid = wgid / nig, fm = gid * WGM, gsz = (nM - fm) < WGM ? (nM - fm) : WGM;
        u.pm = fm + ((wgid % nig) % gsz); u.pn = (wgid % nig) / gsz; u.k0 = 0; u.nk = 0; u.mode = 0; u.slot = 0; u.np = 0; return true;
    }
    __device__ __forceinline__ void a_ready(const Unit&) const {}
    __device__ __forceinline__ void done(const Unit&) const {}
};

__device__ __forceinline__ unsigned cvt_pk_bf16(float lo, float hi) { unsigned r; asm volatile("v_cvt_pk_bf16_f32 %0, %1, %2" : "=v"(r) : "v"(lo), "v"(hi)); return r; }
typedef float f32x2 __attribute__((ext_vector_type(2)));


#define PG8_GAS __attribute__((address_space(1)))
struct PartialReader {
    const PG8_GAS f32x4* p;
    template <int NP> __device__ __forceinline__ f32x4 next() {
        if constexpr (NP == 0) return (f32x4){0.f, 0.f, 0.f, 0.f};
        else {
            f32x4 x = p[0];
            if constexpr (NP > 1) x += p[16384];
            if constexpr (NP > 2) x += p[32768];
            p += 64; asm volatile("" : "+v"(p));
            return x;
        }
    }
    template <int NP> __device__ __forceinline__ void skip(int n) { if constexpr (NP > 0) { p += 64 * n; asm volatile("" : "+v"(p)); } }
};

constexpr int P_D = 2048, P_INDIM = 4864, P_NROW = 8320  , P_MPAD = 8448, P_NSSQ = 32;
constexpr long OFF_YP = 0, OFF_YS = 16777216, OFF_KP = 17039360, OFF_VP = 17170432, OFF_CP = 17301504, OFF_MKP = 17424384, OFF_MVP = 18472960,
               OFF_KS = 19521536, OFF_VS = 20045824, OFF_CS = 20570112, OUT_TOTAL = 21061632;
constexpr float QS_SWA = 0.125f * 1.4426950408889634f;
constexpr float QS_MEM = 0.08838834764831845f * 1.4426950408889634f;

__device__ __forceinline__ float sigmoid_f(float x) { return __builtin_amdgcn_rcpf(1.0f + __builtin_amdgcn_exp2f(x * -1.4426950408889634f)); }
__device__ __forceinline__ f32x4 sigmoid4(f32x4 x) { return (f32x4){sigmoid_f(x[0]), sigmoid_f(x[1]), sigmoid_f(x[2]), sigmoid_f(x[3])}; }
__device__ __forceinline__ u32x4 pack8(f32x4 a, f32x4 b) { u32x4 w; w.x = cvt_pk_bf16(a[0], a[1]); w.y = cvt_pk_bf16(a[2], a[3]); w.z = cvt_pk_bf16(b[0], b[1]); w.w = cvt_pk_bf16(b[2], b[3]); return w; }

__device__ __forceinline__ void row_rstd(float (&rs)[2][4], const float* ssq, int rbase, int fq) {
    f32x4 pa[2][4], pb[2][4];
#pragma unroll
    for (int ai = 0; ai < 2; ++ai)
#pragma unroll
        for (int m = 0; m < 4; ++m) { const PG8_GAS f32x4* p = (const PG8_GAS f32x4*)(ssq + (size_t)(rbase + ai * HALF + m * 16) * P_NSSQ + fq * 8); pa[ai][m] = p[0]; pb[ai][m] = p[1]; }
#pragma unroll
    for (int ai = 0; ai < 2; ++ai)
#pragma unroll
        for (int m = 0; m < 4; ++m) {
            const f32x4 a = pa[ai][m], b = pb[ai][m];
            float s = ((a[0] + a[1]) + (a[2] + a[3])) + ((b[0] + b[1]) + (b[2] + b[3]));
            s += __shfl_xor(s, 16); s += __shfl_xor(s, 32);
            rs[ai][m] = __builtin_amdgcn_rsqf(s * (1.0f / (float)P_D) + 1e-6f);
        }
}

struct EpiIn {
    static constexpr bool PERM = true, AFTER_DRAIN = false;
    bf16_t* Z; const float* ssq; float* out; int layer;
    __device__ __forceinline__ static void init(f32x4 (&acc)[2][2][4][2], const Unit&, int, int) {
#pragma unroll
        for (int a = 0; a < 2; ++a)
#pragma unroll
            for (int b = 0; b < 2; ++b)
#pragma unroll
                for (int m = 0; m < 4; ++m)
#pragma unroll
                    for (int n = 0; n < 2; ++n) acc[a][b][m][n] = (f32x4){0.f, 0.f, 0.f, 0.f};
    }
    template <int HASP> __device__ __forceinline__ void run(const f32x4 (&acc)[2][2][4][2], const Unit& u, int wr, int wc, int fr, int fq, PartialReader& PR) const {
        { int t_ = threadIdx.x; asm volatile("" : "+v"(t_)); fr = t_ & 15; fq = (t_ >> 4) & 3; }
        const int pn = u.pn, rbase = u.pm * BM + wr * 64 + fr;
        bf16_t* Z = this->Z; const float* ssq = this->ssq; float* out = this->out;
        asm volatile("" : "+s"(Z), "+s"(ssq), "+s"(out));
        float rs[2][4];
        row_rstd(rs, ssq, rbase, fq);
        const bool tailtile = (u.pm == 15) || (u.pm == 31) || (u.pm == 32);
        const bool is_q = (pn >= 6 && pn <= 9), is_cq = (pn == 15 || pn == 16);
        const float qs = is_q ? QS_SWA : QS_MEM;
#pragma unroll
        for (int ai = 0; ai < 2; ++ai) {
            if (u.pm * BM + wr * 64 + ai * HALF >= P_NROW) { PR.template skip<HASP>(16); continue; }
#pragma unroll
            for (int m2 = 0; m2 < 4; m2 += 2) {
            f32x4 v[4][2][2];
#pragma unroll
            for (int m = m2; m < m2 + 2; ++m)
#pragma unroll
                for (int bj = 0; bj < 2; ++bj)
#pragma unroll
                    for (int n = 0; n < 2; ++n) { if constexpr (HASP == 0) v[m][bj][n] = acc[ai][bj][m][n]; else v[m][bj][n] = acc[ai][bj][m][n] + PR.template next<HASP>(); }
#pragma unroll
            for (int m = m2; m < m2 + 2; ++m) {
                const int row = rbase + ai * HALF + m * 16;
                const float r = rs[ai][m];
                if (pn < 4) {
                    const int ch0 = 128 * pn + 32 * wc + 8 * fq;
                    const f32x4 u0 = (v[m][0][0] * r) * sigmoid4(v[m][1][0] * r), u1 = (v[m][0][1] * r) * sigmoid4(v[m][1][1] * r);
                    *(PG8_GAS u32x4*)(Z + (size_t)row * P_INDIM + ch0) = pack8(u0, u1);
                    if (tailtile) {
                        float* dst = nullptr;
                        if (row < 8192) { const int t = row & 4095, b = row >> 12; if (t >= 4066) dst = out + OFF_CP + ((size_t)(layer * 2 + b) * 30 + (t - 4066)) * 512 + ch0; }
                        else { const int rr = row - 8192, b = rr >> 4, s = rr & 15; dst = out + OFF_CS + ((size_t)(layer * 8 + b) * 30 + 14 + s) * 512 + ch0; }
                        if (dst) { *(PG8_GAS f32x4*)dst = u0; *(PG8_GAS f32x4*)(dst + 4) = u1; }
                    }
                } else if (pn == 10) {
#pragma unroll
                    for (int bj = 0; bj < 2; ++bj) {
                        const f32x4 v0 = v[m][bj][0] * r, v1 = v[m][bj][1] * r;
                        const int c128 = 32 * wc + 8 * fq;
                        *(PG8_GAS u32x4*)(Z + (size_t)row * P_INDIM + 2560 + 128 * bj + c128) = pack8(v0, v1);
                        if (tailtile) {
                            float* dst = nullptr;
                            if (row < 8192) { const int t = row & 4095, b = row >> 12; if (t >= 3968) dst = out + (bj ? OFF_VP : OFF_KP) + ((size_t)(layer * 2 + b) * 128 + (t - 3968)) * 128 + c128; }
                            else { const int rr = row - 8192, b = rr >> 4, s = rr & 15; dst = out + (bj ? OFF_VS : OFF_KS) + ((size_t)(layer * 8 + b) * 128 + 112 + s) * 128 + c128; }
                            if (dst) { *(PG8_GAS f32x4*)dst = v0; *(PG8_GAS f32x4*)(dst + 4) = v1; }
                        }
                    }
                } else {
#pragma unroll
                    for (int bj = 0; bj < 2; ++bj) {
                        f32x4 v0 = v[m][bj][0] * r, v1 = v[m][bj][1] * r;
                        if (!(is_q || is_cq)) { v0 = v0 * sigmoid4(v0); v1 = v1 * sigmoid4(v1); } else { v0 = v0 * qs; v1 = v1 * qs; }
                        *(PG8_GAS u32x4*)(Z + (size_t)row * P_INDIM + pn * BM + 128 * bj + 32 * wc + 8 * fq) = pack8(v0, v1);
                    }
                }
            }
            }
        }
    }
};

struct EpiMemKV {
    static constexpr bool PERM = true, AFTER_DRAIN = false;
    bf16_t* MKV; float* out;
    __device__ __forceinline__ static void init(f32x4 (&acc)[2][2][4][2], const Unit&, int, int) {
#pragma unroll
        for (int a = 0; a < 2; ++a)
#pragma unroll
            for (int b = 0; b < 2; ++b)
#pragma unroll
                for (int m = 0; m < 4; ++m)
#pragma unroll
                    for (int n = 0; n < 2; ++n) acc[a][b][m][n] = (f32x4){0.f, 0.f, 0.f, 0.f};
    }
    template <int HASP> __device__ __forceinline__ void run(const f32x4 (&acc)[2][2][4][2], const Unit& u, int wr, int wc, int fr, int fq, PartialReader& PR) const {
        const int l = u.pn >> 2, kv = (u.pn >> 1) & 1, cb = (u.pn & 1) * 256;
        bf16_t* MKV = this->MKV; float* out = this->out; asm volatile("" : "+s"(MKV), "+s"(out));
        const int row0 = u.pm * BM + wr * 64 + fr, cl = 32 * wc + 8 * fq;
        bf16_t* zb = MKV + (size_t)row0 * 4096 + u.pn * BM + cl;
        float* ob = out + (kv ? OFF_MVP : OFF_MKP) + ((size_t)(l * 512 + row0)) * 512 + cb + cl;
#pragma unroll
        for (int ai = 0; ai < 2; ++ai)
#pragma unroll
            for (int m = 0; m < 4; ++m)
#pragma unroll
                for (int bj = 0; bj < 2; ++bj) {
                    const f32x4 v0 = acc[ai][bj][m][0], v1 = acc[ai][bj][m][1];
                    *(PG8_GAS u32x4*)(zb + (size_t)(ai * HALF + m * 16) * 4096 + 128 * bj) = pack8(v0, v1);
                    float* dst = ob + (size_t)(ai * HALF + m * 16) * 512 + 128 * bj;
                    *(PG8_GAS f32x4*)dst = v0; *(PG8_GAS f32x4*)(dst + 4) = v1;
                }
    }
};

struct EpiOut {
    static constexpr bool PERM = false, AFTER_DRAIN = false;
    bf16_t* XB; float* ssq;
    typedef unsigned u32x2v __attribute__((ext_vector_type(2)));
    __device__ __forceinline__ static void row_out(const f32x4 (&xn)[2][2], bf16_t* XB, float* ssq, int row, int colbase, int slot, int fq) {
        float q = 0.f;
#pragma unroll
        for (int bj = 0; bj < 2; ++bj)
#pragma unroll
            for (int n = 0; n < 2; ++n) {
                const size_t off = (size_t)row * P_D + colbase + bj * HALF + n * 16;
                u32x2v w; w.x = cvt_pk_bf16(xn[bj][n][0], xn[bj][n][1]); w.y = cvt_pk_bf16(xn[bj][n][2], xn[bj][n][3]);
                *(PG8_GAS u32x2v*)(XB + off) = w;
                q += (xn[bj][n][0] * xn[bj][n][0] + xn[bj][n][1] * xn[bj][n][1]) + (xn[bj][n][2] * xn[bj][n][2] + xn[bj][n][3] * xn[bj][n][3]);
            }
        q += __shfl_xor(q, 16); q += __shfl_xor(q, 32);
        if (fq == 0) *(PG8_GAS float*)(ssq + (size_t)row * P_NSSQ + slot) = q;
    }
    __device__ __forceinline__ void init(f32x4 (&acc)[2][2][4][2], const Unit& u, int wr, int wc) const {
        int t_ = threadIdx.x; asm volatile("" : "+v"(t_)); const int fr = t_ & 15, fq = (t_ >> 4) & 3;
        const bf16_t* rin = XB; asm volatile("" : "+s"(rin));
        const int rbase = u.pm * BM + wr * 64 + fr, colbase = u.pn * BM + wc * 32 + fq * 4;
#pragma unroll
        for (int ai = 0; ai < 2; ++ai) {
            const bool ld = (u.mode != 1) && (u.pm * BM + wr * 64 + ai * HALF < P_NROW);
#pragma unroll
            for (int m = 0; m < 4; ++m)
#pragma unroll
                for (int bj = 0; bj < 2; ++bj)
#pragma unroll
                    for (int n = 0; n < 2; ++n) {
                        u32x2v w; w.x = 0u; w.y = 0u;
                        if (ld) w = *(const PG8_GAS u32x2v*)(rin + (size_t)(rbase + ai * HALF + m * 16) * P_D + colbase + bj * HALF + n * 16);
                        acc[ai][bj][m][n] = (f32x4){__uint_as_float(w.x << 16), __uint_as_float(w.x & 0xffff0000u), __uint_as_float(w.y << 16), __uint_as_float(w.y & 0xffff0000u)};
                    }
        }
    }
    template <int HASP> __device__ __forceinline__ void run(const f32x4 (&acc)[2][2][4][2], const Unit& u, int wr, int wc, int fr, int fq, PartialReader& PR) const {
        { int t_ = threadIdx.x; asm volatile("" : "+v"(t_)); fr = t_ & 15; fq = (t_ >> 4) & 3; }
        const int rbase = u.pm * BM + wr * 64 + fr, colbase = u.pn * BM + wc * 32 + fq * 4, slot = u.pn * 4 + wc;
        bf16_t* XB = this->XB; float* ssq = this->ssq; asm volatile("" : "+s"(XB), "+s"(ssq));
#pragma unroll
        for (int ai = 0; ai < 2; ++ai) {
            if (u.pm * BM + wr * 64 + ai * HALF >= P_NROW) { PR.template skip<HASP>(16); continue; }
            if constexpr (HASP == 0) {
#pragma unroll
                for (int m = 0; m < 4; ++m) {
                    f32x4 xn[2][2];
#pragma unroll
                    for (int bj = 0; bj < 2; ++bj)
#pragma unroll
                        for (int n = 0; n < 2; ++n) xn[bj][n] = acc[ai][bj][m][n];
                    row_out(xn, XB, ssq, rbase + ai * HALF + m * 16, colbase, slot, fq);
                }
            } else {
#pragma unroll
                for (int m2 = 0; m2 < 4; m2 += 2) {
                    f32x4 pv[2][2][2];
#pragma unroll
                    for (int mm = 0; mm < 2; ++mm)
#pragma unroll
                        for (int bj = 0; bj < 2; ++bj)
#pragma unroll
                            for (int n = 0; n < 2; ++n) pv[mm][bj][n] = PR.template next<HASP>();
#pragma unroll
                    for (int mm = 0; mm < 2; ++mm) {
                        f32x4 xn[2][2];
#pragma unroll
                        for (int bj = 0; bj < 2; ++bj)
#pragma unroll
                            for (int n = 0; n < 2; ++n) xn[bj][n] = acc[ai][bj][m2 + mm][n] + pv[mm][bj][n];
                        row_out(xn, XB, ssq, rbase + ai * HALF + (m2 + mm) * 16, colbase, slot, fq);
                    }
                }
            }
        }
    }
};

struct NoSplit {
    static constexpr int NP = 0;
    __device__ __forceinline__ void dump(const f32x4 (&)[2][2][4][2], const Unit&, int, int) const {}
    __device__ __forceinline__ PartialReader reader(const Unit&, int, int) const { PartialReader r; r.p = nullptr; return r; }
};
template <int NP_> struct SplitK {
    static constexpr int NP = NP_;
    float* slots; unsigned* flags;
    __device__ __forceinline__ void dump(const f32x4 (&acc)[2][2][4][2], const Unit& u, int wid, int lane) const {
        const __amdgpu_buffer_rsrc_t rs = __builtin_amdgcn_make_buffer_rsrc(slots, (short)0, 256 * 65536 * 4, 0x00020000);
        unsigned off = (unsigned)u.slot * 262144u + ((unsigned)wid * 32u * 64u + (unsigned)lane) * 16u;
#pragma unroll
        for (int a = 0; a < 2; ++a)
#pragma unroll
            for (int m = 0; m < 4; ++m)
#pragma unroll
                for (int b = 0; b < 2; ++b)
#pragma unroll
                    for (int n = 0; n < 2; ++n) {
                        __builtin_amdgcn_raw_buffer_store_b128(__builtin_bit_cast(u32x4, acc[a][b][m][n]), rs, off, 0,   16);
                        off += 1024u; asm volatile("" : "+v"(off)); }
        asm volatile("s_waitcnt vmcnt(0)" ::: "memory");
        if (lane == 0) __hip_atomic_fetch_add(flags + 16 * u.slot, 1u, __ATOMIC_RELAXED, __HIP_MEMORY_SCOPE_AGENT);
    }
    __device__ __forceinline__ PartialReader reader(const Unit& u, int wid, int lane) const {
#pragma unroll
        for (int q = 0; q < NP; ++q) { unsigned sp = 0;
            while ((unsigned)__builtin_amdgcn_readfirstlane(__hip_atomic_load(flags + 16 * (u.slot + q), __ATOMIC_RELAXED, __HIP_MEMORY_SCOPE_AGENT)) < 8u) { __builtin_amdgcn_s_sleep(2); if (++sp > (1u << 22)) break; } }
        __builtin_amdgcn_fence(__ATOMIC_ACQUIRE, "agent");
        asm volatile("s_waitcnt vmcnt(0)" ::: "memory");
        PartialReader r; r.p = (const PG8_GAS f32x4*)(slots + (size_t)u.slot * 65536) + ((size_t)wid * 32 * 64 + lane); return r;
    }
};
struct Hybrid {
    static constexpr int G = 256;
    int nM, nN, v, R, S, P;
    __device__ void init(int M, int N, int v_, int P_) { nM = M / BM; nN = N / BM; v = v_; P = P_; const int nu = nM * nN; R = nu / G; S = nu - R * G; }
    __device__ bool next(int i, Unit& u) const {
        const bool hasp = v < S * P; const int sp = v / P, q = v - sp * P;
        const bool dumper = hasp && q > 0, owner = hasp && q == 0;
        const int idx = i - (dumper ? 1 : 0);
        int ui;
        const int kb0 = (P == 2) ? (q == 0 ? 0 : 8) : (q == 0 ? 0 : 8 * q - 4), kb1 = (P == 2) ? (q == 0 ? 8 : 32) : (q == 3 ? 32 : 8 * q + 4);
        if (dumper && i == 0) { ui = R * G + sp; u.k0 = kb0; u.nk = kb1 - kb0; u.mode = 1; u.slot = sp * (P - 1) + q - 1; u.np = 0; }
        else if (idx < R) { ui = idx * G + v; u.k0 = 0; u.nk = 0; u.mode = 0; u.slot = 0; u.np = 0; }
        else if (idx == R && owner) { ui = R * G + sp; u.k0 = 0; u.nk = kb1; u.mode = 2; u.slot = sp * (P - 1); u.np = P - 1; }
        else return false;
        const int nig = WGM * nN, gid = ui / nig, fm = gid * WGM, gsz = (nM - fm) < WGM ? (nM - fm) : WGM, r = ui % nig;
        u.pm = fm + r % gsz; u.pn = r / gsz; return true;
    }
    __device__ __forceinline__ void a_ready(const Unit&) const {}
    __device__ __forceinline__ void done(const Unit&) const {}
};
template <class Epi, class Sched, bool ALIGN_EPI = false, bool SP2 = false, class SKT = NoSplit>
__device__ __forceinline__ void gemm_phase(PG8_LAS unsigned char* lds, const Gemm g, const Sched& S, const Epi& E, const SKT SK = SKT()) {
    int tid_ = threadIdx.x; asm volatile("" : "+v"(tid_));
    const int tid = tid_, wid = __builtin_amdgcn_readfirstlane(tid >> 6), lane = tid & 63, wr = wid >> 2, wc = wid & 3, fr = lane & 15, fq = lane >> 4;
    const int K = g.K, ntf = K / BK;
    unsigned voffA[2], voffB[2];
#pragma unroll
    for (int i = 0; i < 2; ++i) { int R, C; stage_rc(tid * 16 + i * 8192, R, C); const int Rb = Epi::PERM ? ((R & ~31) + perm32(R & 31)) : R;
        voffA[i] = (unsigned)(R * K + C) * 2u; voffB[i] = (unsigned)(Rb * K + C) * 2u; }
    const size_t kstep = (size_t)(BK * 2);
    const size_t hstep = (size_t)HALF * K * 2;
    const size_t tstep = 2 * hstep;
    const unsigned ldsw = (unsigned)wid * 1024u;
    const int aoff = lds_byte(wr * 64 + fr, fq * 8), boff = lds_byte(wc * 32 + fr, fq * 8);
#define PG8_SA(b, h) (((b) * 2 + (h)) * HTB)
#define PG8_SB(b, h) ((4 + (b) * 2 + (h)) * HTB)
#define PG8_STAGE(bufoff, gbase, voff) do { _Pragma("unroll") for (int _i = 0; _i < 2; ++_i) \
        __builtin_amdgcn_global_load_lds((const unsigned*)((const char*)(gbase) + (voff)[_i]), (PG8_LAS unsigned*)(lds + (bufoff) + ldsw + _i * 8192), 16, 0, 0); } while (0)
#define PG8_LDA(dst, b, h) do { _Pragma("unroll") for (int m = 0; m < 4; ++m) _Pragma("unroll") for (int k = 0; k < 2; ++k) dst[m][k] = *(const PG8_LAS bf16x8*)(lds + PG8_SA(b, h) + aoff + m * 2048 + k * 1024); } while (0)
#define PG8_LDB(dst, b, h) do { _Pragma("unroll") for (int n = 0; n < 2; ++n) _Pragma("unroll") for (int k = 0; k < 2; ++k) dst[n][k] = *(const PG8_LAS bf16x8*)(lds + PG8_SB(b, h) + boff + n * 2048 + k * 1024); } while (0)
#define PG8_MMA(ai, bj, At, Bt) do { __builtin_amdgcn_s_setprio(1); _Pragma("unroll") for (int m = 0; m < 4; ++m) _Pragma("unroll") for (int n = 0; n < 2; ++n) _Pragma("unroll") for (int k = 0; k < 2; ++k) \
        acc[ai][bj][m][n] = __builtin_amdgcn_mfma_f32_16x16x32_bf16(Bt[n][k], At[m][k], acc[ai][bj][m][n], 0, 0, 0); __builtin_amdgcn_s_setprio(0); } while (0)
#define PG8_WAIT_V(n) asm volatile("s_waitcnt vmcnt(" #n ")" ::: "memory")
#define PG8_WAIT_L(n) asm volatile("s_waitcnt lgkmcnt(" #n ")" ::: "memory")
#define PG8_BAR __builtin_amdgcn_s_barrier()
#define PG8_SCHED __builtin_amdgcn_sched_barrier(0)
    Unit cur, nxt; int ui = 0;
    if (!S.next(0, cur)) return;
    f32x4 acc[2][2][4][2];
    E.init(acc, cur, wr, wc);
    bf16x8 At[4][2], B0[2][2], B1[2][2];
    const char* cA = (const char*)g.A + (size_t)cur.pm * tstep + (size_t)cur.k0 * (BK * 2); const char* cB = (const char*)g.Bt + (size_t)cur.pn * tstep + (size_t)cur.k0 * (BK * 2);
    S.a_ready(cur);
    if constexpr (SP2) {
        PG8_STAGE(PG8_SB(0, 0), cB, voffB); PG8_STAGE(PG8_SB(0, 1), cB + hstep, voffB); PG8_STAGE(PG8_SA(0, 0), cA, voffA); PG8_STAGE(PG8_SA(0, 1), cA + hstep, voffA);
        if (wr == 1) PG8_BAR;
        PG8_WAIT_V(2); PG8_BAR;
        PG8_STAGE(PG8_SB(1, 0), cB + kstep, voffB); PG8_STAGE(PG8_SA(1, 0), cA + kstep, voffA); PG8_STAGE(PG8_SB(1, 1), cB + hstep + kstep, voffB);
        PG8_WAIT_V(6); PG8_BAR;
    } else {
        PG8_STAGE(PG8_SB(0, 0), cB, voffB); PG8_STAGE(PG8_SA(0, 0), cA, voffA); PG8_STAGE(PG8_SB(0, 1), cB + hstep, voffB); PG8_STAGE(PG8_SA(0, 1), cA + hstep, voffA);
        if (wr == 1) PG8_BAR;
        PG8_WAIT_V(4); PG8_BAR;
        PG8_STAGE(PG8_SB(1, 0), cB + kstep, voffB); PG8_STAGE(PG8_SA(1, 0), cA + kstep, voffA); PG8_STAGE(PG8_SB(1, 1), cB + hstep + kstep, voffB);
        PG8_WAIT_V(6); PG8_BAR;
    }
    for (;;) {
        const bool has_next = S.next(ui + 1, nxt);
        const char* nA = has_next ? (const char*)g.A + (size_t)nxt.pm * tstep + (size_t)nxt.k0 * (BK * 2) : cA; const char* nB = has_next ? (const char*)g.Bt + (size_t)nxt.pn * tstep + (size_t)nxt.k0 * (BK * 2) : cB;
        const int nt = cur.nk ? cur.nk : ntf;
        for (int t = 0; t < nt; t += 2) {
            const bool last = (t == nt - 2);
            const char* a1 = cA + (size_t)(t + 1) * kstep;
            const char* a2 = last ? nA : cA + (size_t)(t + 2) * kstep; const char* b2 = last ? nB : cB + (size_t)(t + 2) * kstep;
            const char* a3 = a2 + kstep; const char* b3 = b2 + kstep;
            if (last && has_next) S.a_ready(nxt);
            if constexpr (SP2) {
            PG8_LDB(B0, 0, 0); PG8_LDB(B1, 0, 1); PG8_SCHED; PG8_LDA(At, 0, 0); PG8_STAGE(PG8_SA(1, 1), a1 + hstep, voffA);
            PG8_WAIT_V(8); PG8_WAIT_L(0); PG8_BAR; PG8_MMA(0, 0, At, B0); PG8_MMA(0, 1, At, B1); PG8_BAR; PG8_SCHED;
            PG8_LDA(At, 0, 1); PG8_STAGE(PG8_SB(0, 0), b2, voffB); PG8_STAGE(PG8_SB(0, 1), b2 + hstep, voffB); PG8_STAGE(PG8_SA(0, 0), a2, voffA);
            PG8_WAIT_V(8); PG8_WAIT_L(0); PG8_BAR; PG8_MMA(1, 0, At, B0); PG8_MMA(1, 1, At, B1); PG8_BAR; PG8_SCHED;
            PG8_LDB(B0, 1, 0); PG8_LDB(B1, 1, 1); PG8_SCHED; PG8_LDA(At, 1, 0); PG8_STAGE(PG8_SA(0, 1), a2 + hstep, voffA);
            PG8_WAIT_V(8); PG8_WAIT_L(0); PG8_BAR; PG8_MMA(0, 0, At, B0); PG8_MMA(0, 1, At, B1); PG8_BAR; PG8_SCHED;
            PG8_LDA(At, 1, 1); PG8_STAGE(PG8_SB(1, 0), b3, voffB); PG8_STAGE(PG8_SB(1, 1), b3 + hstep, voffB); PG8_STAGE(PG8_SA(1, 0), a3, voffA);
            PG8_WAIT_V(8); PG8_WAIT_L(0); PG8_BAR; PG8_MMA(1, 0, At, B0); PG8_MMA(1, 1, At, B1); PG8_BAR; PG8_SCHED;
            } else {
            PG8_LDB(B0, 0, 0); PG8_SCHED; PG8_LDA(At, 0, 0); PG8_STAGE(PG8_SA(1, 1), a1 + hstep, voffA);
            PG8_WAIT_L(8); PG8_BAR; PG8_WAIT_L(0); PG8_MMA(0, 0, At, B0); PG8_BAR; PG8_SCHED;
            PG8_LDB(B1, 0, 1); PG8_STAGE(PG8_SB(0, 0), b2, voffB);
            PG8_BAR; PG8_WAIT_L(0); PG8_MMA(0, 1, At, B1); PG8_BAR;
            PG8_LDA(At, 0, 1); PG8_STAGE(PG8_SA(0, 0), a2, voffA);
            PG8_BAR; PG8_WAIT_L(0); PG8_MMA(1, 0, At, B0); PG8_BAR; PG8_SCHED;
            PG8_STAGE(PG8_SB(0, 1), b2 + hstep, voffB);
            PG8_WAIT_V(6); PG8_BAR; PG8_MMA(1, 1, At, B1); PG8_BAR;
            PG8_LDB(B0, 1, 0); PG8_SCHED; PG8_LDA(At, 1, 0); PG8_STAGE(PG8_SA(0, 1), a2 + hstep, voffA);
            PG8_WAIT_L(8); PG8_BAR; PG8_WAIT_L(0); PG8_MMA(0, 0, At, B0); PG8_BAR; PG8_SCHED;
            PG8_LDB(B1, 1, 1); PG8_STAGE(PG8_SB(1, 0), b3, voffB);
            PG8_BAR; PG8_WAIT_L(0); PG8_MMA(0, 1, At, B1); PG8_BAR;
            PG8_LDA(At, 1, 1); PG8_STAGE(PG8_SA(1, 0), a3, voffA);
            PG8_BAR; PG8_WAIT_L(0); PG8_MMA(1, 0, At, B0); PG8_BAR; PG8_SCHED;
            PG8_STAGE(PG8_SB(1, 1), b3 + hstep, voffB);
            PG8_WAIT_V(6); PG8_BAR; PG8_MMA(1, 1, At, B1); PG8_BAR;
            }
        }
        if constexpr (ALIGN_EPI) { if (wr == 0) PG8_BAR; }
        if constexpr (!Epi::AFTER_DRAIN) { if (cur.mode == 1) SK.dump(acc, cur, wid, lane); else if (SKT::NP > 0 && cur.mode == 2) { PartialReader PR = SK.reader(cur, wid, lane); E.template run<SKT::NP>(acc, cur, wr, wc, fr, fq, PR); } else { PartialReader PR; PR.p = nullptr; E.template run<0>(acc, cur, wr, wc, fr, fq, PR); } S.done(cur); }
        if (!has_next) break;
        E.init(acc, nxt, wr, wc);
        cur = nxt; cA = nA; cB = nB; ++ui;
        if constexpr (ALIGN_EPI) { if (wr == 1) PG8_BAR; }
    }
    PG8_WAIT_V(0);
    if constexpr (!ALIGN_EPI) { if (wr == 0) PG8_BAR; }
    PG8_BAR;
    if constexpr (Epi::AFTER_DRAIN) { E.fused(acc, cur, wr, wc, fr, fq, lds, wid, lane); S.done(cur); }
#undef PG8_SA
#undef PG8_SB
#undef PG8_STAGE
#undef PG8_LDA
#undef PG8_LDB
#undef PG8_MMA
#undef PG8_WAIT_V
#undef PG8_WAIT_L
#undef PG8_BAR
#undef PG8_SCHED
}
}


constexpr int NWAVES = 8, NTHREADS = 512;
constexpr int DM = 2048, SEQ = 4096, NBP = 2, NROWP = 8192, NBS = 8, NSS = 16, NROWS = 128, NROW = 8320, MPAD = 8448, INDIM = 4864, DEPTH = 4;
constexpr int ZP = INDIM;
constexpr int ZC_U = 0, ZC_GA = 1024, ZC_Q = 1536, ZC_K = 2560, ZC_V = 2688, ZC_GB = 2816, ZC_CQ = 3840, ZC_GC = 4352;
constexpr float LOG2E = 1.4426950408889634f;
using pg8::OFF_YP; using pg8::OFF_YS; using pg8::OFF_KP; using pg8::OFF_VP; using pg8::OFF_CP; using pg8::OFF_MKP; using pg8::OFF_MVP; using pg8::OFF_KS; using pg8::OFF_VS; using pg8::OFF_CS; using pg8::OUT_TOTAL;

constexpr size_t MiB = 1u << 20;
constexpr size_t WS_CTL = 0, CTL_ZERO_BYTES = 1 * MiB;
constexpr size_t WS_BT = 1 * MiB;
constexpr size_t WS_SSQ = 2 * MiB;
constexpr size_t WS_WIN = 4 * MiB;
constexpr size_t WS_WOUT = 80 * MiB;
constexpr size_t WS_WMEM = 112 * MiB;
constexpr size_t WS_WPW = 128 * MiB;
constexpr size_t WS_MEMN = 130 * MiB;
constexpr size_t WS_MKVP = 132 * MiB;
constexpr size_t WS_CMK = 136 * MiB, WS_CMV = 144 * MiB;
constexpr size_t WS_CSK = 152 * MiB, WS_CSV = 153 * MiB;
constexpr size_t WS_XB = 154 * MiB;
constexpr size_t WS_X = 187 * MiB;
constexpr size_t WS_Z = 253 * MiB;
constexpr size_t WS_YMIX = 332 * MiB;
constexpr size_t WS_DUMP = 365 * MiB;
constexpr size_t WS_END = 429 * MiB;
constexpr int CW_BAR = 4096, CW_SK = 65536;

constexpr int RING_BYTES = 131072;
constexpr int LDSCTL_OFF = 158720, MISC_OFF = LDSCTL_OFF + 320;
constexpr int LDS_BYTES = 159744;


#define GAS __attribute__((address_space(1)))
#define LAS __attribute__((address_space(3)))
typedef unsigned short bf16;
typedef unsigned v4u __attribute__((ext_vector_type(4)));
typedef float f32x4 __attribute__((ext_vector_type(4)));
typedef short bf16x8 __attribute__((ext_vector_type(8)));
typedef GAS unsigned gu32;
typedef GAS unsigned long long gu64;
#define RLX_AGENT __ATOMIC_RELAXED, __HIP_MEMORY_SCOPE_AGENT
#define LDS_WAIT() asm volatile("s_waitcnt lgkmcnt(0)" ::: "memory")
#define VM_WAIT() asm volatile("s_waitcnt vmcnt(0)" ::: "memory")
__device__ __forceinline__ unsigned long long rt() { return __builtin_amdgcn_s_memrealtime(); }
__device__ __forceinline__ unsigned f2bf(float f) { unsigned u = __builtin_bit_cast(unsigned, f); return (u + 0x7fffu + ((u >> 16) & 1u)) >> 16; }
__device__ __forceinline__ unsigned pk2(float lo, float hi) { return f2bf(lo) | (f2bf(hi) << 16); }

#define XB_TMO      128
#define XB_XCNT(j)  (256  + 64 * (j))
#define XB_XSUB(j)  (1280 + 64 * (j))
#define XB_XGEN(j)  (2304 + 64 * (j))
#define XB_TOP      3328
#define XB_TOPGEN   3392
#define XCD_BAR_WORDS 3456
#define XB_SPIN_CAP (1u << 18)

__device__ __forceinline__ unsigned xb_ld(unsigned* p)              { return __hip_atomic_load(p, __ATOMIC_RELAXED, __HIP_MEMORY_SCOPE_AGENT); }
__device__ __forceinline__ unsigned xb_add(unsigned* p, unsigned v) { return __hip_atomic_fetch_add(p, v, __ATOMIC_RELAXED, __HIP_MEMORY_SCOPE_AGENT); }
__device__ __forceinline__ unsigned xb_xcc_id() { return (unsigned)__builtin_amdgcn_s_getreg((3 << 11) | 20) & 0xFu; }
#define XB_SPIN(cond, bar) do { unsigned _sp = 0; while (cond) { __builtin_amdgcn_s_sleep(1); \
    if ((++_sp & 255u) == 0u) { if (xb_ld(&(bar)[XB_TMO])) break; if (_sp > XB_SPIN_CAP) { atomicAdd(&(bar)[XB_TMO], 1u); break; } } } } while (0)

struct XcdBarrier {
    unsigned* bar; unsigned x;
    volatile LAS unsigned* st;
};

__device__ __forceinline__ XcdBarrier xcd_barrier_post(unsigned* bar, volatile LAS unsigned* st) {
    XcdBarrier b; b.bar = bar; b.x = xb_xcc_id(); b.st = st;
    if (threadIdx.x == 0) (void)xb_add(&bar[XB_XCNT(b.x)], 1u);
    return b;
}
__device__ __forceinline__ void xcd_barrier_complete(unsigned* bar, unsigned x, unsigned& nloc, unsigned& nx) {
    const unsigned G = gridDim.x * gridDim.y * gridDim.z;
    unsigned sum, cnt, mine, sp = 0u;
    for (;;) {
        sum = 0u; cnt = 0u; mine = 0u;
#pragma unroll
        for (unsigned j = 0; j < 16; ++j) { const unsigned c = xb_ld(&bar[XB_XCNT(j)]); sum += c; cnt += (c > 0u) ? 1u : 0u; mine = (j == x) ? c : mine; }
        if (sum == G) break;
        __builtin_amdgcn_s_sleep(1);
        if ((++sp & 255u) == 0u) { if (xb_ld(&bar[XB_TMO])) break; if (sp > XB_SPIN_CAP) { atomicAdd(&bar[XB_TMO], 1u); break; } }
    }
    nloc = mine > 0u ? mine : 1u; nx = cnt > 0u ? cnt : 1u;
}

__device__ __forceinline__ void xcd_barrier(const XcdBarrier& b) {
    asm volatile("s_waitcnt vmcnt(0)" ::: "memory");
    __syncthreads();
    int xb_tid = threadIdx.x; asm volatile("" : "+v"(xb_tid));
    if (xb_tid == 0) {
        unsigned* bar = b.bar;
        __builtin_amdgcn_s_waitcnt(0);
        unsigned nloc = b.st[0], nx = b.st[1];
        if (nloc == 0u) { xcd_barrier_complete(bar, b.x, nloc, nx); b.st[0] = nloc; b.st[1] = nx; }
        const unsigned old = xb_add(&bar[XB_XSUB(b.x)], 1u);
        const unsigned gen = old / nloc;
        if (old + 1u == (gen + 1u) * nloc) {
            __builtin_amdgcn_fence(__ATOMIC_RELEASE, "agent");
            asm volatile("s_waitcnt vmcnt(0)" ::: "memory");
            const unsigned og = xb_add(&bar[XB_TOP], 1u);
            const unsigned tg = og / nx;
            if (og + 1u == (tg + 1u) * nx) xb_add(&bar[XB_TOPGEN], 1u);
            else XB_SPIN(xb_ld(&bar[XB_TOPGEN]) == tg, bar);
            __builtin_amdgcn_fence(__ATOMIC_ACQUIRE, "agent");
            xb_add(&bar[XB_XGEN(b.x)], 1u);
            asm volatile("s_waitcnt vmcnt(0)" ::: "memory");
        } else {
            XB_SPIN(xb_ld(&bar[XB_XGEN(b.x)]) == gen, bar);
            __builtin_amdgcn_fence(__ATOMIC_ACQUIRE, "agent");
            asm volatile("s_waitcnt vmcnt(0)" ::: "memory");
        }
    }
    __syncthreads();
}


struct Args { const float* in[22]; float* out; unsigned char* ws; int ph_lo, ph_hi; int mix_mask, pflags; };
struct Frame {
    LAS unsigned char* lds; unsigned char* glds;
    volatile LAS unsigned* MISC;
    gu32* ctl;
    int tid, lane, wave, vcu, G;
};
__device__ __forceinline__ float wave_sum(float v) {
#pragma unroll
    for (int o = 1; o < 64; o <<= 1) v += __shfl_xor(v, o);
    return v;
}
__device__ __forceinline__ float wave_max(float v) {
#pragma unroll
    for (int o = 1; o < 64; o <<= 1) v = fmaxf(v, __shfl_xor(v, o));
    return v;
}
__device__ __forceinline__ int opaque_tid() { int t = threadIdx.x; asm volatile("" : "+v"(t)); return t; }
__device__ __forceinline__ float bf2f(bf16 v) { return __builtin_bit_cast(float, (unsigned)v << 16); }
__device__ __forceinline__ float rbf(float f) { return __builtin_bit_cast(float, f2bf(f) << 16); }

__device__ __forceinline__ void p0_transpose_item(const float* W, int K, int N, const float* g, bf16* WT, int k0, int n0, int dst_row0, LAS float* scr, int lane) {
    const int kq = lane >> 4, n4 = (lane & 15) * 4;
    f32x4 v[16];
#pragma unroll
    for (int i = 0; i < 16; ++i) v[i] = *(const GAS f32x4*)(W + (size_t)(k0 + 4 * i + kq) * N + n0 + n4);
    if (g) {
#pragma unroll
        for (int i = 0; i < 16; ++i) v[i] = v[i] * g[k0 + 4 * i + kq];
    }
#pragma unroll
    for (int i = 0; i < 16; ++i) { LAS float* d = scr + (4 * i + kq) * 65 + n4; d[0] = v[i].x; d[1] = v[i].y; d[2] = v[i].z; d[3] = v[i].w; }
    LDS_WAIT(); asm volatile("" ::: "memory");
    const int c = lane & 7;
#pragma unroll
    for (int s8 = 0; s8 < 8; ++s8) { const int n = 8 * s8 + (lane >> 3); const LAS float* s = scr + (8 * c) * 65 + n;
        v4u o; o.x = pk2(s[0 * 65], s[1 * 65]); o.y = pk2(s[2 * 65], s[3 * 65]); o.z = pk2(s[4 * 65], s[5 * 65]); o.w = pk2(s[6 * 65], s[7 * 65]);
        *(GAS v4u*)(WT + (size_t)(dst_row0 + n) * K + k0 + 8 * c) = o; }
    LDS_WAIT(); asm volatile("" ::: "memory");
}
__device__ __forceinline__ int t5_bucket(int rel) {
    const int side = rel > 0 ? 16 : 0, n = rel < 0 ? -rel : rel;
    const int large = 8 + (n >= 12) + (n >= 16) + (n >= 23) + (n >= 32) + (n >= 46) + (n >= 64) + (n >= 91);
    return side + (n < 8 ? n : large);
}
__device__ __forceinline__ void p0_prologue(Frame& F, const Args& A) {
    unsigned char* ws = A.ws;
    const int tid_ = opaque_tid(), lane = tid_ & 63, wave_ = __builtin_amdgcn_readfirstlane(tid_ >> 6);
    const int gw = F.vcu * NWAVES + wave_, NGW = F.G * NWAVES;
    LAS float* scr = (LAS float*)(F.lds + wave_ * 17408);
    constexpr int I_IN = 32 * 76, I_OUT = 32 * 32, I_MEM = 32 * 16, I_PW = 8 * 8;
    constexpr int NITEMS = DEPTH * (I_IN + I_OUT + I_MEM + I_PW);
#pragma unroll 1
    for (int it = gw; it < NITEMS; it += NGW) {
        int r = it;
        if (r < DEPTH * I_IN) { const int l = r / I_IN, q = r % I_IN, kb = q / 76, nb = q % 76, n0 = nb * 64;
            int dst; if (n0 < 512) dst = 256 * (n0 >> 7) + (n0 & 127); else if (n0 < 1024) dst = 256 * ((n0 - 512) >> 7) + 128 + (n0 & 127); else dst = n0;
            p0_transpose_item(A.in[9] + (size_t)l * DM * INDIM, DM, INDIM, A.in[8] + l * DM, (bf16*)(ws + WS_WIN) + (size_t)l * INDIM * DM, kb * 64, n0, dst, scr, lane); continue; }
        r -= DEPTH * I_IN;
        if (r < DEPTH * I_OUT) { const int l = r / I_OUT, q = r % I_OUT, kb = q / 32, nb = q % 32;
            p0_transpose_item(A.in[20] + (size_t)l * DM * DM, DM, DM, nullptr, (bf16*)(ws + WS_WOUT) + (size_t)l * DM * DM, kb * 64, nb * 64, nb * 64, scr, lane); continue; }
        r -= DEPTH * I_OUT;
        if (r < DEPTH * I_MEM) { const int l = r / I_MEM, q = r % I_MEM, kb = q / 16, nb = q % 16;
            p0_transpose_item(A.in[18] + (size_t)l * DM * 1024, DM, 1024, A.in[17] + l * DM, (bf16*)(ws + WS_WMEM) + (size_t)l * 1024 * DM, kb * 64, nb * 64, nb * 64, scr, lane); continue; }
        r -= DEPTH * I_MEM;
        { const int l = r / I_PW, q = r % I_PW, kb = q / 8, nb = q % 8;
            p0_transpose_item(A.in[14] + (size_t)l * 512 * 512, 512, 512, nullptr, (bf16*)(ws + WS_WPW) + (size_t)l * 512 * 512, kb * 64, nb * 64, nb * 64, scr, lane); }
    }
    bf16* XB = (bf16*)(ws + WS_XB); float* SSQ = (float*)(ws + WS_SSQ);
    for (int m = gw; m < MPAD; m += NGW) {
        GAS unsigned long long* o8 = (GAS unsigned long long*)(XB + (size_t)m * DM) + lane;
        if (m >= NROW) {
#pragma unroll
            for (int j = 0; j < 8; ++j) o8[64 * j] = 0ull;
            continue;
        }
        const float* src = (m < NROWP) ? A.in[0] + (size_t)m * DM : A.in[1] + (size_t)(m - NROWP) * DM;
        const GAS f32x4* xr = (const GAS f32x4*)src + lane;
        float s = 0.f;
#pragma unroll
        for (int j = 0; j < 8; ++j) { const f32x4 v = xr[64 * j]; s += (v.x * v.x + v.y * v.y) + (v.z * v.z + v.w * v.w);
            o8[64 * j] = (unsigned long long)pk2(v.x, v.y) | ((unsigned long long)pk2(v.z, v.w) << 32); }
        s = wave_sum(s);
        if (lane < 32) SSQ[(size_t)m * 32 + lane] = (lane == 0) ? s : 0.f;
    }
    for (int m = gw; m < 512; m += NGW) {
        const GAS f32x4* xr = (const GAS f32x4*)(A.in[2] + (size_t)m * DM) + lane;
        f32x4 v[8]; float s = 0.f;
#pragma unroll
        for (int j = 0; j < 8; ++j) { v[j] = xr[64 * j]; s += (v[j].x * v[j].x + v[j].y * v[j].y) + (v[j].z * v[j].z + v[j].w * v[j].w); }
        const float rstd = 1.0f / sqrtf(wave_sum(s) * (1.0f / DM) + 1e-6f);
        GAS unsigned long long* o8 = (GAS unsigned long long*)((bf16*)(ws + WS_MEMN) + (size_t)m * DM) + lane;
#pragma unroll
        for (int j = 0; j < 8; ++j) o8[64 * j] = (unsigned long long)pk2(v[j].x * rstd, v[j].y * rstd) | ((unsigned long long)pk2(v[j].z * rstd, v[j].w * rstd) << 32);
    }
    const int gt = gw * 64 + lane, NGT = NGW * 64;
    {
        const f32x4* sk = (const f32x4*)A.in[6]; const f32x4* sv = (const f32x4*)A.in[7];
        unsigned long long* dk = (unsigned long long*)(ws + WS_CMK); unsigned long long* dv = (unsigned long long*)(ws + WS_CMV);
        for (int i = gt; i < 1048576; i += NGT) { const f32x4 a = sk[i], b = sv[i];
            dk[i] = (unsigned long long)pk2(a.x, a.y) | ((unsigned long long)pk2(a.z, a.w) << 32);
            dv[i] = (unsigned long long)pk2(b.x, b.y) | ((unsigned long long)pk2(b.z, b.w) << 32); }
        const f32x4* ck = (const f32x4*)A.in[3]; const f32x4* cv = (const f32x4*)A.in[4];
        unsigned long long* ek = (unsigned long long*)(ws + WS_CSK); unsigned long long* ev = (unsigned long long*)(ws + WS_CSV);
        for (int i = gt; i < 131072; i += NGT) { const f32x4 a = ck[i], b = cv[i];
            ek[i] = (unsigned long long)pk2(a.x, a.y) | ((unsigned long long)pk2(a.z, a.w) << 32);
            ev[i] = (unsigned long long)pk2(b.x, b.y) | ((unsigned long long)pk2(b.z, b.w) << 32);
            const int lb = i >> 12, rem = i & 4095, row = rem >> 5, c4 = rem & 31;
            if (row >= 16) { const size_t o = ((size_t)lb * 128 + (row - 16)) * 128 + c4 * 4;
                *(f32x4*)(A.out + OFF_KS + o) = a; *(f32x4*)(A.out + OFF_VS + o) = b; } }
        const f32x4* cc = (const f32x4*)A.in[5];
        for (int i = gt; i < 32 * 30 * 128; i += NGT) { const int lb = i / 3840, rem = i % 3840, row = rem >> 7, c4 = rem & 127;
            if (row >= 16) *(f32x4*)(A.out + OFF_CS + ((size_t)lb * 30 + (row - 16)) * 512 + c4 * 4) = cc[i]; }
        float* BT = (float*)(ws + WS_BT);
        for (int i = gt; i < 16 * 256; i += NGT) { const int h = i >> 8, idx = i & 255; const int rel = idx - 191;
            BT[i] = (idx < 255) ? A.in[19][t5_bucket(rel) * 16 + h] * LOG2E : 0.f; }
    }
}

struct KSrc { const bf16* p0; int pitch0; int n0; const bf16* p1; int pitch1; };
__device__ __forceinline__ const bf16* ks_row(const KSrc& s, int j) { return j < s.n0 ? s.p0 + (long)j * s.pitch0 : s.p1 + (long)(j - s.n0) * s.pitch1; }

template <int HD, bool SWA>
__device__ __forceinline__ void naive_attn(float* S, float* INV, const bf16* Q, int qpitch, int nq, KSrc ks, KSrc vs, int jlo, int nk,
                                           const float* btab, float sink2, const bf16* gate, int gpitch, bf16* out, int opitch) {
    const int tid = opaque_tid(), lane = tid & 63, wave = tid >> 6;
#pragma unroll 1
    for (int idx = tid; idx < nq * nk; idx += NTHREADS) {
        const int i = idx / nk, j = idx - i * nk;
        float s;
        if (j < jlo) s = -1e30f;
        else {
            const bf16* q = Q + (long)i * qpitch; const bf16* k = ks_row(ks, j);
            float a = 0.f;
#pragma unroll 2
            for (int d = 0; d < HD; d += 8) {
                const v4u qv = *(const v4u*)(q + d), kv = *(const v4u*)(k + d);
                a += __builtin_bit_cast(float, qv.x << 16) * __builtin_bit_cast(float, kv.x << 16) + __builtin_bit_cast(float, qv.x & 0xffff0000u) * __builtin_bit_cast(float, kv.x & 0xffff0000u);
                a += __builtin_bit_cast(float, qv.y << 16) * __builtin_bit_cast(float, kv.y << 16) + __builtin_bit_cast(float, qv.y & 0xffff0000u) * __builtin_bit_cast(float, kv.y & 0xffff0000u);
                a += __builtin_bit_cast(float, qv.z << 16) * __builtin_bit_cast(float, kv.z << 16) + __builtin_bit_cast(float, qv.z & 0xffff0000u) * __builtin_bit_cast(float, kv.z & 0xffff0000u);
                a += __builtin_bit_cast(float, qv.w << 16) * __builtin_bit_cast(float, kv.w << 16) + __builtin_bit_cast(float, qv.w & 0xffff0000u) * __builtin_bit_cast(float, kv.w & 0xffff0000u);
            }
            s = a; if (SWA) s += btab[j - i + 63];
        }
        S[i * 257 + j] = s;
    }
    __syncthreads();
    for (int i = wave; i < nq; i += NWAVES) {
        float m = SWA ? sink2 : -3.0e38f;
        for (int j = lane; j < nk; j += 64) m = fmaxf(m, S[i * 257 + j]);
        m = wave_max(m);
        float sum = 0.f;
        for (int j = lane; j < nk; j += 64) { const float p = exp2f(S[i * 257 + j] - m); sum += p; S[i * 257 + j] = rbf(p); }
        sum = wave_sum(sum);
        if (SWA) sum += exp2f(sink2 - m);
        if (lane == 0) INV[i] = 1.0f / sum;
    }
    __syncthreads();
#pragma unroll 1
    for (int idx = tid; idx < nq * HD; idx += NTHREADS) {
        const int i = idx / HD, d = idx % HD;
        float o = 0.f;
#pragma unroll 4
        for (int j = jlo; j < nk; ++j) o += S[i * 257 + j] * bf2f(ks_row(vs, j)[d]);
        o *= INV[i];
        o *= bf2f(gate[(long)i * gpitch + d]);
        out[(long)i * opitch + d] = (bf16)f2bf(o);
    }
    __syncthreads();
}

__device__ __forceinline__ void naive_conv(float* C, const bf16* Useq, int t0, int nfr, const float* left, const float* cw, const float* cb, const float* lng, const float* lnb,
                                           const float* wpw  , const float* bpw, const bf16* gate  , bf16* out  ) {
    const int tid = opaque_tid(), lane = tid & 63, wave = tid >> 6;
    {
        const int ch = tid;
        float w[31];
#pragma unroll
        for (int j = 0; j < 31; ++j) w[j] = cw[j * 512 + ch];
        const float b = cb[ch];
#pragma unroll 1
        for (int tt = 0; tt < 64; ++tt) {
            float a = 0.f;
            if (tt < nfr) {
                a = b;
#pragma unroll
                for (int j = 0; j < 31; ++j) { const int e = t0 + tt - 30 + j;
                    const float uv = (e >= 0) ? bf2f(Useq[(long)e * ZP + ch]) : (left ? left[(30 + e) * 512 + ch] : 0.f);
                    a += w[j] * uv; }
            }
            C[tt * 516 + ch] = a;
        }
    }
    __syncthreads();
    for (int tt = wave; tt < 64; tt += NWAVES) {
        float v[8]; float s = 0.f;
#pragma unroll
        for (int j = 0; j < 8; ++j) { v[j] = C[tt * 516 + lane + 64 * j]; s += v[j]; }
        const float mu = wave_sum(s) * (1.0f / 512.0f); float q = 0.f;
#pragma unroll
        for (int j = 0; j < 8; ++j) { v[j] -= mu; q += v[j] * v[j]; }
        const float rstd = 1.0f / sqrtf(wave_sum(q) * (1.0f / 512.0f) + 1e-6f);
#pragma unroll
        for (int j = 0; j < 8; ++j) { const int ch = lane + 64 * j; const float y = v[j] * rstd * lng[ch] + lnb[ch]; C[tt * 516 + ch] = rbf(y / (1.0f + __expf(-y))); }
    }
    __syncthreads();
    {
        const int n = tid;
        const float bb = bpw[n];
#pragma unroll 1
        for (int tg = 0; tg < 64; tg += 16) {
            if (tg >= nfr) break;
            float acc[16];
#pragma unroll
            for (int tt = 0; tt < 16; ++tt) acc[tt] = 0.f;
#pragma unroll 1
            for (int k = 0; k < 512; k += 4) {
                const float w0 = rbf(wpw[(size_t)(k + 0) * 512 + n]), w1 = rbf(wpw[(size_t)(k + 1) * 512 + n]), w2 = rbf(wpw[(size_t)(k + 2) * 512 + n]), w3 = rbf(wpw[(size_t)(k + 3) * 512 + n]);
#pragma unroll
                for (int tt = 0; tt < 16; ++tt) { const f32x4 c = *(const f32x4*)(C + (tg + tt) * 516 + k); acc[tt] += (c.x * w0 + c.y * w1) + (c.z * w2 + c.w * w3); }
            }
#pragma unroll
            for (int tt = 0; tt < 16; ++tt) if (tg + tt < nfr) out[(long)(tg + tt) * DM + n] = (bf16)f2bf((acc[tt] + bb) * bf2f(gate[(long)(tg + tt) * ZP + n]));
        }
    }
    __syncthreads();
}

__device__ __forceinline__ void naive_mixer_phase(Frame& F, const Args& A, int l) {
    unsigned char* ws = A.ws;
    float* S = (float*)F.glds;
    float* INV = S + 64 * 257;
    const bf16* Z = (const bf16*)(ws + WS_Z); bf16* Y = (bf16*)(ws + WS_YMIX);
    const float* BT = (const float*)(ws + WS_BT);
    constexpr int U0 = 128, U1 = U0 + 8, U2 = U1 + 512, U3 = U2 + 32, U4 = U3 + 2048, U5 = U4 + 128;
    for (int u = blockIdx.x; u < U5; u += F.G) {
        if (!((A.mix_mask >> (u < U1 ? 0 : (u < U3 ? 1 : 2))) & 1)) continue;
        if (u < U1) {
            int rowbase, t0, nfr; const float* left = nullptr;
            if (u < U0) { const int b = u >> 6, c = u & 63; rowbase = b * SEQ; t0 = c * 64; nfr = 64; }
            else { const int b = u - U0; rowbase = NROWP + b * NSS; t0 = 0; nfr = NSS; left = A.in[5] + (size_t)(l * 8 + b) * 30 * 512; }
            naive_conv(S, Z + (size_t)rowbase * ZP + ZC_U, t0, nfr, left, A.in[10] + l * 31 * 512, A.in[11] + l * 512, A.in[12] + l * 512, A.in[13] + l * 512,
                       A.in[14] + (size_t)l * 512 * 512, A.in[15] + l * 512, Z + (size_t)(rowbase + t0) * ZP + ZC_GA, Y + (size_t)(rowbase + t0) * DM);
        } else if (u < U3) {
            int row0, nq, h; KSrc ks, vs;
            if (u < U2) { const int v = u - U1, b = v >> 8, h_ = (v >> 6) & 3, qt = v & 63; h = h_; row0 = b * SEQ + qt * 64; nq = 64;
                const bf16* kb = (const bf16*)(ws + WS_MKVP) + (size_t)(b * 256) * 4096 + l * 1024 + h * 128;
                ks = KSrc{kb, 4096, 256, kb, 4096}; vs = KSrc{kb + 512, 4096, 256, kb + 512, 4096}; }
            else { const int v = u - U2, b = v >> 2; h = v & 3; row0 = NROWP + b * NSS; nq = NSS;
                const bf16* kb = (const bf16*)(ws + WS_CMK) + (size_t)((l * 8 + b) * 256) * 512 + h * 128; const bf16* vb = (const bf16*)(ws + WS_CMV) + (size_t)((l * 8 + b) * 256) * 512 + h * 128;
                ks = KSrc{kb, 512, 256, kb, 512}; vs = KSrc{vb, 512, 256, vb, 512}; }
            naive_attn<128, false>(S, INV, Z + (size_t)row0 * ZP + ZC_CQ + h * 128, ZP, nq, ks, vs, 0, 256, nullptr, 0.f,
                                   Z + (size_t)row0 * ZP + ZC_GC + h * 128, ZP, Y + (size_t)row0 * DM + 1536 + h * 128, DM);
        } else {
            int row0, nq, h, jlo, nk; KSrc ks, vs;
            if (u < U4) { const int v = u - U3, b = v >> 10, c = (v >> 4) & 63; h = v & 15; row0 = b * SEQ + c * 64; nq = 64; const int kv = h >> 3;
                const bf16* kb = Z + ((long)row0 - 128) * ZP + ZC_K + kv * 64;
                ks = KSrc{kb, ZP, 192, kb, ZP}; vs = KSrc{kb + (ZC_V - ZC_K), ZP, 192, kb + (ZC_V - ZC_K), ZP}; jlo = (c >= 2) ? 0 : 128 - 64 * c; nk = 192; }
            else { const int v = u - U4, b = v >> 4; h = v & 15; row0 = NROWP + b * NSS; nq = NSS; const int kv = h >> 3;
                const bf16* ck = (const bf16*)(ws + WS_CSK) + (size_t)((l * 8 + b) * 128) * 128 + kv * 64; const bf16* cv = (const bf16*)(ws + WS_CSV) + (size_t)((l * 8 + b) * 128) * 128 + kv * 64;
                const bf16* zk = Z + (size_t)row0 * ZP + ZC_K + kv * 64;
                ks = KSrc{ck, 128, 128, zk, ZP}; vs = KSrc{cv, 128, 128, zk + (ZC_V - ZC_K), ZP}; jlo = 0; nk = 144; }
            naive_attn<64, true>(S, INV, Z + (size_t)row0 * ZP + ZC_Q + h * 64, ZP, nq, ks, vs, jlo, nk, BT + h * 256, A.in[16][l * 16 + h] * LOG2E,
                                 Z + (size_t)row0 * ZP + ZC_GB + h * 64, ZP, Y + (size_t)row0 * DM + 512 + h * 64, DM);
        }
    }
}

typedef float f32x16 __attribute__((ext_vector_type(16)));
typedef short s16x4 __attribute__((ext_vector_type(4)));
__device__ __forceinline__ bf16x8 pack_bf16x8(float a0, float a1, float a2, float a3, float a4, float a5, float a6, float a7) {
    v4u w; w.x = pg8::cvt_pk_bf16(a0, a1); w.y = pg8::cvt_pk_bf16(a2, a3); w.z = pg8::cvt_pk_bf16(a4, a5); w.w = pg8::cvt_pk_bf16(a6, a7);
    return __builtin_bit_cast(bf16x8, w);
}
__device__ __forceinline__ bf16x8 join4(s16x4 lo, s16x4 hi) { return (bf16x8){lo[0], lo[1], lo[2], lo[3], hi[0], hi[1], hi[2], hi[3]}; }
__device__ __forceinline__ float ex2(float x) { return __builtin_amdgcn_exp2f(x); }

constexpr int SW_KP = 144, SW_VP = 408;
constexpr int SW_KS = 0, SW_VT = 192 * SW_KP, SW_BT = SW_VT + 64 * SW_VP, SW_END = SW_BT + 8 * 256 * 4;
__device__ __forceinline__ int swa_vt_off(int d, int key) { return d * SW_VP + ((((key >> 2) ^ ((d >> 3) & 7))) << 3) + (key & 3) * 2; }
struct SwaUnit { const bf16* q; int nq; KSrc ks, vs; int jlo, nk; const bf16* gate; bf16* out; int kvh; };

__device__ __forceinline__ void swa_unit(LAS unsigned char* L, const SwaUnit& U, const float* BT, const float* sinks) {
    const int tid = opaque_tid(), lane = tid & 63, wave = __builtin_amdgcn_readfirstlane(tid >> 6);
    typedef unsigned u32x2v __attribute__((ext_vector_type(2)));
    const int i32 = lane & 31, hf = lane >> 5, g = wave;
    v4u kreg[3], va[2], vb[2]; float btv[4]; bf16x8 qf[2][4]; u32x2v gv[2][2][4];
#pragma unroll
    for (int it = 0; it < 3; ++it) {
        const int t = tid + NTHREADS * it, row = t >> 3, c8 = t & 7;
        kreg[it] = (v4u){0u, 0u, 0u, 0u};
        if (row >= U.jlo && row < U.nk) kreg[it] = *(const v4u*)(ks_row(U.ks, row) + c8 * 8);
    }
#pragma unroll
    for (int it = 0; it < 2; ++it) {
        const int t = tid + NTHREADS * it, rp = t >> 3, c8 = t & 7, j0 = 2 * rp;
        va[it] = (v4u){0u, 0u, 0u, 0u}; vb[it] = (v4u){0u, 0u, 0u, 0u};
        if (t < 768) {
            if (j0 >= U.jlo && j0 < U.nk) va[it] = *(const v4u*)(ks_row(U.vs, j0) + c8 * 8);
            if (j0 + 1 >= U.jlo && j0 + 1 < U.nk) vb[it] = *(const v4u*)(ks_row(U.vs, j0 + 1) + c8 * 8);
        }
    }
#pragma unroll
    for (int it = 0; it < 4; ++it) btv[it] = BT[U.kvh * 8 * 256 + tid + NTHREADS * it];
#pragma unroll
    for (int qb = 0; qb < 2; ++qb) {
        const int i = qb * 32 + i32, iq = (i < U.nq) ? i : 0;
        const bf16* qrow = U.q + (long)iq * ZP + g * 64;
#pragma unroll
        for (int ds = 0; ds < 4; ++ds) qf[qb][ds] = *(const bf16x8*)(qrow + 16 * ds + 8 * hf);
#pragma unroll
        for (int dt = 0; dt < 2; ++dt)
#pragma unroll
            for (int g4 = 0; g4 < 4; ++g4) gv[qb][dt][g4] = *(const u32x2v*)(U.gate + (long)iq * ZP + g * 64 + dt * 32 + 8 * g4 + 4 * hf);
    }
    const float sink2 = sinks[U.kvh * 8 + g] * LOG2E;
#pragma unroll
    for (int it = 0; it < 3; ++it) { const int t = tid + NTHREADS * it, row = t >> 3, c8 = t & 7; *(LAS v4u*)(L + SW_KS + row * SW_KP + c8 * 16) = kreg[it]; }
#pragma unroll
    for (int it = 0; it < 2; ++it) {
        const int t = tid + NTHREADS * it, rp = t >> 3, c8 = t & 7, j0 = 2 * rp;
        if (t < 768) {
#pragma unroll
            for (int e = 0; e < 8; ++e) {
                const unsigned lo = (va[it][e >> 1] >> (16 * (e & 1))) & 0xffffu, hi = (vb[it][e >> 1] >> (16 * (e & 1))) & 0xffffu;
                *(LAS unsigned*)(L + SW_VT + swa_vt_off(c8 * 8 + e, j0)) = lo | (hi << 16);
            }
        }
    }
#pragma unroll
    for (int it = 0; it < 4; ++it) ((LAS float*)(L + SW_BT))[tid + NTHREADS * it] = btv[it];
    __syncthreads();
    const LAS float* bt = (const LAS float*)(L + SW_BT) + g * 256;
#pragma unroll
    for (int qb = 0; qb < 2; ++qb) {
        if (qb * 32 < U.nq) {
        const int i = qb * 32 + i32;
        f32x16 S[6];
        {
            bf16x8 kf[2][4];
#pragma unroll
            for (int ds = 0; ds < 4; ++ds) kf[0][ds] = *(const LAS bf16x8*)(L + SW_KS + (0 * 32 + i32) * SW_KP + ds * 32 + hf * 16);
#pragma unroll
            for (int kt = 0; kt < 6; ++kt) {
                if (kt + 1 < 6) {
#pragma unroll
                    for (int ds = 0; ds < 4; ++ds) kf[(kt + 1) & 1][ds] = *(const LAS bf16x8*)(L + SW_KS + ((kt + 1) * 32 + i32) * SW_KP + ds * 32 + hf * 16);
                }
                f32x16 acc = {};
#pragma unroll
                for (int ds = 0; ds < 4; ++ds) acc = __builtin_amdgcn_mfma_f32_32x32x16_bf16(kf[kt & 1][ds], qf[qb][ds], acc, 0, 0, 0);
                S[kt] = acc;
            }
        }
        float m = sink2;
#pragma unroll
        for (int kt = 0; kt < 6; ++kt)
#pragma unroll
            for (int r = 0; r < 16; ++r) {
                const int j = kt * 32 + (r & 3) + 8 * (r >> 2) + 4 * hf;
                float s = S[kt][r] + bt[j - i + 63];
                if (j < U.jlo || j >= U.nk) s = -1e30f;
                S[kt][r] = s; m = fmaxf(m, s);
            }
        m = fmaxf(m, __shfl_xor(m, 32));
        float lsum = 0.f;
#pragma unroll
        for (int kt = 0; kt < 6; ++kt)
#pragma unroll
            for (int r = 0; r < 16; ++r) { const float p = ex2(S[kt][r] - m); S[kt][r] = p; lsum += p; }
        lsum += __shfl_xor(lsum, 32);
        const float inv = 1.0f / (lsum + ex2(sink2 - m));
        f32x16 O[2]; O[0] = (f32x16){}; O[1] = (f32x16){};
        {
            s16x4 vq[2][2][2][2];
#pragma unroll
            for (int s2 = 0; s2 < 2; ++s2)
#pragma unroll
                for (int dt = 0; dt < 2; ++dt) { const int d = dt * 32 + i32, key0 = 16 * s2 + 4 * hf;
                    vq[0][s2][dt][0] = *(const LAS s16x4*)(L + SW_VT + swa_vt_off(d, key0)); vq[0][s2][dt][1] = *(const LAS s16x4*)(L + SW_VT + swa_vt_off(d, key0 + 8)); }
#pragma unroll
            for (int kt = 0; kt < 6; ++kt) {
                if (kt + 1 < 6) {
#pragma unroll
                    for (int s2 = 0; s2 < 2; ++s2)
#pragma unroll
                        for (int dt = 0; dt < 2; ++dt) { const int d = dt * 32 + i32, key0 = (kt + 1) * 32 + 16 * s2 + 4 * hf;
                            vq[(kt + 1) & 1][s2][dt][0] = *(const LAS s16x4*)(L + SW_VT + swa_vt_off(d, key0)); vq[(kt + 1) & 1][s2][dt][1] = *(const LAS s16x4*)(L + SW_VT + swa_vt_off(d, key0 + 8)); }
                }
#pragma unroll
                for (int s2 = 0; s2 < 2; ++s2) {
                    const bf16x8 pf = pack_bf16x8(S[kt][8 * s2 + 0], S[kt][8 * s2 + 1], S[kt][8 * s2 + 2], S[kt][8 * s2 + 3], S[kt][8 * s2 + 4], S[kt][8 * s2 + 5], S[kt][8 * s2 + 6], S[kt][8 * s2 + 7]);
#pragma unroll
                    for (int dt = 0; dt < 2; ++dt) O[dt] = __builtin_amdgcn_mfma_f32_32x32x16_bf16(join4(vq[kt & 1][s2][dt][0], vq[kt & 1][s2][dt][1]), pf, O[dt], 0, 0, 0);
                }
            }
        }
        if (i < U.nq) {
#pragma unroll
            for (int dt = 0; dt < 2; ++dt)
#pragma unroll
                for (int g4 = 0; g4 < 4; ++g4) {
                    const int d0 = dt * 32 + 8 * g4 + 4 * hf;
                    const u32x2v gg = gv[qb][dt][g4];
                    const float o0 = O[dt][4 * g4 + 0] * inv * __builtin_bit_cast(float, gg.x << 16), o1 = O[dt][4 * g4 + 1] * inv * __builtin_bit_cast(float, gg.x & 0xffff0000u);
                    const float o2 = O[dt][4 * g4 + 2] * inv * __builtin_bit_cast(float, gg.y << 16), o3 = O[dt][4 * g4 + 3] * inv * __builtin_bit_cast(float, gg.y & 0xffff0000u);
                    u32x2v w; w.x = pg8::cvt_pk_bf16(o0, o1); w.y = pg8::cvt_pk_bf16(o2, o3);
                    *(u32x2v*)(U.out + (long)i * DM + g * 64 + d0) = w;
                }
        }
        }
    }
    __syncthreads();
}

constexpr int MA_KP = 272, MA_VP = 528;
constexpr int MA_KS = 0, MA_VT = 256 * MA_KP, MA_END = MA_VT + 128 * MA_VP;
__device__ __forceinline__ int ma_vt_off(int d, int key) { return d * MA_VP + ((((key >> 2) ^ ((d >> 3) & 15))) << 3) + (key & 3) * 2; }
struct MemUnit { const bf16* q; int nq; const bf16* k; const bf16* v; int pitch; const bf16* gate; bf16* out; };

__device__ __forceinline__ void mem_unit(LAS unsigned char* L, const MemUnit& U) {
    typedef unsigned u32x2v __attribute__((ext_vector_type(2)));
    const int tid = opaque_tid(), lane = tid & 63, wave = __builtin_amdgcn_readfirstlane(tid >> 6);
    const int i16 = lane & 15, q4 = lane >> 4;
    bf16x8 qf[2][4]; u32x2v gv[2][8];
#pragma unroll
    for (int gi = 0; gi < 2; ++gi) {
        const int grp = wave + NWAVES * gi, i = (grp * 16 < U.nq) ? grp * 16 + i16 : i16;
        const bf16* qrow = U.q + (long)i * ZP;
#pragma unroll
        for (int ds = 0; ds < 4; ++ds) qf[gi][ds] = *(const bf16x8*)(qrow + 32 * ds + 8 * q4);
#pragma unroll
        for (int dt = 0; dt < 8; ++dt) gv[gi][dt] = *(const u32x2v*)(U.gate + (long)i * ZP + dt * 16 + 4 * q4);
    }
    {
        v4u kr[8];
#pragma unroll
        for (int it = 0; it < 8; ++it) { const int t = tid + NTHREADS * it, row = t >> 4, c8 = t & 15; kr[it] = *(const v4u*)(U.k + (long)row * U.pitch + c8 * 8); }
#pragma unroll
        for (int it = 0; it < 8; ++it) { const int t = tid + NTHREADS * it, row = t >> 4, c8 = t & 15; *(LAS v4u*)(L + MA_KS + row * MA_KP + c8 * 16) = kr[it]; }
    }
    {
        v4u va[4], vb[4];
#pragma unroll
        for (int it = 0; it < 4; ++it) { const int t = tid + NTHREADS * it, rp = t >> 4, c8 = t & 15, j0 = 2 * rp;
            va[it] = *(const v4u*)(U.v + (long)j0 * U.pitch + c8 * 8); vb[it] = *(const v4u*)(U.v + (long)(j0 + 1) * U.pitch + c8 * 8); }
#pragma unroll
        for (int it = 0; it < 4; ++it) { const int t = tid + NTHREADS * it, rp = t >> 4, c8 = t & 15, j0 = 2 * rp;
#pragma unroll
            for (int e = 0; e < 8; ++e) {
                const unsigned lo = (va[it][e >> 1] >> (16 * (e & 1))) & 0xffffu, hi = (vb[it][e >> 1] >> (16 * (e & 1))) & 0xffffu;
                *(LAS unsigned*)(L + MA_VT + ma_vt_off(c8 * 8 + e, j0)) = lo | (hi << 16);
            } }
    }
    __syncthreads();
#pragma unroll
    for (int gi = 0; gi < 2; ++gi) {
        const int grp = wave + NWAVES * gi;
        if (grp * 16 < U.nq) {
        const int i = grp * 16 + i16;
        f32x4 S[16];
        {
            bf16x8 kf[2][2][4];
#pragma unroll
            for (int t2 = 0; t2 < 2; ++t2)
#pragma unroll
                for (int ds = 0; ds < 4; ++ds) kf[0][t2][ds] = *(const LAS bf16x8*)(L + MA_KS + (t2 * 16 + i16) * MA_KP + ds * 64 + q4 * 16);
#pragma unroll
            for (int kp = 0; kp < 8; ++kp) {
                if (kp + 1 < 8) {
#pragma unroll
                    for (int t2 = 0; t2 < 2; ++t2)
#pragma unroll
                        for (int ds = 0; ds < 4; ++ds) kf[(kp + 1) & 1][t2][ds] = *(const LAS bf16x8*)(L + MA_KS + (((kp + 1) * 2 + t2) * 16 + i16) * MA_KP + ds * 64 + q4 * 16);
                }
#pragma unroll
                for (int t2 = 0; t2 < 2; ++t2) {
                    f32x4 acc = {};
#pragma unroll
                    for (int ds = 0; ds < 4; ++ds) acc = __builtin_amdgcn_mfma_f32_16x16x32_bf16(kf[kp & 1][t2][ds], qf[gi][ds], acc, 0, 0, 0);
                    S[kp * 2 + t2] = acc;
                }
            }
        }
        float m = -3.0e38f;
#pragma unroll
        for (int kt = 0; kt < 16; ++kt) m = fmaxf(fmaxf(m, fmaxf(S[kt][0], S[kt][1])), fmaxf(S[kt][2], S[kt][3]));
        m = fmaxf(m, __shfl_xor(m, 16)); m = fmaxf(m, __shfl_xor(m, 32));
        float lsum = 0.f;
#pragma unroll
        for (int kt = 0; kt < 16; ++kt)
#pragma unroll
            for (int r = 0; r < 4; ++r) { const float p = ex2(S[kt][r] - m); S[kt][r] = p; lsum += p; }
        lsum += __shfl_xor(lsum, 16); lsum += __shfl_xor(lsum, 32);
        const float inv = 1.0f / lsum;
        f32x4 O[8];
#pragma unroll
        for (int dt = 0; dt < 8; ++dt) O[dt] = (f32x4){0.f, 0.f, 0.f, 0.f};
        {
            s16x4 vq[2][8][2];
#pragma unroll
            for (int dt = 0; dt < 8; ++dt) { const int d = dt * 16 + i16, key0 = 4 * q4;
                vq[0][dt][0] = *(const LAS s16x4*)(L + MA_VT + ma_vt_off(d, key0)); vq[0][dt][1] = *(const LAS s16x4*)(L + MA_VT + ma_vt_off(d, key0 + 16)); }
#pragma unroll
            for (int st = 0; st < 8; ++st) {
                if (st + 1 < 8) {
#pragma unroll
                    for (int dt = 0; dt < 8; ++dt) { const int d = dt * 16 + i16, key0 = 32 * (st + 1) + 4 * q4;
                        vq[(st + 1) & 1][dt][0] = *(const LAS s16x4*)(L + MA_VT + ma_vt_off(d, key0)); vq[(st + 1) & 1][dt][1] = *(const LAS s16x4*)(L + MA_VT + ma_vt_off(d, key0 + 16)); }
                }
                const bf16x8 pf = pack_bf16x8(S[2 * st][0], S[2 * st][1], S[2 * st][2], S[2 * st][3], S[2 * st + 1][0], S[2 * st + 1][1], S[2 * st + 1][2], S[2 * st + 1][3]);
#pragma unroll
                for (int dt = 0; dt < 8; ++dt) O[dt] = __builtin_amdgcn_mfma_f32_16x16x32_bf16(join4(vq[st & 1][dt][0], vq[st & 1][dt][1]), pf, O[dt], 0, 0, 0);
            }
        }
#pragma unroll
        for (int dt = 0; dt < 8; ++dt) {
            const int d0 = dt * 16 + 4 * q4;
            const u32x2v gg = gv[gi][dt];
            const float o0 = O[dt][0] * inv * __builtin_bit_cast(float, gg.x << 16), o1 = O[dt][1] * inv * __builtin_bit_cast(float, gg.x & 0xffff0000u);
            const float o2 = O[dt][2] * inv * __builtin_bit_cast(float, gg.y << 16), o3 = O[dt][3] * inv * __builtin_bit_cast(float, gg.y & 0xffff0000u);
            u32x2v w; w.x = pg8::cvt_pk_bf16(o0, o1); w.y = pg8::cvt_pk_bf16(o2, o3);
            *(u32x2v*)(U.out + (long)i * DM + d0) = w;
        }
        }
    }
    __syncthreads();
}

typedef float cv_f32x2 __attribute__((ext_vector_type(2)));
template <int R> __device__ __forceinline__ void conv_rows(cv_f32x2 (&acc)[32], const cv_f32x2 (&w)[31], const unsigned (&raw)[62], bool neg, const float* left, int ch) {
    cv_f32x2 x = (cv_f32x2){__builtin_bit_cast(float, raw[R] << 16), __builtin_bit_cast(float, raw[R] & 0xffff0000u)};
    constexpr int TLO = (R > 30) ? R - 30 : 0, THI = (R < 31) ? R : 31;
#pragma unroll
    for (int tt = TLO; tt <= THI; ++tt) acc[tt] += w[R - tt] * x;
    if constexpr (R + 1 < 62) conv_rows<R + 1>(acc, w, raw, neg, left, ch);
}
constexpr int CV_P = 2064;
__device__ __forceinline__ void conv_unit(LAS unsigned char* L, const bf16* Useq, int t0, int nfr, const float* left, const float* cw, const float* cb, const float* lng, const float* lnb,
                                          const bf16* WpwT, const float* bpw, const bf16* gate, bf16* out) {
    typedef float f32x2 __attribute__((ext_vector_type(2)));
    const int tid = opaque_tid(), lane = tid & 63, wave = __builtin_amdgcn_readfirstlane(tid >> 6);
    {
        const int cp = tid & 255, fh = __builtin_amdgcn_readfirstlane(tid >> 8), ch = 2 * cp;
        f32x2 w[31];
#pragma unroll
        for (int j = 0; j < 31; ++j) w[j] = *(const f32x2*)(cw + j * 512 + ch);
        const f32x2 bias = *(const f32x2*)(cb + ch);
        f32x2 acc[32];
#pragma unroll
        for (int tt = 0; tt < 32; ++tt) acc[tt] = bias;
        const int tbase = t0 + 32 * fh;
        unsigned raw[62];
        if (tbase == 0) {
#pragma unroll
            for (int r = 0; r < 30; ++r) raw[r] = 0u;
            if (left) {
                cv_f32x2 lf[30];
#pragma unroll
                for (int r = 0; r < 30; ++r) lf[r] = *(const cv_f32x2*)(left + r * 512 + ch);
#pragma unroll
                for (int r = 0; r < 30; ++r) raw[r] = pg8::cvt_pk_bf16(lf[r].x, lf[r].y);
            }
#pragma unroll
            for (int r = 30; r < 62; ++r) raw[r] = *(const unsigned*)(Useq + (long)(r - 30) * ZP + ch);
        } else {
#pragma unroll
            for (int r = 0; r < 62; ++r) raw[r] = *(const unsigned*)(Useq + (long)(tbase - 30 + r) * ZP + ch);
        }
        conv_rows<0>(acc, w, raw, false, left, ch);
#pragma unroll
        for (int tt = 0; tt < 32; ++tt) { const int fr_ = 32 * fh + tt; *(LAS f32x2*)(L + fr_ * CV_P + ch * 4) = (fr_ < nfr) ? acc[tt] : (f32x2){0.f, 0.f}; }
    }
    __syncthreads();
    {
        const f32x4 g0 = *(const f32x4*)(lng + 8 * lane), g1 = *(const f32x4*)(lng + 8 * lane + 4), b0 = *(const f32x4*)(lnb + 8 * lane), b1 = *(const f32x4*)(lnb + 8 * lane + 4);
        f32x4 a[8], b[8]; float sm[8];
#pragma unroll
        for (int f = 0; f < 8; ++f) { const LAS unsigned char* row = L + (wave + NWAVES * f) * CV_P; a[f] = *(const LAS f32x4*)(row + 32 * lane); b[f] = *(const LAS f32x4*)(row + 32 * lane + 16);
            sm[f] = ((a[f][0] + a[f][1]) + (a[f][2] + a[f][3])) + ((b[f][0] + b[f][1]) + (b[f][2] + b[f][3])); }
#pragma unroll
        for (int o = 1; o < 64; o <<= 1)
#pragma unroll
            for (int f = 0; f < 8; ++f) sm[f] += __shfl_xor(sm[f], o);
#pragma unroll
        for (int f = 0; f < 8; ++f) { const float mu = sm[f] * (1.0f / 512.0f); a[f] = a[f] - mu; b[f] = b[f] - mu;
            sm[f] = ((a[f][0] * a[f][0] + a[f][1] * a[f][1]) + (a[f][2] * a[f][2] + a[f][3] * a[f][3])) + ((b[f][0] * b[f][0] + b[f][1] * b[f][1]) + (b[f][2] * b[f][2] + b[f][3] * b[f][3])); }
#pragma unroll
        for (int o = 1; o < 64; o <<= 1)
#pragma unroll
            for (int f = 0; f < 8; ++f) sm[f] += __shfl_xor(sm[f], o);
#pragma unroll
        for (int f = 0; f < 8; ++f) { const float rstd = __builtin_amdgcn_rsqf(sm[f] * (1.0f / 512.0f) + 1e-6f);
            f32x4 ya = a[f] * rstd * g0 + b0, yb = b[f] * rstd * g1 + b1;
            ya = ya * pg8::sigmoid4(ya); yb = yb * pg8::sigmoid4(yb);
            *(LAS v4u*)(L + (wave + NWAVES * f) * CV_P + 16 * lane) = __builtin_bit_cast(v4u, pg8::pack8(ya, yb)); }
    }
    __syncthreads();
    {
        typedef unsigned u32x2v __attribute__((ext_vector_type(2)));
        const int i16 = lane & 15, q4 = lane >> 4;
        f32x4 acc[4][4];
#pragma unroll
        for (int rt = 0; rt < 4; ++rt)
#pragma unroll
            for (int nt = 0; nt < 4; ++nt) acc[rt][nt] = (f32x4){0.f, 0.f, 0.f, 0.f};
        const bf16* wbase = WpwT + (size_t)(64 * wave + i16) * 512 + 8 * q4;
        {
            constexpr int WD = 8;
            bf16x8 wf[WD][4], cf[2][4];
#pragma unroll
            for (int k4 = 0; k4 < WD; ++k4)
#pragma unroll
                for (int nt = 0; nt < 4; ++nt) wf[k4][nt] = *(const bf16x8*)(wbase + nt * 16 * 512 + k4 * 32);
            __builtin_amdgcn_sched_barrier(0);
#pragma unroll
            for (int rt = 0; rt < 4; ++rt) cf[0][rt] = *(const LAS bf16x8*)(L + (rt * 16 + i16) * CV_P + q4 * 16);
#pragma unroll
            for (int ks = 0; ks < 16; ++ks) {
                if (ks + 1 < 16) {
#pragma unroll
                    for (int rt = 0; rt < 4; ++rt) cf[(ks + 1) & 1][rt] = *(const LAS bf16x8*)(L + (rt * 16 + i16) * CV_P + (ks + 1) * 64 + q4 * 16);
                }
#pragma unroll
                for (int rt = 0; rt < 4; ++rt)
#pragma unroll
                    for (int nt = 0; nt < 4; ++nt) acc[rt][nt] = __builtin_amdgcn_mfma_f32_16x16x32_bf16(wf[ks % WD][nt], cf[ks & 1][rt], acc[rt][nt], 0, 0, 0);
                if (ks + WD < 16) {
#pragma unroll
                    for (int nt = 0; nt < 4; ++nt) wf[ks % WD][nt] = *(const bf16x8*)(wbase + nt * 16 * 512 + (ks + WD) * 32);
                }
                __builtin_amdgcn_sched_barrier(0);
            }
        }
        f32x4 bb[4]; u32x2v gvv[4][4];
#pragma unroll
        for (int nt = 0; nt < 4; ++nt) bb[nt] = *(const f32x4*)(bpw + 64 * wave + nt * 16 + 4 * q4);
#pragma unroll
        for (int rt = 0; rt < 4; ++rt) { const int frame = rt * 16 + i16, fl = frame < nfr ? frame : 0;
#pragma unroll
            for (int nt = 0; nt < 4; ++nt) gvv[rt][nt] = *(const u32x2v*)(gate + (long)fl * ZP + 64 * wave + nt * 16 + 4 * q4); }
#pragma unroll
        for (int rt = 0; rt < 4; ++rt) {
            const int frame = rt * 16 + i16;
            if (frame < nfr) {
#pragma unroll
                for (int nt = 0; nt < 4; ++nt) {
                    const int n0 = 64 * wave + nt * 16 + 4 * q4;
                    const u32x2v gv = gvv[rt][nt];
                    const float o0 = (acc[rt][nt][0] + bb[nt][0]) * __builtin_bit_cast(float, gv.x << 16), o1 = (acc[rt][nt][1] + bb[nt][1]) * __builtin_bit_cast(float, gv.x & 0xffff0000u);
                    const float o2 = (acc[rt][nt][2] + bb[nt][2]) * __builtin_bit_cast(float, gv.y << 16), o3 = (acc[rt][nt][3] + bb[nt][3]) * __builtin_bit_cast(float, gv.y & 0xffff0000u);
                    u32x2v wv; wv.x = pg8::cvt_pk_bf16(o0, o1); wv.y = pg8::cvt_pk_bf16(o2, o3);
                    *(u32x2v*)(out + (long)frame * DM + n0) = wv;
                }
            }
        }
    }
    __syncthreads();
}

#ifndef USE_MFMA_ATTN
#define USE_MFMA_ATTN 1
#endif
#ifndef USE_MFMA_CONV
#define USE_MFMA_CONV 1
#endif
__device__ __forceinline__ void mixer_phase(Frame& F, const Args& A, int l) {
    unsigned char* ws = A.ws;
    float* S = (float*)F.glds;
    const bf16* Z = (const bf16*)(ws + WS_Z); bf16* Y = (bf16*)(ws + WS_YMIX);
    const float* BT = (const float*)(ws + WS_BT);
    constexpr int U0 = 128, U1 = U0 + 8, U2 = U1 + 128, U3 = U2 + 32, U4 = U3 + 256, U5 = U4 + 16;
    const int bx = blockIdx.x;
#pragma unroll 1
    for (int slot = 0; slot < 3; ++slot) {
        int u;
        if (slot == 0) u = (bx < 128) ? bx : U1 + (bx - 128);
        else if (slot == 1) { if (bx >= 128 && bx < 136) continue; u = U3 + bx; }
        else { const int e = bx - 128;
            if (bx >= 248) u = U3 + (bx - 120);
            else if (e < 0 || e >= 56) break;
            else u = (e < 8) ? U0 + e : (e < 40 ? U2 + (e - 8) : U4 + (e - 40)); }
        if (!((A.mix_mask >> (u < U1 ? 0 : (u < U3 ? 1 : 2))) & 1)) continue;
        if (u < U1) {
            int rowbase, t0, nfr; const float* left = nullptr;
            if (u < U0) { const int b = u >> 6, c = u & 63; rowbase = b * SEQ; t0 = c * 64; nfr = 64; }
            else { const int b = u - U0; rowbase = NROWP + b * NSS; t0 = 0; nfr = NSS; left = A.in[5] + (size_t)(l * 8 + b) * 30 * 512; }
#if USE_MFMA_CONV
            conv_unit(F.lds, Z + (size_t)rowbase * ZP + ZC_U, t0, nfr, left, A.in[10] + l * 31 * 512, A.in[11] + l * 512, A.in[12] + l * 512, A.in[13] + l * 512,
                      (const bf16*)(ws + WS_WPW) + (size_t)l * 512 * 512, A.in[15] + l * 512, Z + (size_t)(rowbase + t0) * ZP + ZC_GA, Y + (size_t)(rowbase + t0) * DM);
#else
            naive_conv(S, Z + (size_t)rowbase * ZP + ZC_U, t0, nfr, left, A.in[10] + l * 31 * 512, A.in[11] + l * 512, A.in[12] + l * 512, A.in[13] + l * 512,
                       A.in[14] + (size_t)l * 512 * 512, A.in[15] + l * 512, Z + (size_t)(rowbase + t0) * ZP + ZC_GA, Y + (size_t)(rowbase + t0) * DM);
#endif
        } else if (u < U3) {
            MemUnit M; int row0, h;
            if (u < U2) { const int v = u - U1, b = v >> 6, qblk = v & 15; h = (v >> 4) & 3; row0 = b * SEQ + qblk * 256; M.nq = 256;
                M.k = (const bf16*)(ws + WS_MKVP) + (size_t)(b * 256) * 4096 + l * 1024 + h * 128; M.v = M.k + 512; M.pitch = 4096; }
            else { const int v = u - U2, b = v >> 2; h = v & 3; row0 = NROWP + b * NSS; M.nq = NSS;
                M.k = (const bf16*)(ws + WS_CMK) + (size_t)((l * 8 + b) * 256) * 512 + h * 128; M.v = (const bf16*)(ws + WS_CMV) + (size_t)((l * 8 + b) * 256) * 512 + h * 128; M.pitch = 512; }
            M.q = Z + (size_t)row0 * ZP + ZC_CQ + h * 128; M.gate = Z + (size_t)row0 * ZP + ZC_GC + h * 128; M.out = Y + (size_t)row0 * DM + 1536 + h * 128;
            mem_unit(F.lds, M);
        } else {
            SwaUnit W; int row0, kv;
            if (u < U4) { const int v = u - U3, b = v >> 7, c = (v >> 1) & 63; kv = v & 1; row0 = b * SEQ + c * 64; W.nq = 64;
                const bf16* kb = Z + ((long)row0 - 128) * ZP + ZC_K + kv * 64;
                W.ks = KSrc{kb, ZP, 192, kb, ZP}; W.vs = KSrc{kb + (ZC_V - ZC_K), ZP, 192, kb + (ZC_V - ZC_K), ZP}; W.jlo = (c >= 2) ? 0 : 128 - 64 * c; W.nk = 192; }
            else { const int v = u - U4, b = v >> 1; kv = v & 1; row0 = NROWP + b * NSS; W.nq = NSS;
                const bf16* ck = (const bf16*)(ws + WS_CSK) + (size_t)((l * 8 + b) * 128) * 128 + kv * 64; const bf16* cv = (const bf16*)(ws + WS_CSV) + (size_t)((l * 8 + b) * 128) * 128 + kv * 64;
                const bf16* zk = Z + (size_t)row0 * ZP + ZC_K + kv * 64;
                W.ks = KSrc{ck, 128, 128, zk, ZP}; W.vs = KSrc{cv, 128, 128, zk + (ZC_V - ZC_K), ZP}; W.jlo = 0; W.nk = 144; }
            W.q = Z + (size_t)row0 * ZP + ZC_Q + kv * 512; W.gate = Z + (size_t)row0 * ZP + ZC_GB + kv * 512; W.out = Y + (size_t)row0 * DM + 512 + kv * 512; W.kvh = kv;
            swa_unit(F.lds, W, BT, A.in[16] + l * 16);
        }
    }
}

__device__ __forceinline__ void final_norm_phase(Frame& F, const Args& A) {
    const bf16* XB = (const bf16*)(A.ws + WS_XB); const float* SSQ = (const float*)(A.ws + WS_SSQ); const float* g = A.in[21];
    const int tid_ = opaque_tid(), lane = tid_ & 63, wave_ = __builtin_amdgcn_readfirstlane(tid_ >> 6);
    const int gw = F.vcu * NWAVES + wave_, NGW = F.G * NWAVES;
    f32x4 gv[8];
#pragma unroll
    for (int j = 0; j < 8; ++j) gv[j] = ((const f32x4*)g)[lane + 64 * j];
    for (int m = gw; m < NROW; m += NGW) {
        float s = (lane < 32) ? SSQ[(size_t)m * 32 + lane] : 0.f;
        s = wave_sum(s);
        const float rstd = 1.0f / sqrtf(s * (1.0f / DM) + 1e-6f);
        const unsigned long long* xr = (const unsigned long long*)(XB + (size_t)m * DM) + lane;
        f32x4* o = (f32x4*)(A.out + (m < NROWP ? OFF_YP + (size_t)m * DM : OFF_YS + (size_t)(m - NROWP) * DM)) + lane;
#pragma unroll
        for (int j = 0; j < 8; ++j) { const unsigned long long w = xr[64 * j]; const unsigned lo = (unsigned)w, hi = (unsigned)(w >> 32);
            const f32x4 x = (f32x4){__builtin_bit_cast(float, lo << 16), __builtin_bit_cast(float, lo & 0xffff0000u), __builtin_bit_cast(float, hi << 16), __builtin_bit_cast(float, hi & 0xffff0000u)};
            o[64 * j] = x * rstd * gv[j]; }
    }
}

constexpr int N_PHASES = 2 + 3 * DEPTH;
#ifndef MK_SINGLE
#define MK_SINGLE 1
#endif
__global__ void __launch_bounds__(NTHREADS, 2) mk_fwd(Args args) {
    extern __shared__ __attribute__((aligned(16))) unsigned char lds[];
    Frame F;
    F.lds = (LAS unsigned char*)lds; F.glds = lds;
    F.MISC = (volatile LAS unsigned*)(F.lds + MISC_OFF);
    F.tid = threadIdx.x; F.lane = F.tid & 63; F.wave = __builtin_amdgcn_readfirstlane(F.tid >> 6);
    F.G = gridDim.x; { const int bx = blockIdx.x; F.vcu = (F.G % 8 == 0) ? (bx % 8) * (F.G / 8) + bx / 8 : bx; }
    unsigned char* ws = args.ws;
    F.ctl = (gu32*)(ws + WS_CTL);
    for (int u = F.tid; u < (LDS_BYTES - LDSCTL_OFF) / 4; u += NTHREADS) ((LAS unsigned*)(F.lds + LDSCTL_OFF))[u] = 0u;
    __syncthreads();
    XcdBarrier bar; bar.bar = (unsigned*)(F.ctl + CW_BAR); bar.x = 0; bar.st = nullptr;
    const int lo = args.ph_lo, hi = args.ph_hi;
    const bool multi = (hi - lo) > 1;
    if (multi) bar = xcd_barrier_post((unsigned*)(F.ctl + CW_BAR), F.MISC + 8);
#define SEAM(k) do { if (lo <= (k) && (k) + 1 < hi) xcd_barrier(bar); } while (0)
#define IN(k) (lo <= (k) && (k) < hi)
    if (IN(0)) { p0_prologue(F, args); SEAM(0); }
    if (IN(1)) {
        unsigned char* wsl = ws; asm volatile("" : "+s"(wsl));
        pg8::Gemm g{(const pg8::bf16_t*)(wsl + WS_MEMN), (const pg8::bf16_t*)(wsl + WS_WMEM), 512, 4096, DM};
        pg8::StaticOrder S; S.init(512, 4096, F.G, (int)(F.G - 1 - blockIdx.x));
        pg8::EpiMemKV E{(pg8::bf16_t*)(wsl + WS_MKVP), args.out};
        pg8::gemm_phase<pg8::EpiMemKV, pg8::StaticOrder, true, true>(F.lds, g, S, E);
    }
#pragma unroll 1
    for (int l = 0; l < DEPTH; ++l) {
        const int p1 = 1 + 3 * l, p2 = p1 + 1, p3 = p1 + 2;
        unsigned char* wsl = ws; int bxl = blockIdx.x; asm volatile("" : "+s"(wsl), "+s"(bxl));
        if (IN(p1)) {
            pg8::Gemm g{(const pg8::bf16_t*)(wsl + WS_XB), (const pg8::bf16_t*)(wsl + WS_WIN) + (size_t)l * INDIM * DM, MPAD, INDIM, DM};
            int vc1 = F.vcu; asm volatile("" : "+s"(vc1));
            pg8::Hybrid S; S.init(MPAD, INDIM, vc1, 2);
            pg8::EpiIn E{(pg8::bf16_t*)(wsl + WS_Z), (const float*)(wsl + WS_SSQ), args.out, l};
            pg8::SplitK<1> SK{(float*)(wsl + WS_DUMP), (unsigned*)(wsl + WS_CTL) + CW_SK + (l * 2 + 0) * 4096};
            pg8::gemm_phase<pg8::EpiIn, pg8::Hybrid, true, true, pg8::SplitK<1>>(F.lds, g, S, E, SK);
            SEAM(p1);
        }
#if USE_MFMA_ATTN
        if (IN(p2)) { mixer_phase(F, args, l); SEAM(p2); }
#else
        if (IN(p2)) { naive_mixer_phase(F, args, l); SEAM(p2); }
#endif
        if (IN(p3)) {
            pg8::Gemm g{(const pg8::bf16_t*)(wsl + WS_YMIX), (const pg8::bf16_t*)(wsl + WS_WOUT) + (size_t)l * DM * DM, MPAD, DM, DM};
            int vcl = F.vcu; asm volatile("" : "+s"(vcl));
            pg8::Hybrid S; S.init(MPAD, DM, vcl, 4);
            pg8::EpiOut E{(pg8::bf16_t*)(wsl + WS_XB), (float*)(wsl + WS_SSQ)};
            pg8::SplitK<3> SK{(float*)(wsl + WS_DUMP), (unsigned*)(wsl + WS_CTL) + CW_SK + (l * 2 + 1) * 4096};
            pg8::gemm_phase<pg8::EpiOut, pg8::Hybrid, true, true, pg8::SplitK<3>>(F.lds, g, S, E, SK);
            SEAM(p3);
        }
    }
    if (IN(N_PHASES - 1)) final_norm_phase(F, args);
#undef SEAM
#undef IN
}

extern "C" void kernel_launch(void* const* d_in, const int* in_sizes, int n_in, void* d_out, int out_size, void* d_ws, size_t ws_size, hipStream_t stream) {
    static int grid = 0;
    if (grid == 0) {
        if (n_in != 22 || out_size != (int)OUT_TOTAL || ws_size < WS_END) { fprintf(stderr, "kernel_launch: unexpected shapes: n_in %d out %d ws %zu\n", n_in, out_size, ws_size); grid = -1; return; }
        int dev = 0, cus = 0, per_cu = 0;
        if (hipGetDevice(&dev) != hipSuccess || hipDeviceGetAttribute(&cus, hipDeviceAttributeMultiprocessorCount, dev) != hipSuccess) { grid = -1; return; }
        if (hipFuncSetAttribute((const void*)mk_fwd, hipFuncAttributeMaxDynamicSharedMemorySize, LDS_BYTES) != hipSuccess) { fprintf(stderr, "kernel_launch: hipFuncSetAttribute failed\n"); grid = -1; return; }
        if (hipOccupancyMaxActiveBlocksPerMultiprocessor(&per_cu, (const void*)mk_fwd, NTHREADS, LDS_BYTES) != hipSuccess || per_cu < 1) { fprintf(stderr, "kernel_launch: occupancy query says %d blocks per CU\n", per_cu); (void)hipGetLastError(); grid = -1; return; }
        if (cus != 256) { fprintf(stderr, "kernel_launch: built for a 256-CU device, found %d CUs\n", cus); grid = -1; return; }
        grid = cus;
    }
    if (grid < 0) return;
    (void)hipMemsetAsync((char*)d_ws + WS_CTL, 0, CTL_ZERO_BYTES, stream);
    Args a{};
    for (int i = 0; i < 22; ++i) a.in[i] = (const float*)d_in[i];
    a.out = (float*)d_out; a.ws = (unsigned char*)d_ws;
#if MK_SINGLE
    a.mix_mask = 7;
#ifdef PROBE_PREFIX
#ifdef PROBE_MASK
    a.mix_mask = PROBE_MASK;
#endif
#ifdef PROBE_FLAGS
    a.pflags = PROBE_FLAGS;
#endif
    a.ph_lo = 0; a.ph_hi = PROBE_PREFIX;
    hipLaunchKernelGGL(mk_fwd, dim3(grid), dim3(NTHREADS), LDS_BYTES, stream, a);
    (void)hipMemsetAsync((char*)d_ws + WS_CTL, 0, CTL_ZERO_BYTES, stream);
    a.mix_mask = 7; a.pflags = 0;
#endif
    a.ph_lo = 0; a.ph_hi = N_PHASES;
    hipLaunchKernelGGL(mk_fwd, dim3(grid), dim3(NTHREADS), LDS_BYTES, stream, a);
#else
    for (int p = 0; p < N_PHASES; ++p) { a.ph_lo = p; a.ph_hi = p + 1; hipLaunchKernelGGL(mk_fwd, dim3(grid), dim3(NTHREADS), LDS_BYTES, stream, a); }
#endif
}
```

```cpp
#include <hip/hip_runtime.h>
#include <cstdio>
#include <cstdint>

namespace pg8 {
#define PG8_LAS __attribute__((address_space(3)))
typedef unsigned short bf16_t;
typedef short bf16x8 __attribute__((ext_vector_type(8)));
typedef float f32x4 __attribute__((ext_vector_type(4)));
typedef unsigned u32x4 __attribute__((ext_vector_type(4)));
constexpr int BM = 256, BK = 64, HALF = 128, HTB = HALF * BK * 2  , STAGE_BYTES = 8 * HTB, NXCD = 8, WGM = 8;

__host__ __device__ __forceinline__ int lds_byte(int r, int c) { const int st = (r >> 4) * 2 + (c >> 5), rr = r & 15, cc = c & 31, ob = rr * 64 + cc * 2; return st * 1024 + (ob ^ (((ob >> 9) & 1) << 5)); }
__host__ __device__ __forceinline__ void stage_rc(int b, int& R, int& C) { const int st = b / 1024, sb = b % 1024, swz = sb ^ (((sb >> 9) & 1) << 5); R = (st >> 1) * 16 + swz / 64; C = (st & 1) * 32 + (swz % 64) / 2; }
__host__ __device__ __forceinline__ int perm32(int rho) { const int n = rho >> 4, i = rho & 15; return 8 * (i >> 2) + 4 * n + (i & 3); }

struct Unit { int pm, pn, k0, nk, mode, slot, np; };
struct Gemm { const bf16_t* A; const bf16_t* Bt; int M, N, K; };

struct StaticOrder {
    int nM, nN, nwg, G, c;
    __host__ __device__ void init(int M, int N, int G_, int c_) { nM = M / BM; nN = N / BM; nwg = nM * nN; G = G_; c = c_; }
    __host__ __device__ bool next(int i, Unit& u) const {
        const long L = (long)i * G + c; if (L >= nwg) return false;
        int wgid = (int)L; { const int q = nwg / NXCD, r = nwg % NXCD, xcd = wgid % NXCD, off = wgid / NXCD; wgid = (xcd < r ? xcd * (q + 1) : r * (q + 1) + (xcd - r) * q) + off; }
        const int nig = WGM * nN, gid = wgid / nig, fm = gid * WGM, gsz = (nM - fm) < WGM ? (nM - fm) : WGM;
        u.pm = fm + ((wgid % nig) % gsz); u.pn = (wgid % nig) / gsz; u.k0 = 0; u.nk = 0; u.mode = 0; u.slot = 0; u.np = 0; return true;
    }
    __device__ __forceinline__ void a_ready(const Unit&) const {}
    __device__ __forceinline__ void done(const Unit&) const {}
};

__device__ __forceinline__ unsigned cvt_pk_bf16(float lo, float hi) { unsigned r; asm volatile("v_cvt_pk_bf16_f32 %0, %1, %2" : "=v"(r) : "v"(lo), "v"(hi)); return r; }
typedef float f32x2 __attribute__((ext_vector_type(2)));


#define PG8_GAS __attribute__((address_space(1)))
struct PartialReader {
    const PG8_GAS f32x4* p;
    template <int NP> __device__ __forceinline__ f32x4 next() {
        if constexpr (NP == 0) return (f32x4){0.f, 0.f, 0.f, 0.f};
        else {
            f32x4 x = p[0];
            if constexpr (NP > 1) x += p[16384];
            if constexpr (NP > 2) x += p[32768];
            p += 64; asm volatile("" : "+v"(p));
            return x;
        }
    }
    template <int NP> __device__ __forceinline__ void skip(int n) { if constexpr (NP > 0) { p += 64 * n; asm volatile("" : "+v"(p)); } }
};

constexpr int P_D = 2048, P_INDIM = 4864, P_NROW = 8320  , P_MPAD = 8448, P_NSSQ = 32;
constexpr long OFF_YP = 0, OFF_YS = 16777216, OFF_KP = 17039360, OFF_VP = 17170432, OFF_CP = 17301504, OFF_MKP = 17424384, OFF_MVP = 18472960,
               OFF_KS = 19521536, OFF_VS = 20045824, OFF_CS = 20570112, OUT_TOTAL = 21061632;
constexpr float QS_SWA = 0.125f * 1.4426950408889634f;
constexpr float QS_MEM = 0.08838834764831845f * 1.4426950408889634f;

__device__ __forceinline__ float sigmoid_f(float x) { return __builtin_amdgcn_rcpf(1.0f + __builtin_amdgcn_exp2f(x * -1.4426950408889634f)); }
__device__ __forceinline__ f32x4 sigmoid4(f32x4 x) { return (f32x4){sigmoid_f(x[0]), sigmoid_f(x[1]), sigmoid_f(x[2]), sigmoid_f(x[3])}; }
__device__ __forceinline__ u32x4 pack8(f32x4 a, f32x4 b) { u32x4 w; w.x = cvt_pk_bf16(a[0], a[1]); w.y = cvt_pk_bf16(a[2], a[3]); w.z = cvt_pk_bf16(b[0], b[1]); w.w = cvt_pk_bf16(b[2], b[3]); return w; }

__device__ __forceinline__ void row_rstd(float (&rs)[2][4], const float* ssq, int rbase, int fq) {
    f32x4 pa[2][4], pb[2][4];
#pragma unroll
    for (int ai = 0; ai < 2; ++ai)
#pragma unroll
        for (int m = 0; m < 4; ++m) { const PG8_GAS f32x4* p = (const PG8_GAS f32x4*)(ssq + (size_t)(rbase + ai * HALF + m * 16) * P_NSSQ + fq * 8); pa[ai][m] = p[0]; pb[ai][m] = p[1]; }
#pragma unroll
    for (int ai = 0; ai < 2; ++ai)
#pragma unroll
        for (int m = 0; m < 4; ++m) {
            const f32x4 a = pa[ai][m], b = pb[ai][m];
            float s = ((a[0] + a[1]) + (a[2] + a[3])) + ((b[0] + b[1]) + (b[2] + b[3]));
            s += __shfl_xor(s, 16); s += __shfl_xor(s, 32);
            rs[ai][m] = __builtin_amdgcn_rsqf(s * (1.0f / (float)P_D) + 1e-6f);
        }
}

struct EpiIn {
    static constexpr bool PERM = true, AFTER_DRAIN = false;
    bf16_t* Z; const float* ssq; float* out; int layer;
    __device__ __forceinline__ static void init(f32x4 (&acc)[2][2][4][2], const Unit&, int, int) {
#pragma unroll
        for (int a = 0; a < 2; ++a)
#pragma unroll
            for (int b = 0; b < 2; ++b)
#pragma unroll
                for (int m = 0; m < 4; ++m)
#pragma unroll
                    for (int n = 0; n < 2; ++n) acc[a][b][m][n] = (f32x4){0.f, 0.f, 0.f, 0.f};
    }
    template <int HASP> __device__ __forceinline__ void run(const f32x4 (&acc)[2][2][4][2], const Unit& u, int wr, int wc, int fr, int fq, PartialReader& PR) const {
        { int t_ = threadIdx.x; asm volatile("" : "+v"(t_)); fr = t_ & 15; fq = (t_ >> 4) & 3; }
        const int pn = u.pn, rbase = u.pm * BM + wr * 64 + fr;
        bf16_t* Z = this->Z; const float* ssq = this->ssq; float* out = this->out;
        asm volatile("" : "+s"(Z), "+s"(ssq), "+s"(out));
        float rs[2][4];
        row_rstd(rs, ssq, rbase, fq);
        const bool tailtile = (u.pm == 15) || (u.pm == 31) || (u.pm == 32);
        const bool is_q = (pn >= 6 && pn <= 9), is_cq = (pn == 15 || pn == 16);
        const float qs = is_q ? QS_SWA : QS_MEM;
#pragma unroll
        for (int ai = 0; ai < 2; ++ai) {
            if (u.pm * BM + wr * 64 + ai * HALF >= P_NROW) { PR.template skip<HASP>(16); continue; }
#pragma unroll
            for (int m2 = 0; m2 < 4; m2 += 2) {
            f32x4 v[4][2][2];
#pragma unroll
            for (int m = m2; m < m2 + 2; ++m)
#pragma unroll
                for (int bj = 0; bj < 2; ++bj)
#pragma unroll
                    for (int n = 0; n < 2; ++n) { if constexpr (HASP == 0) v[m][bj][n] = acc[ai][bj][m][n]; else v[m][bj][n] = acc[ai][bj][m][n] + PR.template next<HASP>(); }
#pragma unroll
            for (int m = m2; m < m2 + 2; ++m) {
                const int row = rbase + ai * HALF + m * 16;
                const float r = rs[ai][m];
                if (pn < 4) {
                    const int ch0 = 128 * pn + 32 * wc + 8 * fq;
                    const f32x4 u0 = (v[m][0][0] * r) * sigmoid4(v[m][1][0] * r), u1 = (v[m][0][1] * r) * sigmoid4(v[m][1][1] * r);
                    *(PG8_GAS u32x4*)(Z + (size_t)row * P_INDIM + ch0) = pack8(u0, u1);
                    if (tailtile) {
                        float* dst = nullptr;
                        if (row < 8192) { const int t = row & 4095, b = row >> 12; if (t >= 4066) dst = out + OFF_CP + ((size_t)(layer * 2 + b) * 30 + (t - 4066)) * 512 + ch0; }
                        else { const int rr = row - 8192, b = rr >> 4, s = rr & 15; dst = out + OFF_CS + ((size_t)(layer * 8 + b) * 30 + 14 + s) * 512 + ch0; }
                        if (dst) { *(PG8_GAS f32x4*)dst = u0; *(PG8_GAS f32x4*)(dst + 4) = u1; }
                    }
                } else if (pn == 10) {
#pragma unroll
                    for (int bj = 0; bj < 2; ++bj) {
                        const f32x4 v0 = v[m][bj][0] * r, v1 = v[m][bj][1] * r;
                        const int c128 = 32 * wc + 8 * fq;
                        *(PG8_GAS u32x4*)(Z + (size_t)row * P_INDIM + 2560 + 128 * bj + c128) = pack8(v0, v1);
                        if (tailtile) {
                            float* dst = nullptr;
                            if (row < 8192) { const int t = row & 4095, b = row >> 12; if (t >= 3968) dst = out + (bj ? OFF_VP : OFF_KP) + ((size_t)(layer * 2 + b) * 128 + (t - 3968)) * 128 + c128; }
                            else { const int rr = row - 8192, b = rr >> 4, s = rr & 15; dst = out + (bj ? OFF_VS : OFF_KS) + ((size_t)(layer * 8 + b) * 128 + 112 + s) * 128 + c128; }
                            if (dst) { *(PG8_GAS f32x4*)dst = v0; *(PG8_GAS f32x4*)(dst + 4) = v1; }
                        }
                    }
                } else {
#pragma unroll
                    for (int bj = 0; bj < 2; ++bj) {
                        f32x4 v0 = v[m][bj][0] * r, v1 = v[m][bj][1] * r;
                        if (!(is_q || is_cq)) { v0 = v0 * sigmoid4(v0); v1 = v1 * sigmoid4(v1); } else { v0 = v0 * qs; v1 = v1 * qs; }
                        *(PG8_GAS u32x4*)(Z + (size_t)row * P_INDIM + pn * BM + 128 * bj + 32 * wc + 8 * fq) = pack8(v0, v1);
                    }
                }
            }
            }
        }
    }
};

struct EpiMemKV {
    static constexpr bool PERM = true, AFTER_DRAIN = false;
    bf16_t* MKV; float* out;
    __device__ __forceinline__ static void init(f32x4 (&acc)[2][2][4][2], const Unit&, int, int) {
#pragma unroll
        for (int a = 0; a < 2; ++a)
#pragma unroll
            for (int b = 0; b < 2; ++b)
#pragma unroll
                for (int m = 0; m < 4; ++m)
#pragma unroll
                    for (int n = 0; n < 2; ++n) acc[a][b][m][n] = (f32x4){0.f, 0.f, 0.f, 0.f};
    }
    template <int HASP> __device__ __forceinline__ void run(const f32x4 (&acc)[2][2][4][2], const Unit& u, int wr, int wc, int fr, int fq, PartialReader& PR) const {
        const int l = u.pn >> 2, kv = (u.pn >> 1) & 1, cb = (u.pn & 1) * 256;
        bf16_t* MKV = this->MKV; float* out = this->out; asm volatile("" : "+s"(MKV), "+s"(out));
        const int row0 = u.pm * BM + wr * 64 + fr, cl = 32 * wc + 8 * fq;
        bf16_t* zb = MKV + (size_t)row0 * 4096 + u.pn * BM + cl;
        float* ob = out + (kv ? OFF_MVP : OFF_MKP) + ((size_t)(l * 512 + row0)) * 512 + cb + cl;
#pragma unroll
        for (int ai = 0; ai < 2; ++ai)
#pragma unroll
            for (int m = 0; m < 4; ++m)
#pragma unroll
                for (int bj = 0; bj < 2; ++bj) {
                    const f32x4 v0 = acc[ai][bj][m][0], v1 = acc[ai][bj][m][1];
                    *(PG8_GAS u32x4*)(zb + (size_t)(ai * HALF + m * 16) * 4096 + 128 * bj) = pack8(v0, v1);
                    float* dst = ob + (size_t)(ai * HALF + m * 16) * 512 + 128 * bj;
                    *(PG8_GAS f32x4*)dst = v0; *(PG8_GAS f32x4*)(dst + 4) = v1;
                }
    }
};

struct EpiOut {
    static constexpr bool PERM = false, AFTER_DRAIN = false;
    bf16_t* XB; float* ssq;
    typedef unsigned u32x2v __attribute__((ext_vector_type(2)));
    __device__ __forceinline__ static void row_out(const f32x4 (&xn)[2][2], bf16_t* XB, float* ssq, int row, int colbase, int slot, int fq) {
        float q = 0.f;
#pragma unroll
        for (int bj = 0; bj < 2; ++bj)
#pragma unroll
            for (int n = 0; n < 2; ++n) {
                const size_t off = (size_t)row * P_D + colbase + bj * HALF + n * 16;
                u32x2v w; w.x = cvt_pk_bf16(xn[bj][n][0], xn[bj][n][1]); w.y = cvt_pk_bf16(xn[bj][n][2], xn[bj][n][3]);
                *(PG8_GAS u32x2v*)(XB + off) = w;
                q += (xn[bj][n][0] * xn[bj][n][0] + xn[bj][n][1] * xn[bj][n][1]) + (xn[bj][n][2] * xn[bj][n][2] + xn[bj][n][3] * xn[bj][n][3]);
            }
        q += __shfl_xor(q, 16); q += __shfl_xor(q, 32);
        if (fq == 0) *(PG8_GAS float*)(ssq + (size_t)row * P_NSSQ + slot) = q;
    }
    __device__ __forceinline__ void init(f32x4 (&acc)[2][2][4][2], const Unit& u, int wr, int wc) const {
        int t_ = threadIdx.x; asm volatile("" : "+v"(t_)); const int fr = t_ & 15, fq = (t_ >> 4) & 3;
        const bf16_t* rin = XB; asm volatile("" : "+s"(rin));
        const int rbase = u.pm * BM + wr * 64 + fr, colbase = u.pn * BM + wc * 32 + fq * 4;
#pragma unroll
        for (int ai = 0; ai < 2; ++ai) {
            const bool ld = (u.mode != 1) && (u.pm * BM + wr * 64 + ai * HALF < P_NROW);
#pragma unroll
            for (int m = 0; m < 4; ++m)
#pragma unroll
                for (int bj = 0; bj < 2; ++bj)
#pragma unroll
                    for (int n = 0; n < 2; ++n) {
                        u32x2v w; w.x = 0u; w.y = 0u;
                        if (ld) w = *(const PG8_GAS u32x2v*)(rin + (size_t)(rbase + ai * HALF + m * 16) * P_D + colbase + bj * HALF + n * 16);
                        acc[ai][bj][m][n] = (f32x4){__uint_as_float(w.x << 16), __uint_as_float(w.x & 0xffff0000u), __uint_as_float(w.y << 16), __uint_as_float(w.y & 0xffff0000u)};
                    }
        }
    }
    template <int HASP> __device__ __forceinline__ void run(const f32x4 (&acc)[2][2][4][2], const Unit& u, int wr, int wc, int fr, int fq, PartialReader& PR) const {
        { int t_ = threadIdx.x; asm volatile("" : "+v"(t_)); fr = t_ & 15; fq = (t_ >> 4) & 3; }
        const int rbase = u.pm * BM + wr * 64 + fr, colbase = u.pn * BM + wc * 32 + fq * 4, slot = u.pn * 4 + wc;
        bf16_t* XB = this->XB; float* ssq = this->ssq; asm volatile("" : "+s"(XB), "+s"(ssq));
#pragma unroll
        for (int ai = 0; ai < 2; ++ai) {
            if (u.pm * BM + wr * 64 + ai * HALF >= P_NROW) { PR.template skip<HASP>(16); continue; }
            if constexpr (HASP == 0) {
#pragma unroll
                for (int m = 0; m < 4; ++m) {
                    f32x4 xn[2][2];
#pragma unroll
                    for (int bj = 0; bj < 2; ++bj)
#pragma unroll
                        for (int n = 0; n < 2; ++n) xn[bj][n] = acc[ai][bj][m][n];
                    row_out(xn, XB, ssq, rbase + ai * HALF + m * 16, colbase, slot, fq);
                }
            } else {
#pragma unroll
                for (int m2 = 0; m2 < 4; m2 += 2) {
                    f32x4 pv[2][2][2];
#pragma unroll
                    for (int mm = 0; mm < 2; ++mm)
#pragma unroll
                        for (int bj = 0; bj < 2; ++bj)
#pragma unroll
                            for (int n = 0; n < 2; ++n) pv[mm][bj][n] = PR.template next<HASP>();
#pragma unroll
                    for (int mm = 0; mm < 2; ++mm) {
                        f32x4 xn[2][2];
#pragma unroll
                        for (int bj = 0; bj < 2; ++bj)
#pragma unroll
                            for (int n = 0; n < 2; ++n) xn[bj][n] = acc[ai][bj][m2 + mm][n] + pv[mm][bj][n];
                        row_out(xn, XB, ssq, rbase + ai * HALF + (m2 + mm) * 16, colbase, slot, fq);
                    }
                }
            }
        }
    }
};

struct NoSplit {
    static constexpr int NP = 0;
    __device__ __forceinline__ void dump(const f32x4 (&)[2][2][4][2], const Unit&, int, int) const {}
    __device__ __forceinline__ PartialReader reader(const Unit&, int, int) const { PartialReader r; r.p = nullptr; return r; }
};
template <int NP_> struct SplitK {
    static constexpr int NP = NP_;
    float* slots; unsigned* flags;
    __device__ __forceinline__ void dump(const f32x4 (&acc)[2][2][4][2], const Unit& u, int wid, int lane) const {
        const __amdgpu_buffer_rsrc_t rs = __builtin_amdgcn_make_buffer_rsrc(slots, (short)0, 256 * 65536 * 4, 0x00020000);
        unsigned off = (unsigned)u.slot * 262144u + ((unsigned)wid * 32u * 64u + (unsigned)lane) * 16u;
#pragma unroll
        for (int a = 0; a < 2; ++a)
#pragma unroll
            for (int m = 0; m < 4; ++m)
#pragma unroll
                for (int b = 0; b < 2; ++b)
#pragma unroll
                    for (int n = 0; n < 2; ++n) {
                        __builtin_amdgcn_raw_buffer_store_b128(__builtin_bit_cast(u32x4, acc[a][b][m][n]), rs, off, 0,   16);
                        off += 1024u; asm volatile("" : "+v"(off)); }
        asm volatile("s_waitcnt vmcnt(0)" ::: "memory");
        if (lane == 0) __hip_atomic_fetch_add(flags + 16 * u.slot, 1u, __ATOMIC_RELAXED, __HIP_MEMORY_SCOPE_AGENT);
    }
    __device__ __forceinline__ PartialReader reader(const Unit& u, int wid, int lane) const {
#pragma unroll
        for (int q = 0; q < NP; ++q) { unsigned sp = 0;
            while ((unsigned)__builtin_amdgcn_readfirstlane(__hip_atomic_load(flags + 16 * (u.slot + q), __ATOMIC_RELAXED, __HIP_MEMORY_SCOPE_AGENT)) < 8u) { __builtin_amdgcn_s_sleep(2); if (++sp > (1u << 22)) break; } }
        __builtin_amdgcn_fence(__ATOMIC_ACQUIRE, "agent");
        asm volatile("s_waitcnt vmcnt(0)" ::: "memory");
        PartialReader r; r.p = (const PG8_GAS f32x4*)(slots + (size_t)u.slot * 65536) + ((size_t)wid * 32 * 64 + lane); return r;
    }
};
struct Hybrid {
    static constexpr int G = 256;
    int nM, nN, v, R, S, P;
    __device__ void init(int M, int N, int v_, int P_) { nM = M / BM; nN = N / BM; v = v_; P = P_; const int nu = nM * nN; R = nu / G; S = nu - R * G; }
    __device__ bool next(int i, Unit& u) const {
        const bool hasp = v < S * P; const int sp = v / P, q = v - sp * P;
        const bool dumper = hasp && q > 0, owner = hasp && q == 0;
        const int idx = i - (dumper ? 1 : 0);
        int ui;
        const int kb0 = (P == 2) ? (q == 0 ? 0 : 12) : (q == 0 ? 0 : 8 * q - 4), kb1 = (P == 2) ? (q == 0 ? 12 : 32) : (q == 3 ? 32 : 8 * q + 4);
        if (dumper && i == 0) { ui = R * G + sp; u.k0 = kb0; u.nk = kb1 - kb0; u.mode = 1; u.slot = sp * (P - 1) + q - 1; u.np = 0; }
        else if (idx < R) { ui = idx * G + v; u.k0 = 0; u.nk = 0; u.mode = 0; u.slot = 0; u.np = 0; }
        else if (idx == R && owner) { ui = R * G + sp; u.k0 = 0; u.nk = kb1; u.mode = 2; u.slot = sp * (P - 1); u.np = P - 1; }
        else return false;
        const int nig = WGM * nN, gid = ui / nig, fm = gid * WGM, gsz = (nM - fm) < WGM ? (nM - fm) : WGM, r = ui % nig;
        u.pm = fm + r % gsz; u.pn = r / gsz; return true;
    }
    __device__ __forceinline__ void a_ready(const Unit&) const {}
    __device__ __forceinline__ void done(const Unit&) const {}
};
template <class Epi, class Sched, bool ALIGN_EPI = false, bool SP2 = false, class SKT = NoSplit>
__device__ __forceinline__ void gemm_phase(PG8_LAS unsigned char* lds, const Gemm g, const Sched& S, const Epi& E, const SKT SK = SKT()) {
    int tid_ = threadIdx.x; asm volatile("" : "+v"(tid_));
    const int tid = tid_, wid = __builtin_amdgcn_readfirstlane(tid >> 6), lane = tid & 63, wr = wid >> 2, wc = wid & 3, fr = lane & 15, fq = lane >> 4;
    const int K = g.K, ntf = K / BK;
    unsigned voffA[2], voffB[2];
#pragma unroll
    for (int i = 0; i < 2; ++i) { int R, C; stage_rc(tid * 16 + i * 8192, R, C); const int Rb = Epi::PERM ? ((R & ~31) + perm32(R & 31)) : R;
        voffA[i] = (unsigned)(R * K + C) * 2u; voffB[i] = (unsigned)(Rb * K + C) * 2u; }
    const size_t kstep = (size_t)(BK * 2);
    const size_t hstep = (size_t)HALF * K * 2;
    const size_t tstep = 2 * hstep;
    const unsigned ldsw = (unsigned)wid * 1024u;
    const int aoff = lds_byte(wr * 64 + fr, fq * 8), boff = lds_byte(wc * 32 + fr, fq * 8);
#define PG8_SA(b, h) (((b) * 2 + (h)) * HTB)
#define PG8_SB(b, h) ((4 + (b) * 2 + (h)) * HTB)
#define PG8_STAGE(bufoff, gbase, voff) do { _Pragma("unroll") for (int _i = 0; _i < 2; ++_i) \
        __builtin_amdgcn_global_load_lds((const unsigned*)((const char*)(gbase) + (voff)[_i]), (PG8_LAS unsigned*)(lds + (bufoff) + ldsw + _i * 8192), 16, 0, 0); } while (0)
#define PG8_LDA(dst, b, h) do { _Pragma("unroll") for (int m = 0; m < 4; ++m) _Pragma("unroll") for (int k = 0; k < 2; ++k) dst[m][k] = *(const PG8_LAS bf16x8*)(lds + PG8_SA(b, h) + aoff + m * 2048 + k * 1024); } while (0)
#define PG8_LDB(dst, b, h) do { _Pragma("unroll") for (int n = 0; n < 2; ++n) _Pragma("unroll") for (int k = 0; k < 2; ++k) dst[n][k] = *(const PG8_LAS bf16x8*)(lds + PG8_SB(b, h) + boff + n * 2048 + k * 1024); } while (0)
#define PG8_MMA(ai, bj, At, Bt) do { __builtin_amdgcn_s_setprio(1); _Pragma("unroll") for (int m = 0; m < 4; ++m) _Pragma("unroll") for (int n = 0; n < 2; ++n) _Pragma("unroll") for (int k = 0; k < 2; ++k) \
        acc[ai][bj][m][n] = __builtin_amdgcn_mfma_f32_16x16x32_bf16(Bt[n][k], At[m][k], acc[ai][bj][m][n], 0, 0, 0); __builtin_amdgcn_s_setprio(0); } while (0)
#define PG8_WAIT_V(n) asm volatile("s_waitcnt vmcnt(" #n ")" ::: "memory")
#define PG8_WAIT_L(n) asm volatile("s_waitcnt lgkmcnt(" #n ")" ::: "memory")
#define PG8_BAR __builtin_amdgcn_s_barrier()
#define PG8_SCHED __builtin_amdgcn_sched_barrier(0)
    Unit cur, nxt; int ui = 0;
    if (!S.next(0, cur)) return;
    f32x4 acc[2][2][4][2];
    E.init(acc, cur, wr, wc);
    bf16x8 At[4][2], B0[2][2], B1[2][2];
    const char* cA = (const char*)g.A + (size_t)cur.pm * tstep + (size_t)cur.k0 * (BK * 2); const char* cB = (const char*)g.Bt + (size_t)cur.pn * tstep + (size_t)cur.k0 * (BK * 2);
    S.a_ready(cur);
    if constexpr (SP2) {
        PG8_STAGE(PG8_SB(0, 0), cB, voffB); PG8_STAGE(PG8_SB(0, 1), cB + hstep, voffB); PG8_STAGE(PG8_SA(0, 0), cA, voffA); PG8_STAGE(PG8_SA(0, 1), cA + hstep, voffA);
        if (wr == 1) PG8_BAR;
        PG8_WAIT_V(2); PG8_BAR;
        PG8_STAGE(PG8_SB(1, 0), cB + kstep, voffB); PG8_STAGE(PG8_SA(1, 0), cA + kstep, voffA); PG8_STAGE(PG8_SB(1, 1), cB + hstep + kstep, voffB);
        PG8_WAIT_V(6); PG8_BAR;
    } else {
        PG8_STAGE(PG8_SB(0, 0), cB, voffB); PG8_STAGE(PG8_SA(0, 0), cA, voffA); PG8_STAGE(PG8_SB(0, 1), cB + hstep, voffB); PG8_STAGE(PG8_SA(0, 1), cA + hstep, voffA);
        if (wr == 1) PG8_BAR;
        PG8_WAIT_V(4); PG8_BAR;
        PG8_STAGE(PG8_SB(1, 0), cB + kstep, voffB); PG8_STAGE(PG8_SA(1, 0), cA + kstep, voffA); PG8_STAGE(PG8_SB(1, 1), cB + hstep + kstep, voffB);
        PG8_WAIT_V(6); PG8_BAR;
    }
    for (;;) {
        const bool has_next = S.next(ui + 1, nxt);
        const char* nA = has_next ? (const char*)g.A + (size_t)nxt.pm * tstep + (size_t)nxt.k0 * (BK * 2) : cA; const char* nB = has_next ? (const char*)g.Bt + (size_t)nxt.pn * tstep + (size_t)nxt.k0 * (BK * 2) : cB;
        const int nt = cur.nk ? cur.nk : ntf;
        for (int t = 0; t < nt; t += 2) {
            const bool last = (t == nt - 2);
            const char* a1 = cA + (size_t)(t + 1) * kstep;
            const char* a2 = last ? nA : cA + (size_t)(t + 2) * kstep; const char* b2 = last ? nB : cB + (size_t)(t + 2) * kstep;
            const char* a3 = a2 + kstep; const char* b3 = b2 + kstep;
            if (last && has_next) S.a_ready(nxt);
            if constexpr (SP2) {
            PG8_LDB(B0, 0, 0); PG8_LDB(B1, 0, 1); PG8_SCHED; PG8_LDA(At, 0, 0); PG8_STAGE(PG8_SA(1, 1), a1 + hstep, voffA);
            PG8_WAIT_V(8); PG8_WAIT_L(0); PG8_BAR; PG8_MMA(0, 0, At, B0); PG8_MMA(0, 1, At, B1); PG8_BAR; PG8_SCHED;
            PG8_LDA(At, 0, 1); PG8_STAGE(PG8_SB(0, 0), b2, voffB); PG8_STAGE(PG8_SB(0, 1), b2 + hstep, voffB); PG8_STAGE(PG8_SA(0, 0), a2, voffA);
            PG8_WAIT_V(8); PG8_WAIT_L(0); PG8_BAR; PG8_MMA(1, 0, At, B0); PG8_MMA(1, 1, At, B1); PG8_BAR; PG8_SCHED;
            PG8_LDB(B0, 1, 0); PG8_LDB(B1, 1, 1); PG8_SCHED; PG8_LDA(At, 1, 0); PG8_STAGE(PG8_SA(0, 1), a2 + hstep, voffA);
            PG8_WAIT_V(8); PG8_WAIT_L(0); PG8_BAR; PG8_MMA(0, 0, At, B0); PG8_MMA(0, 1, At, B1); PG8_BAR; PG8_SCHED;
            PG8_LDA(At, 1, 1); PG8_STAGE(PG8_SB(1, 0), b3, voffB); PG8_STAGE(PG8_SB(1, 1), b3 + hstep, voffB); PG8_STAGE(PG8_SA(1, 0), a3, voffA);
            PG8_WAIT_V(8); PG8_WAIT_L(0); PG8_BAR; PG8_MMA(1, 0, At, B0); PG8_MMA(1, 1, At, B1); PG8_BAR; PG8_SCHED;
            } else {
            PG8_LDB(B0, 0, 0); PG8_SCHED; PG8_LDA(At, 0, 0); PG8_STAGE(PG8_SA(1, 1), a1 + hstep, voffA);
            PG8_WAIT_L(8); PG8_BAR; PG8_WAIT_L(0); PG8_MMA(0, 0, At, B0); PG8_BAR; PG8_SCHED;
            PG8_LDB(B1, 0, 1); PG8_STAGE(PG8_SB(0, 0), b2, voffB);
            PG8_BAR; PG8_WAIT_L(0); PG8_MMA(0, 1, At, B1); PG8_BAR;
            PG8_LDA(At, 0, 1); PG8_STAGE(PG8_SA(0, 0), a2, voffA);
            PG8_BAR; PG8_WAIT_L(0); PG8_MMA(1, 0, At, B0); PG8_BAR; PG8_SCHED;
            PG8_STAGE(PG8_SB(0, 1), b2 + hstep, voffB);
            PG8_WAIT_V(6); PG8_BAR; PG8_MMA(1, 1, At, B1); PG8_BAR;
            PG8_LDB(B0, 1, 0); PG8_SCHED; PG8_LDA(At, 1, 0); PG8_STAGE(PG8_SA(0, 1), a2 + hstep, voffA);
            PG8_WAIT_L(8); PG8_BAR; PG8_WAIT_L(0); PG8_MMA(0, 0, At, B0); PG8_BAR; PG8_SCHED;
            PG8_LDB(B1, 1, 1); PG8_STAGE(PG8_SB(1, 0), b3, voffB);
            PG8_BAR; PG8_WAIT_L(0); PG8_MMA(0, 1, At, B1); PG8_BAR;
            PG8_LDA(At, 1, 1); PG8_STAGE(PG8_SA(1, 0), a3, voffA);
            PG8_BAR; PG8_WAIT_L(0); PG8_MMA(1, 0, At, B0); PG8_BAR; PG8_SCHED;
            PG8_STAGE(PG8_SB(1, 1), b3 + hstep, voffB);
            PG8_WAIT_V(6); PG8_BAR; PG8_MMA(1, 1, At, B1); PG8_BAR;
            }
        }
        if constexpr (ALIGN_EPI) { if (wr == 0) PG8_BAR; }
        if constexpr (!Epi::AFTER_DRAIN) { if (cur.mode == 1) SK.dump(acc, cur, wid, lane); else if (SKT::NP > 0 && cur.mode == 2) { PartialReader PR = SK.reader(cur, wid, lane); E.template run<SKT::NP>(acc, cur, wr, wc, fr, fq, PR); } else { PartialReader PR; PR.p = nullptr; E.template run<0>(acc, cur, wr, wc, fr, fq, PR); } S.done(cur); }
        if (!has_next) break;
        E.init(acc, nxt, wr, wc);
        cur = nxt; cA = nA; cB = nB; ++ui;
        if constexpr (ALIGN_EPI) { if (wr == 1) PG8_BAR; }
    }
    PG8_WAIT_V(0);
    if constexpr (!ALIGN_EPI) { if (wr == 0) PG8_BAR; }
    PG8_BAR;
    if constexpr (Epi::AFTER_DRAIN) { E.fused(acc, cur, wr, wc, fr, fq, lds, wid, lane); S.done(cur); }
#undef PG8_SA
#undef PG8_SB
#undef PG8_STAGE
#undef PG8_LDA
#undef PG8_LDB
#undef PG8_MMA
#undef PG8_WAIT_V
#undef PG8_WAIT_L
#undef PG8_BAR
#undef PG8_SCHED
}
}


constexpr int NWAVES = 8, NTHREADS = 512;
constexpr int DM = 2048, SEQ = 4096, NBP = 2, NROWP = 8192, NBS = 8, NSS = 16, NROWS = 128, NROW = 8320, MPAD = 8448, INDIM = 4864, DEPTH = 4;
constexpr int ZP = INDIM;
constexpr int ZC_U = 0, ZC_GA = 1024, ZC_Q = 1536, ZC_K = 2560, ZC_V = 2688, ZC_GB = 2816, ZC_CQ = 3840, ZC_GC = 4352;
constexpr float LOG2E = 1.4426950408889634f;
using pg8::OFF_YP; using pg8::OFF_YS; using pg8::OFF_KP; using pg8::OFF_VP; using pg8::OFF_CP; using pg8::OFF_MKP; using pg8::OFF_MVP; using pg8::OFF_KS; using pg8::OFF_VS; using pg8::OFF_CS; using pg8::OUT_TOTAL;

constexpr size_t MiB = 1u << 20;
constexpr size_t WS_CTL = 0, CTL_ZERO_BYTES = 1 * MiB;
constexpr size_t WS_BT = 1 * MiB;
constexpr size_t WS_SSQ = 2 * MiB;
constexpr size_t WS_WIN = 4 * MiB;
constexpr size_t WS_WOUT = 80 * MiB;
constexpr size_t WS_WMEM = 112 * MiB;
constexpr size_t WS_WPW = 128 * MiB;
constexpr size_t WS_MEMN = 130 * MiB;
constexpr size_t WS_MKVP = 132 * MiB;
constexpr size_t WS_CMK = 136 * MiB, WS_CMV = 144 * MiB;
constexpr size_t WS_CSK = 152 * MiB, WS_CSV = 153 * MiB;
constexpr size_t WS_XB = 154 * MiB;
constexpr size_t WS_X = 187 * MiB;
constexpr size_t WS_Z = 253 * MiB;
constexpr size_t WS_YMIX = 332 * MiB;
constexpr size_t WS_DUMP = 365 * MiB;
constexpr size_t WS_END = 429 * MiB;
constexpr int CW_BAR = 4096, CW_SK = 65536;

constexpr int RING_BYTES = 131072;
constexpr int LDSCTL_OFF = 158720, MISC_OFF = LDSCTL_OFF + 320;
constexpr int LDS_BYTES = 159744;


#define GAS __attribute__((address_space(1)))
#define LAS __attribute__((address_space(3)))
typedef unsigned short bf16;
typedef unsigned v4u __attribute__((ext_vector_type(4)));
typedef float f32x4 __attribute__((ext_vector_type(4)));
typedef short bf16x8 __attribute__((ext_vector_type(8)));
typedef GAS unsigned gu32;
typedef GAS unsigned long long gu64;
#define RLX_AGENT __ATOMIC_RELAXED, __HIP_MEMORY_SCOPE_AGENT
#define LDS_WAIT() asm volatile("s_waitcnt lgkmcnt(0)" ::: "memory")
#define VM_WAIT() asm volatile("s_waitcnt vmcnt(0)" ::: "memory")
__device__ __forceinline__ unsigned long long rt() { return __builtin_amdgcn_s_memrealtime(); }
__device__ __forceinline__ unsigned f2bf(float f) { unsigned u = __builtin_bit_cast(unsigned, f); return (u + 0x7fffu + ((u >> 16) & 1u)) >> 16; }
__device__ __forceinline__ unsigned pk2(float lo, float hi) { return f2bf(lo) | (f2bf(hi) << 16); }

#define XB_TMO      128
#define XB_XCNT(j)  (256  + 64 * (j))
#define XB_XSUB(j)  (1280 + 64 * (j))
#define XB_XGEN(j)  (2304 + 64 * (j))
#define XB_TOP      3328
#define XB_TOPGEN   3392
#define XCD_BAR_WORDS 3456
#define XB_SPIN_CAP (1u << 18)

__device__ __forceinline__ unsigned xb_ld(unsigned* p)              { return __hip_atomic_load(p, __ATOMIC_RELAXED, __HIP_MEMORY_SCOPE_AGENT); }
__device__ __forceinline__ unsigned xb_add(unsigned* p, unsigned v) { return __hip_atomic_fetch_add(p, v, __ATOMIC_RELAXED, __HIP_MEMORY_SCOPE_AGENT); }
__device__ __forceinline__ unsigned xb_xcc_id() { return (unsigned)__builtin_amdgcn_s_getreg((3 << 11) | 20) & 0xFu; }
#define XB_SPIN(cond, bar) do { unsigned _sp = 0; while (cond) { __builtin_amdgcn_s_sleep(1); \
    if ((++_sp & 255u) == 0u) { if (xb_ld(&(bar)[XB_TMO])) break; if (_sp > XB_SPIN_CAP) { atomicAdd(&(bar)[XB_TMO], 1u); break; } } } } while (0)

struct XcdBarrier {
    unsigned* bar; unsigned x;
    volatile LAS unsigned* st;
};

__device__ __forceinline__ XcdBarrier xcd_barrier_post(unsigned* bar, volatile LAS unsigned* st) {
    XcdBarrier b; b.bar = bar; b.x = xb_xcc_id(); b.st = st;
    if (threadIdx.x == 0) (void)xb_add(&bar[XB_XCNT(b.x)], 1u);
    return b;
}
__device__ __forceinline__ void xcd_barrier_complete(unsigned* bar, unsigned x, unsigned& nloc, unsigned& nx) {
    const unsigned G = gridDim.x * gridDim.y * gridDim.z;
    unsigned sum, cnt, mine, sp = 0u;
    for (;;) {
        sum = 0u; cnt = 0u; mine = 0u;
#pragma unroll
        for (unsigned j = 0; j < 16; ++j) { const unsigned c = xb_ld(&bar[XB_XCNT(j)]); sum += c; cnt += (c > 0u) ? 1u : 0u; mine = (j == x) ? c : mine; }
        if (sum == G) break;
        __builtin_amdgcn_s_sleep(1);
        if ((++sp & 255u) == 0u) { if (xb_ld(&bar[XB_TMO])) break; if (sp > XB_SPIN_CAP) { atomicAdd(&bar[XB_TMO], 1u); break; } }
    }
    nloc = mine > 0u ? mine : 1u; nx = cnt > 0u ? cnt : 1u;
}

__device__ __forceinline__ void xcd_barrier(const XcdBarrier& b) {
    asm volatile("s_waitcnt vmcnt(0)" ::: "memory");
    __syncthreads();
    int xb_tid = threadIdx.x; asm volatile("" : "+v"(xb_tid));
    if (xb_tid == 0) {
        unsigned* bar = b.bar;
        __builtin_amdgcn_s_waitcnt(0);
        unsigned nloc = b.st[0], nx = b.st[1];
        if (nloc == 0u) { xcd_barrier_complete(bar, b.x, nloc, nx); b.st[0] = nloc; b.st[1] = nx; }
        const unsigned old = xb_add(&bar[XB_XSUB(b.x)], 1u);
        const unsigned gen = old / nloc;
        if (old + 1u == (gen + 1u) * nloc) {
            __builtin_amdgcn_fence(__ATOMIC_RELEASE, "agent");
            asm volatile("s_waitcnt vmcnt(0)" ::: "memory");
            const unsigned og = xb_add(&bar[XB_TOP], 1u);
            const unsigned tg = og / nx;
            if (og + 1u == (tg + 1u) * nx) xb_add(&bar[XB_TOPGEN], 1u);
            else XB_SPIN(xb_ld(&bar[XB_TOPGEN]) == tg, bar);
            __builtin_amdgcn_fence(__ATOMIC_ACQUIRE, "agent");
            xb_add(&bar[XB_XGEN(b.x)], 1u);
            asm volatile("s_waitcnt vmcnt(0)" ::: "memory");
        } else {
            XB_SPIN(xb_ld(&bar[XB_XGEN(b.x)]) == gen, bar);
            __builtin_amdgcn_fence(__ATOMIC_ACQUIRE, "agent");
            asm volatile("s_waitcnt vmcnt(0)" ::: "memory");
        }
    }
    __syncthreads();
}


struct Args { const float* in[22]; float* out; unsigned char* ws; int ph_lo, ph_hi; int mix_mask, pflags; };
struct Frame {
    LAS unsigned char* lds; unsigned char* glds;
    volatile LAS unsigned* MISC;
    gu32* ctl;
    int tid, lane, wave, vcu, G;
};
__device__ __forceinline__ float wave_sum(float v) {
#pragma unroll
    for (int o = 1; o < 64; o <<= 1) v += __shfl_xor(v, o);
    return v;
}
__device__ __forceinline__ float wave_max(float v) {
#pragma unroll
    for (int o = 1; o < 64; o <<= 1) v = fmaxf(v, __shfl_xor(v, o));
    return v;
}
__device__ __forceinline__ int opaque_tid() { int t = threadIdx.x; asm volatile("" : "+v"(t)); return t; }
__device__ __forceinline__ float bf2f(bf16 v) { return __builtin_bit_cast(float, (unsigned)v << 16); }
__device__ __forceinline__ float rbf(float f) { return __builtin_bit_cast(float, f2bf(f) << 16); }

__device__ __forceinline__ void p0_transpose_item(const float* W, int K, int N, const float* g, bf16* WT, int k0, int n0, int dst_row0, LAS float* scr, int lane) {
    const int kq = lane >> 4, n4 = (lane & 15) * 4;
    f32x4 v[16];
#pragma unroll
    for (int i = 0; i < 16; ++i) v[i] = *(const GAS f32x4*)(W + (size_t)(k0 + 4 * i + kq) * N + n0 + n4);
    if (g) {
#pragma unroll
        for (int i = 0; i < 16; ++i) v[i] = v[i] * g[k0 + 4 * i + kq];
    }
#pragma unroll
    for (int i = 0; i < 16; ++i) { LAS float* d = scr + (4 * i + kq) * 65 + n4; d[0] = v[i].x; d[1] = v[i].y; d[2] = v[i].z; d[3] = v[i].w; }
    LDS_WAIT(); asm volatile("" ::: "memory");
    const int c = lane & 7;
#pragma unroll
    for (int s8 = 0; s8 < 8; ++s8) { const int n = 8 * s8 + (lane >> 3); const LAS float* s = scr + (8 * c) * 65 + n;
        v4u o; o.x = pk2(s[0 * 65], s[1 * 65]); o.y = pk2(s[2 * 65], s[3 * 65]); o.z = pk2(s[4 * 65], s[5 * 65]); o.w = pk2(s[6 * 65], s[7 * 65]);
        *(GAS v4u*)(WT + (size_t)(dst_row0 + n) * K + k0 + 8 * c) = o; }
    LDS_WAIT(); asm volatile("" ::: "memory");
}
__device__ __forceinline__ int t5_bucket(int rel) {
    const int side = rel > 0 ? 16 : 0, n = rel < 0 ? -rel : rel;
    const int large = 8 + (n >= 12) + (n >= 16) + (n >= 23) + (n >= 32) + (n >= 46) + (n >= 64) + (n >= 91);
    return side + (n < 8 ? n : large);
}
__device__ __forceinline__ void convert_items(const Args& A, unsigned char* ws, LAS float* scr, int lane, int first, int stride, int l_lo, int l_hi, bool with_mem) {
    constexpr int I_IN = 32 * 76, I_OUT = 32 * 32, I_PW = 8 * 8, PER = I_IN + I_OUT + I_PW, I_MEM = 32 * 16;
    const int nlay = (l_hi - l_lo) * PER, total = nlay + (with_mem ? DEPTH * I_MEM : 0);
#pragma unroll 1
    for (int it = first; it < total; it += stride) {
        const float* W; const float* g = nullptr; bf16* WT; int K = DM, N, kb, n0, dst;
        if (it < nlay) {
            const int l = l_lo + it / PER, r = it % PER;
            if (r < I_IN) { kb = r / 76; n0 = (r % 76) * 64; N = INDIM; W = A.in[9] + (size_t)l * DM * INDIM; g = A.in[8] + l * DM; WT = (bf16*)(ws + WS_WIN) + (size_t)l * INDIM * DM;
                if (n0 < 512) dst = 256 * (n0 >> 7) + (n0 & 127); else if (n0 < 1024) dst = 256 * ((n0 - 512) >> 7) + 128 + (n0 & 127); else dst = n0; }
            else if (r < I_IN + I_OUT) { const int q = r - I_IN; kb = q / 32; n0 = (q % 32) * 64; dst = n0; N = DM; W = A.in[20] + (size_t)l * DM * DM; WT = (bf16*)(ws + WS_WOUT) + (size_t)l * DM * DM; }
            else { const int q = r - I_IN - I_OUT; kb = q / 8; n0 = (q % 8) * 64; dst = n0; N = 512; K = 512; W = A.in[14] + (size_t)l * 512 * 512; WT = (bf16*)(ws + WS_WPW) + (size_t)l * 512 * 512; }
        } else {
            const int r = it - nlay, l = r / I_MEM, q = r % I_MEM; kb = q / 16; n0 = (q % 16) * 64; dst = n0; N = 1024; W = A.in[18] + (size_t)l * DM * 1024; g = A.in[17] + l * DM; WT = (bf16*)(ws + WS_WMEM) + (size_t)l * 1024 * DM;
        }
        p0_transpose_item(W, K, N, g, WT, kb * 64, n0, dst, scr, lane);
    }
}
__device__ __forceinline__ void p0_prologue(Frame& F, const Args& A) {
    unsigned char* ws = A.ws;
    const int tid_ = opaque_tid(), lane = tid_ & 63, wave_ = __builtin_amdgcn_readfirstlane(tid_ >> 6);
    const int gw = F.vcu * NWAVES + wave_, NGW = F.G * NWAVES;
    convert_items(A, ws, (LAS float*)(F.lds + wave_ * 17408), lane, gw, NGW, 0, 1, true);
    bf16* XB = (bf16*)(ws + WS_XB); float* SSQ = (float*)(ws + WS_SSQ);
    for (int m = gw; m < MPAD; m += NGW) {
        GAS unsigned long long* o8 = (GAS unsigned long long*)(XB + (size_t)m * DM) + lane;
        if (m >= NROW) {
#pragma unroll
            for (int j = 0; j < 8; ++j) o8[64 * j] = 0ull;
            continue;
        }
        const float* src = (m < NROWP) ? A.in[0] + (size_t)m * DM : A.in[1] + (size_t)(m - NROWP) * DM;
        const GAS f32x4* xr = (const GAS f32x4*)src + lane;
        float s = 0.f;
#pragma unroll
        for (int j = 0; j < 8; ++j) { const f32x4 v = xr[64 * j]; s += (v.x * v.x + v.y * v.y) + (v.z * v.z + v.w * v.w);
            o8[64 * j] = (unsigned long long)pk2(v.x, v.y) | ((unsigned long long)pk2(v.z, v.w) << 32); }
        s = wave_sum(s);
        if (lane < 32) SSQ[(size_t)m * 32 + lane] = (lane == 0) ? s : 0.f;
    }
    for (int m = gw; m < 512; m += NGW) {
        const GAS f32x4* xr = (const GAS f32x4*)(A.in[2] + (size_t)m * DM) + lane;
        f32x4 v[8]; float s = 0.f;
#pragma unroll
        for (int j = 0; j < 8; ++j) { v[j] = xr[64 * j]; s += (v[j].x * v[j].x + v[j].y * v[j].y) + (v[j].z * v[j].z + v[j].w * v[j].w); }
        const float rstd = 1.0f / sqrtf(wave_sum(s) * (1.0f / DM) + 1e-6f);
        GAS unsigned long long* o8 = (GAS unsigned long long*)((bf16*)(ws + WS_MEMN) + (size_t)m * DM) + lane;
#pragma unroll
        for (int j = 0; j < 8; ++j) o8[64 * j] = (unsigned long long)pk2(v[j].x * rstd, v[j].y * rstd) | ((unsigned long long)pk2(v[j].z * rstd, v[j].w * rstd) << 32);
    }
    const int gt = gw * 64 + lane, NGT = NGW * 64;
    {
        const f32x4* sk = (const f32x4*)A.in[6]; const f32x4* sv = (const f32x4*)A.in[7];
        unsigned long long* dk = (unsigned long long*)(ws + WS_CMK); unsigned long long* dv = (unsigned long long*)(ws + WS_CMV);
        for (int i = gt; i < 1048576; i += NGT) { const f32x4 a = sk[i], b = sv[i];
            dk[i] = (unsigned long long)pk2(a.x, a.y) | ((unsigned long long)pk2(a.z, a.w) << 32);
            dv[i] = (unsigned long long)pk2(b.x, b.y) | ((unsigned long long)pk2(b.z, b.w) << 32); }
        const f32x4* ck = (const f32x4*)A.in[3]; const f32x4* cv = (const f32x4*)A.in[4];
        unsigned long long* ek = (unsigned long long*)(ws + WS_CSK); unsigned long long* ev = (unsigned long long*)(ws + WS_CSV);
        for (int i = gt; i < 131072; i += NGT) { const f32x4 a = ck[i], b = cv[i];
            ek[i] = (unsigned long long)pk2(a.x, a.y) | ((unsigned long long)pk2(a.z, a.w) << 32);
            ev[i] = (unsigned long long)pk2(b.x, b.y) | ((unsigned long long)pk2(b.z, b.w) << 32);
            const int lb = i >> 12, rem = i & 4095, row = rem >> 5, c4 = rem & 31;
            if (row >= 16) { const size_t o = ((size_t)lb * 128 + (row - 16)) * 128 + c4 * 4;
                *(f32x4*)(A.out + OFF_KS + o) = a; *(f32x4*)(A.out + OFF_VS + o) = b; } }
        const f32x4* cc = (const f32x4*)A.in[5];
        for (int i = gt; i < 32 * 30 * 128; i += NGT) { const int lb = i / 3840, rem = i % 3840, row = rem >> 7, c4 = rem & 127;
            if (row >= 16) *(f32x4*)(A.out + OFF_CS + ((size_t)lb * 30 + (row - 16)) * 512 + c4 * 4) = cc[i]; }
        float* BT = (float*)(ws + WS_BT);
        for (int i = gt; i < 16 * 256; i += NGT) { const int h = i >> 8, idx = i & 255; const int rel = idx - 191;
            BT[i] = (idx < 255) ? A.in[19][t5_bucket(rel) * 16 + h] * LOG2E : 0.f; }
    }
}

struct KSrc { const bf16* p0; int pitch0; int n0; const bf16* p1; int pitch1; };
__device__ __forceinline__ const bf16* ks_row(const KSrc& s, int j) { return j < s.n0 ? s.p0 + (long)j * s.pitch0 : s.p1 + (long)(j - s.n0) * s.pitch1; }

template <int HD, bool SWA>
__device__ __forceinline__ void naive_attn(float* S, float* INV, const bf16* Q, int qpitch, int nq, KSrc ks, KSrc vs, int jlo, int nk,
                                           const float* btab, float sink2, const bf16* gate, int gpitch, bf16* out, int opitch) {
    const int tid = opaque_tid(), lane = tid & 63, wave = tid >> 6;
#pragma unroll 1
    for (int idx = tid; idx < nq * nk; idx += NTHREADS) {
        const int i = idx / nk, j = idx - i * nk;
        float s;
        if (j < jlo) s = -1e30f;
        else {
            const bf16* q = Q + (long)i * qpitch; const bf16* k = ks_row(ks, j);
            float a = 0.f;
#pragma unroll 2
            for (int d = 0; d < HD; d += 8) {
                const v4u qv = *(const v4u*)(q + d), kv = *(const v4u*)(k + d);
                a += __builtin_bit_cast(float, qv.x << 16) * __builtin_bit_cast(float, kv.x << 16) + __builtin_bit_cast(float, qv.x & 0xffff0000u) * __builtin_bit_cast(float, kv.x & 0xffff0000u);
                a += __builtin_bit_cast(float, qv.y << 16) * __builtin_bit_cast(float, kv.y << 16) + __builtin_bit_cast(float, qv.y & 0xffff0000u) * __builtin_bit_cast(float, kv.y & 0xffff0000u);
                a += __builtin_bit_cast(float, qv.z << 16) * __builtin_bit_cast(float, kv.z << 16) + __builtin_bit_cast(float, qv.z & 0xffff0000u) * __builtin_bit_cast(float, kv.z & 0xffff0000u);
                a += __builtin_bit_cast(float, qv.w << 16) * __builtin_bit_cast(float, kv.w << 16) + __builtin_bit_cast(float, qv.w & 0xffff0000u) * __builtin_bit_cast(float, kv.w & 0xffff0000u);
            }
            s = a; if (SWA) s += btab[j - i + 63];
        }
        S[i * 257 + j] = s;
    }
    __syncthreads();
    for (int i = wave; i < nq; i += NWAVES) {
        float m = SWA ? sink2 : -3.0e38f;
        for (int j = lane; j < nk; j += 64) m = fmaxf(m, S[i * 257 + j]);
        m = wave_max(m);
        float sum = 0.f;
        for (int j = lane; j < nk; j += 64) { const float p = exp2f(S[i * 257 + j] - m); sum += p; S[i * 257 + j] = rbf(p); }
        sum = wave_sum(sum);
        if (SWA) sum += exp2f(sink2 - m);
        if (lane == 0) INV[i] = 1.0f / sum;
    }
    __syncthreads();
#pragma unroll 1
    for (int idx = tid; idx < nq * HD; idx += NTHREADS) {
        const int i = idx / HD, d = idx % HD;
        float o = 0.f;
#pragma unroll 4
        for (int j = jlo; j < nk; ++j) o += S[i * 257 + j] * bf2f(ks_row(vs, j)[d]);
        o *= INV[i];
        o *= bf2f(gate[(long)i * gpitch + d]);
        out[(long)i * opitch + d] = (bf16)f2bf(o);
    }
    __syncthreads();
}

__device__ __forceinline__ void naive_conv(float* C, const bf16* Useq, int t0, int nfr, const float* left, const float* cw, const float* cb, const float* lng, const float* lnb,
                                           const float* wpw  , const float* bpw, const bf16* gate  , bf16* out  ) {
    const int tid = opaque_tid(), lane = tid & 63, wave = tid >> 6;
    {
        const int ch = tid;
        float w[31];
#pragma unroll
        for (int j = 0; j < 31; ++j) w[j] = cw[j * 512 + ch];
        const float b = cb[ch];
#pragma unroll 1
        for (int tt = 0; tt < 64; ++tt) {
            float a = 0.f;
            if (tt < nfr) {
                a = b;
#pragma unroll
                for (int j = 0; j < 31; ++j) { const int e = t0 + tt - 30 + j;
                    const float uv = (e >= 0) ? bf2f(Useq[(long)e * ZP + ch]) : (left ? left[(30 + e) * 512 + ch] : 0.f);
                    a += w[j] * uv; }
            }
            C[tt * 516 + ch] = a;
        }
    }
    __syncthreads();
    for (int tt = wave; tt < 64; tt += NWAVES) {
        float v[8]; float s = 0.f;
#pragma unroll
        for (int j = 0; j < 8; ++j) { v[j] = C[tt * 516 + lane + 64 * j]; s += v[j]; }
        const float mu = wave_sum(s) * (1.0f / 512.0f); float q = 0.f;
#pragma unroll
        for (int j = 0; j < 8; ++j) { v[j] -= mu; q += v[j] * v[j]; }
        const float rstd = 1.0f / sqrtf(wave_sum(q) * (1.0f / 512.0f) + 1e-6f);
#pragma unroll
        for (int j = 0; j < 8; ++j) { const int ch = lane + 64 * j; const float y = v[j] * rstd * lng[ch] + lnb[ch]; C[tt * 516 + ch] = rbf(y / (1.0f + __expf(-y))); }
    }
    __syncthreads();
    {
        const int n = tid;
        const float bb = bpw[n];
#pragma unroll 1
        for (int tg = 0; tg < 64; tg += 16) {
            if (tg >= nfr) break;
            float acc[16];
#pragma unroll
            for (int tt = 0; tt < 16; ++tt) acc[tt] = 0.f;
#pragma unroll 1
            for (int k = 0; k < 512; k += 4) {
                const float w0 = rbf(wpw[(size_t)(k + 0) * 512 + n]), w1 = rbf(wpw[(size_t)(k + 1) * 512 + n]), w2 = rbf(wpw[(size_t)(k + 2) * 512 + n]), w3 = rbf(wpw[(size_t)(k + 3) * 512 + n]);
#pragma unroll
                for (int tt = 0; tt < 16; ++tt) { const f32x4 c = *(const f32x4*)(C + (tg + tt) * 516 + k); acc[tt] += (c.x * w0 + c.y * w1) + (c.z * w2 + c.w * w3); }
            }
#pragma unroll
            for (int tt = 0; tt < 16; ++tt) if (tg + tt < nfr) out[(long)(tg + tt) * DM + n] = (bf16)f2bf((acc[tt] + bb) * bf2f(gate[(long)(tg + tt) * ZP + n]));
        }
    }
    __syncthreads();
}

__device__ __forceinline__ void naive_mixer_phase(Frame& F, const Args& A, int l) {
    unsigned char* ws = A.ws;
    float* S = (float*)F.glds;
    float* INV = S + 64 * 257;
    const bf16* Z = (const bf16*)(ws + WS_Z); bf16* Y = (bf16*)(ws + WS_YMIX);
    const float* BT = (const float*)(ws + WS_BT);
    constexpr int U0 = 128, U1 = U0 + 8, U2 = U1 + 512, U3 = U2 + 32, U4 = U3 + 2048, U5 = U4 + 128;
    for (int u = blockIdx.x; u < U5; u += F.G) {
        if (!((A.mix_mask >> (u < U1 ? 0 : (u < U3 ? 1 : 2))) & 1)) continue;
        if (u < U1) {
            int rowbase, t0, nfr; const float* left = nullptr;
            if (u < U0) { const int b = u >> 6, c = u & 63; rowbase = b * SEQ; t0 = c * 64; nfr = 64; }
            else { const int b = u - U0; rowbase = NROWP + b * NSS; t0 = 0; nfr = NSS; left = A.in[5] + (size_t)(l * 8 + b) * 30 * 512; }
            naive_conv(S, Z + (size_t)rowbase * ZP + ZC_U, t0, nfr, left, A.in[10] + l * 31 * 512, A.in[11] + l * 512, A.in[12] + l * 512, A.in[13] + l * 512,
                       A.in[14] + (size_t)l * 512 * 512, A.in[15] + l * 512, Z + (size_t)(rowbase + t0) * ZP + ZC_GA, Y + (size_t)(rowbase + t0) * DM);
        } else if (u < U3) {
            int row0, nq, h; KSrc ks, vs;
            if (u < U2) { const int v = u - U1, b = v >> 8, h_ = (v >> 6) & 3, qt = v & 63; h = h_; row0 = b * SEQ + qt * 64; nq = 64;
                const bf16* kb = (const bf16*)(ws + WS_MKVP) + (size_t)(b * 256) * 4096 + l * 1024 + h * 128;
                ks = KSrc{kb, 4096, 256, kb, 4096}; vs = KSrc{kb + 512, 4096, 256, kb + 512, 4096}; }
            else { const int v = u - U2, b = v >> 2; h = v & 3; row0 = NROWP + b * NSS; nq = NSS;
                const bf16* kb = (const bf16*)(ws + WS_CMK) + (size_t)((l * 8 + b) * 256) * 512 + h * 128; const bf16* vb = (const bf16*)(ws + WS_CMV) + (size_t)((l * 8 + b) * 256) * 512 + h * 128;
                ks = KSrc{kb, 512, 256, kb, 512}; vs = KSrc{vb, 512, 256, vb, 512}; }
            naive_attn<128, false>(S, INV, Z + (size_t)row0 * ZP + ZC_CQ + h * 128, ZP, nq, ks, vs, 0, 256, nullptr, 0.f,
                                   Z + (size_t)row0 * ZP + ZC_GC + h * 128, ZP, Y + (size_t)row0 * DM + 1536 + h * 128, DM);
        } else {
            int row0, nq, h, jlo, nk; KSrc ks, vs;
            if (u < U4) { const int v = u - U3, b = v >> 10, c = (v >> 4) & 63; h = v & 15; row0 = b * SEQ + c * 64; nq = 64; const int kv = h >> 3;
                const bf16* kb = Z + ((long)row0 - 128) * ZP + ZC_K + kv * 64;
                ks = KSrc{kb, ZP, 192, kb, ZP}; vs = KSrc{kb + (ZC_V - ZC_K), ZP, 192, kb + (ZC_V - ZC_K), ZP}; jlo = (c >= 2) ? 0 : 128 - 64 * c; nk = 192; }
            else { const int v = u - U4, b = v >> 4; h = v & 15; row0 = NROWP + b * NSS; nq = NSS; const int kv = h >> 3;
                const bf16* ck = (const bf16*)(ws + WS_CSK) + (size_t)((l * 8 + b) * 128) * 128 + kv * 64; const bf16* cv = (const bf16*)(ws + WS_CSV) + (size_t)((l * 8 + b) * 128) * 128 + kv * 64;
                const bf16* zk = Z + (size_t)row0 * ZP + ZC_K + kv * 64;
                ks = KSrc{ck, 128, 128, zk, ZP}; vs = KSrc{cv, 128, 128, zk + (ZC_V - ZC_K), ZP}; jlo = 0; nk = 144; }
            naive_attn<64, true>(S, INV, Z + (size_t)row0 * ZP + ZC_Q + h * 64, ZP, nq, ks, vs, jlo, nk, BT + h * 256, A.in[16][l * 16 + h] * LOG2E,
                                 Z + (size_t)row0 * ZP + ZC_GB + h * 64, ZP, Y + (size_t)row0 * DM + 512 + h * 64, DM);
        }
    }
}

#define LDS_BARRIER() asm volatile("s_waitcnt lgkmcnt(0)\n\ts_barrier" ::: "memory")
typedef float f32x16 __attribute__((ext_vector_type(16)));
typedef short s16x4 __attribute__((ext_vector_type(4)));
__device__ __forceinline__ bf16x8 pack_bf16x8(float a0, float a1, float a2, float a3, float a4, float a5, float a6, float a7) {
    v4u w; w.x = pg8::cvt_pk_bf16(a0, a1); w.y = pg8::cvt_pk_bf16(a2, a3); w.z = pg8::cvt_pk_bf16(a4, a5); w.w = pg8::cvt_pk_bf16(a6, a7);
    return __builtin_bit_cast(bf16x8, w);
}
__device__ __forceinline__ bf16x8 join4(s16x4 lo, s16x4 hi) { return (bf16x8){lo[0], lo[1], lo[2], lo[3], hi[0], hi[1], hi[2], hi[3]}; }
__device__ __forceinline__ float ex2(float x) { return __builtin_amdgcn_exp2f(x); }

constexpr int SW_KP = 144, SW_VP = 408;
constexpr int SW_KS = 0, SW_VT = 192 * SW_KP, SW_BT = SW_VT + 64 * SW_VP, SW_END = SW_BT + 8 * 256 * 4;
__device__ __forceinline__ int swa_vt_off(int d, int key) { return d * SW_VP + ((((key >> 2) ^ ((d >> 3) & 7))) << 3) + (key & 3) * 2; }
struct SwaUnit { const bf16* q; int nq; KSrc ks, vs; int jlo, nk; const bf16* gate; bf16* out; int kvh; };

__device__ __forceinline__ void swa_unit(LAS unsigned char* L, const SwaUnit& U, const float* BT, const float* sinks) {
    const int tid = opaque_tid(), lane = tid & 63, wave = __builtin_amdgcn_readfirstlane(tid >> 6);
    typedef unsigned u32x2v __attribute__((ext_vector_type(2)));
    const int i32 = lane & 31, hf = lane >> 5, g = wave;
    v4u kreg[3], va[2], vb[2]; float btv[4]; bf16x8 qf[2][4]; u32x2v gv[2][2][4];
#pragma unroll
    for (int it = 0; it < 3; ++it) {
        const int t = tid + NTHREADS * it, row = t >> 3, c8 = t & 7;
        kreg[it] = (v4u){0u, 0u, 0u, 0u};
        if (row >= U.jlo && row < U.nk) kreg[it] = *(const v4u*)(ks_row(U.ks, row) + c8 * 8);
    }
#pragma unroll
    for (int it = 0; it < 2; ++it) {
        const int t = tid + NTHREADS * it, rp = t >> 3, c8 = t & 7, j0 = 2 * rp;
        va[it] = (v4u){0u, 0u, 0u, 0u}; vb[it] = (v4u){0u, 0u, 0u, 0u};
        if (t < 768) {
            if (j0 >= U.jlo && j0 < U.nk) va[it] = *(const v4u*)(ks_row(U.vs, j0) + c8 * 8);
            if (j0 + 1 >= U.jlo && j0 + 1 < U.nk) vb[it] = *(const v4u*)(ks_row(U.vs, j0 + 1) + c8 * 8);
        }
    }
#pragma unroll
    for (int it = 0; it < 4; ++it) btv[it] = BT[U.kvh * 8 * 256 + tid + NTHREADS * it];
#pragma unroll
    for (int qb = 0; qb < 2; ++qb) {
        const int i = qb * 32 + i32, iq = (i < U.nq) ? i : 0;
        const bf16* qrow = U.q + (long)iq * ZP + g * 64;
#pragma unroll
        for (int ds = 0; ds < 4; ++ds) qf[qb][ds] = *(const bf16x8*)(qrow + 16 * ds + 8 * hf);
#pragma unroll
        for (int dt = 0; dt < 2; ++dt)
#pragma unroll
            for (int g4 = 0; g4 < 4; ++g4) gv[qb][dt][g4] = *(const u32x2v*)(U.gate + (long)iq * ZP + g * 64 + dt * 32 + 8 * g4 + 4 * hf);
    }
    const float sink2 = sinks[U.kvh * 8 + g] * LOG2E;
#pragma unroll
    for (int it = 0; it < 3; ++it) { const int t = tid + NTHREADS * it, row = t >> 3, c8 = t & 7; *(LAS v4u*)(L + SW_KS + row * SW_KP + c8 * 16) = kreg[it]; }
#pragma unroll
    for (int it = 0; it < 2; ++it) {
        const int t = tid + NTHREADS * it, rp = t >> 3, c8 = t & 7, j0 = 2 * rp;
        if (t < 768) {
#pragma unroll
            for (int e = 0; e < 8; ++e) {
                const unsigned lo = (va[it][e >> 1] >> (16 * (e & 1))) & 0xffffu, hi = (vb[it][e >> 1] >> (16 * (e & 1))) & 0xffffu;
                *(LAS unsigned*)(L + SW_VT + swa_vt_off(c8 * 8 + e, j0)) = lo | (hi << 16);
            }
        }
    }
#pragma unroll
    for (int it = 0; it < 4; ++it) ((LAS float*)(L + SW_BT))[tid + NTHREADS * it] = btv[it];
    __syncthreads();
    const LAS float* bt = (const LAS float*)(L + SW_BT) + g * 256;
    const bool masked = (U.jlo > 0) || (U.nk < 192);
#pragma unroll
    for (int qb = 0; qb < 2; ++qb) {
        if (qb * 32 < U.nq) {
        const int i = qb * 32 + i32;
        f32x16 S[6];
        {
            bf16x8 kf[2][4];
#pragma unroll
            for (int ds = 0; ds < 4; ++ds) kf[0][ds] = *(const LAS bf16x8*)(L + SW_KS + (0 * 32 + i32) * SW_KP + ds * 32 + hf * 16);
#pragma unroll
            for (int kt = 0; kt < 6; ++kt) {
                if (kt + 1 < 6) {
#pragma unroll
                    for (int ds = 0; ds < 4; ++ds) kf[(kt + 1) & 1][ds] = *(const LAS bf16x8*)(L + SW_KS + ((kt + 1) * 32 + i32) * SW_KP + ds * 32 + hf * 16);
                }
                f32x16 acc = {};
#pragma unroll
                for (int ds = 0; ds < 4; ++ds) acc = __builtin_amdgcn_mfma_f32_32x32x16_bf16(kf[kt & 1][ds], qf[qb][ds], acc, 0, 0, 0);
                S[kt] = acc;
            }
        }
        float m = sink2;
        const LAS float* btl = bt + (4 * hf - i + 63);
#pragma unroll
        for (int kt = 0; kt < 6; ++kt)
#pragma unroll
            for (int r = 0; r < 16; ++r) {
                const int j = kt * 32 + (r & 3) + 8 * (r >> 2) + 4 * hf;
                float s = S[kt][r] + btl[kt * 32 + (r & 3) + 8 * (r >> 2)];
                if (masked) { if (j < U.jlo || j >= U.nk) s = -1e30f; }
                S[kt][r] = s; m = fmaxf(m, s);
            }
        m = fmaxf(m, __shfl_xor(m, 32));
        float lsum = 0.f;
#pragma unroll
        for (int kt = 0; kt < 6; ++kt)
#pragma unroll
            for (int r = 0; r < 16; ++r) { const float p = ex2(S[kt][r] - m); S[kt][r] = p; lsum += p; }
        lsum += __shfl_xor(lsum, 32);
        const float inv = 1.0f / (lsum + ex2(sink2 - m));
        f32x16 O[2]; O[0] = (f32x16){}; O[1] = (f32x16){};
        {
            s16x4 vq[2][2][2][2];
            int vo[2][2][2];
#pragma unroll
            for (int s2 = 0; s2 < 2; ++s2)
#pragma unroll
                for (int dt = 0; dt < 2; ++dt)
#pragma unroll
                    for (int hh = 0; hh < 2; ++hh) vo[s2][dt][hh] = SW_VT + swa_vt_off(dt * 32 + i32, 16 * s2 + 4 * hf + 8 * hh);
#pragma unroll
            for (int s2 = 0; s2 < 2; ++s2)
#pragma unroll
                for (int dt = 0; dt < 2; ++dt) { vq[0][s2][dt][0] = *(const LAS s16x4*)(L + vo[s2][dt][0]); vq[0][s2][dt][1] = *(const LAS s16x4*)(L + vo[s2][dt][1]); }
#pragma unroll
            for (int kt = 0; kt < 6; ++kt) {
                if (kt + 1 < 6) {
#pragma unroll
                    for (int s2 = 0; s2 < 2; ++s2)
#pragma unroll
                        for (int dt = 0; dt < 2; ++dt) { vq[(kt + 1) & 1][s2][dt][0] = *(const LAS s16x4*)(L + vo[s2][dt][0] + (kt + 1) * 64); vq[(kt + 1) & 1][s2][dt][1] = *(const LAS s16x4*)(L + vo[s2][dt][1] + (kt + 1) * 64); }
                }
#pragma unroll
                for (int s2 = 0; s2 < 2; ++s2) {
                    const bf16x8 pf = pack_bf16x8(S[kt][8 * s2 + 0], S[kt][8 * s2 + 1], S[kt][8 * s2 + 2], S[kt][8 * s2 + 3], S[kt][8 * s2 + 4], S[kt][8 * s2 + 5], S[kt][8 * s2 + 6], S[kt][8 * s2 + 7]);
#pragma unroll
                    for (int dt = 0; dt < 2; ++dt) O[dt] = __builtin_amdgcn_mfma_f32_32x32x16_bf16(join4(vq[kt & 1][s2][dt][0], vq[kt & 1][s2][dt][1]), pf, O[dt], 0, 0, 0);
                }
            }
        }
        if (i < U.nq) {
#pragma unroll
            for (int dt = 0; dt < 2; ++dt)
#pragma unroll
                for (int g4 = 0; g4 < 4; ++g4) {
                    const int d0 = dt * 32 + 8 * g4 + 4 * hf;
                    const u32x2v gg = gv[qb][dt][g4];
                    const float o0 = O[dt][4 * g4 + 0] * inv * __builtin_bit_cast(float, gg.x << 16), o1 = O[dt][4 * g4 + 1] * inv * __builtin_bit_cast(float, gg.x & 0xffff0000u);
                    const float o2 = O[dt][4 * g4 + 2] * inv * __builtin_bit_cast(float, gg.y << 16), o3 = O[dt][4 * g4 + 3] * inv * __builtin_bit_cast(float, gg.y & 0xffff0000u);
                    u32x2v w; w.x = pg8::cvt_pk_bf16(o0, o1); w.y = pg8::cvt_pk_bf16(o2, o3);
                    *(u32x2v*)(U.out + (long)i * DM + g * 64 + d0) = w;
                }
        }
        }
    }
    LDS_BARRIER();
}

constexpr int MA_KP = 272, MA_VP = 528;
constexpr int MA_KS = 0, MA_VT = 256 * MA_KP, MA_END = MA_VT + 128 * MA_VP;
__device__ __forceinline__ int ma_vt_off(int d, int key) { return d * MA_VP + ((((key >> 2) ^ ((d >> 3) & 15))) << 3) + (key & 3) * 2; }
struct MemUnit { const bf16* q; int nq; const bf16* k; const bf16* v; int pitch; const bf16* gate; bf16* out; };

__device__ __forceinline__ void mem_unit(LAS unsigned char* L, const MemUnit& U) {
    typedef unsigned u32x2v __attribute__((ext_vector_type(2)));
    const int tid = opaque_tid(), lane = tid & 63, wave = __builtin_amdgcn_readfirstlane(tid >> 6);
    const int i16 = lane & 15, q4 = lane >> 4;
    bf16x8 qf[2][4]; u32x2v gv[2][8];
#pragma unroll
    for (int gi = 0; gi < 2; ++gi) {
        const int grp = wave + NWAVES * gi, i = (grp * 16 < U.nq) ? grp * 16 + i16 : i16;
        const bf16* qrow = U.q + (long)i * ZP;
#pragma unroll
        for (int ds = 0; ds < 4; ++ds) qf[gi][ds] = *(const bf16x8*)(qrow + 32 * ds + 8 * q4);
#pragma unroll
        for (int dt = 0; dt < 8; ++dt) gv[gi][dt] = *(const u32x2v*)(U.gate + (long)i * ZP + dt * 16 + 4 * q4);
    }
    {
        v4u kr[8];
#pragma unroll
        for (int it = 0; it < 8; ++it) { const int t = tid + NTHREADS * it, row = t >> 4, c8 = t & 15; kr[it] = *(const v4u*)(U.k + (long)row * U.pitch + c8 * 8); }
#pragma unroll
        for (int it = 0; it < 8; ++it) { const int t = tid + NTHREADS * it, row = t >> 4, c8 = t & 15; *(LAS v4u*)(L + MA_KS + row * MA_KP + c8 * 16) = kr[it]; }
    }
    {
        v4u va[4], vb[4];
#pragma unroll
        for (int it = 0; it < 4; ++it) { const int t = tid + NTHREADS * it, rp = t >> 4, c8 = t & 15, j0 = 2 * rp;
            va[it] = *(const v4u*)(U.v + (long)j0 * U.pitch + c8 * 8); vb[it] = *(const v4u*)(U.v + (long)(j0 + 1) * U.pitch + c8 * 8); }
#pragma unroll
        for (int it = 0; it < 4; ++it) { const int t = tid + NTHREADS * it, rp = t >> 4, c8 = t & 15, j0 = 2 * rp;
#pragma unroll
            for (int e = 0; e < 8; ++e) {
                const unsigned lo = (va[it][e >> 1] >> (16 * (e & 1))) & 0xffffu, hi = (vb[it][e >> 1] >> (16 * (e & 1))) & 0xffffu;
                *(LAS unsigned*)(L + MA_VT + ma_vt_off(c8 * 8 + e, j0)) = lo | (hi << 16);
            } }
    }
    __syncthreads();
#pragma unroll
    for (int gi = 0; gi < 2; ++gi) {
        const int grp = wave + NWAVES * gi;
        if (grp * 16 < U.nq) {
        const int i = grp * 16 + i16;
        f32x4 S[16];
        {
            bf16x8 kf[2][2][4];
#pragma unroll
            for (int t2 = 0; t2 < 2; ++t2)
#pragma unroll
                for (int ds = 0; ds < 4; ++ds) kf[0][t2][ds] = *(const LAS bf16x8*)(L + MA_KS + (t2 * 16 + i16) * MA_KP + ds * 64 + q4 * 16);
#pragma unroll
            for (int kp = 0; kp < 8; ++kp) {
                if (kp + 1 < 8) {
#pragma unroll
                    for (int t2 = 0; t2 < 2; ++t2)
#pragma unroll
                        for (int ds = 0; ds < 4; ++ds) kf[(kp + 1) & 1][t2][ds] = *(const LAS bf16x8*)(L + MA_KS + (((kp + 1) * 2 + t2) * 16 + i16) * MA_KP + ds * 64 + q4 * 16);
                }
#pragma unroll
                for (int t2 = 0; t2 < 2; ++t2) {
                    f32x4 acc = {};
#pragma unroll
                    for (int ds = 0; ds < 4; ++ds) acc = __builtin_amdgcn_mfma_f32_16x16x32_bf16(kf[kp & 1][t2][ds], qf[gi][ds], acc, 0, 0, 0);
                    S[kp * 2 + t2] = acc;
                }
            }
        }
        float m = -3.0e38f;
#pragma unroll
        for (int kt = 0; kt < 16; ++kt) m = fmaxf(fmaxf(m, fmaxf(S[kt][0], S[kt][1])), fmaxf(S[kt][2], S[kt][3]));
        m = fmaxf(m, __shfl_xor(m, 16)); m = fmaxf(m, __shfl_xor(m, 32));
        float lsum = 0.f;
#pragma unroll
        for (int kt = 0; kt < 16; ++kt)
#pragma unroll
            for (int r = 0; r < 4; ++r) { const float p = ex2(S[kt][r] - m); S[kt][r] = p; lsum += p; }
        lsum += __shfl_xor(lsum, 16); lsum += __shfl_xor(lsum, 32);
        const float inv = 1.0f / lsum;
        f32x4 O[8];
#pragma unroll
        for (int dt = 0; dt < 8; ++dt) O[dt] = (f32x4){0.f, 0.f, 0.f, 0.f};
        {
            s16x4 vq[2][8][2];
#pragma unroll
            for (int dt = 0; dt < 8; ++dt) { const int d = dt * 16 + i16, key0 = 4 * q4;
                vq[0][dt][0] = *(const LAS s16x4*)(L + MA_VT + ma_vt_off(d, key0)); vq[0][dt][1] = *(const LAS s16x4*)(L + MA_VT + ma_vt_off(d, key0 + 16)); }
#pragma unroll
            for (int st = 0; st < 8; ++st) {
                if (st + 1 < 8) {
#pragma unroll
                    for (int dt = 0; dt < 8; ++dt) { const int d = dt * 16 + i16, key0 = 32 * (st + 1) + 4 * q4;
                        vq[(st + 1) & 1][dt][0] = *(const LAS s16x4*)(L + MA_VT + ma_vt_off(d, key0)); vq[(st + 1) & 1][dt][1] = *(const LAS s16x4*)(L + MA_VT + ma_vt_off(d, key0 + 16)); }
                }
                const bf16x8 pf = pack_bf16x8(S[2 * st][0], S[2 * st][1], S[2 * st][2], S[2 * st][3], S[2 * st + 1][0], S[2 * st + 1][1], S[2 * st + 1][2], S[2 * st + 1][3]);
#pragma unroll
                for (int dt = 0; dt < 8; ++dt) O[dt] = __builtin_amdgcn_mfma_f32_16x16x32_bf16(join4(vq[st & 1][dt][0], vq[st & 1][dt][1]), pf, O[dt], 0, 0, 0);
            }
        }
#pragma unroll
        for (int dt = 0; dt < 8; ++dt) {
            const int d0 = dt * 16 + 4 * q4;
            const u32x2v gg = gv[gi][dt];
            const float o0 = O[dt][0] * inv * __builtin_bit_cast(float, gg.x << 16), o1 = O[dt][1] * inv * __builtin_bit_cast(float, gg.x & 0xffff0000u);
            const float o2 = O[dt][2] * inv * __builtin_bit_cast(float, gg.y << 16), o3 = O[dt][3] * inv * __builtin_bit_cast(float, gg.y & 0xffff0000u);
            u32x2v w; w.x = pg8::cvt_pk_bf16(o0, o1); w.y = pg8::cvt_pk_bf16(o2, o3);
            *(u32x2v*)(U.out + (long)i * DM + d0) = w;
        }
        }
    }
    LDS_BARRIER();
}

typedef float cv_f32x2 __attribute__((ext_vector_type(2)));
template <int R> __device__ __forceinline__ void conv_rows(cv_f32x2 (&acc)[32], const cv_f32x2 (&w)[31], const unsigned (&raw)[62], bool neg, const float* left, int ch) {
    cv_f32x2 x = (cv_f32x2){__builtin_bit_cast(float, raw[R] << 16), __builtin_bit_cast(float, raw[R] & 0xffff0000u)};
    constexpr int TLO = (R > 30) ? R - 30 : 0, THI = (R < 31) ? R : 31;
#pragma unroll
    for (int tt = TLO; tt <= THI; ++tt) acc[tt] += w[R - tt] * x;
    if constexpr (R + 1 < 62) conv_rows<R + 1>(acc, w, raw, neg, left, ch);
}
constexpr int CV_P = 2064;
__device__ __forceinline__ void conv_unit(LAS unsigned char* L, const bf16* Useq, int t0, int nfr, const float* left, const float* cw, const float* cb, const float* lng, const float* lnb,
                                          const bf16* WpwT, const float* bpw, const bf16* gate, bf16* out) {
    typedef float f32x2 __attribute__((ext_vector_type(2)));
    const int tid = opaque_tid(), lane = tid & 63, wave = __builtin_amdgcn_readfirstlane(tid >> 6);
    {
        const int cp = tid & 255, fh = __builtin_amdgcn_readfirstlane(tid >> 8), ch = 2 * cp;
        f32x2 w[31];
#pragma unroll
        for (int j = 0; j < 31; ++j) w[j] = *(const f32x2*)(cw + j * 512 + ch);
        const f32x2 bias = *(const f32x2*)(cb + ch);
        f32x2 acc[32];
#pragma unroll
        for (int tt = 0; tt < 32; ++tt) acc[tt] = bias;
        const int tbase = t0 + 32 * fh;
        unsigned raw[62];
        if (tbase == 0) {
#pragma unroll
            for (int r = 0; r < 30; ++r) raw[r] = 0u;
            if (left) {
                cv_f32x2 lf[30];
#pragma unroll
                for (int r = 0; r < 30; ++r) lf[r] = *(const cv_f32x2*)(left + r * 512 + ch);
#pragma unroll
                for (int r = 0; r < 30; ++r) raw[r] = pg8::cvt_pk_bf16(lf[r].x, lf[r].y);
            }
#pragma unroll
            for (int r = 30; r < 62; ++r) raw[r] = *(const unsigned*)(Useq + (long)(r - 30) * ZP + ch);
        } else {
#pragma unroll
            for (int r = 0; r < 62; ++r) raw[r] = *(const unsigned*)(Useq + (long)(tbase - 30 + r) * ZP + ch);
        }
        conv_rows<0>(acc, w, raw, false, left, ch);
#pragma unroll
        for (int tt = 0; tt < 32; ++tt) { const int fr_ = 32 * fh + tt; *(LAS f32x2*)(L + fr_ * CV_P + ch * 4) = (fr_ < nfr) ? acc[tt] : (f32x2){0.f, 0.f}; }
    }
    __syncthreads();
    {
        const f32x4 g0 = *(const f32x4*)(lng + 8 * lane), g1 = *(const f32x4*)(lng + 8 * lane + 4), b0 = *(const f32x4*)(lnb + 8 * lane), b1 = *(const f32x4*)(lnb + 8 * lane + 4);
        f32x4 a[8], b[8]; float sm[8];
#pragma unroll
        for (int f = 0; f < 8; ++f) { const LAS unsigned char* row = L + (wave + NWAVES * f) * CV_P; a[f] = *(const LAS f32x4*)(row + 32 * lane); b[f] = *(const LAS f32x4*)(row + 32 * lane + 16);
            sm[f] = ((a[f][0] + a[f][1]) + (a[f][2] + a[f][3])) + ((b[f][0] + b[f][1]) + (b[f][2] + b[f][3])); }
#pragma unroll
        for (int o = 1; o < 64; o <<= 1)
#pragma unroll
            for (int f = 0; f < 8; ++f) sm[f] += __shfl_xor(sm[f], o);
#pragma unroll
        for (int f = 0; f < 8; ++f) { const float mu = sm[f] * (1.0f / 512.0f); a[f] = a[f] - mu; b[f] = b[f] - mu;
            sm[f] = ((a[f][0] * a[f][0] + a[f][1] * a[f][1]) + (a[f][2] * a[f][2] + a[f][3] * a[f][3])) + ((b[f][0] * b[f][0] + b[f][1] * b[f][1]) + (b[f][2] * b[f][2] + b[f][3] * b[f][3])); }
#pragma unroll
        for (int o = 1; o < 64; o <<= 1)
#pragma unroll
            for (int f = 0; f < 8; ++f) sm[f] += __shfl_xor(sm[f], o);
#pragma unroll
        for (int f = 0; f < 8; ++f) { const float rstd = __builtin_amdgcn_rsqf(sm[f] * (1.0f / 512.0f) + 1e-6f);
            f32x4 ya = a[f] * rstd * g0 + b0, yb = b[f] * rstd * g1 + b1;
            ya = ya * pg8::sigmoid4(ya); yb = yb * pg8::sigmoid4(yb);
            *(LAS v4u*)(L + (wave + NWAVES * f) * CV_P + 16 * lane) = __builtin_bit_cast(v4u, pg8::pack8(ya, yb)); }
    }
    __syncthreads();
    {
        typedef unsigned u32x2v __attribute__((ext_vector_type(2)));
        const int i16 = lane & 15, q4 = lane >> 4;
        f32x4 acc[4][4];
#pragma unroll
        for (int rt = 0; rt < 4; ++rt)
#pragma unroll
            for (int nt = 0; nt < 4; ++nt) acc[rt][nt] = (f32x4){0.f, 0.f, 0.f, 0.f};
        const bf16* wbase = WpwT + (size_t)(64 * wave + i16) * 512 + 8 * q4;
        {
            constexpr int WD = 8;
            bf16x8 wf[WD][4], cf[2][4];
#pragma unroll
            for (int k4 = 0; k4 < WD; ++k4)
#pragma unroll
                for (int nt = 0; nt < 4; ++nt) wf[k4][nt] = *(const bf16x8*)(wbase + nt * 16 * 512 + k4 * 32);
            __builtin_amdgcn_sched_barrier(0);
#pragma unroll
            for (int rt = 0; rt < 4; ++rt) cf[0][rt] = *(const LAS bf16x8*)(L + (rt * 16 + i16) * CV_P + q4 * 16);
#pragma unroll
            for (int ks = 0; ks < 16; ++ks) {
                if (ks + 1 < 16) {
#pragma unroll
                    for (int rt = 0; rt < 4; ++rt) cf[(ks + 1) & 1][rt] = *(const LAS bf16x8*)(L + (rt * 16 + i16) * CV_P + (ks + 1) * 64 + q4 * 16);
                }
#pragma unroll
                for (int rt = 0; rt < 4; ++rt)
#pragma unroll
                    for (int nt = 0; nt < 4; ++nt) acc[rt][nt] = __builtin_amdgcn_mfma_f32_16x16x32_bf16(wf[ks % WD][nt], cf[ks & 1][rt], acc[rt][nt], 0, 0, 0);
                if (ks + WD < 16) {
#pragma unroll
                    for (int nt = 0; nt < 4; ++nt) wf[ks % WD][nt] = *(const bf16x8*)(wbase + nt * 16 * 512 + (ks + WD) * 32);
                }
                __builtin_amdgcn_sched_barrier(0);
            }
        }
        f32x4 bb[4]; u32x2v gvv[4][4];
#pragma unroll
        for (int nt = 0; nt < 4; ++nt) bb[nt] = *(const f32x4*)(bpw + 64 * wave + nt * 16 + 4 * q4);
#pragma unroll
        for (int rt = 0; rt < 4; ++rt) { const int frame = rt * 16 + i16, fl = frame < nfr ? frame : 0;
#pragma unroll
            for (int nt = 0; nt < 4; ++nt) gvv[rt][nt] = *(const u32x2v*)(gate + (long)fl * ZP + 64 * wave + nt * 16 + 4 * q4); }
#pragma unroll
        for (int rt = 0; rt < 4; ++rt) {
            const int frame = rt * 16 + i16;
            if (frame < nfr) {
#pragma unroll
                for (int nt = 0; nt < 4; ++nt) {
                    const int n0 = 64 * wave + nt * 16 + 4 * q4;
                    const u32x2v gv = gvv[rt][nt];
                    const float o0 = (acc[rt][nt][0] + bb[nt][0]) * __builtin_bit_cast(float, gv.x << 16), o1 = (acc[rt][nt][1] + bb[nt][1]) * __builtin_bit_cast(float, gv.x & 0xffff0000u);
                    const float o2 = (acc[rt][nt][2] + bb[nt][2]) * __builtin_bit_cast(float, gv.y << 16), o3 = (acc[rt][nt][3] + bb[nt][3]) * __builtin_bit_cast(float, gv.y & 0xffff0000u);
                    u32x2v wv; wv.x = pg8::cvt_pk_bf16(o0, o1); wv.y = pg8::cvt_pk_bf16(o2, o3);
                    *(u32x2v*)(out + (long)frame * DM + n0) = wv;
                }
            }
        }
    }
    LDS_BARRIER();
}

#ifndef USE_MFMA_ATTN
#define USE_MFMA_ATTN 1
#endif
#ifndef USE_MFMA_CONV
#define USE_MFMA_CONV 1
#endif
__device__ __forceinline__ void mixer_phase(Frame& F, const Args& A, int l) {
    unsigned char* ws = A.ws;
    float* S = (float*)F.glds;
    const bf16* Z = (const bf16*)(ws + WS_Z); bf16* Y = (bf16*)(ws + WS_YMIX);
    const float* BT = (const float*)(ws + WS_BT);
    constexpr int U0 = 128, U1 = U0 + 8, U2 = U1 + 128, U3 = U2 + 32, U4 = U3 + 256, U5 = U4 + 16;
    const int bx = blockIdx.x;
#pragma unroll 1
    for (int slot = 0; slot < 3; ++slot) {
        int u;
        if (slot == 0) u = (bx < 128) ? bx : U1 + (bx - 128);
        else if (slot == 1) { if (bx >= 128 && bx < 136) continue; u = U3 + bx; }
        else { const int e = bx - 128;
            if (bx >= 248) u = U3 + (bx - 120);
            else if (e < 0 || e >= 56) break;
            else u = (e < 8) ? U0 + e : (e < 40 ? U2 + (e - 8) : U4 + (e - 40)); }
        if (!((A.mix_mask >> (u < U1 ? 0 : (u < U3 ? 1 : 2))) & 1)) continue;
        if (u < U1) {
            int rowbase, t0, nfr; const float* left = nullptr;
            if (u < U0) { const int b = u >> 6, c = u & 63; rowbase = b * SEQ; t0 = c * 64; nfr = 64; }
            else { const int b = u - U0; rowbase = NROWP + b * NSS; t0 = 0; nfr = NSS; left = A.in[5] + (size_t)(l * 8 + b) * 30 * 512; }
#if USE_MFMA_CONV
            conv_unit(F.lds, Z + (size_t)rowbase * ZP + ZC_U, t0, nfr, left, A.in[10] + l * 31 * 512, A.in[11] + l * 512, A.in[12] + l * 512, A.in[13] + l * 512,
                      (const bf16*)(ws + WS_WPW) + (size_t)l * 512 * 512, A.in[15] + l * 512, Z + (size_t)(rowbase + t0) * ZP + ZC_GA, Y + (size_t)(rowbase + t0) * DM);
#else
            naive_conv(S, Z + (size_t)rowbase * ZP + ZC_U, t0, nfr, left, A.in[10] + l * 31 * 512, A.in[11] + l * 512, A.in[12] + l * 512, A.in[13] + l * 512,
                       A.in[14] + (size_t)l * 512 * 512, A.in[15] + l * 512, Z + (size_t)(rowbase + t0) * ZP + ZC_GA, Y + (size_t)(rowbase + t0) * DM);
#endif
        } else if (u < U3) {
            MemUnit M; int row0, h;
            if (u < U2) { const int v = u - U1, b = v >> 6, qblk = v & 15; h = (v >> 4) & 3; row0 = b * SEQ + qblk * 256; M.nq = 256;
                M.k = (const bf16*)(ws + WS_MKVP) + (size_t)(b * 256) * 4096 + l * 1024 + h * 128; M.v = M.k + 512; M.pitch = 4096; }
            else { const int v = u - U2, b = v >> 2; h = v & 3; row0 = NROWP + b * NSS; M.nq = NSS;
                M.k = (const bf16*)(ws + WS_CMK) + (size_t)((l * 8 + b) * 256) * 512 + h * 128; M.v = (const bf16*)(ws + WS_CMV) + (size_t)((l * 8 + b) * 256) * 512 + h * 128; M.pitch = 512; }
            M.q = Z + (size_t)row0 * ZP + ZC_CQ + h * 128; M.gate = Z + (size_t)row0 * ZP + ZC_GC + h * 128; M.out = Y + (size_t)row0 * DM + 1536 + h * 128;
            mem_unit(F.lds, M);
        } else {
            SwaUnit W; int row0, kv;
            if (u < U4) { const int v = u - U3, b = v >> 7, c = (v >> 1) & 63; kv = v & 1; row0 = b * SEQ + c * 64; W.nq = 64;
                const bf16* kb = Z + ((long)row0 - 128) * ZP + ZC_K + kv * 64;
                W.ks = KSrc{kb, ZP, 192, kb, ZP}; W.vs = KSrc{kb + (ZC_V - ZC_K), ZP, 192, kb + (ZC_V - ZC_K), ZP}; W.jlo = (c >= 2) ? 0 : 128 - 64 * c; W.nk = 192; }
            else { const int v = u - U4, b = v >> 1; kv = v & 1; row0 = NROWP + b * NSS; W.nq = NSS;
                const bf16* ck = (const bf16*)(ws + WS_CSK) + (size_t)((l * 8 + b) * 128) * 128 + kv * 64; const bf16* cv = (const bf16*)(ws + WS_CSV) + (size_t)((l * 8 + b) * 128) * 128 + kv * 64;
                const bf16* zk = Z + (size_t)row0 * ZP + ZC_K + kv * 64;
                W.ks = KSrc{ck, 128, 128, zk, ZP}; W.vs = KSrc{cv, 128, 128, zk + (ZC_V - ZC_K), ZP}; W.jlo = 0; W.nk = 144; }
            W.q = Z + (size_t)row0 * ZP + ZC_Q + kv * 512; W.gate = Z + (size_t)row0 * ZP + ZC_GB + kv * 512; W.out = Y + (size_t)row0 * DM + 512 + kv * 512; W.kvh = kv;
            swa_unit(F.lds, W, BT, A.in[16] + l * 16);
        }
    }
}

__device__ __forceinline__ void final_norm_phase(Frame& F, const Args& A) {
    const bf16* XB = (const bf16*)(A.ws + WS_XB); const float* SSQ = (const float*)(A.ws + WS_SSQ); const float* g = A.in[21];
    const int tid_ = opaque_tid(), lane = tid_ & 63, wave_ = __builtin_amdgcn_readfirstlane(tid_ >> 6);
    const int gw = F.vcu * NWAVES + wave_, NGW = F.G * NWAVES;
    f32x4 gv[8];
#pragma unroll
    for (int j = 0; j < 8; ++j) gv[j] = ((const f32x4*)g)[lane + 64 * j];
    for (int m = gw; m < NROW; m += NGW) {
        float s = (lane < 32) ? SSQ[(size_t)m * 32 + lane] : 0.f;
        s = wave_sum(s);
        const float rstd = 1.0f / sqrtf(s * (1.0f / DM) + 1e-6f);
        const unsigned long long* xr = (const unsigned long long*)(XB + (size_t)m * DM) + lane;
        f32x4* o = (f32x4*)(A.out + (m < NROWP ? OFF_YP + (size_t)m * DM : OFF_YS + (size_t)(m - NROWP) * DM)) + lane;
#pragma unroll
        for (int j = 0; j < 8; ++j) { const unsigned long long w = xr[64 * j]; const unsigned lo = (unsigned)w, hi = (unsigned)(w >> 32);
            const f32x4 x = (f32x4){__builtin_bit_cast(float, lo << 16), __builtin_bit_cast(float, lo & 0xffff0000u), __builtin_bit_cast(float, hi << 16), __builtin_bit_cast(float, hi & 0xffff0000u)};
            o[64 * j] = x * rstd * gv[j]; }
    }
}

constexpr int N_PHASES = 2 + 3 * DEPTH;
#ifndef MK_SINGLE
#define MK_SINGLE 1
#endif
__global__ void __launch_bounds__(NTHREADS, 2) mk_fwd(Args args) {
    extern __shared__ __attribute__((aligned(16))) unsigned char lds[];
    Frame F;
    F.lds = (LAS unsigned char*)lds; F.glds = lds;
    F.MISC = (volatile LAS unsigned*)(F.lds + MISC_OFF);
    F.tid = threadIdx.x; F.lane = F.tid & 63; F.wave = __builtin_amdgcn_readfirstlane(F.tid >> 6);
    F.G = gridDim.x; { const int bx = blockIdx.x; F.vcu = (F.G % 8 == 0) ? (bx % 8) * (F.G / 8) + bx / 8 : bx; }
    unsigned char* ws = args.ws;
    F.ctl = (gu32*)(ws + WS_CTL);
    for (int u = F.tid; u < (LDS_BYTES - LDSCTL_OFF) / 4; u += NTHREADS) ((LAS unsigned*)(F.lds + LDSCTL_OFF))[u] = 0u;
    __syncthreads();
    XcdBarrier bar; bar.bar = (unsigned*)(F.ctl + CW_BAR); bar.x = 0; bar.st = nullptr;
    const int lo = args.ph_lo, hi = args.ph_hi;
    const bool multi = (hi - lo) > 1;
    if (multi) bar = xcd_barrier_post((unsigned*)(F.ctl + CW_BAR), F.MISC + 8);
#define SEAM(k) do { if (lo <= (k) && (k) + 1 < hi) xcd_barrier(bar); } while (0)
#define IN(k) (lo <= (k) && (k) < hi)
    if (IN(0)) { p0_prologue(F, args); SEAM(0); }
    if (IN(1)) {
        unsigned char* wsl = ws; asm volatile("" : "+s"(wsl));
        pg8::Gemm g{(const pg8::bf16_t*)(wsl + WS_MEMN), (const pg8::bf16_t*)(wsl + WS_WMEM), 512, 4096, DM};
        pg8::StaticOrder S; S.init(512, 4096, F.G, (int)(F.G - 1 - blockIdx.x));
        pg8::EpiMemKV E{(pg8::bf16_t*)(wsl + WS_MKVP), args.out};
        pg8::gemm_phase<pg8::EpiMemKV, pg8::StaticOrder, true, true>(F.lds, g, S, E);
    }
#pragma unroll 1
    for (int l = 0; l < DEPTH; ++l) {
        const int p1 = 1 + 3 * l, p2 = p1 + 1, p3 = p1 + 2;
        unsigned char* wsl = ws; int bxl = blockIdx.x; asm volatile("" : "+s"(wsl), "+s"(bxl));
        if (IN(p1)) {
            pg8::Gemm g{(const pg8::bf16_t*)(wsl + WS_XB), (const pg8::bf16_t*)(wsl + WS_WIN) + (size_t)l * INDIM * DM, MPAD, INDIM, DM};
            int vc1 = F.vcu; asm volatile("" : "+s"(vc1));
            pg8::Hybrid S; S.init(MPAD, INDIM, vc1, 2);
            pg8::EpiIn E{(pg8::bf16_t*)(wsl + WS_Z), (const float*)(wsl + WS_SSQ), args.out, l};
            pg8::SplitK<1> SK{(float*)(wsl + WS_DUMP), (unsigned*)(wsl + WS_CTL) + CW_SK + (l * 2 + 0) * 4096};
            pg8::gemm_phase<pg8::EpiIn, pg8::Hybrid, true, true, pg8::SplitK<1>>(F.lds, g, S, E, SK);
            SEAM(p1);
        }
#if USE_MFMA_ATTN
        if (IN(p2)) { mixer_phase(F, args, l); SEAM(p2); }
#else
        if (IN(p2)) { naive_mixer_phase(F, args, l); SEAM(p2); }
#endif
        if (IN(p3)) {
            pg8::Gemm g{(const pg8::bf16_t*)(wsl + WS_YMIX), (const pg8::bf16_t*)(wsl + WS_WOUT) + (size_t)l * DM * DM, MPAD, DM, DM};
            int vcl = F.vcu; asm volatile("" : "+s"(vcl));
            pg8::Hybrid S; S.init(MPAD, DM, vcl, 4);
            pg8::EpiOut E{(pg8::bf16_t*)(wsl + WS_XB), (float*)(wsl + WS_SSQ)};
            pg8::SplitK<3> SK{(float*)(wsl + WS_DUMP), (unsigned*)(wsl + WS_CTL) + CW_SK + (l * 2 + 1) * 4096};
            pg8::gemm_phase<pg8::EpiOut, pg8::Hybrid, true, true, pg8::SplitK<3>>(F.lds, g, S, E, SK);
            if (l + 1 < DEPTH && vcl >= 32) {
                const int tid_ = opaque_tid(), lane_ = tid_ & 63, wave_ = __builtin_amdgcn_readfirstlane(tid_ >> 6);
                convert_items(args, wsl, (LAS float*)(F.lds + wave_ * 17408), lane_, (vcl - 32) * NWAVES + wave_, 224 * NWAVES, l + 1, l + 2, false);
            }
            SEAM(p3);
        }
    }
    if (IN(N_PHASES - 1)) final_norm_phase(F, args);
#undef SEAM
#undef IN
}

extern "C" void kernel_launch(void* const* d_in, const int* in_sizes, int n_in, void* d_out, int out_size, void* d_ws, size_t ws_size, hipStream_t stream) {
    static int grid = 0;
    if (grid == 0) {
        if (n_in != 22 || out_size != (int)OUT_TOTAL || ws_size < WS_END) { fprintf(stderr, "kernel_launch: unexpected shapes: n_in %d out %d ws %zu\n", n_in, out_size, ws_size); grid = -1; return; }
        int dev = 0, cus = 0, per_cu = 0;
        if (hipGetDevice(&dev) != hipSuccess || hipDeviceGetAttribute(&cus, hipDeviceAttributeMultiprocessorCount, dev) != hipSuccess) { grid = -1; return; }
        if (hipFuncSetAttribute((const void*)mk_fwd, hipFuncAttributeMaxDynamicSharedMemorySize, LDS_BYTES) != hipSuccess) { fprintf(stderr, "kernel_launch: hipFuncSetAttribute failed\n"); grid = -1; return; }
        if (hipOccupancyMaxActiveBlocksPerMultiprocessor(&per_cu, (const void*)mk_fwd, NTHREADS, LDS_BYTES) != hipSuccess || per_cu < 1) { fprintf(stderr, "kernel_launch: occupancy query says %d blocks per CU\n", per_cu); (void)hipGetLastError(); grid = -1; return; }
        if (cus != 256) { fprintf(stderr, "kernel_launch: built for a 256-CU device, found %d CUs\n", cus); grid = -1; return; }
        grid = cus;
    }
    if (grid < 0) return;
    (void)hipMemsetAsync((char*)d_ws + WS_CTL, 0, CTL_ZERO_BYTES, stream);
    Args a{};
    for (int i = 0; i < 22; ++i) a.in[i] = (const float*)d_in[i];
    a.out = (float*)d_out; a.ws = (unsigned char*)d_ws;
#if MK_SINGLE
    a.mix_mask = 7;
#ifdef PROBE_PREFIX
#ifdef PROBE_MASK
    a.mix_mask = PROBE_MASK;
#endif
#ifdef PROBE_FLAGS
    a.pflags = PROBE_FLAGS;
#endif
    a.ph_lo = 0; a.ph_hi = PROBE_PREFIX;
    hipLaunchKernelGGL(mk_fwd, dim3(grid), dim3(NTHREADS), LDS_BYTES, stream, a);
    (void)hipMemsetAsync((char*)d_ws + WS_CTL, 0, CTL_ZERO_BYTES, stream);
    a.mix_mask = 7; a.pflags = 0;
#endif
    a.ph_lo = 0; a.ph_hi = N_PHASES;
    hipLaunchKernelGGL(mk_fwd, dim3(grid), dim3(NTHREADS), LDS_BYTES, stream, a);
#else
    for (int p = 0; p < N_PHASES; ++p) { a.ph_lo = p; a.ph_hi = p + 1; hipLaunchKernelGGL(mk_fwd, dim3(grid), dim3(NTHREADS), LDS_BYTES, stream, a); }
#endif
}
```
